# Optimizing an MI355X kernel written in HIP

```python
import math
import jax
import jax.numpy as jnp
from jax import lax
import numpy as np

D_MODEL = 1024
BATCH = 4
SEQ = 4096
DEPTH = 2

CTX_LEN = 256
GRID_W = 64
HEAD_DIM = 64
N_GROUPS = 4
GROUP_HEADS = D_MODEL // (N_GROUPS * HEAD_DIM)
GW = GROUP_HEADS * HEAD_DIM
D_MIX = N_GROUPS * GW
DIFF_HALF = HEAD_DIM // 2
Q_BLOCK = 128
ROPE_BASE = 10000.0
DECAY_LORA = 64
ICLR_LORA = 64
GATE_LORA = 128
RWKV_GN_EPS = 64e-5
RWKV_COLS = 3 * GW + 2 * DECAY_LORA + 2 * ICLR_LORA + GATE_LORA
GDN_CONV = 3
GDN_CHUNK = 64
GDN_COLS = 4 * GW + 4 * GROUP_HEADS
WIN_H = 8
WIN_W = 16
ATTN_COLS = 3 * GW
IN_COLS = ATTN_COLS + RWKV_COLS + GDN_COLS + ATTN_COLS
PEER_HEADS = 8
PEER_KEYS = 128
PEER_EXPERTS = PEER_KEYS * PEER_KEYS
PEER_QDIM = 256
PEER_HALF = PEER_QDIM // 2
PEER_TOPK = 16
PEER_BLOCK = 128
DN_ALPHA = (2 * DEPTH) ** 0.25
DN_BETA = (8 * DEPTH) ** -0.25
LN_EPS = 1e-5

kernel_name = 'hybrid_diffusion_parallel_groups_peer'

F32 = jnp.float32


def _split(x, sizes):
    offs = np.cumsum(sizes)[:-1].tolist()
    return jnp.split(x, offs, axis=-1)


def _heads(x):
    return x.reshape(x.shape[0], x.shape[1], -1, HEAD_DIM)


def _layer_norm(x):
    xf = x.astype(F32)
    mu = xf.mean(-1, keepdims=True)
    var = jnp.square(xf - mu).mean(-1, keepdims=True)
    return (xf - mu) * lax.rsqrt(var + LN_EPS)


def _rms_norm(x, g):
    xf = x.astype(F32)
    return xf * lax.rsqrt(jnp.mean(xf * xf, -1, keepdims=True) + 1e-6) * g.astype(F32)


def _l2norm(x):
    xf = x.astype(F32)
    return xf * lax.rsqrt(jnp.sum(xf * xf, -1, keepdims=True) + 1e-6)


def _modulate(h, shift, scale, dtype):
    return (_layer_norm(h) * (1.0 + scale) + shift).astype(dtype)


def _post_norm(h, gate, y, g, b, dtype):
    z = DN_ALPHA * h.astype(F32) + gate.astype(F32) * y.astype(F32)
    return (_layer_norm(z) * g + b).astype(dtype)


def _dwconv_centred(x, w):
    k = w.shape[0]
    pad = k // 2
    t = x.shape[1]
    xp = jnp.pad(x, ((0, 0), (pad, pad), (0, 0)))
    out = xp[:, 0:t] * w[0]
    for i in range(1, k):
        out = out + xp[:, i:i + t] * w[i]
    return out


def _grid_pos(n_tok):
    t = jnp.arange(n_tok, dtype=jnp.int32)
    return t // GRID_W, t % GRID_W


def _rope_1d(x, pos):
    half = x.shape[-1] // 2
    inv = ROPE_BASE ** (-jnp.arange(half, dtype=F32) / half)
    ang = pos.astype(F32)[:, None] * inv
    cos = jnp.cos(ang)[:, None, :]
    sin = jnp.sin(ang)[:, None, :]
    x1 = x[..., :half].astype(F32)
    x2 = x[..., half:].astype(F32)
    return jnp.concatenate([x1 * cos - x2 * sin, x1 * sin + x2 * cos], -1)


def _rope_2d(x, row, col):
    n = x.shape[-1] // 2
    return jnp.concatenate([_rope_1d(x[..., :n], row), _rope_1d(x[..., n:], col)], -1)


def _diff_core(q, k, v, lam):
    scale = DIFF_HALF ** -0.5
    q = q.astype(F32)
    k = k.astype(F32)
    s1 = jnp.einsum('bqhd,bkhd->bhqk', q[..., :DIFF_HALF], k[..., :DIFF_HALF]) * scale
    s2 = jnp.einsum('bqhd,bkhd->bhqk', q[..., DIFF_HALF:], k[..., DIFF_HALF:]) * scale
    p = jax.nn.softmax(s1, -1) - lam * jax.nn.softmax(s2, -1)
    return jnp.einsum('bhqk,bkhd->bqhd', p, v.astype(F32))


def _diff_attention(q, k, v, qc, kc, vc, lam_vecs, norm_g, lam_init, ctx_out):
    bsz, lat_len = q.shape[:2]
    row, col = _grid_pos(lat_len)
    rot = lambda z: jnp.concatenate([_rope_2d(z[..., :DIFF_HALF], row, col),
                                     _rope_2d(z[..., DIFF_HALF:], row, col)], -1)
    q = rot(q)
    k = rot(k)
    lv = lam_vecs.astype(F32)
    lam = jnp.exp(jnp.sum(lv[0] * lv[1])) - jnp.exp(jnp.sum(lv[2] * lv[3])) + lam_init
    k_all = jnp.concatenate([k, kc.astype(F32)], 1)
    v_all = jnp.concatenate([v.astype(F32), vc.astype(F32)], 1)
    nb = lat_len // Q_BLOCK
    qb = jnp.moveaxis(q.reshape(bsz, nb, Q_BLOCK, GROUP_HEADS, HEAD_DIM), 1, 0)
    ob = lax.map(lambda qq: _diff_core(qq, k_all, v_all, lam), qb)
    o = jnp.moveaxis(ob, 0, 1).reshape(bsz, lat_len, GROUP_HEADS, HEAD_DIM)
    post = lambda z: (_rms_norm(z, norm_g) * (1.0 - lam_init)).reshape(z.shape[0], z.shape[1], GW)
    out_ctx = post(_diff_core(qc, kc, vc, lam)) if ctx_out else None
    return post(o), out_ctx


def _wkv7_scan(r, w, k, v, kk, a, s0, reverse):
    def step(s, inp):
        r_t, w_t, k_t, v_t, kk_t, a_t = inp
        sa = jnp.einsum('bhvk,bhk->bhv', s, kk_t)
        s = (s * w_t[:, :, None, :] - sa[..., None] * (kk_t * a_t)[:, :, None, :]
             + v_t[..., None] * k_t[:, :, None, :])
        return s, jnp.einsum('bhvk,bhk->bhv', s, r_t)
    xs = tuple(jnp.moveaxis(z, 1, 0) for z in (r, w, k, v, kk, a))
    s, y = lax.scan(step, s0, xs, reverse=reverse)
    return jnp.moveaxis(y, 0, 1), s


def _rwkv7(f_lat, f_ctx, mu, w0, w2, a0, a2, g2, k_k, k_a, r_k, ln_g, ln_b, ctx_out):
    shift_w = jnp.stack([mu[0], 1.0 - mu[0] - mu[1], mu[1]])

    def prep(f):
        f = _dwconv_centred(f, shift_w).astype(F32)
        r, k, v, wd, ad, gd = _split(f, [GW, GW, GW, 2 * DECAY_LORA, 2 * ICLR_LORA, GATE_LORA])
        bsz, t = f.shape[:2]
        wd = jnp.tanh(wd.reshape(bsz, t, 2, DECAY_LORA))
        ad = ad.reshape(bsz, t, 2, ICLR_LORA)
        w_raw = w0 + jnp.einsum('btdr,drc->btdc', wd, w2)
        decay = jnp.exp(-jnp.exp(-jax.nn.softplus(-w_raw) - 0.5))
        a = jax.nn.sigmoid(a0 + jnp.einsum('btdr,drc->btdc', ad, a2))
        g = jax.nn.sigmoid(gd) @ g2
        kk = _l2norm(_heads(k * k_k))
        kd = k[:, :, None] * (1.0 + (a - 1.0) * k_a)
        return r, v, g, kk, decay, a, kd

    def run(p, d, s0, rev):
        r, v, g, kk, decay, a, kd = p
        return _wkv7_scan(_heads(r), _heads(decay[:, :, d]), _heads(kd[:, :, d]), _heads(v),
                          kk, _heads(a[:, :, d]), s0, rev)

    def post(p, ys):
        r, v, g, kk, decay, a, kd = p
        bsz, t = r.shape[:2]
        y = ys[0] + ys[1]
        m = y.mean(-1, keepdims=True)
        var = jnp.square(y - m).mean(-1, keepdims=True)
        yn = ((y - m) * lax.rsqrt(var + RWKV_GN_EPS)).reshape(bsz, t, GW) * ln_g + ln_b
        rh, vh = _heads(r), _heads(v)
        bonus = ((rh * _heads(kd[:, :, 0]) * r_k).sum(-1, keepdims=True) * vh
                 + (rh * _heads(kd[:, :, 1]) * r_k).sum(-1, keepdims=True) * vh)
        return (yn + bonus.reshape(bsz, t, GW)) * g

    pl, pc = prep(f_lat), prep(f_ctx)
    s0 = jnp.zeros((f_lat.shape[0], GROUP_HEADS, HEAD_DIM, HEAD_DIM), F32)
    y_lat, y_ctx = [], []
    for d, rev in ((0, False), (1, True)):
        yc, sc = run(pc, d, s0, rev)
        yl, _ = run(pl, d, sc, rev)
        y_lat.append(yl)
        y_ctx.append(yc)
    out_ctx = post(pc, y_ctx) if ctx_out else None
    return post(pl, y_lat), out_ctx


def _gdn_chunked(q, k, v, beta, g, s0):
    bsz, t, h, dk = q.shape
    dv = v.shape[-1]
    n = t // GDN_CHUNK
    ch = lambda z: jnp.moveaxis(z.reshape(bsz, n, GDN_CHUNK, h, *z.shape[3:]), 3, 2)
    q, k, v, beta, g = ch(q), ch(k), ch(v), ch(beta), ch(g)
    gc = jnp.cumsum(g, axis=-1)
    i = jnp.arange(GDN_CHUNK)
    incl = i[:, None] >= i[None, :]
    strict = i[:, None] > i[None, :]
    decay = jnp.exp(jnp.where(incl, gc[..., :, None] - gc[..., None, :], -jnp.inf))
    kb = k * beta[..., None]
    a_low = jnp.where(strict, jnp.einsum('bnhid,bnhjd->bnhij', kb, k) * decay, 0.0)
    tmat = a_low + jnp.eye(GDN_CHUNK, dtype=F32)
    rhs = jnp.concatenate([v * beta[..., None], kb * jnp.exp(gc)[..., None]], -1)
    sol = lax.linalg.triangular_solve(tmat, rhs, left_side=True, lower=True, unit_diagonal=True)
    u, w = sol[..., :dv], sol[..., dv:]
    qk = jnp.where(incl, jnp.einsum('bnhid,bnhjd->bnhij', q, k) * decay, 0.0)
    qg = q * jnp.exp(gc)[..., None]
    kg = k * jnp.exp(gc[..., -1:] - gc)[..., None]
    glast = jnp.exp(gc[..., -1])

    def step(s, xs):
        qg_i, kg_i, u_i, w_i, qk_i, gl_i = xs
        v_new = u_i - jnp.einsum('bhcd,bhdv->bhcv', w_i, s)
        o = jnp.einsum('bhcd,bhdv->bhcv', qg_i, s) + jnp.einsum('bhij,bhjv->bhiv', qk_i, v_new)
        s = s * gl_i[..., None, None] + jnp.einsum('bhcd,bhcv->bhdv', kg_i, v_new)
        return s, o

    xs = tuple(jnp.moveaxis(z, 1, 0) for z in (qg, kg, u, w, qk, glast))
    s, o = lax.scan(step, s0, xs)
    o = jnp.moveaxis(jnp.moveaxis(o, 0, 1), 2, 3).reshape(bsz, t, h, dv)
    return o, s


def _gated_deltanet(f_lat, f_ctx, conv_w, a_log, dt_bias, norm_g, ctx_out):
    def prep(f):
        qkv, gate, ab = _split(f, [3 * GW, GW, 4 * GROUP_HEADS])
        qkv = jax.nn.silu(_dwconv_centred(qkv, conv_w).astype(F32))
        q, k, v = [_heads(z) for z in _split(qkv, [GW, GW, GW])]
        q = _l2norm(q) * HEAD_DIM ** -0.5
        k = _l2norm(k)
        ab = ab.astype(F32).reshape(f.shape[0], f.shape[1], 2, 2, GROUP_HEADS)
        log_alpha = -jnp.exp(a_log) * jax.nn.softplus(ab[:, :, 0] + dt_bias)
        beta = jax.nn.sigmoid(ab[:, :, 1])
        return q, k, v, gate, log_alpha, beta

    def run(p, d, s0):
        tr = (lambda z: jnp.flip(z, 1)) if d == 1 else (lambda z: z)
        q, k, v, gate, log_alpha, beta = p
        o, s = _gdn_chunked(tr(q), tr(k), tr(v), tr(beta[:, :, d]), tr(log_alpha[:, :, d]), s0)
        return tr(o), s

    def post(p, os_):
        gate = p[3]
        o = os_[0] + os_[1]
        y = _rms_norm(o, norm_g) * jax.nn.silu(_heads(gate.astype(F32)))
        return y.reshape(o.shape[0], o.shape[1], GW)

    pl, pc = prep(f_lat), prep(f_ctx)
    s0 = jnp.zeros((f_lat.shape[0], GROUP_HEADS, HEAD_DIM, HEAD_DIM), F32)
    o_lat, o_ctx = [], []
    for d in range(2):
        oc, sc = run(pc, d, s0)
        ol, _ = run(pl, d, sc)
        o_lat.append(ol)
        o_ctx.append(oc)
    out_ctx = post(pc, o_ctx) if ctx_out else None
    return post(pl, o_lat), out_ctx


def _softmax_attn(q, k, v):
    s = jnp.einsum('bqhd,bkhd->bhqk', q.astype(F32), k.astype(F32)) * HEAD_DIM ** -0.5
    return jnp.einsum('bhqk,bkhd->bqhd', jax.nn.softmax(s, -1), v.astype(F32))


def _neighbourhood_attention(q, k, v, qc, kc, vc, rpb, ctx_out):
    bsz, lat_len = q.shape[:2]
    rows = lat_len // GRID_W
    kh = min(WIN_H, rows)
    scale = HEAD_DIM ** -0.5
    grid = lambda z: z.astype(F32).reshape(bsz, rows, GRID_W, GROUP_HEADS, HEAD_DIM)
    qg, kg, vg = grid(q), grid(k), grid(v)
    kc32, vc32 = kc.astype(F32), vc.astype(F32)
    rpb = rpb.astype(F32)
    cq = jnp.arange(GRID_W)
    c_start = jnp.clip(cq - WIN_W // 2, 0, GRID_W - WIN_W)
    col_ok = (cq[None, :] >= c_start[:, None]) & (cq[None, :] < c_start[:, None] + WIN_W)
    d_col = jnp.clip(cq[None, :] - cq[:, None], -(WIN_W - 1), WIN_W - 1) + (WIN_W - 1)

    def row_block(r):
        rs = jnp.clip(r - kh // 2, 0, rows - kh)
        q_r = lax.dynamic_index_in_dim(qg, r, axis=1, keepdims=False)
        k_r = lax.dynamic_slice_in_dim(kg, rs, kh, axis=1)
        v_r = lax.dynamic_slice_in_dim(vg, rs, kh, axis=1)
        s = jnp.einsum('bqhd,bkwhd->bqhkw', q_r, k_r) * scale
        d_row = rs + jnp.arange(kh) - r + (WIN_H - 1)
        bias = rpb[:, d_row[None, :, None], d_col[:, None, :]]
        s = jnp.where(col_ok[:, None, None, :], s + jnp.transpose(bias, (1, 0, 2, 3)), -jnp.inf)
        s_c = jnp.einsum('bqhd,bchd->bqhc', q_r, kc32) * scale
        p = jax.nn.softmax(jnp.concatenate(
            [s.reshape(bsz, GRID_W, GROUP_HEADS, kh * GRID_W), s_c], -1), -1)
        p_win = p[..., :kh * GRID_W].reshape(bsz, GRID_W, GROUP_HEADS, kh, GRID_W)
        return (jnp.einsum('bqhkw,bkwhd->bqhd', p_win, v_r)
                + jnp.einsum('bqhc,bchd->bqhd', p[..., kh * GRID_W:], vc32))

    o = lax.map(row_block, jnp.arange(rows))
    out_lat = jnp.moveaxis(o, 0, 1).reshape(bsz, lat_len, GW)
    out_ctx = _softmax_attn(qc, kc, vc).reshape(bsz, qc.shape[1], GW) if ctx_out else None
    return out_lat, out_ctx


def _peer(h, w_q, keys, u_tab, v_tab):
    bsz, t, d = h.shape
    blocks = h.reshape(bsz * t // PEER_BLOCK, PEER_BLOCK, d)
    keys = keys.astype(F32)

    def block(tb):
        q = (tb @ w_q).astype(F32).reshape(PEER_BLOCK, PEER_HEADS, 2, PEER_HALF)
        s = jnp.einsum('thpd,hpnd->thpn', q, keys)
        top_s, top_i = lax.top_k(s, PEER_TOPK)
        cand_s = (top_s[:, :, 0, :, None] + top_s[:, :, 1, None, :]).reshape(
            PEER_BLOCK, PEER_HEADS, PEER_TOPK * PEER_TOPK)
        cand_i = (top_i[:, :, 0, :, None] * PEER_KEYS + top_i[:, :, 1, None, :]).reshape(
            PEER_BLOCK, PEER_HEADS, PEER_TOPK * PEER_TOPK)
        best_s, pos = lax.top_k(cand_s, PEER_TOPK)
        idx = jnp.take_along_axis(cand_i, pos, axis=-1)
        gate = jax.nn.softmax(best_s, -1)
        u = jnp.take(u_tab, idx, axis=0).astype(F32)
        act = jax.nn.gelu(jnp.einsum('td,thkd->thk', tb.astype(F32), u), approximate=False)
        v = jnp.take(v_tab, idx, axis=0).astype(F32)
        return jnp.einsum('thk,thkd->td', gate * act, v)

    return lax.map(block, blocks).reshape(bsz, t, d)


def _qkv_heads(p):
    return [_heads(z) for z in _split(p, [GW, GW, GW])]


def setup_inputs(seed: int = 0) -> dict:
    key = jax.random.key(seed)
    ks = iter(jax.random.split(key, 48))
    nrm = lambda shape, std: jax.random.normal(next(ks), shape, F32) * std
    uni = lambda shape, lo, hi: jax.random.uniform(next(ks), shape, F32, lo, hi)
    L, D = DEPTH, D_MODEL
    return {
        'x': nrm((BATCH, SEQ, D), 1.0),
        'c': nrm((BATCH, D), 1.0),
        'ctx': nrm((BATCH, CTX_LEN, D), 1.0),
        'c_ctx': nrm((D,), 1.0),
        'w_ada': nrm((L, D, 6 * D), 0.5 * D ** -0.5),
        'b_ada': nrm((L, 6 * D), 0.02),
        'w_in': nrm((L, D, IN_COLS), D ** -0.5),
        'w_out': nrm((L, D_MIX, D), DN_BETA * D_MIX ** -0.5),
        'ln_mix_g': 1.0 + nrm((L, D), 0.02),
        'ln_mix_b': nrm((L, D), 0.02),
        'ln_ffn_g': 1.0 + nrm((L, D), 0.02),
        'ln_ffn_b': nrm((L, D), 0.02),
        'diff_lam': nrm((L, 4, DIFF_HALF), 0.1),
        'diff_norm_g': 1.0 + nrm((L, HEAD_DIM), 0.02),
        'rwkv_mu': uni((L, 2, RWKV_COLS), 0.0, 0.5),
        'rwkv_w0': uni((L, 2, GW), -6.0, 0.0),
        'rwkv_w2': nrm((L, 2, DECAY_LORA, GW), 0.1),
        'rwkv_a0': nrm((L, 2, GW), 0.3),
        'rwkv_a2': nrm((L, 2, ICLR_LORA, GW), 0.5 * ICLR_LORA ** -0.5),
        'rwkv_g2': nrm((L, GATE_LORA, GW), GATE_LORA ** -0.5),
        'rwkv_kk': 0.85 + nrm((L, GW), 0.05),
        'rwkv_ka': 1.0 + nrm((L, GW), 0.05),
        'rwkv_rk': nrm((L, GROUP_HEADS, HEAD_DIM), 0.1),
        'rwkv_ln_g': 1.0 + nrm((L, GW), 0.02),
        'rwkv_ln_b': nrm((L, GW), 0.02),
        'gdn_conv': nrm((L, GDN_CONV, 3 * GW), GDN_CONV ** -0.5),
        'gdn_a_log': jnp.log(uni((L, 2, GROUP_HEADS), 1.0, 16.0)),
        'gdn_dt_bias': uni((L, 2, GROUP_HEADS), -5.0, -2.0),
        'gdn_norm_g': 1.0 + nrm((L, HEAD_DIM), 0.02),
        'nat_rpb': nrm((L, GROUP_HEADS, 2 * WIN_H - 1, 2 * WIN_W - 1), 0.2),
        'peer_wq': nrm((L, D, PEER_HEADS * PEER_QDIM), D ** -0.5),
        'peer_keys': nrm((L, PEER_HEADS, 2, PEER_KEYS, PEER_HALF), PEER_HALF ** -0.5),
        'peer_u': nrm((L, PEER_EXPERTS, D), D ** -0.5),
        'peer_v': nrm((L, PEER_EXPERTS, D), DN_BETA),
    }


def reference(x, c, ctx, c_ctx, w_ada, b_ada, w_in, w_out, ln_mix_g, ln_mix_b, ln_ffn_g, ln_ffn_b,
              diff_lam, diff_norm_g, rwkv_mu, rwkv_w0, rwkv_w2, rwkv_a0, rwkv_a2, rwkv_g2,
              rwkv_kk, rwkv_ka, rwkv_rk, rwkv_ln_g, rwkv_ln_b, gdn_conv, gdn_a_log, gdn_dt_bias,
              gdn_norm_g, nat_rpb, peer_wq, peer_keys, peer_u, peer_v):
    dtype = x.dtype
    h_lat, h_ctx = x, ctx
    col_sizes = [ATTN_COLS, RWKV_COLS, GDN_COLS, ATTN_COLS]
    for l in range(DEPTH):
        last = l == DEPTH - 1
        lam_init = 0.8 - 0.6 * math.exp(-0.3 * l)
        m_lat = jnp.split((jax.nn.silu(c) @ w_ada[l] + b_ada[l])[:, None, :], 6, axis=-1)
        m_ctx = jnp.split((jax.nn.silu(c_ctx) @ w_ada[l] + b_ada[l])[None, None, :], 6, axis=-1)
        u_lat = _modulate(h_lat, m_lat[0], m_lat[1], dtype)
        u_ctx = _modulate(h_ctx, m_ctx[0], m_ctx[1], dtype)
        pa, pb, pc, pd = _split(u_lat @ w_in[l], col_sizes)
        ca, cb, cc, cd = _split(u_ctx @ w_in[l], col_sizes)
        qa, ka, va = _qkv_heads(pa)
        qca, kca, vca = _qkv_heads(ca)
        ya, yca = _diff_attention(qa, ka, va, qca, kca, vca, diff_lam[l], diff_norm_g[l],
                                  lam_init, not last)
        yb, ycb = _rwkv7(pb, cb, rwkv_mu[l], rwkv_w0[l], rwkv_w2[l], rwkv_a0[l], rwkv_a2[l],
                         rwkv_g2[l], rwkv_kk[l], rwkv_ka[l], rwkv_rk[l], rwkv_ln_g[l],
                         rwkv_ln_b[l], not last)
        yc, ycc = _gated_deltanet(pc, cc, gdn_conv[l], gdn_a_log[l], gdn_dt_bias[l],
                                  gdn_norm_g[l], not last)
        qd, kd, vd = _qkv_heads(pd)
        qcd, kcd, vcd = _qkv_heads(cd)
        yd, ycd = _neighbourhood_attention(qd, kd, vd, qcd, kcd, vcd, nat_rpb[l], not last)
        mix = jnp.concatenate([ya, yb, yc, yd], -1).astype(dtype) @ w_out[l]
        h_lat = _post_norm(h_lat, m_lat[2], mix, ln_mix_g[l], ln_mix_b[l], dtype)
        ffn = _peer(_modulate(h_lat, m_lat[3], m_lat[4], dtype), peer_wq[l], peer_keys[l],
                    peer_u[l], peer_v[l])
        h_lat = _post_norm(h_lat, m_lat[5], ffn, ln_ffn_g[l], ln_ffn_b[l], dtype)
        if not last:
            mix_c = jnp.concatenate([yca, ycb, ycc, ycd], -1).astype(dtype) @ w_out[l]
            h_ctx = _post_norm(h_ctx, m_ctx[2], mix_c, ln_mix_g[l], ln_mix_b[l], dtype)
            ffn_c = _peer(_modulate(h_ctx, m_ctx[3], m_ctx[4], dtype), peer_wq[l], peer_keys[l],
                          peer_u[l], peer_v[l])
            h_ctx = _post_norm(h_ctx, m_ctx[5], ffn_c, ln_ffn_g[l], ln_ffn_b[l], dtype)
    return h_lat
```

```cpp
#ifndef CPU_EMU
#include <hip/hip_runtime.h>
#include <hip/hip_cooperative_groups.h>
namespace cg = cooperative_groups;
#define DEVFN __device__ __forceinline__
#else
#include <cmath>
#include <cstdio>
#include <cstdlib>
#include <cstring>
#define DEVFN static inline
struct float4 { float x, y, z, w; };
static inline float4 make_float4(float a, float b, float c, float d) { float4 r{a, b, c, d}; return r; }
#endif

#ifndef MEGA
#define MEGA 1
#endif
#ifndef K_B
#define K_B 4
#define K_T 4096
#define K_C 256
#endif

constexpr int NB = K_B, NTL = K_T, NCX = K_C;
constexpr int DM = 1024;
constexpr int NLAT = NB * NTL, NCTX = NB * NCX, NTOK = NLAT + NCTX;
constexpr int GROWS = NTL / 64;
constexpr int INC = 3728;
constexpr int OFF_A = 0, OFF_B = 768, OFF_C = 1920, OFF_D = 2960;
constexpr int RWS = 2560;
constexpr int NMODV = NB + 1;
constexpr float DN_ALPHA = 1.4142135623730951f;
constexpr float LN_EPS = 1e-5f;

struct Params {
  const float *x, *c, *ctx, *c_ctx, *w_ada, *b_ada, *w_in, *w_out, *ln_mix_g, *ln_mix_b, *ln_ffn_g, *ln_ffn_b;
  const float *diff_lam, *diff_norm_g, *rwkv_mu, *rwkv_w0, *rwkv_w2, *rwkv_a0, *rwkv_a2, *rwkv_g2;
  const float *rwkv_kk, *rwkv_ka, *rwkv_rk, *rwkv_ln_g, *rwkv_ln_b, *gdn_conv, *gdn_a_log, *gdn_dt_bias;
  const float *gdn_norm_g, *nat_rpb, *peer_wq, *peer_keys, *peer_u, *peer_v;
  float *out;
  float *mod, *hctx, *Y, *P, *RW;
};

DEVFN float sigmoidf_(float x) { return 1.0f / (1.0f + expf(-x)); }
DEVFN float siluf_(float x) { return x / (1.0f + expf(-x)); }
DEVFN float softplusf_(float x) { return x > 20.f ? x : log1pf(expf(x)); }
DEVFN float geluf_(float x) { return 0.5f * x * (1.0f + erff(x * 0.70710678118654752f)); }

DEVFN int modv_of_row(int row) { return row < NLAT ? row / NTL : NB; }
DEVFN const float* hsrc_row(const Params& p, int l, int row) {
  if (row < NLAT) return (l == 0 ? p.x : p.out) + (size_t)row * DM;
  return (l == 0 ? p.ctx : p.hctx) + (size_t)(row - NLAT) * DM;
}
DEVFN float* hdst_row(const Params& p, int row) {
  if (row < NLAT) return p.out + (size_t)row * DM;
  return p.hctx + (size_t)(row - NLAT) * DM;
}
DEVFN void seq_pos(int row, int& t, int& len) {
  if (row < NLAT) { t = row % NTL; len = NTL; } else { t = (row - NLAT) % NCX; len = NCX; }
}

DEVFN void ph_ada(const Params& p, long item) {
  int l = (int)(item / 6144), j = (int)(item % 6144);
  float acc[NMODV];
#pragma unroll
  for (int v = 0; v < NMODV; ++v) acc[v] = 0.f;
  for (int i = 0; i < DM; ++i) {
    float w = p.w_ada[((size_t)l * DM + i) * 6144 + j];
#pragma unroll
    for (int v = 0; v < NB; ++v) acc[v] += siluf_(p.c[v * DM + i]) * w;
    acc[NB] += siluf_(p.c_ctx[i]) * w;
  }
  float bb = p.b_ada[l * 6144 + j];
#pragma unroll
  for (int v = 0; v < NMODV; ++v) p.mod[((size_t)l * NMODV + v) * 6144 + j] = acc[v] + bb;
}

DEVFN void row_stats(const float* r, float& mu, float& rstd) {
  float s = 0.f;
  for (int i = 0; i < DM; ++i) s += r[i];
  mu = s * (1.0f / DM);
  float v = 0.f;
  for (int i = 0; i < DM; ++i) { float d = r[i] - mu; v += d * d; }
  rstd = 1.0f / sqrtf(v * (1.0f / DM) + LN_EPS);
}

DEVFN void ph_ln1(const Params& p, int l, long item) {
  int row = (int)item;
  const float* src = hsrc_row(p, l, row);
  const float* m = p.mod + ((size_t)l * NMODV + modv_of_row(row)) * 6144;
  float mu, rstd;
  row_stats(src, mu, rstd);
  float* dst = p.Y + (size_t)row * DM;
  for (int i = 0; i < DM; ++i) dst[i] = (src[i] - mu) * rstd * (1.0f + m[1024 + i]) + m[i];
}

DEVFN void gemm_item(const float* A, int lda, const float* Bw, int ldb, float* C, int ldc, int N, int K, long item) {
  int ntn = N / 4;
  int mt = (int)(item / ntn), nt = (int)(item % ntn);
  int r0 = mt * 4, c0 = nt * 4;
  float acc[4][4];
#pragma unroll
  for (int i = 0; i < 4; ++i)
#pragma unroll
    for (int j = 0; j < 4; ++j) acc[i][j] = 0.f;
  for (int k = 0; k < K; k += 4) {
    float4 a[4], b[4];
#pragma unroll
    for (int i = 0; i < 4; ++i) a[i] = *(const float4*)(A + (size_t)(r0 + i) * lda + k);
#pragma unroll
    for (int kk = 0; kk < 4; ++kk) b[kk] = *(const float4*)(Bw + (size_t)(k + kk) * ldb + c0);
#pragma unroll
    for (int i = 0; i < 4; ++i) {
      float av[4] = {a[i].x, a[i].y, a[i].z, a[i].w};
#pragma unroll
      for (int kk = 0; kk < 4; ++kk) {
        acc[i][0] += av[kk] * b[kk].x;
        acc[i][1] += av[kk] * b[kk].y;
        acc[i][2] += av[kk] * b[kk].z;
        acc[i][3] += av[kk] * b[kk].w;
      }
    }
  }
#pragma unroll
  for (int i = 0; i < 4; ++i)
    *(float4*)(C + (size_t)(r0 + i) * ldc + c0) = make_float4(acc[i][0], acc[i][1], acc[i][2], acc[i][3]);
}

DEVFN void ph_rope(const Params& p, long item) {
  int token = (int)(item / 256), j = (int)(item % 256);
  int which = j / 128, jj = j % 128, h = jj / 32, pr = jj % 32, blk = pr / 8, i = pr % 8;
  int t = token % NTL;
  int pos = (blk & 1) ? (t % 64) : (t / 64);
  float inv = expf(-(float)i * (9.210340371976184f / 8.0f));
  float ang = (float)pos * inv;
  float cs = cosf(ang), sn = sinf(ang);
  float* base = p.P + (size_t)token * INC + OFF_A + which * 256 + h * 64 + blk * 16;
  float x1 = base[i], x2 = base[i + 8];
  base[i] = x1 * cs - x2 * sn;
  base[i + 8] = x1 * sn + x2 * cs;
}

DEVFN float dot32(const float* q, const float* k) {
  float s = 0.f;
#pragma unroll
  for (int d = 0; d < 32; d += 4) {
    float4 kv = *(const float4*)(k + d);
    s += q[d] * kv.x + q[d + 1] * kv.y + q[d + 2] * kv.z + q[d + 3] * kv.w;
  }
  return s;
}

DEVFN void mixA_item(const Params& p, int l, int b, int h, int qrow, bool lat) {
  const float* lv = p.diff_lam + l * 128;
  float d01 = 0.f, d23 = 0.f;
  for (int i = 0; i < 32; ++i) { d01 += lv[i] * lv[32 + i]; d23 += lv[64 + i] * lv[96 + i]; }
  float lam_init = 0.8f - 0.6f * expf(-0.3f * (float)l);
  float lam = expf(d01) - expf(d23) + lam_init;
  const float scale = 0.17677669529663687f;
  float q[64];
  const float* qp = p.P + (size_t)qrow * INC + OFF_A + h * 64;
#pragma unroll
  for (int d = 0; d < 64; ++d) q[d] = qp[d] * scale;
  int nlat = lat ? NTL : 0;
  int nk = nlat + NCX;
  float m1 = -1e30f, l1 = 0.f, m2 = -1e30f, l2 = 0.f;
  for (int j = 0; j < nk; ++j) {
    int krow = j < nlat ? b * NTL + j : NLAT + b * NCX + (j - nlat);
    const float* kp = p.P + (size_t)krow * INC + OFF_A + 256 + h * 64;
    float s1 = dot32(q, kp), s2 = dot32(q + 32, kp + 32);
    float n1 = fmaxf(m1, s1); l1 = l1 * expf(m1 - n1) + expf(s1 - n1); m1 = n1;
    float n2 = fmaxf(m2, s2); l2 = l2 * expf(m2 - n2) + expf(s2 - n2); m2 = n2;
  }
  float i1 = 1.0f / l1, i2 = lam / l2;
  float o[64];
#pragma unroll
  for (int d = 0; d < 64; ++d) o[d] = 0.f;
  for (int j = 0; j < nk; ++j) {
    int krow = j < nlat ? b * NTL + j : NLAT + b * NCX + (j - nlat);
    const float* kp = p.P + (size_t)krow * INC + OFF_A + 256 + h * 64;
    float s1 = dot32(q, kp), s2 = dot32(q + 32, kp + 32);
    float pw = expf(s1 - m1) * i1 - expf(s2 - m2) * i2;
    const float* vp = kp + 256;
#pragma unroll
    for (int d = 0; d < 64; d += 4) {
      float4 vv = *(const float4*)(vp + d);
      o[d] += pw * vv.x; o[d + 1] += pw * vv.y; o[d + 2] += pw * vv.z; o[d + 3] += pw * vv.w;
    }
  }
  float ss = 0.f;
#pragma unroll
  for (int d = 0; d < 64; ++d) ss += o[d] * o[d];
  float rs = (1.0f / sqrtf(ss * (1.0f / 64) + 1e-6f)) * (1.0f - lam_init);
  const float* g = p.diff_norm_g + l * 64;
  float* yp = p.Y + (size_t)qrow * DM + 0 + h * 64;
#pragma unroll
  for (int d = 0; d < 64; ++d) yp[d] = o[d] * rs * g[d];
}

DEVFN float dot64s(const float* q, const float* k) {
  float s = 0.f;
#pragma unroll
  for (int d = 0; d < 64; d += 4) {
    float4 kv = *(const float4*)(k + d);
    s += q[d] * kv.x + q[d + 1] * kv.y + q[d + 2] * kv.z + q[d + 3] * kv.w;
  }
  return s;
}

DEVFN void mixD_item(const Params& p, int l, int b, int h, int qrow, bool lat, int t) {
  float q[64];
  const float* qp = p.P + (size_t)qrow * INC + OFF_D + h * 64;
#pragma unroll
  for (int d = 0; d < 64; ++d) q[d] = qp[d] * 0.125f;
  int r = t / 64, cq = t % 64;
  int rs = r - 4; rs = rs < 0 ? 0 : (rs > GROWS - 8 ? GROWS - 8 : rs);
  int cs = cq - 8; cs = cs < 0 ? 0 : (cs > 48 ? 48 : cs);
  const float* rpb = p.nat_rpb + ((size_t)l * 4 + h) * 15 * 31;
  int nwin = lat ? 128 : 0;
  int nk = nwin + NCX;
  float o[64];
  float m = -1e30f, ls = 0.f;
  for (int pass = 0; pass < 2; ++pass) {
    float inv = pass ? 1.0f / ls : 0.f;
    if (pass) {
#pragma unroll
      for (int d = 0; d < 64; ++d) o[d] = 0.f;
    }
    for (int j = 0; j < nk; ++j) {
      int krow; float bias = 0.f;
      if (j < nwin) {
        int i = j / 16, jj = j % 16;
        krow = b * NTL + (rs + i) * 64 + cs + jj;
        int dr = rs + i - r + 7;
        int dc = cs + jj - cq; dc = dc < -15 ? -15 : (dc > 15 ? 15 : dc); dc += 15;
        bias = rpb[dr * 31 + dc];
      } else {
        krow = NLAT + b * NCX + (j - nwin);
      }
      const float* kp = p.P + (size_t)krow * INC + OFF_D + 256 + h * 64;
      float s = dot64s(q, kp) + bias;
      if (!pass) {
        float n = fmaxf(m, s); ls = ls * expf(m - n) + expf(s - n); m = n;
      } else {
        float pw = expf(s - m) * inv;
        const float* vp = kp + 256;
#pragma unroll
        for (int d = 0; d < 64; d += 4) {
          float4 vv = *(const float4*)(vp + d);
          o[d] += pw * vv.x; o[d + 1] += pw * vv.y; o[d + 2] += pw * vv.z; o[d + 3] += pw * vv.w;
        }
      }
    }
  }
  float* yp = p.Y + (size_t)qrow * DM + 768 + h * 64;
#pragma unroll
  for (int d = 0; d < 64; ++d) yp[d] = o[d];
}

DEVFN float rw_conv(const Params& p, int l, int row, int col, bool hp, bool hn) {
  const float* mu = p.rwkv_mu + (size_t)l * 2 * 1152;
  float m0 = mu[col], m1 = mu[1152 + col];
  const float* c = p.P + (size_t)row * INC + OFF_B + col;
  float v = c[0] * (1.0f - m0 - m1);
  if (hp) v += c[-INC] * m0;
  if (hn) v += c[INC] * m1;
  return v;
}
DEVFN void rwprep_item(const Params& p, int l, long item) {
  int row = (int)(item / 256), c = (int)(item % 256);
  int h = c / 64;
  int t, len; seq_pos(row, t, len);
  bool hp = t > 0, hn = t < len - 1;
  float r = rw_conv(p, l, row, c, hp, hn);
  float k = rw_conv(p, l, row, 256 + c, hp, hn);
  float v = rw_conv(p, l, row, 512 + c, hp, hn);
  float wr[2], ar[2];
#pragma unroll
  for (int d = 0; d < 2; ++d) {
    float aw = p.rwkv_w0[(l * 2 + d) * 256 + c];
    float aa = p.rwkv_a0[(l * 2 + d) * 256 + c];
    for (int rr = 0; rr < 64; ++rr) {
      aw += tanhf(rw_conv(p, l, row, 768 + d * 64 + rr, hp, hn)) * p.rwkv_w2[((size_t)(l * 2 + d) * 64 + rr) * 256 + c];
      aa += rw_conv(p, l, row, 896 + d * 64 + rr, hp, hn) * p.rwkv_a2[((size_t)(l * 2 + d) * 64 + rr) * 256 + c];
    }
    wr[d] = expf(-sigmoidf_(aw) * 0.6065306597126334f);
    ar[d] = sigmoidf_(aa);
  }
  float g = 0.f;
  for (int rr = 0; rr < 128; ++rr)
    g += sigmoidf_(rw_conv(p, l, row, 1024 + rr, hp, hn)) * p.rwkv_g2[((size_t)l * 128 + rr) * 256 + c];
  float n2 = 0.f;
  for (int cc = h * 64; cc < h * 64 + 64; ++cc) {
    float kc = rw_conv(p, l, row, 256 + cc, hp, hn) * p.rwkv_kk[l * 256 + cc];
    n2 += kc * kc;
  }
  float kk = k * p.rwkv_kk[l * 256 + c] * (1.0f / sqrtf(n2 + 1e-6f));
  float ka = p.rwkv_ka[l * 256 + c];
  float* o = p.RW + (size_t)row * RWS;
  o[c] = r; o[256 + c] = v; o[512 + c] = g; o[768 + c] = kk;
  o[1024 + c] = wr[0]; o[1280 + c] = wr[1];
  o[1536 + c] = kk * ar[0]; o[1792 + c] = kk * ar[1];
  o[2048 + c] = k * (1.0f + (ar[0] - 1.0f) * ka);
  o[2304 + c] = k * (1.0f + (ar[1] - 1.0f) * ka);
}

DEVFN float gd_conv(const Params& p, int l, int row, int col, bool hp, bool hn) {
  const float* cw = p.gdn_conv + (size_t)l * 3 * 768;
  const float* c = p.P + (size_t)row * INC + OFF_C + col;
  float v = c[0] * cw[768 + col];
  if (hp) v += c[-INC] * cw[col];
  if (hn) v += c[INC] * cw[1536 + col];
  return siluf_(v);
}
DEVFN void gdprep_item(const Params& p, int l, long item) {
  int row = (int)(item / 256), c = (int)(item % 256);
  int h = c / 64;
  int t, len; seq_pos(row, t, len);
  bool hp = t > 0, hn = t < len - 1;
  float q = gd_conv(p, l, row, c, hp, hn);
  float k = gd_conv(p, l, row, 256 + c, hp, hn);
  float v = gd_conv(p, l, row, 512 + c, hp, hn);
  float nq = 0.f, nk = 0.f;
  for (int cc = h * 64; cc < h * 64 + 64; ++cc) {
    float a = gd_conv(p, l, row, cc, hp, hn); nq += a * a;
    float bq = gd_conv(p, l, row, 256 + cc, hp, hn); nk += bq * bq;
  }
  float* o = p.P + (size_t)row * INC + OFF_B;
  o[c] = q * (1.0f / sqrtf(nq + 1e-6f)) * 0.125f;
  o[256 + c] = k * (1.0f / sqrtf(nk + 1e-6f));
  o[512 + c] = v;
  if (c < 8) {
    int d = c / 4, hh = c % 4;
    const float* ab = p.P + (size_t)row * INC + OFF_C + 1024;
    float la = -expf(p.gdn_a_log[(l * 2 + d) * 4 + hh]) * softplusf_(ab[d * 4 + hh] + p.gdn_dt_bias[(l * 2 + d) * 4 + hh]);
    o[768 + c] = la;
    o[776 + c] = sigmoidf_(ab[8 + d * 4 + hh]);
  }
}

DEVFN int scan_row(int b, int d, int step) {
  if (step < NCX) return NLAT + b * NCX + (d ? NCX - 1 - step : step);
  int s2 = step - NCX;
  return b * NTL + (d ? NTL - 1 - s2 : s2);
}
DEVFN void rwscan_item(const Params& p, bool last, long item) {
  int v = (int)(item % 64), h = (int)((item / 64) % 4), b = (int)((item / 256) % NB), d = (int)(item / (256 * NB));
  float s[64];
#pragma unroll
  for (int k = 0; k < 64; ++k) s[k] = 0.f;
  for (int step = 0; step < NCX + NTL; ++step) {
    int row = scan_row(b, d, step);
    const float* base = p.RW + (size_t)row * RWS + h * 64;
    const float* kkp = base + 768;
    const float* wp = base + 1024 + d * 256;
    const float* kap = base + 1536 + d * 256;
    const float* kdp = base + 2048 + d * 256;
    float vv = base[256 + v];
    float sa = 0.f;
#pragma unroll
    for (int k = 0; k < 64; ++k) sa += s[k] * kkp[k];
    float y = 0.f;
#pragma unroll
    for (int k = 0; k < 64; ++k) {
      s[k] = s[k] * wp[k] - sa * kap[k] + vv * kdp[k];
      y += s[k] * base[k];
    }
    if (!(last && row >= NLAT)) p.P[(size_t)row * INC + OFF_A + d * 256 + h * 64 + v] = y;
  }
}
DEVFN void gdscan_item(const Params& p, bool last, long item) {
  int dv = (int)(item % 64), h = (int)((item / 64) % 4), b = (int)((item / 256) % NB), d = (int)(item / (256 * NB));
  float s[64];
#pragma unroll
  for (int k = 0; k < 64; ++k) s[k] = 0.f;
  for (int step = 0; step < NCX + NTL; ++step) {
    int row = scan_row(b, d, step);
    const float* base = p.P + (size_t)row * INC + OFF_B;
    const float* qp = base + h * 64;
    const float* kp = base + 256 + h * 64;
    float vv = base[512 + h * 64 + dv];
    float eg = expf(base[768 + d * 4 + h]);
    float beta = base[776 + d * 4 + h];
    float ks = 0.f;
#pragma unroll
    for (int k = 0; k < 64; ++k) { s[k] *= eg; ks += kp[k] * s[k]; }
    float vn = beta * (vv - ks);
    float o = 0.f;
#pragma unroll
    for (int k = 0; k < 64; ++k) { s[k] += kp[k] * vn; o += qp[k] * s[k]; }
    if (!(last && row >= NLAT)) p.P[(size_t)row * INC + OFF_D + d * 256 + h * 64 + dv] = o;
  }
}

DEVFN void rwpost_item(const Params& p, int l, int row, int h) {
  const float* y0 = p.P + (size_t)row * INC + OFF_A + h * 64;
  const float* rw = p.RW + (size_t)row * RWS + h * 64;
  float y[64];
  float m = 0.f;
#pragma unroll
  for (int k = 0; k < 64; ++k) { y[k] = y0[k] + y0[256 + k]; m += y[k]; }
  m *= (1.0f / 64);
  float var = 0.f;
#pragma unroll
  for (int k = 0; k < 64; ++k) { float dd = y[k] - m; var += dd * dd; }
  float rstd = 1.0f / sqrtf(var * (1.0f / 64) + 64e-5f);
  float bonus = 0.f;
  const float* rk = p.rwkv_rk + (l * 4 + h) * 64;
#pragma unroll
  for (int k = 0; k < 64; ++k) bonus += rw[k] * (rw[2048 + k] + rw[2304 + k]) * rk[k];
  float* yp = p.Y + (size_t)row * DM + 256 + h * 64;
  const float* lg = p.rwkv_ln_g + l * 256 + h * 64;
  const float* lb = p.rwkv_ln_b + l * 256 + h * 64;
#pragma unroll
  for (int k = 0; k < 64; ++k) yp[k] = ((y[k] - m) * rstd * lg[k] + lb[k] + bonus * rw[256 + k]) * rw[512 + k];
}
DEVFN void gdpost_item(const Params& p, int l, int row, int h) {
  const float* o0 = p.P + (size_t)row * INC + OFF_D + h * 64;
  const float* gate = p.P + (size_t)row * INC + OFF_C + 768 + h * 64;
  float o[64];
  float ss = 0.f;
#pragma unroll
  for (int k = 0; k < 64; ++k) { o[k] = o0[k] + o0[256 + k]; ss += o[k] * o[k]; }
  float rs = 1.0f / sqrtf(ss * (1.0f / 64) + 1e-6f);
  const float* g = p.gdn_norm_g + l * 64;
  float* yp = p.Y + (size_t)row * DM + 512 + h * 64;
#pragma unroll
  for (int k = 0; k < 64; ++k) yp[k] = o[k] * rs * g[k] * siluf_(gate[k]);
}

DEVFN void ph_pn1(const Params& p, int l, long item) {
  int row = (int)item;
  const float* hs = hsrc_row(p, l, row);
  float* hd = hdst_row(p, row);
  const float* m = p.mod + ((size_t)l * NMODV + modv_of_row(row)) * 6144;
  const float* mix = p.RW + (size_t)row * DM;
  float s = 0.f;
  for (int i = 0; i < DM; ++i) s += DN_ALPHA * hs[i] + m[2048 + i] * mix[i];
  float mu = s * (1.0f / DM);
  float v = 0.f;
  for (int i = 0; i < DM; ++i) { float z = DN_ALPHA * hs[i] + m[2048 + i] * mix[i] - mu; v += z * z; }
  float rstd = 1.0f / sqrtf(v * (1.0f / DM) + LN_EPS);
  const float* g = p.ln_mix_g + l * DM;
  const float* bb = p.ln_mix_b + l * DM;
  float s2 = 0.f;
  for (int i = 0; i < DM; ++i) {
    float z = DN_ALPHA * hs[i] + m[2048 + i] * mix[i];
    float hn = (z - mu) * rstd * g[i] + bb[i];
    hd[i] = hn;
    s2 += hn;
  }
  float mu2 = s2 * (1.0f / DM);
  float v2 = 0.f;
  for (int i = 0; i < DM; ++i) { float dd = hd[i] - mu2; v2 += dd * dd; }
  float rstd2 = 1.0f / sqrtf(v2 * (1.0f / DM) + LN_EPS);
  float* x2 = p.Y + (size_t)row * DM;
  for (int i = 0; i < DM; ++i) x2[i] = (hd[i] - mu2) * rstd2 * (1.0f + m[4096 + i]) + m[3072 + i];
}
DEVFN void ph_pn2(const Params& p, int l, long item) {
  int row = (int)item;
  float* hd = hdst_row(p, row);
  const float* m = p.mod + ((size_t)l * NMODV + modv_of_row(row)) * 6144;
  const float* ffn = p.RW + (size_t)row * DM;
  float s = 0.f;
  for (int i = 0; i < DM; ++i) s += DN_ALPHA * hd[i] + m[5120 + i] * ffn[i];
  float mu = s * (1.0f / DM);
  float v = 0.f;
  for (int i = 0; i < DM; ++i) { float z = DN_ALPHA * hd[i] + m[5120 + i] * ffn[i] - mu; v += z * z; }
  float rstd = 1.0f / sqrtf(v * (1.0f / DM) + LN_EPS);
  const float* g = p.ln_ffn_g + l * DM;
  const float* bb = p.ln_ffn_b + l * DM;
  for (int i = 0; i < DM; ++i) {
    float z = DN_ALPHA * hd[i] + m[5120 + i] * ffn[i];
    hd[i] = (z - mu) * rstd * g[i] + bb[i];
  }
}

DEVFN float* peerQ(const Params& p) { return p.P; }
DEVFN float* sel1s(const Params& p) { return p.P + (size_t)NTOK * 2048; }
DEVFN int* sel1i(const Params& p) { return (int*)(p.P + (size_t)NTOK * (2048 + 256)); }
DEVFN int* sel2i(const Params& p) { return (int*)(p.P + (size_t)NTOK * (2048 + 512)); }
DEVFN float* sel2g(const Params& p) { return p.P + (size_t)NTOK * (2048 + 640); }
DEVFN float* coefb(const Params& p) { return p.P + (size_t)NTOK * (2048 + 768); }

#define TOPK_INSERT(ts, ti, xs, xi)                                      \
  {                                                                      \
    float cs_ = (xs); int ci_ = (xi);                                    \
    _Pragma("unroll") for (int z_ = 0; z_ < 16; ++z_) {                  \
      bool gt_ = cs_ > ts[z_];                                           \
      float os_ = ts[z_]; int oi_ = ti[z_];                              \
      ts[z_] = gt_ ? cs_ : os_; ti[z_] = gt_ ? ci_ : oi_;                \
      cs_ = gt_ ? os_ : cs_; ci_ = gt_ ? oi_ : ci_;                      \
    }                                                                    \
  }

DEVFN void ph_topk1(const Params& p, int l, int nrows, long item) {
  int hp = (int)(item / nrows), row = (int)(item % nrows);
  const float* q = peerQ(p) + (size_t)row * 2048 + hp * 128;
  const float* keys = p.peer_keys + ((size_t)l * 16 + hp) * 128 * 128;
  float qv[128];
#pragma unroll
  for (int d = 0; d < 128; ++d) qv[d] = q[d];
  float ts[16]; int ti[16];
#pragma unroll
  for (int z = 0; z < 16; ++z) { ts[z] = -3e38f; ti[z] = 0; }
  for (int n = 0; n < 128; ++n) {
    const float* kr = keys + n * 128;
    float s = 0.f;
#pragma unroll
    for (int d = 0; d < 128; ++d) s += qv[d] * kr[d];
    TOPK_INSERT(ts, ti, s, n);
  }
  float* os = sel1s(p) + ((size_t)row * 16 + hp) * 16;
  int* oi = sel1i(p) + ((size_t)row * 16 + hp) * 16;
#pragma unroll
  for (int z = 0; z < 16; ++z) { os[z] = ts[z]; oi[z] = ti[z]; }
}
DEVFN void ph_topk2(const Params& p, int nrows, long item) {
  int h = (int)(item / nrows), row = (int)(item % nrows);
  const float* s0 = sel1s(p) + ((size_t)row * 16 + h * 2) * 16;
  const int* i0 = sel1i(p) + ((size_t)row * 16 + h * 2) * 16;
  float s1[16]; int i1[16];
#pragma unroll
  for (int z = 0; z < 16; ++z) { s1[z] = s0[16 + z]; i1[z] = i0[16 + z]; }
  float ts[16]; int ti[16];
#pragma unroll
  for (int z = 0; z < 16; ++z) { ts[z] = -3e38f; ti[z] = 0; }
  for (int i = 0; i < 16; ++i) {
    float a = s0[i]; int ai = i0[i] * 128;
#pragma unroll
    for (int j = 0; j < 16; ++j) TOPK_INSERT(ts, ti, a + s1[j], ai + i1[j]);
  }
  float sum = 0.f;
  float mx = ts[0];
#pragma unroll
  for (int z = 0; z < 16; ++z) { ts[z] = expf(ts[z] - mx); }
#pragma unroll
  for (int z = 0; z < 16; ++z) sum += ts[z];
  float inv = 1.0f / sum;
  int* oi = sel2i(p) + ((size_t)row * 8 + h) * 16;
  float* og = sel2g(p) + ((size_t)row * 8 + h) * 16;
#pragma unroll
  for (int z = 0; z < 16; ++z) { oi[z] = ti[z]; og[z] = ts[z] * inv; }
}
DEVFN void ph_act(const Params& p, int l, long item) {
  int row = (int)(item / 128);
  int idx = sel2i(p)[item];
  const float* x2 = p.Y + (size_t)row * DM;
  const float* u = p.peer_u + ((size_t)l * 16384 + idx) * DM;
  float s = 0.f;
  for (int i = 0; i < DM; i += 4) {
    float4 a = *(const float4*)(x2 + i), b = *(const float4*)(u + i);
    s += a.x * b.x + a.y * b.y + a.z * b.z + a.w * b.w;
  }
  coefb(p)[item] = sel2g(p)[item] * geluf_(s);
}
DEVFN void ph_ffn(const Params& p, int l, long item) {
  int row = (int)(item / 256), c4 = (int)(item % 256);
  const int* idx = sel2i(p) + (size_t)row * 128;
  const float* cf = coefb(p) + (size_t)row * 128;
  float4 acc = make_float4(0.f, 0.f, 0.f, 0.f);
  for (int j = 0; j < 128; ++j) {
    float4 vv = *(const float4*)(p.peer_v + ((size_t)l * 16384 + idx[j]) * DM + c4 * 4);
    float c = cf[j];
    acc.x += c * vv.x; acc.y += c * vv.y; acc.z += c * vv.z; acc.w += c * vv.w;
  }
  *(float4*)(p.RW + (size_t)row * DM + c4 * 4) = acc;
}

enum { PH_ADA = 0, PH_LN1, PH_GEMM_IN, PH_ROPE, PH_MIX, PH_GDPREP, PH_SCAN, PH_POST, PH_GEMM_OUT, PH_PN1, PH_GEMM_Q,
       PH_TOPK1, PH_TOPK2, PH_ACT, PH_FFN, PH_PN2, PH_COUNT };

DEVFN int rows_out(int l) { return l == 1 ? NLAT : NTOK; }

DEVFN long phase_items(int ph, int l) {
  bool last = l == 1;
  long nr = rows_out(l);
  switch (ph) {
    case PH_ADA: return l == 0 ? 2 * 6144 : 0;
    case PH_LN1: return NTOK;
    case PH_GEMM_IN: return (long)(NTOK / 4) * (INC / 4);
    case PH_ROPE: return (long)NLAT * 256;
    case PH_MIX: return 2L * NB * 4 * NTL + (last ? 0 : 2L * NB * 4 * NCX) + (long)NTOK * 256;
    case PH_GDPREP: return (long)NTOK * 256;
    case PH_SCAN: return 2L * 2 * NB * 4 * 64;
    case PH_POST: return nr * 4 * 2;
    case PH_GEMM_OUT: return (nr / 4) * (DM / 4);
    case PH_PN1: return nr;
    case PH_GEMM_Q: return (nr / 4) * (2048 / 4);
    case PH_TOPK1: return nr * 16;
    case PH_TOPK2: return nr * 8;
    case PH_ACT: return nr * 128;
    case PH_FFN: return nr * 256;
    case PH_PN2: return nr;
  }
  return 0;
}

template <int PH>
DEVFN void phase_item(const Params& p, int l, long item) {
  bool last = l == 1;
  int nr = rows_out(l);
  if (PH == PH_ADA) ph_ada(p, item);
  else if (PH == PH_LN1) ph_ln1(p, l, item);
  else if (PH == PH_GEMM_IN) gemm_item(p.Y, DM, p.w_in + (size_t)l * DM * INC, INC, p.P, INC, INC, DM, item);
  else if (PH == PH_ROPE) ph_rope(p, item);
  else if (PH == PH_MIX) {
    long nAl = (long)NB * 4 * NTL, nAc = last ? 0 : (long)NB * 4 * NCX;
    if (item < nAl) {
      int bh = (int)(item / NTL), t = (int)(item % NTL);
      mixA_item(p, l, bh / 4, bh % 4, (bh / 4) * NTL + t, true);
    } else if (item < nAl + nAc) {
      long it = item - nAl; int bh = (int)(it / NCX), t = (int)(it % NCX);
      mixA_item(p, l, bh / 4, bh % 4, NLAT + (bh / 4) * NCX + t, false);
    } else if (item < 2 * nAl + nAc) {
      long it = item - nAl - nAc; int bh = (int)(it / NTL), t = (int)(it % NTL);
      mixD_item(p, l, bh / 4, bh % 4, (bh / 4) * NTL + t, true, t);
    } else if (item < 2 * nAl + 2 * nAc) {
      long it = item - 2 * nAl - nAc; int bh = (int)(it / NCX), t = (int)(it % NCX);
      mixD_item(p, l, bh / 4, bh % 4, NLAT + (bh / 4) * NCX + t, false, 0);
    } else {
      rwprep_item(p, l, item - 2 * nAl - 2 * nAc);
    }
  } else if (PH == PH_GDPREP) gdprep_item(p, l, item);
  else if (PH == PH_SCAN) {
    long n1 = 2L * NB * 4 * 64;
    if (item < n1) rwscan_item(p, last, item); else gdscan_item(p, last, item - n1);
  } else if (PH == PH_POST) {
    long n1 = (long)nr * 4;
    if (item < n1) rwpost_item(p, l, (int)(item / 4), (int)(item % 4));
    else { long it = item - n1; gdpost_item(p, l, (int)(it / 4), (int)(it % 4)); }
  } else if (PH == PH_GEMM_OUT) gemm_item(p.Y, DM, p.w_out + (size_t)l * DM * DM, DM, p.RW, DM, DM, DM, item);
  else if (PH == PH_PN1) ph_pn1(p, l, item);
  else if (PH == PH_GEMM_Q) gemm_item(p.Y, DM, p.peer_wq + (size_t)l * DM * 2048, 2048, peerQ(p), 2048, 2048, DM, item);
  else if (PH == PH_TOPK1) ph_topk1(p, l, nr, item);
  else if (PH == PH_TOPK2) ph_topk2(p, nr, item);
  else if (PH == PH_ACT) ph_act(p, l, item);
  else if (PH == PH_FFN) ph_ffn(p, l, item);
  else if (PH == PH_PN2) ph_pn2(p, l, item);
}

constexpr size_t WS_MOD = 0;
constexpr size_t WS_HCTX = WS_MOD + (size_t)2 * NMODV * 6144;
constexpr size_t WS_Y = WS_HCTX + (size_t)NCTX * DM;
constexpr size_t WS_P = WS_Y + (size_t)NTOK * DM;
constexpr size_t WS_RW = WS_P + (size_t)NTOK * INC;
constexpr size_t WS_END = WS_RW + (size_t)NTOK * RWS;

#ifndef CPU_EMU
template <int PH>
__device__ __forceinline__ void run_phase(const Params& p, int l, long gtid, long nth) {
  long n = phase_items(PH, l);
  for (long i = gtid; i < n; i += nth) phase_item<PH>(p, l, i);
}

#if MEGA
__global__ void __launch_bounds__(256) fwd_megakernel(Params p) {
  cg::grid_group grid = cg::this_grid();
  long gtid = (long)blockIdx.x * blockDim.x + threadIdx.x;
  long nth = (long)gridDim.x * blockDim.x;
  run_phase<PH_ADA>(p, 0, gtid, nth); grid.sync();
  for (int l = 0; l < 2; ++l) {
    run_phase<PH_LN1>(p, l, gtid, nth); grid.sync();
    run_phase<PH_GEMM_IN>(p, l, gtid, nth); grid.sync();
    run_phase<PH_ROPE>(p, l, gtid, nth); grid.sync();
    run_phase<PH_MIX>(p, l, gtid, nth); grid.sync();
    run_phase<PH_GDPREP>(p, l, gtid, nth); grid.sync();
    run_phase<PH_SCAN>(p, l, gtid, nth); grid.sync();
    run_phase<PH_POST>(p, l, gtid, nth); grid.sync();
    run_phase<PH_GEMM_OUT>(p, l, gtid, nth); grid.sync();
    run_phase<PH_PN1>(p, l, gtid, nth); grid.sync();
    run_phase<PH_GEMM_Q>(p, l, gtid, nth); grid.sync();
    run_phase<PH_TOPK1>(p, l, gtid, nth); grid.sync();
    run_phase<PH_TOPK2>(p, l, gtid, nth); grid.sync();
    run_phase<PH_ACT>(p, l, gtid, nth); grid.sync();
    run_phase<PH_FFN>(p, l, gtid, nth); grid.sync();
    run_phase<PH_PN2>(p, l, gtid, nth); grid.sync();
  }
}
#else
template <int PH>
__global__ void __launch_bounds__(256) phase_kernel(Params p, int l) {
  long gtid = (long)blockIdx.x * blockDim.x + threadIdx.x;
  long nth = (long)gridDim.x * blockDim.x;
  run_phase<PH>(p, l, gtid, nth);
}
template <int PH>
static void launch_phase(const Params& p, int l, hipStream_t stream) {
  long n = phase_items(PH, l);
  if (n <= 0) return;
  long blocks = (n + 255) / 256;
  if (blocks > 8192) blocks = 8192;
  hipLaunchKernelGGL(phase_kernel<PH>, dim3((unsigned)blocks), dim3(256), 0, stream, p, l);
}
#endif

extern "C" void kernel_launch(void* const* d_in, const int* in_sizes, int n_in, void* d_out, int out_size, void* d_ws,
                              size_t ws_size, hipStream_t stream) {
  Params p{};
  const float** pin = (const float**)&p;
  for (int i = 0; i < 34; ++i) pin[i] = (const float*)d_in[i];
  p.out = (float*)d_out;
  float* ws = (float*)d_ws;
  if (ws_size < WS_END * sizeof(float)) return;
  p.mod = ws + WS_MOD; p.hctx = ws + WS_HCTX; p.Y = ws + WS_Y; p.P = ws + WS_P; p.RW = ws + WS_RW;
#if MEGA
  static int grid_blocks = 0;
  if (!grid_blocks) {
    int dev = 0, cus = 0, per_cu = 0;
    hipGetDevice(&dev);
    hipDeviceGetAttribute(&cus, hipDeviceAttributeMultiprocessorCount, dev);
    hipOccupancyMaxActiveBlocksPerMultiprocessor(&per_cu, fwd_megakernel, 256, 0);
    if (per_cu > 2) per_cu = 2;
    grid_blocks = cus * per_cu;
  }
  void* args[] = {&p};
  hipLaunchCooperativeKernel((void*)fwd_megakernel, dim3(grid_blocks), dim3(256), args, 0, stream);
#else
  launch_phase<PH_ADA>(p, 0, stream);
  for (int l = 0; l < 2; ++l) {
    launch_phase<PH_LN1>(p, l, stream);
    launch_phase<PH_GEMM_IN>(p, l, stream);
    launch_phase<PH_ROPE>(p, l, stream);
    launch_phase<PH_MIX>(p, l, stream);
    launch_phase<PH_GDPREP>(p, l, stream);
    launch_phase<PH_SCAN>(p, l, stream);
    launch_phase<PH_POST>(p, l, stream);
    launch_phase<PH_GEMM_OUT>(p, l, stream);
    launch_phase<PH_PN1>(p, l, stream);
    launch_phase<PH_GEMM_Q>(p, l, stream);
    launch_phase<PH_TOPK1>(p, l, stream);
    launch_phase<PH_TOPK2>(p, l, stream);
    launch_phase<PH_ACT>(p, l, stream);
    launch_phase<PH_FFN>(p, l, stream);
    launch_phase<PH_PN2>(p, l, stream);
  }
#endif
}
#endif
```

```cpp
#ifndef CPU_EMU
#include <hip/hip_runtime.h>
#include <hip/hip_cooperative_groups.h>
namespace cg = cooperative_groups;
#define DEVFN __device__ __forceinline__
#define HDFN __host__ __device__ __forceinline__
#define MEMFN __host__ __device__ __forceinline__
#define LOAD_FENCE() asm volatile("" ::: "memory")
#define LDS_BAR() { asm volatile("s_waitcnt lgkmcnt(0)" ::: "memory"); __builtin_amdgcn_s_barrier(); asm volatile("" ::: "memory"); }
#else
#include <cmath>
#include <cstdio>
#include <cstdlib>
#include <cstring>
#define DEVFN static inline
#define HDFN static inline
#define MEMFN inline
#define LOAD_FENCE()
struct float4 { float x, y, z, w; };
static inline float4 make_float4(float a, float b, float c, float d) { float4 r{a, b, c, d}; return r; }
#endif

#ifndef MEGA
#define MEGA 1
#endif
#ifndef PROBE_DUP
#define PROBE_DUP 0
#endif
#ifndef K_B
#define K_B 4
#define K_T 4096
#define K_C 256
#endif

typedef unsigned short bf16_t;
constexpr int NB = K_B, NTL = K_T, NCX = K_C;
constexpr int DM = 1024;
constexpr int NLAT = NB * NTL, NCTX = NB * NCX, NTOK = NLAT + NCTX;
constexpr int GROWS = NTL / 64;
constexpr int INC = 3728;
constexpr int OFF_A = 0, OFF_B = 768, OFF_C = 1920, OFF_D = 2960;
constexpr int RWS = 2560;
constexpr int GPS = 784;
constexpr int RWREC = 648;
constexpr int GDREC = 200;
constexpr int NMODV = NB + 1;
constexpr float DN_ALPHA = 1.4142135623730951f;
constexpr float LN_EPS = 1e-5f;

constexpr size_t al256(size_t x) { return (x + 255) & ~(size_t)255; }
constexpr size_t WS_MOD = 0;
constexpr size_t WS_HCTX = al256(WS_MOD + (size_t)2 * NMODV * 6144 * 4);
constexpr size_t WS_Y = al256(WS_HCTX + (size_t)NCTX * DM * 4);
constexpr size_t WS_P = al256(WS_Y + (size_t)NTOK * DM * 2);
constexpr size_t WS_RW = al256(WS_P + (size_t)NTOK * INC * 2);
constexpr size_t WS_GP = al256(WS_RW + (size_t)NTOK * (RWS > 4 * RWREC ? RWS : 4 * RWREC) * 4);
constexpr size_t WS_YS = al256(WS_GP + (size_t)NTOK * (GPS > 4 * GDREC ? GPS : 4 * GDREC) * 4);
constexpr size_t WS_TB = al256(WS_YS + (size_t)NTOK * 1024 * 2);
constexpr size_t WS_G16 = al256(WS_TB + (size_t)2 * 16384 * 1024 * 2);
constexpr size_t WS_VT = al256(WS_G16 + (size_t)NTOK * 256 * 2);
constexpr size_t WS_BAR = al256(WS_VT + (size_t)2 * NB * 4 * 64 * (NTL + NCX) * 2);
constexpr size_t WS_BAR_BYTES = 3456 * 4;
constexpr size_t WS_END = al256(WS_BAR + WS_BAR_BYTES);
struct Params {
  const float *x, *c, *ctx, *c_ctx, *w_ada, *b_ada, *w_in, *w_out, *ln_mix_g, *ln_mix_b, *ln_ffn_g, *ln_ffn_b;
  const float *diff_lam, *diff_norm_g, *rwkv_mu, *rwkv_w0, *rwkv_w2, *rwkv_a0, *rwkv_a2, *rwkv_g2;
  const float *rwkv_kk, *rwkv_ka, *rwkv_rk, *rwkv_ln_g, *rwkv_ln_b, *gdn_conv, *gdn_a_log, *gdn_dt_bias;
  const float *gdn_norm_g, *nat_rpb, *peer_wq, *peer_keys, *peer_u, *peer_v;
  float *out;
  char *ws;
  MEMFN float* mod() const { return (float*)(ws + WS_MOD); }
  MEMFN float* hctx() const { return (float*)(ws + WS_HCTX); }
  MEMFN float* RW() const { return (float*)(ws + WS_RW); }
  MEMFN float* GP() const { return (float*)(ws + WS_GP); }
  MEMFN bf16_t* Y() const { return (bf16_t*)(ws + WS_Y); }
  MEMFN bf16_t* P() const { return (bf16_t*)(ws + WS_P); }
  MEMFN bf16_t* YS() const { return (bf16_t*)(ws + WS_YS); }
  MEMFN bf16_t* TB() const { return (bf16_t*)(ws + WS_TB); }
  MEMFN bf16_t* WBT() const { return (bf16_t*)(ws + WS_TB + (size_t)2 * 16384 * 1024); }
  MEMFN bf16_t* G16() const { return (bf16_t*)(ws + WS_G16); }
  MEMFN bf16_t* VT() const { return (bf16_t*)(ws + WS_VT); }
  MEMFN unsigned* bar() const { return (unsigned*)(ws + WS_BAR); }
};

DEVFN float bf2f(bf16_t v) {
  unsigned u = (unsigned)v << 16; float f;
#ifdef CPU_EMU
  memcpy(&f, &u, 4);
#else
  f = __uint_as_float(u);
#endif
  return f;
}
DEVFN bf16_t f2bf(float f) {
#if !defined(CPU_EMU) && defined(__HIP_DEVICE_COMPILE__)
  typedef __attribute__((ext_vector_type(2))) float f2bf_f2; typedef __attribute__((ext_vector_type(2))) __bf16 f2bf_b2;
  const f2bf_f2 v = {f, 0.f};
  return (bf16_t)(__builtin_bit_cast(unsigned, __builtin_convertvector(v, f2bf_b2)) & 0xffffu);
#else
  unsigned u;
#ifdef CPU_EMU
  memcpy(&u, &f, 4);
#else
  u = __float_as_uint(f);
#endif
  u += 0x7fffu + ((u >> 16) & 1u);
  return (bf16_t)(u >> 16);
#endif
}
DEVFN float4 ld4(const bf16_t* p) {
  const unsigned* q = (const unsigned*)p;
  unsigned a = q[0], b = q[1];
  unsigned x0 = a << 16, x1 = a & 0xffff0000u, x2 = b << 16, x3 = b & 0xffff0000u;
  float4 r;
#ifdef CPU_EMU
  memcpy(&r.x, &x0, 4); memcpy(&r.y, &x1, 4); memcpy(&r.z, &x2, 4); memcpy(&r.w, &x3, 4);
#else
  r.x = __uint_as_float(x0); r.y = __uint_as_float(x1); r.z = __uint_as_float(x2); r.w = __uint_as_float(x3);
#endif
  return r;
}

#ifdef CPU_EMU
#define FEXP expf
#define FLOG logf
#define FSIN sinf
#define FCOS cosf
#define FRCP(x) (1.0f / (x))
#define FRSQ(x) (1.0f / sqrtf(x))
#else
#define FEXP __expf
#define FLOG __logf
#define FSIN __sinf
#define FCOS __cosf
#define FRCP(x) __builtin_amdgcn_rcpf(x)
#define FRSQ(x) __builtin_amdgcn_rsqf(x)
#endif
DEVFN float sigmoidf_(float x) { return FRCP(1.0f + FEXP(-x)); }
DEVFN float siluf_(float x) { return x * FRCP(1.0f + FEXP(-x)); }
DEVFN float softplusf_(float x) { return fmaxf(x, 0.f) + FLOG(1.0f + FEXP(-fabsf(x))); }
DEVFN float tanhf_(float x) { float e = FEXP(2.0f * x); return 1.0f - 2.0f * FRCP(e + 1.0f); }
DEVFN float geluf_(float x) { return 0.5f * x * (1.0f + erff(x * 0.70710678118654752f)); }

DEVFN int modv_of_row(int row) { return row < NLAT ? row / NTL : NB; }
DEVFN const float* hsrc_row(const Params& p, int l, int row) {
  if (row < NLAT) return (l == 0 ? p.x : p.out) + (size_t)row * DM;
  return (l == 0 ? p.ctx : p.hctx()) + (size_t)(row - NLAT) * DM;
}
DEVFN float* hdst_row(const Params& p, int row) {
  if (row < NLAT) return p.out + (size_t)row * DM;
  return p.hctx() + (size_t)(row - NLAT) * DM;
}
DEVFN void seq_pos(int row, int& t, int& len) {
  if (row < NLAT) { t = row % NTL; len = NTL; } else { t = (row - NLAT) % NCX; len = NCX; }
}

DEVFN void ph_ada(const Params& p, long item) {
  int l = (int)(item / 6144), j = (int)(item % 6144);
  float acc[NMODV];
#pragma unroll
  for (int v = 0; v < NMODV; ++v) acc[v] = 0.f;
  for (int i = 0; i < DM; ++i) {
    float w = p.w_ada[((size_t)l * DM + i) * 6144 + j];
#pragma unroll
    for (int v = 0; v < NB; ++v) acc[v] += siluf_(p.c[v * DM + i]) * w;
    acc[NB] += siluf_(p.c_ctx[i]) * w;
  }
  float bb = p.b_ada[l * 6144 + j];
#pragma unroll
  for (int v = 0; v < NMODV; ++v) p.mod()[((size_t)l * NMODV + v) * 6144 + j] = acc[v] + bb;
}

DEVFN void row_stats(const float* r, float& mu, float& rstd) {
  float s = 0.f;
  for (int i = 0; i < DM; ++i) s += r[i];
  mu = s * (1.0f / DM);
  float v = 0.f;
  for (int i = 0; i < DM; ++i) { float d = r[i] - mu; v += d * d; }
  rstd = 1.0f / sqrtf(v * (1.0f / DM) + LN_EPS);
}

DEVFN void ph_ln1(const Params& p, int l, long item) {
  int row = (int)item;
  const float* src = hsrc_row(p, l, row);
  const float* m = p.mod() + ((size_t)l * NMODV + modv_of_row(row)) * 6144;
  float mu, rstd;
  row_stats(src, mu, rstd);
  bf16_t* dst = p.Y() + (size_t)row * DM;
  for (int i = 0; i < DM; ++i) dst[i] = f2bf((src[i] - mu) * rstd * (1.0f + m[1024 + i]) + m[i]);
}

DEVFN void gemm_item(const bf16_t* A, int lda, const float* Bw, int ldb, bf16_t* C, int ldc, int N, int K, long item) {
  int ntn = N / 4;
  int mt = (int)(item / ntn), nt = (int)(item % ntn);
  int r0 = mt * 4, c0 = nt * 4;
  float acc[4][4];
#pragma unroll
  for (int i = 0; i < 4; ++i)
#pragma unroll
    for (int j = 0; j < 4; ++j) acc[i][j] = 0.f;
  for (int k = 0; k < K; k += 4) {
    float4 a[4], b[4];
#pragma unroll
    for (int i = 0; i < 4; ++i) a[i] = ld4(A + (size_t)(r0 + i) * lda + k);
#pragma unroll
    for (int kk = 0; kk < 4; ++kk) b[kk] = *(const float4*)(Bw + (size_t)(k + kk) * ldb + c0);
#pragma unroll
    for (int i = 0; i < 4; ++i) {
      float av[4] = {a[i].x, a[i].y, a[i].z, a[i].w};
#pragma unroll
      for (int kk = 0; kk < 4; ++kk) {
        acc[i][0] += av[kk] * b[kk].x;
        acc[i][1] += av[kk] * b[kk].y;
        acc[i][2] += av[kk] * b[kk].z;
        acc[i][3] += av[kk] * b[kk].w;
      }
    }
  }
#pragma unroll
  for (int i = 0; i < 4; ++i)
#pragma unroll
    for (int j = 0; j < 4; ++j) C[(size_t)(r0 + i) * ldc + c0 + j] = f2bf(acc[i][j]);
}

DEVFN void ph_rope(const Params& p, long item) {
  int token = (int)(item / 256), j = (int)(item % 256);
  int which = j / 128, jj = j % 128, h = jj / 32, pr = jj % 32, blk = pr / 8, i = pr % 8;
  int t = token % NTL;
  int pos = (blk & 1) ? (t % 64) : (t / 64);
  float inv = expf(-(float)i * (9.210340371976184f / 8.0f));
  float ang = (float)pos * inv;
  float cs = FCOS(ang), sn = FSIN(ang);
  bf16_t* base = p.P() + (size_t)token * INC + OFF_A + which * 256 + h * 64 + blk * 16;
  float x1 = bf2f(base[i]), x2 = bf2f(base[i + 8]);
  base[i] = f2bf(x1 * cs - x2 * sn);
  base[i + 8] = f2bf(x1 * sn + x2 * cs);
}

DEVFN float dot32(const bf16_t* q, const bf16_t* k) {
  float s = 0.f;
#pragma unroll
  for (int d = 0; d < 32; d += 4) {
    float4 kv = ld4(k + d);
    float4 qv = ld4(q + d);
    s += qv.x * kv.x + qv.y * kv.y + qv.z * kv.z + qv.w * kv.w;
    if ((d & 15) == 12) LOAD_FENCE();
  }
  return s;
}

DEVFN void mixA_item(const Params& p, int l, int b, int h, int qrow, bool lat) {
  const float* lv = p.diff_lam + l * 128;
  float d01 = 0.f, d23 = 0.f;
#pragma unroll 4
  for (int i = 0; i < 32; ++i) { d01 += lv[i] * lv[32 + i]; d23 += lv[64 + i] * lv[96 + i]; }
  float lam_init = 0.8f - 0.6f * expf(-0.3f * (float)l);
  float lam = expf(d01) - expf(d23) + lam_init;
  const float scale = 0.17677669529663687f;
  const bf16_t* q = p.P() + (size_t)qrow * INC + OFF_A + h * 64;
  int nlat = lat ? NTL : 0;
  int nk = nlat + NCX;
  float m1 = -1e30f, l1 = 0.f, m2 = -1e30f, l2 = 0.f;
  for (int j = 0; j < nk; ++j) {
    int krow = j < nlat ? b * NTL + j : NLAT + b * NCX + (j - nlat);
    const bf16_t* kp = p.P() + (size_t)krow * INC + OFF_A + 256 + h * 64;
    float s1 = dot32(q, kp) * scale, s2 = dot32(q + 32, kp + 32) * scale;
    float n1 = fmaxf(m1, s1); l1 = l1 * expf(m1 - n1) + expf(s1 - n1); m1 = n1;
    float n2 = fmaxf(m2, s2); l2 = l2 * expf(m2 - n2) + expf(s2 - n2); m2 = n2;
  }
  float i1 = 1.0f / l1, i2 = lam / l2;
  bf16_t* yp = p.Y() + (size_t)qrow * DM + 0 + h * 64;
  float ss = 0.f;
  for (int dh = 0; dh < 2; ++dh) {
    float o[32];
#pragma unroll
    for (int d = 0; d < 32; ++d) o[d] = 0.f;
    for (int j = 0; j < nk; ++j) {
      int krow = j < nlat ? b * NTL + j : NLAT + b * NCX + (j - nlat);
      const bf16_t* kp = p.P() + (size_t)krow * INC + OFF_A + 256 + h * 64;
      float s1 = dot32(q, kp) * scale, s2 = dot32(q + 32, kp + 32) * scale;
      float pw = expf(s1 - m1) * i1 - expf(s2 - m2) * i2;
      const bf16_t* vp = kp + 256 + dh * 32;
#pragma unroll
      for (int d = 0; d < 32; d += 4) {
        float4 vv = ld4(vp + d);
        o[d] += pw * vv.x; o[d + 1] += pw * vv.y; o[d + 2] += pw * vv.z; o[d + 3] += pw * vv.w;
      }
    }
#pragma unroll
    for (int d = 0; d < 32; ++d) { ss += o[d] * o[d]; yp[dh * 32 + d] = f2bf(o[d]); }
  }
  float rs = (1.0f / sqrtf(ss * (1.0f / 64) + 1e-6f)) * (1.0f - lam_init);
  const float* g = p.diff_norm_g + l * 64;
#pragma unroll 4
  for (int d = 0; d < 64; ++d) yp[d] = f2bf(bf2f(yp[d]) * rs * g[d]);
}

DEVFN float dot64s(const bf16_t* q, const bf16_t* k) {
  float s = 0.f;
#pragma unroll
  for (int d = 0; d < 64; d += 4) {
    float4 kv = ld4(k + d);
    float4 qv = ld4(q + d);
    s += qv.x * kv.x + qv.y * kv.y + qv.z * kv.z + qv.w * kv.w;
    if ((d & 15) == 12) LOAD_FENCE();
  }
  return s;
}

DEVFN void mixD_item(const Params& p, int l, int b, int h, int qrow, bool lat, int t) {
  const bf16_t* q = p.P() + (size_t)qrow * INC + OFF_D + h * 64;
  int r = t / 64, cq = t % 64;
  int rs = r - 4; rs = rs < 0 ? 0 : (rs > GROWS - 8 ? GROWS - 8 : rs);
  int cs = cq - 8; cs = cs < 0 ? 0 : (cs > 48 ? 48 : cs);
  const float* rpb = p.nat_rpb + ((size_t)l * 4 + h) * 15 * 31;
  int nwin = lat ? 128 : 0;
  int nk = nwin + NCX;
  float m = -1e30f, ls = 0.f;
  bf16_t* yp = p.Y() + (size_t)qrow * DM + 768 + h * 64;
  for (int pass = 0; pass < 3; ++pass) {
    float inv = pass ? 1.0f / ls : 0.f;
    float o[32];
#pragma unroll
    for (int d = 0; d < 32; ++d) o[d] = 0.f;
    for (int j = 0; j < nk; ++j) {
      int krow; float bias = 0.f;
      if (j < nwin) {
        int i = j / 16, jj = j % 16;
        krow = b * NTL + (rs + i) * 64 + cs + jj;
        int dr = rs + i - r + 7;
        int dc = cs + jj - cq; dc = dc < -15 ? -15 : (dc > 15 ? 15 : dc); dc += 15;
        bias = rpb[dr * 31 + dc];
      } else {
        krow = NLAT + b * NCX + (j - nwin);
      }
      const bf16_t* kp = p.P() + (size_t)krow * INC + OFF_D + 256 + h * 64;
      float s = dot64s(q, kp) * 0.125f + bias;
      if (!pass) {
        float n = fmaxf(m, s); ls = ls * expf(m - n) + expf(s - n); m = n;
      } else {
        float pw = expf(s - m) * inv;
        const bf16_t* vp = kp + 256 + (pass - 1) * 32;
#pragma unroll
        for (int d = 0; d < 32; d += 4) {
          float4 vv = ld4(vp + d);
          o[d] += pw * vv.x; o[d + 1] += pw * vv.y; o[d + 2] += pw * vv.z; o[d + 3] += pw * vv.w;
        }
      }
    }
    if (pass) {
#pragma unroll
      for (int d = 0; d < 32; ++d) yp[(pass - 1) * 32 + d] = f2bf(o[d]);
    }
  }
}

DEVFN float rw_conv(const Params& p, int l, int row, int col, bool hp, bool hn) {
  const float* mu = p.rwkv_mu + (size_t)l * 2 * 1152;
  float m0 = mu[col], m1 = mu[1152 + col];
  const bf16_t* c = p.P() + (size_t)row * INC + OFF_B + col;
  float v = bf2f(c[0]) * (1.0f - m0 - m1);
  if (hp) v += bf2f(c[-INC]) * m0;
  if (hn) v += bf2f(c[INC]) * m1;
  return v;
}
DEVFN void rwprep_item(const Params& p, int l, long item) {
  int row = (int)(item / 256), c = (int)(item % 256);
  int h = c / 64;
  int t, len; seq_pos(row, t, len);
  bool hp = t > 0, hn = t < len - 1;
  float r = rw_conv(p, l, row, c, hp, hn);
  float k = rw_conv(p, l, row, 256 + c, hp, hn);
  float v = rw_conv(p, l, row, 512 + c, hp, hn);
  float wr[2], ar[2];
#pragma unroll
  for (int d = 0; d < 2; ++d) {
    float aw = p.rwkv_w0[(l * 2 + d) * 256 + c];
    float aa = p.rwkv_a0[(l * 2 + d) * 256 + c];
#pragma unroll 2
    for (int rr = 0; rr < 64; ++rr) {
      aw += tanhf_(rw_conv(p, l, row, 768 + d * 64 + rr, hp, hn)) * p.rwkv_w2[((size_t)(l * 2 + d) * 64 + rr) * 256 + c];
      aa += rw_conv(p, l, row, 896 + d * 64 + rr, hp, hn) * p.rwkv_a2[((size_t)(l * 2 + d) * 64 + rr) * 256 + c];
    }
    wr[d] = FEXP(-sigmoidf_(aw) * 0.6065306597126334f);
    ar[d] = sigmoidf_(aa);
  }
  float g = 0.f;
#pragma unroll 2
  for (int rr = 0; rr < 128; ++rr)
    g += sigmoidf_(rw_conv(p, l, row, 1024 + rr, hp, hn)) * p.rwkv_g2[((size_t)l * 128 + rr) * 256 + c];
  float n2 = 0.f;
#pragma unroll 2
  for (int cc = h * 64; cc < h * 64 + 64; ++cc) {
    float kc = rw_conv(p, l, row, 256 + cc, hp, hn) * p.rwkv_kk[l * 256 + cc];
    n2 += kc * kc;
  }
  float kk = k * p.rwkv_kk[l * 256 + c] * (1.0f / sqrtf(n2 + 1e-6f));
  float ka = p.rwkv_ka[l * 256 + c];
  float* o = p.RW() + (size_t)row * RWS;
  o[c] = r; o[256 + c] = v; o[512 + c] = g; o[768 + c] = kk;
  o[1024 + c] = wr[0]; o[1280 + c] = wr[1];
  o[1536 + c] = kk * ar[0]; o[1792 + c] = kk * ar[1];
  o[2048 + c] = k * (1.0f + (ar[0] - 1.0f) * ka);
  o[2304 + c] = k * (1.0f + (ar[1] - 1.0f) * ka);
}

DEVFN float gd_conv(const Params& p, int l, int row, int col, bool hp, bool hn) {
  const float* cw = p.gdn_conv + (size_t)l * 3 * 768;
  const bf16_t* c = p.P() + (size_t)row * INC + OFF_C + col;
  float v = bf2f(c[0]) * cw[768 + col];
  if (hp) v += bf2f(c[-INC]) * cw[col];
  if (hn) v += bf2f(c[INC]) * cw[1536 + col];
  return siluf_(v);
}
DEVFN void gdprep_item(const Params& p, int l, long item) {
  int row = (int)(item / 256), c = (int)(item % 256);
  int h = c / 64;
  int t, len; seq_pos(row, t, len);
  bool hp = t > 0, hn = t < len - 1;
  float q = gd_conv(p, l, row, c, hp, hn);
  float k = gd_conv(p, l, row, 256 + c, hp, hn);
  float v = gd_conv(p, l, row, 512 + c, hp, hn);
  float nq = 0.f, nk = 0.f;
#pragma unroll 2
  for (int cc = h * 64; cc < h * 64 + 64; ++cc) {
    float a = gd_conv(p, l, row, cc, hp, hn); nq += a * a;
    float bq = gd_conv(p, l, row, 256 + cc, hp, hn); nk += bq * bq;
  }
  float* o = p.GP() + (size_t)row * GPS;
  o[c] = q * (1.0f / sqrtf(nq + 1e-6f)) * 0.125f;
  o[256 + c] = k * (1.0f / sqrtf(nk + 1e-6f));
  o[512 + c] = v;
  if (c < 8) {
    int d = c / 4, hh = c % 4;
    const bf16_t* ab = p.P() + (size_t)row * INC + OFF_C + 1024;
    float la = -FEXP(p.gdn_a_log[(l * 2 + d) * 4 + hh]) * softplusf_(bf2f(ab[d * 4 + hh]) + p.gdn_dt_bias[(l * 2 + d) * 4 + hh]);
    o[768 + c] = la;
    o[776 + c] = sigmoidf_(bf2f(ab[8 + d * 4 + hh]));
  }
}

DEVFN int scan_row(int b, int d, int step) {
  if (step < NCX) return NLAT + b * NCX + (d ? NCX - 1 - step : step);
  int s2 = step - NCX;
  return b * NTL + (d ? NTL - 1 - s2 : s2);
}
DEVFN void rwscan_item(const Params& p, bool last, long item) {
  int v = (int)(item % 64), h = (int)((item / 64) % 4), b = (int)((item / 256) % NB), d = (int)(item / (256 * NB));
  float s[64];
#pragma unroll
  for (int k = 0; k < 64; ++k) s[k] = 0.f;
  for (int step = 0; step < NCX + NTL; ++step) {
    int row = scan_row(b, d, step);
    const float* base = p.RW() + (size_t)row * RWS + h * 64;
    const float* kkp = base + 768;
    const float* wp = base + 1024 + d * 256;
    const float* kap = base + 1536 + d * 256;
    const float* kdp = base + 2048 + d * 256;
    float vv = base[256 + v];
    float sa = 0.f;
#pragma unroll
    for (int k = 0; k < 64; ++k) sa += s[k] * kkp[k];
    float y = 0.f;
#pragma unroll
    for (int k = 0; k < 64; ++k) {
      s[k] = s[k] * wp[k] - sa * kap[k] + vv * kdp[k];
      y += s[k] * base[k];
    }
    if (!(last && row >= NLAT)) p.YS()[(size_t)row * 1024 + d * 256 + h * 64 + v] = f2bf(y);
  }
}
DEVFN void gdscan_item(const Params& p, bool last, long item) {
  int dv = (int)(item % 64), h = (int)((item / 64) % 4), b = (int)((item / 256) % NB), d = (int)(item / (256 * NB));
  float s[64];
#pragma unroll
  for (int k = 0; k < 64; ++k) s[k] = 0.f;
  for (int step = 0; step < NCX + NTL; ++step) {
    int row = scan_row(b, d, step);
    const float* base = p.GP() + (size_t)row * GPS;
    const float* qp = base + h * 64;
    const float* kp = base + 256 + h * 64;
    float vv = base[512 + h * 64 + dv];
    float eg = FEXP(base[768 + d * 4 + h]);
    float beta = base[776 + d * 4 + h];
    float ks = 0.f;
#pragma unroll
    for (int k = 0; k < 64; ++k) { s[k] *= eg; ks += kp[k] * s[k]; }
    float vn = beta * (vv - ks);
    float o = 0.f;
#pragma unroll
    for (int k = 0; k < 64; ++k) { s[k] += kp[k] * vn; o += qp[k] * s[k]; }
    if (!(last && row >= NLAT)) p.YS()[(size_t)row * 1024 + 512 + d * 256 + h * 64 + dv] = f2bf(o);
  }
}

DEVFN void rwpost_item(const Params& p, int l, int row, int h) {
  const bf16_t* y0 = p.YS() + (size_t)row * 1024 + h * 64;
  const float* rw = p.RW() + (size_t)row * RWS + h * 64;
  float y[64];
  float m = 0.f;
#pragma unroll
  for (int k = 0; k < 64; ++k) { y[k] = bf2f(y0[k]) + bf2f(y0[256 + k]); m += y[k]; if ((k & 7) == 7) LOAD_FENCE(); }
  m *= (1.0f / 64);
  float var = 0.f;
#pragma unroll
  for (int k = 0; k < 64; ++k) { float dd = y[k] - m; var += dd * dd; }
  float rstd = 1.0f / sqrtf(var * (1.0f / 64) + 64e-5f);
  float bonus = 0.f;
  const float* rk = p.rwkv_rk + (l * 4 + h) * 64;
#pragma unroll
  for (int k = 0; k < 64; ++k) { bonus += rw[k] * (rw[2048 + k] + rw[2304 + k]) * rk[k]; if ((k & 7) == 7) LOAD_FENCE(); }
  bf16_t* yp = p.Y() + (size_t)row * DM + 256 + h * 64;
  const float* lg = p.rwkv_ln_g + l * 256 + h * 64;
  const float* lb = p.rwkv_ln_b + l * 256 + h * 64;
#pragma unroll
  for (int k = 0; k < 64; ++k) { yp[k] = f2bf(((y[k] - m) * rstd * lg[k] + lb[k] + bonus * rw[256 + k]) * rw[512 + k]); if ((k & 7) == 7) LOAD_FENCE(); }
}
DEVFN void gdpost_item(const Params& p, int l, int row, int h) {
  const bf16_t* o0 = p.YS() + (size_t)row * 1024 + 512 + h * 64;
  const bf16_t* gate = p.P() + (size_t)row * INC + OFF_C + 768 + h * 64;
  float o[64];
  float ss = 0.f;
#pragma unroll
  for (int k = 0; k < 64; ++k) { o[k] = bf2f(o0[k]) + bf2f(o0[256 + k]); ss += o[k] * o[k]; if ((k & 7) == 7) LOAD_FENCE(); }
  float rs = 1.0f / sqrtf(ss * (1.0f / 64) + 1e-6f);
  const float* g = p.gdn_norm_g + l * 64;
  bf16_t* yp = p.Y() + (size_t)row * DM + 512 + h * 64;
#pragma unroll
  for (int k = 0; k < 64; ++k) { yp[k] = f2bf(o[k] * rs * g[k] * siluf_(bf2f(gate[k]))); if ((k & 7) == 7) LOAD_FENCE(); }
}

DEVFN void ph_pn1(const Params& p, int l, long item) {
  int row = (int)item;
  const float* hs = hsrc_row(p, l, row);
  float* hd = hdst_row(p, row);
  const float* m = p.mod() + ((size_t)l * NMODV + modv_of_row(row)) * 6144;
  const bf16_t* mix = (const bf16_t*)p.RW() + (size_t)row * DM;
  float s = 0.f;
  for (int i = 0; i < DM; ++i) s += DN_ALPHA * hs[i] + m[2048 + i] * bf2f(mix[i]);
  float mu = s * (1.0f / DM);
  float v = 0.f;
  for (int i = 0; i < DM; ++i) { float z = DN_ALPHA * hs[i] + m[2048 + i] * bf2f(mix[i]) - mu; v += z * z; }
  float rstd = 1.0f / sqrtf(v * (1.0f / DM) + LN_EPS);
  const float* g = p.ln_mix_g + l * DM;
  const float* bb = p.ln_mix_b + l * DM;
  float s2 = 0.f;
  for (int i = 0; i < DM; ++i) {
    float z = DN_ALPHA * hs[i] + m[2048 + i] * bf2f(mix[i]);
    float hn = (z - mu) * rstd * g[i] + bb[i];
    hd[i] = hn;
    s2 += hn;
  }
  float mu2 = s2 * (1.0f / DM);
  float v2 = 0.f;
  for (int i = 0; i < DM; ++i) { float dd = hd[i] - mu2; v2 += dd * dd; }
  float rstd2 = 1.0f / sqrtf(v2 * (1.0f / DM) + LN_EPS);
  bf16_t* x2 = p.Y() + (size_t)row * DM;
  for (int i = 0; i < DM; ++i) x2[i] = f2bf((hd[i] - mu2) * rstd2 * (1.0f + m[4096 + i]) + m[3072 + i]);
}
DEVFN void ph_pn2(const Params& p, int l, long item) {
  int row = (int)item;
  float* hd = hdst_row(p, row);
  const float* m = p.mod() + ((size_t)l * NMODV + modv_of_row(row)) * 6144;
  const float* ffn = p.RW() + (size_t)row * DM;
  float s = 0.f;
  for (int i = 0; i < DM; ++i) s += DN_ALPHA * hd[i] + m[5120 + i] * ffn[i];
  float mu = s * (1.0f / DM);
  float v = 0.f;
  for (int i = 0; i < DM; ++i) { float z = DN_ALPHA * hd[i] + m[5120 + i] * ffn[i] - mu; v += z * z; }
  float rstd = 1.0f / sqrtf(v * (1.0f / DM) + LN_EPS);
  const float* g = p.ln_ffn_g + l * DM;
  const float* bb = p.ln_ffn_b + l * DM;
  for (int i = 0; i < DM; ++i) {
    float z = DN_ALPHA * hd[i] + m[5120 + i] * ffn[i];
    hd[i] = (z - mu) * rstd * g[i] + bb[i];
  }
}

DEVFN bf16_t* peerQ(const Params& p) { return p.P(); }
DEVFN float* selbase(const Params& p) { return p.RW() + (size_t)NTOK * 1024; }
DEVFN float* sel1s(const Params& p) { return selbase(p); }
DEVFN int* sel1i(const Params& p) { return (int*)(selbase(p) + (size_t)NTOK * 256); }
DEVFN int* sel2i(const Params& p) { return (int*)(selbase(p) + (size_t)NTOK * 512); }
DEVFN float* sel2g(const Params& p) { return selbase(p) + (size_t)NTOK * 640; }
DEVFN float* coefb(const Params& p) { return selbase(p) + (size_t)NTOK * 768; }

#define TOPK_INSERT(ts, ti, xs, xi)                                      \
  {                                                                      \
    float cs_ = (xs); int ci_ = (xi);                                    \
    _Pragma("unroll") for (int z_ = 0; z_ < 16; ++z_) {                  \
      bool gt_ = cs_ > ts[z_];                                           \
      float os_ = ts[z_]; int oi_ = ti[z_];                              \
      ts[z_] = gt_ ? cs_ : os_; ti[z_] = gt_ ? ci_ : oi_;                \
      cs_ = gt_ ? os_ : cs_; ci_ = gt_ ? oi_ : ci_;                      \
    }                                                                    \
  }

DEVFN void ph_topk1(const Params& p, int l, int nrows, long item) {
  int hp = (int)(item / nrows), row = (int)(item % nrows);
  const bf16_t* q = peerQ(p) + (size_t)row * 2048 + hp * 128;
  const float* keys = p.peer_keys + ((size_t)l * 16 + hp) * 128 * 128;
  float ts[16]; int ti[16];
#pragma unroll
  for (int z = 0; z < 16; ++z) { ts[z] = -3e38f; ti[z] = 0; }
  for (int n = 0; n < 128; ++n) {
    const float* kr = keys + n * 128;
    float s = 0.f;
#pragma unroll 8
    for (int d = 0; d < 128; d += 4) {
      float4 qa = ld4(q + d), kb = *(const float4*)(kr + d);
      s += qa.x * kb.x; s += qa.y * kb.y; s += qa.z * kb.z; s += qa.w * kb.w;
    }
    TOPK_INSERT(ts, ti, s, n);
  }
  float* os = sel1s(p) + ((size_t)row * 16 + hp) * 16;
  int* oi = sel1i(p) + ((size_t)row * 16 + hp) * 16;
#pragma unroll
  for (int z = 0; z < 16; ++z) { os[z] = ts[z]; oi[z] = ti[z]; }
}
DEVFN void ph_topk2(const Params& p, int nrows, long item) {
  int h = (int)(item / nrows), row = (int)(item % nrows);
  const float* s0 = sel1s(p) + ((size_t)row * 16 + h * 2) * 16;
  const int* i0 = sel1i(p) + ((size_t)row * 16 + h * 2) * 16;
  float s1[16]; int i1[16];
#pragma unroll
  for (int z = 0; z < 16; ++z) { s1[z] = s0[16 + z]; i1[z] = i0[16 + z]; }
  float ts[16]; int ti[16];
#pragma unroll
  for (int z = 0; z < 16; ++z) { ts[z] = -3e38f; ti[z] = 0; }
  for (int i = 0; i < 16; ++i) {
    float a = s0[i]; int ai = i0[i] * 128;
#pragma unroll
    for (int j = 0; j < 16; ++j) TOPK_INSERT(ts, ti, a + s1[j], ai + i1[j]);
  }
  float sum = 0.f;
  float mx = ts[0];
#pragma unroll
  for (int z = 0; z < 16; ++z) { ts[z] = expf(ts[z] - mx); }
#pragma unroll
  for (int z = 0; z < 16; ++z) sum += ts[z];
  float inv = 1.0f / sum;
  int* oi = sel2i(p) + ((size_t)row * 8 + h) * 16;
  float* og = sel2g(p) + ((size_t)row * 8 + h) * 16;
#pragma unroll
  for (int z = 0; z < 16; ++z) { oi[z] = ti[z]; og[z] = ts[z] * inv; }
}
DEVFN void ph_act(const Params& p, int l, long item) {
  int row = (int)(item / 128);
  int idx = sel2i(p)[item];
  const bf16_t* x2 = p.Y() + (size_t)row * DM;
  const float* u = p.peer_u + ((size_t)l * 16384 + idx) * DM;
  float s = 0.f;
  for (int i = 0; i < DM; i += 4) {
    float4 a = ld4(x2 + i), b = *(const float4*)(u + i);
    s += a.x * b.x + a.y * b.y + a.z * b.z + a.w * b.w;
  }
  coefb(p)[item] = sel2g(p)[item] * geluf_(s);
}
DEVFN void ph_ffn(const Params& p, int l, long item) {
  int row = (int)(item / 256), c4 = (int)(item % 256);
  const int* idx = sel2i(p) + (size_t)row * 128;
  const float* cf = coefb(p) + (size_t)row * 128;
  float4 acc = make_float4(0.f, 0.f, 0.f, 0.f);
  for (int j = 0; j < 128; ++j) {
    float4 vv = *(const float4*)(p.peer_v + ((size_t)l * 16384 + idx[j]) * DM + c4 * 4);
    float c = cf[j];
    acc.x += c * vv.x; acc.y += c * vv.y; acc.z += c * vv.z; acc.w += c * vv.w;
  }
  *(float4*)(p.RW() + (size_t)row * DM + c4 * 4) = acc;
}

enum { PH_ADA = 0, PH_LN1, PH_GEMM_IN, PH_ROPE, PH_MIX, PH_GDPREP, PH_SCAN, PH_POST, PH_GEMM_OUT, PH_PN1, PH_GEMM_Q,
       PH_TOPK1, PH_TOPK2, PH_ACT, PH_FFN, PH_PN2, PH_COUNT };

HDFN int rows_out(int l) { return l == 1 ? NLAT : NTOK; }

HDFN long phase_items(int ph, int l) {
  bool last = l == 1;
  long nr = rows_out(l);
  switch (ph) {
    case PH_ADA: return l == 0 ? 2 * 6144 : 0;
    case PH_LN1: return NTOK;
    case PH_GEMM_IN: return (long)(NTOK / 4) * (INC / 4);
    case PH_ROPE: return (long)NLAT * 256;
    case PH_MIX: return 2L * NB * 4 * NTL + (last ? 0 : 2L * NB * 4 * NCX) + (long)NTOK * 256;
    case PH_GDPREP: return (long)NTOK * 256;
    case PH_SCAN: return 2L * 2 * NB * 4 * 64;
    case PH_POST: return nr * 4 * 2;
    case PH_GEMM_OUT: return (nr / 4) * (DM / 4);
    case PH_PN1: return nr;
    case PH_GEMM_Q: return (nr / 4) * (2048 / 4);
    case PH_TOPK1: return nr * 16;
    case PH_TOPK2: return nr * 8;
    case PH_ACT: return nr * 128;
    case PH_FFN: return nr * 256;
    case PH_PN2: return nr;
  }
  return 0;
}

template <int PH>
DEVFN void phase_item(const Params& p, int l, long item) {
  bool last = l == 1;
  int nr = rows_out(l);
  if (PH == PH_ADA) ph_ada(p, item);
  else if (PH == PH_LN1) ph_ln1(p, l, item);
  else if (PH == PH_GEMM_IN) gemm_item(p.Y(), DM, p.w_in + (size_t)l * DM * INC, INC, p.P(), INC, INC, DM, item);
  else if (PH == PH_ROPE) ph_rope(p, item);
  else if (PH == PH_MIX) {
    long nAl = (long)NB * 4 * NTL, nAc = last ? 0 : (long)NB * 4 * NCX;
    if (item < nAl) {
      int bh = (int)(item / NTL), t = (int)(item % NTL);
      mixA_item(p, l, bh / 4, bh % 4, (bh / 4) * NTL + t, true);
    } else if (item < nAl + nAc) {
      long it = item - nAl; int bh = (int)(it / NCX), t = (int)(it % NCX);
      mixA_item(p, l, bh / 4, bh % 4, NLAT + (bh / 4) * NCX + t, false);
    } else if (item < 2 * nAl + nAc) {
      long it = item - nAl - nAc; int bh = (int)(it / NTL), t = (int)(it % NTL);
      mixD_item(p, l, bh / 4, bh % 4, (bh / 4) * NTL + t, true, t);
    } else if (item < 2 * nAl + 2 * nAc) {
      long it = item - 2 * nAl - nAc; int bh = (int)(it / NCX), t = (int)(it % NCX);
      mixD_item(p, l, bh / 4, bh % 4, NLAT + (bh / 4) * NCX + t, false, 0);
    } else {
      rwprep_item(p, l, item - 2 * nAl - 2 * nAc);
    }
  } else if (PH == PH_GDPREP) gdprep_item(p, l, item);
  else if (PH == PH_SCAN) {
    long n1 = 2L * NB * 4 * 64;
    if (item < n1) rwscan_item(p, last, item); else gdscan_item(p, last, item - n1);
  } else if (PH == PH_POST) {
    long n1 = (long)nr * 4;
    if (item < n1) rwpost_item(p, l, (int)(item / 4), (int)(item % 4));
    else { long it = item - n1; gdpost_item(p, l, (int)(it / 4), (int)(it % 4)); }
  } else if (PH == PH_GEMM_OUT) gemm_item(p.Y(), DM, p.w_out + (size_t)l * DM * DM, DM, (bf16_t*)p.RW(), DM, DM, DM, item);
  else if (PH == PH_PN1) ph_pn1(p, l, item);
  else if (PH == PH_GEMM_Q) gemm_item(p.Y(), DM, p.peer_wq + (size_t)l * DM * 2048, 2048, peerQ(p), 2048, 2048, DM, item);
  else if (PH == PH_TOPK1) ph_topk1(p, l, nr, item);
  else if (PH == PH_TOPK2) ph_topk2(p, nr, item);
  else if (PH == PH_ACT) ph_act(p, l, item);
  else if (PH == PH_FFN) ph_ffn(p, l, item);
  else if (PH == PH_PN2) ph_pn2(p, l, item);
}


#ifndef CPU_EMU
__device__ __forceinline__ int make_tid(int wave_s) {
  int lane;
  asm volatile("v_mbcnt_lo_u32_b32 %0, -1, 0\n\tv_mbcnt_hi_u32_b32 %0, -1, %0" : "=v"(lane));
  return wave_s * 64 + lane;
}
#define XB_TMO      128
#define XB_XCNT(j)  (256  + 64 * (j))
#define XB_XSUB(j)  (1280 + 64 * (j))
#define XB_XGEN(j)  (2304 + 64 * (j))
#define XB_TOP      3328
#define XB_TOPGEN   3392
#define XCD_BAR_WORDS 3456
#define XB_SPIN_CAP (1u << 18)
#define LAS __attribute__((address_space(3)))

__device__ __forceinline__ unsigned xb_ld(unsigned* p)              { return __hip_atomic_load(p, __ATOMIC_RELAXED, __HIP_MEMORY_SCOPE_AGENT); }
__device__ __forceinline__ unsigned xb_add(unsigned* p, unsigned v) { return __hip_atomic_fetch_add(p, v, __ATOMIC_RELAXED, __HIP_MEMORY_SCOPE_AGENT); }
__device__ __forceinline__ unsigned xb_xcc_id() { return (unsigned)__builtin_amdgcn_s_getreg((3 << 11) | 20) & 0xFu; }
#define XB_SPIN(cond, bar) do { unsigned _sp = 0; while (cond) { __builtin_amdgcn_s_sleep(1); \
    if ((++_sp & 255u) == 0u) { if (xb_ld(&(bar)[XB_TMO])) break; if (_sp > XB_SPIN_CAP) { atomicAdd(&(bar)[XB_TMO], 1u); break; } } } } while (0)

struct XcdBarrier {
    unsigned* bar; unsigned x;
    volatile LAS unsigned* st;
};

__device__ __forceinline__ XcdBarrier xcd_barrier_post(unsigned* bar, volatile LAS unsigned* st) {
    XcdBarrier b; b.bar = bar; b.x = xb_xcc_id(); b.st = st;
    if (threadIdx.x == 0) (void)xb_add(&bar[XB_XCNT(b.x)], 1u);
    return b;
}
__device__ __forceinline__ void xcd_barrier_complete(unsigned* bar, unsigned x, unsigned& nloc, unsigned& nx) {
    const unsigned G = gridDim.x * gridDim.y * gridDim.z;
    unsigned sum, cnt, mine, sp = 0u;
    for (;;) {
        sum = 0u; cnt = 0u; mine = 0u;
#pragma unroll
        for (unsigned j = 0; j < 16; ++j) { const unsigned c = xb_ld(&bar[XB_XCNT(j)]); sum += c; cnt += (c > 0u) ? 1u : 0u; mine = (j == x) ? c : mine; }
        if (sum == G) break;
        __builtin_amdgcn_s_sleep(1);
        if ((++sp & 255u) == 0u) { if (xb_ld(&bar[XB_TMO])) break; if (sp > XB_SPIN_CAP) { atomicAdd(&bar[XB_TMO], 1u); break; } }
    }
    nloc = mine > 0u ? mine : 1u; nx = cnt > 0u ? cnt : 1u;
}

__device__ __forceinline__ void xcd_barrier(const XcdBarrier& b, int wave_s) {
    asm volatile("s_waitcnt vmcnt(0)" ::: "memory");
    __syncthreads();
    if (make_tid(wave_s) == 0) {
        unsigned* bar = b.bar;
        __builtin_amdgcn_s_waitcnt(0);
        unsigned nloc = b.st[0], nx = b.st[1];
        if (nloc == 0u) { xcd_barrier_complete(bar, b.x, nloc, nx); b.st[0] = nloc; b.st[1] = nx; }
        const unsigned old = xb_add(&bar[XB_XSUB(b.x)], 1u);
        const unsigned gen = old / nloc;
        if (old + 1u == (gen + 1u) * nloc) {
            __builtin_amdgcn_fence(__ATOMIC_RELEASE, "agent");
            asm volatile("s_waitcnt vmcnt(0)" ::: "memory");
            const unsigned og = xb_add(&bar[XB_TOP], 1u);
            const unsigned tg = og / nx;
            if (og + 1u == (tg + 1u) * nx) xb_add(&bar[XB_TOPGEN], 1u);
            else XB_SPIN(xb_ld(&bar[XB_TOPGEN]) == tg, bar);
            __builtin_amdgcn_fence(__ATOMIC_ACQUIRE, "agent");
            xb_add(&bar[XB_XGEN(b.x)], 1u);
            asm volatile("s_waitcnt vmcnt(0)" ::: "memory");
        } else {
            XB_SPIN(xb_ld(&bar[XB_XGEN(b.x)]) == gen, bar);
            __builtin_amdgcn_fence(__ATOMIC_ACQUIRE, "agent");
            asm volatile("s_waitcnt vmcnt(0)" ::: "memory");
        }
    }
    __syncthreads();
}


constexpr int NTHREADS = 512;
typedef __attribute__((ext_vector_type(8))) __bf16 bf16x8;
typedef __attribute__((ext_vector_type(2))) __bf16 bf16x2;
typedef __attribute__((ext_vector_type(2))) float f32x2;
typedef __attribute__((ext_vector_type(4))) float f32x4;

__device__ __forceinline__ unsigned pk_bf16(float a, float b) {
  f32x2 v = {a, b};
  return __builtin_bit_cast(unsigned, __builtin_convertvector(v, bf16x2));
}

constexpr int NPAD_IN = 3840;
constexpr size_t WBT_LAYER = (size_t)(NPAD_IN + 1024 + 2048) * 1024;
__device__ __forceinline__ bf16_t* wbt_in(const Params& p, int l) { return p.WBT() + (size_t)l * WBT_LAYER; }
__device__ __forceinline__ bf16_t* wbt_out(const Params& p, int l) { return p.WBT() + (size_t)l * WBT_LAYER + (size_t)NPAD_IN * 1024; }
__device__ __forceinline__ bf16_t* wbt_q(const Params& p, int l) { return p.WBT() + (size_t)l * WBT_LAYER + (size_t)(NPAD_IN + 1024) * 1024; }

__device__ __forceinline__ void conv_weight_tiles(const float* W, int N, int npad, bf16_t* Bt, char* smem, int tid) {
  bf16_t* T = (bf16_t*)smem;
  const int ntn = npad / 64, ntiles = 16 * ntn;
  for (int t0 = blockIdx.x * 4; t0 < ntiles; t0 += gridDim.x * 4) {
    float4 v[4][2];
#pragma unroll
    for (int q = 0; q < 4; ++q) {
      const int tt = t0 + q, kt = tt / ntn, nt = tt % ntn;
#pragma unroll
      for (int j = 0; j < 2; ++j) {
        const int k = (tid >> 4) + 32 * j, n = nt * 64 + (tid & 15) * 4;
        const bool ok = tt < ntiles && n < N;
        v[q][j] = *(const float4*)(W + (size_t)((ok ? kt : 0) * 64 + k) * N + (ok ? n : 0));
      }
    }
#pragma unroll
    for (int q = 0; q < 4; ++q) {
      const int tt = t0 + q, nt = tt % ntn;
      const bool ok = tt < ntiles && nt * 64 + (tid & 15) * 4 < N;
#pragma unroll
      for (int j = 0; j < 2; ++j) if (!ok) v[q][j] = make_float4(0.f, 0.f, 0.f, 0.f);
    }
#pragma unroll
    for (int q = 0; q < 4; ++q)
#pragma unroll
      for (int j = 0; j < 2; ++j) {
        const int k = (tid >> 4) + 32 * j, n4 = (tid & 15) * 4;
        bf16_t* Tq = T + q * 64 * 72;
        Tq[(n4 + 0) * 72 + k] = f2bf(v[q][j].x); Tq[(n4 + 1) * 72 + k] = f2bf(v[q][j].y);
        Tq[(n4 + 2) * 72 + k] = f2bf(v[q][j].z); Tq[(n4 + 3) * 72 + k] = f2bf(v[q][j].w);
      }
    LDS_BAR();
#pragma unroll
    for (int q = 0; q < 4; ++q) {
      const int tt = t0 + q, kt = tt / ntn, nt = tt % ntn;
      const int n = tid >> 3, kc = tid & 7;
      if (tt < ntiles) *(uint4*)(Bt + (size_t)(nt * 64 + n) * 1024 + kt * 64 + kc * 8) = *(const uint4*)(T + q * 64 * 72 + n * 72 + kc * 8);
    }
    LDS_BAR();
  }
}
__device__ __forceinline__ void conv_weights(const Params& p, char* smem, int wave_s) {
  int tid = make_tid(wave_s);
  for (int l = 0; l < 2; ++l) {
    conv_weight_tiles(p.w_in + (size_t)l * DM * INC, INC, NPAD_IN, wbt_in(p, l), smem, tid);
    conv_weight_tiles(p.w_out + (size_t)l * DM * DM, DM, DM, wbt_out(p, l), smem, tid);
    conv_weight_tiles(p.peer_wq + (size_t)l * DM * 2048, 2048, 2048, wbt_q(p, l), smem, tid);
  }
}

template <int BM>
__device__ __forceinline__ void gemm_tile(const bf16_t* __restrict__ A, int lda, const bf16_t* __restrict__ Bt, int N,
                                          bf16_t* __restrict__ C, int ldc, int m0, int n0, char* smem, int tid) {
  constexpr int WM = BM / 4, MJ = WM / 16, ACH = BM * 8 / NTHREADS;
  constexpr int ABYTES = BM * 128, BBYTES = 128 * 128;
  const int lane = tid & 63, w = tid >> 6, wm = w >> 1, wn = w & 1;
  char* As = smem;
  char* Bs = smem + 3 * ABYTES;
  f32x4 acc[4][MJ];
#pragma unroll
  for (int i = 0; i < 4; ++i)
#pragma unroll
    for (int j = 0; j < MJ; ++j) acc[i][j] = f32x4{0.f, 0.f, 0.f, 0.f};
  typedef __attribute__((address_space(3))) void* lds_ptr;
  const int srow = lane >> 3, schunk = (lane & 7) ^ (lane >> 3);
  const bf16_t* aptr[ACH];
  const bf16_t* bptr[2];
#pragma unroll
  for (int i = 0; i < ACH; ++i) aptr[i] = A + (size_t)(m0 + (w + 8 * i) * 8 + srow) * lda + schunk * 8;
#pragma unroll
  for (int i = 0; i < 2; ++i) bptr[i] = Bt + (size_t)(n0 + (w + 8 * i) * 8 + srow) * 1024 + schunk * 8;
#define GEMM_STAGE(kt, buf)                                                                                   \
  {                                                                                                           \
    _Pragma("unroll") for (int i = 0; i < ACH; ++i)                                                           \
      __builtin_amdgcn_global_load_lds((const void*)(aptr[i] + (kt) * 64), (lds_ptr)(As + (buf) * ABYTES + (w + 8 * i) * 1024 + lane * 16), 16, 0, 0); \
    _Pragma("unroll") for (int i = 0; i < 2; ++i)                                                             \
      __builtin_amdgcn_global_load_lds((const void*)(bptr[i] + (kt) * 64), (lds_ptr)(Bs + (buf) * BBYTES + (w + 8 * i) * 1024 + lane * 16), 16, 0, 0); \
  }
  const int l15 = lane & 15, lq = lane >> 4, sw = lane & 7;
  const int bbase = (wn * 64 + l15) * 128, abase = (wm * WM + l15) * 128;
  GEMM_STAGE(0, 0);
  GEMM_STAGE(1, 1);
  int buf = 0;
  for (int kt = 0; kt < 16; ++kt) {
    if (kt < 15) { if (ACH == 4) asm volatile("s_waitcnt vmcnt(6)" ::: "memory"); else asm volatile("s_waitcnt vmcnt(4)" ::: "memory"); }
    else asm volatile("s_waitcnt vmcnt(0)" ::: "memory");
    __builtin_amdgcn_s_barrier();
    if (kt < 14) { const int nb_ = buf == 0 ? 2 : buf - 1; GEMM_STAGE(kt + 2, nb_); }
#pragma unroll
    for (int ks = 0; ks < 2; ++ks) {
      const int koff = ((ks * 4 + lq) ^ sw) << 4;
      bf16x8 af[4], bf[MJ];
#pragma unroll
      for (int i = 0; i < 4; ++i) af[i] = *(const bf16x8*)(Bs + buf * BBYTES + bbase + i * 2048 + koff);
#pragma unroll
      for (int j = 0; j < MJ; ++j) bf[j] = *(const bf16x8*)(As + buf * ABYTES + abase + j * 2048 + koff);
#pragma unroll
      for (int i = 0; i < 4; ++i)
#pragma unroll
        for (int j = 0; j < MJ; ++j) acc[i][j] = __builtin_amdgcn_mfma_f32_16x16x32_bf16(af[i], bf[j], acc[i][j], 0, 0, 0);
    }
    buf = buf == 2 ? 0 : buf + 1;
  }
  __syncthreads();
#undef GEMM_STAGE
#pragma unroll
  for (int i = 0; i < 4; ++i) {
    int n = n0 + wn * 64 + i * 16 + lq * 4;
    if (n < N) {
#pragma unroll
      for (int j = 0; j < MJ; ++j) {
        int m = m0 + wm * WM + j * 16 + l15;
        uint2 v;
        v.x = pk_bf16(acc[i][j][0], acc[i][j][1]);
        v.y = pk_bf16(acc[i][j][2], acc[i][j][3]);
        *(uint2*)(C + (size_t)m * ldc + n) = v;
      }
    }
  }
}

template <int BM>
__device__ __forceinline__ void gemm_phase(const bf16_t* A, int lda, const bf16_t* Bt, int N, bf16_t* C, int ldc, int M, char* smem, int wave_s) {
  const int ntn = (N + 127) / 128, ntm = M / BM;
  const int ntiles = ntm * ntn;
  int tid = make_tid(wave_s);
  const int nb = gridDim.x;
  const int vid = (nb % 8 == 0) ? (int)((blockIdx.x % 8) * (nb / 8) + blockIdx.x / 8) : (int)blockIdx.x;
  for (int t = vid; t < ntiles; t += nb) {
    const int grp = t / (8 * ntn), fm = grp * 8;
    const int gsz = (ntm - fm) < 8 ? (ntm - fm) : 8;
    const int r = t - grp * 8 * ntn;
    const int mt = fm + (r % gsz), nt = r / gsz;
    const int tid2 = make_tid(wave_s);
    gemm_tile<BM>(A, lda, Bt, N, C, ldc, mt * BM, nt * 128, smem, tid2);
  }
}

__device__ __forceinline__ float wave_sum(float v) {
#pragma unroll
  for (int o = 32; o >= 1; o >>= 1) v += __shfl_xor(v, o);
  return v;
}
__device__ __forceinline__ void unpack8(uint4 v, float* x) {
  x[0] = __uint_as_float(v.x << 16); x[1] = __uint_as_float(v.x & 0xffff0000u);
  x[2] = __uint_as_float(v.y << 16); x[3] = __uint_as_float(v.y & 0xffff0000u);
  x[4] = __uint_as_float(v.z << 16); x[5] = __uint_as_float(v.z & 0xffff0000u);
  x[6] = __uint_as_float(v.w << 16); x[7] = __uint_as_float(v.w & 0xffff0000u);
}
__device__ __forceinline__ void ldrow_f32(const float* r, int lane, float (&x)[16]) {
  float4 a = *(const float4*)(r + lane * 8), b = *(const float4*)(r + lane * 8 + 4);
  float4 c = *(const float4*)(r + 512 + lane * 8), d = *(const float4*)(r + 512 + lane * 8 + 4);
  x[0] = a.x; x[1] = a.y; x[2] = a.z; x[3] = a.w; x[4] = b.x; x[5] = b.y; x[6] = b.z; x[7] = b.w;
  x[8] = c.x; x[9] = c.y; x[10] = c.z; x[11] = c.w; x[12] = d.x; x[13] = d.y; x[14] = d.z; x[15] = d.w;
}
__device__ __forceinline__ void ldrow_bf16(const bf16_t* r, int lane, float (&x)[16]) {
  uint4 a = *(const uint4*)(r + lane * 8), b = *(const uint4*)(r + 512 + lane * 8);
  unpack8(a, x); unpack8(b, x + 8);
}
__device__ __forceinline__ void strow_f32(float* r, int lane, const float (&x)[16]) {
  *(float4*)(r + lane * 8) = make_float4(x[0], x[1], x[2], x[3]);
  *(float4*)(r + lane * 8 + 4) = make_float4(x[4], x[5], x[6], x[7]);
  *(float4*)(r + 512 + lane * 8) = make_float4(x[8], x[9], x[10], x[11]);
  *(float4*)(r + 512 + lane * 8 + 4) = make_float4(x[12], x[13], x[14], x[15]);
}
__device__ __forceinline__ void strow_bf16(bf16_t* r, int lane, const float (&x)[16]) {
  uint4 a, b;
  a.x = pk_bf16(x[0], x[1]); a.y = pk_bf16(x[2], x[3]); a.z = pk_bf16(x[4], x[5]); a.w = pk_bf16(x[6], x[7]);
  b.x = pk_bf16(x[8], x[9]); b.y = pk_bf16(x[10], x[11]); b.z = pk_bf16(x[12], x[13]); b.w = pk_bf16(x[14], x[15]);
  *(uint4*)(r + lane * 8) = a;
  *(uint4*)(r + 512 + lane * 8) = b;
}
__device__ __forceinline__ void ldrow16_f32(const float* r, int lane, float (&x)[16]) {
  const float4 a = *(const float4*)(r + lane * 16), b = *(const float4*)(r + lane * 16 + 4);
  const float4 c = *(const float4*)(r + lane * 16 + 8), d = *(const float4*)(r + lane * 16 + 12);
  x[0] = a.x; x[1] = a.y; x[2] = a.z; x[3] = a.w; x[4] = b.x; x[5] = b.y; x[6] = b.z; x[7] = b.w;
  x[8] = c.x; x[9] = c.y; x[10] = c.z; x[11] = c.w; x[12] = d.x; x[13] = d.y; x[14] = d.z; x[15] = d.w;
}
__device__ __forceinline__ void ldrow16_bf16(const bf16_t* r, int lane, float (&x)[16]) {
  const uint4 a = *(const uint4*)(r + lane * 16), b = *(const uint4*)(r + lane * 16 + 8);
  unpack8(a, x); unpack8(b, x + 8);
}
__device__ __forceinline__ void strow16_f32(float* r, int lane, const float (&x)[16]) {
  *(float4*)(r + lane * 16) = make_float4(x[0], x[1], x[2], x[3]);
  *(float4*)(r + lane * 16 + 4) = make_float4(x[4], x[5], x[6], x[7]);
  *(float4*)(r + lane * 16 + 8) = make_float4(x[8], x[9], x[10], x[11]);
  *(float4*)(r + lane * 16 + 12) = make_float4(x[12], x[13], x[14], x[15]);
}
__device__ __forceinline__ void strow16_bf16(bf16_t* r, int lane, const float (&x)[16]) {
  uint4 a, b;
  a.x = pk_bf16(x[0], x[1]); a.y = pk_bf16(x[2], x[3]); a.z = pk_bf16(x[4], x[5]); a.w = pk_bf16(x[6], x[7]);
  b.x = pk_bf16(x[8], x[9]); b.y = pk_bf16(x[10], x[11]); b.z = pk_bf16(x[12], x[13]); b.w = pk_bf16(x[14], x[15]);
  *(uint4*)(r + lane * 16) = a;
  *(uint4*)(r + lane * 16 + 8) = b;
}
__device__ __forceinline__ void row_ln_stats(const float (&x)[16], float& mean, float& rstd) {
  float s = 0.f;
#pragma unroll
  for (int i = 0; i < 16; ++i) s += x[i];
  mean = wave_sum(s) * (1.0f / DM);
  float v = 0.f;
#pragma unroll
  for (int i = 0; i < 16; ++i) { float d = x[i] - mean; v += d * d; }
  rstd = 1.0f / sqrtf(wave_sum(v) * (1.0f / DM) + LN_EPS);
}
__device__ __forceinline__ void row_modulate(float (&x)[16], const float* sh, const float* sc, int lane) {
  float mean, rstd; row_ln_stats(x, mean, rstd);
  float a[16], b[16];
  ldrow_f32(sc, lane, a); ldrow_f32(sh, lane, b);
#pragma unroll
  for (int i = 0; i < 16; ++i) x[i] = (x[i] - mean) * rstd * (1.0f + a[i]) + b[i];
}
__device__ __forceinline__ void row_affine_ln(float (&x)[16], const float* g, const float* bb, int lane) {
  float mean, rstd; row_ln_stats(x, mean, rstd);
  float a[16], b[16];
  ldrow_f32(g, lane, a); ldrow_f32(bb, lane, b);
#pragma unroll
  for (int i = 0; i < 16; ++i) x[i] = (x[i] - mean) * rstd * a[i] + b[i];
}

__device__ __forceinline__ void fast_ln1(const Params& p, int l, int wave_s) {
  for (int row = blockIdx.x * 8 + wave_s; row < NTOK; row += gridDim.x * 8) {
    const int lane = make_tid(wave_s) & 63;
    const float* m = p.mod() + ((size_t)l * NMODV + modv_of_row(row)) * 6144;
    float x[16];
    ldrow_f32(hsrc_row(p, l, row), lane, x);
    row_modulate(x, m, m + 1024, lane);
    strow_bf16(p.Y() + (size_t)row * DM, lane, x);
  }
}
template <int CTRL> __device__ __forceinline__ float dppx(float x) {
  return __builtin_bit_cast(float, __builtin_amdgcn_update_dpp(0, __builtin_bit_cast(int, x), CTRL, 0xf, 0xf, true));
}
typedef __attribute__((ext_vector_type(2))) float f32x2v;
constexpr float XQ_SCALE = 8.0f;
DEVFN unsigned char* xqbuf(const Params& p) { return (unsigned char*)p.P() + (size_t)NTOK * 4096; }
__device__ __forceinline__ void fast_pn1(const Params& p, int l, int nr, int wave_s) {
  for (int row = blockIdx.x * 8 + wave_s; row < nr; row += gridDim.x * 8) {
    const int lane = make_tid(wave_s) & 63;
    const float* m = p.mod() + ((size_t)l * NMODV + modv_of_row(row)) * 6144;
    float x[16], y[16], g[16];
    ldrow_f32(hsrc_row(p, l, row), lane, x);
    ldrow_bf16((const bf16_t*)p.RW() + (size_t)row * DM, lane, y);
    ldrow_f32(m + 2048, lane, g);
#pragma unroll
    for (int i = 0; i < 16; ++i) x[i] = DN_ALPHA * x[i] + g[i] * y[i];
    row_affine_ln(x, p.ln_mix_g + l * DM, p.ln_mix_b + l * DM, lane);
    strow_f32(hdst_row(p, row), lane, x);
    row_modulate(x, m + 3072, m + 4096, lane);
    strow_bf16(p.Y() + (size_t)row * DM, lane, x);
    unsigned char* xq = xqbuf(p) + (size_t)row * 1024;
#pragma unroll
    for (int hf = 0; hf < 2; ++hf) {
      uint2 hi = make_uint2(0u, 0u);
#define XQ_PAIR(k_, hw_, sel_) { \
        const float a = fminf(fmaxf(x[hf * 8 + 2 * (k_)] * XQ_SCALE, -448.f), 448.f); \
        const float b = fminf(fmaxf(x[hf * 8 + 2 * (k_) + 1] * XQ_SCALE, -448.f), 448.f); \
        hw_ = __builtin_amdgcn_cvt_pk_fp8_f32(a, b, hw_, sel_); }
      XQ_PAIR(0, hi.x, false) XQ_PAIR(1, hi.x, true) XQ_PAIR(2, hi.y, false) XQ_PAIR(3, hi.y, true)
      *(uint2*)(xq + (hf * 64 + lane) * 8) = hi;
    }
  }
}

constexpr float U8_SCALE = 64.0f, V8_SCALE = 4.0f;
__device__ __forceinline__ void conv_tables(const Params& p, int l, int wave_s) {
  int tid = make_tid(wave_s);
  const size_t nch = (size_t)16384 * 1024 / 16;
  const size_t nth = (size_t)gridDim.x * NTHREADS;
  const float* su = p.peer_u + (size_t)l * 16384 * 1024;
  const float* sv = p.peer_v + (size_t)l * 16384 * 1024;
  unsigned char* dst = (unsigned char*)p.TB();
  size_t c = (size_t)blockIdx.x * NTHREADS + tid;
  for (; c + 3 * nth < 2 * nch; c += 4 * nth) {
    float4 f[4][4];
#pragma unroll
    for (int q = 0; q < 4; ++q) {
      const size_t cq = c + q * nth;
      const float* src = cq < nch ? su + cq * 16 : sv + (cq - nch) * 16;
#pragma unroll
      for (int j = 0; j < 4; ++j) f[q][j] = *(const float4*)(src + 4 * j);
    }
#pragma unroll
    for (int q = 0; q < 4; ++q) {
      const size_t cq = c + q * nth;
      const float sc = cq < nch ? U8_SCALE : V8_SCALE;
      unsigned w[4];
#pragma unroll
      for (int j = 0; j < 4; ++j) {
        w[j] = __builtin_amdgcn_cvt_pk_fp8_f32(f[q][j].x * sc, f[q][j].y * sc, 0, false);
        w[j] = __builtin_amdgcn_cvt_pk_fp8_f32(f[q][j].z * sc, f[q][j].w * sc, w[j], true);
      }
      *(uint4*)(dst + cq * 16) = make_uint4(w[0], w[1], w[2], w[3]);
    }
  }
  for (; c < 2 * nch; c += nth) {
    const bool isu = c < nch;
    const float* src = isu ? su + c * 16 : sv + (c - nch) * 16;
    const float sc = isu ? U8_SCALE : V8_SCALE;
    const float4 f0 = *(const float4*)src, f1 = *(const float4*)(src + 4), f2 = *(const float4*)(src + 8), f3 = *(const float4*)(src + 12);
    uint4 v;
    v.x = __builtin_amdgcn_cvt_pk_fp8_f32(f0.x * sc, f0.y * sc, 0, false); v.x = __builtin_amdgcn_cvt_pk_fp8_f32(f0.z * sc, f0.w * sc, v.x, true);
    v.y = __builtin_amdgcn_cvt_pk_fp8_f32(f1.x * sc, f1.y * sc, 0, false); v.y = __builtin_amdgcn_cvt_pk_fp8_f32(f1.z * sc, f1.w * sc, v.y, true);
    v.z = __builtin_amdgcn_cvt_pk_fp8_f32(f2.x * sc, f2.y * sc, 0, false); v.z = __builtin_amdgcn_cvt_pk_fp8_f32(f2.z * sc, f2.w * sc, v.z, true);
    v.w = __builtin_amdgcn_cvt_pk_fp8_f32(f3.x * sc, f3.y * sc, 0, false); v.w = __builtin_amdgcn_cvt_pk_fp8_f32(f3.z * sc, f3.w * sc, v.w, true);
    *(uint4*)(dst + c * 16) = v;
  }
}

typedef unsigned long long u64;
__device__ __forceinline__ unsigned f2ord(float f) { unsigned u = __float_as_uint(f); return u ^ ((u >> 31) ? 0xffffffffu : 0x80000000u); }
__device__ __forceinline__ float ord2f(unsigned u) { return __uint_as_float(u ^ ((u >> 31) ? 0x80000000u : 0xffffffffu)); }
__device__ const unsigned char PEER_CAND[56] = {
  0x00,0x01,0x02,0x03,0x04,0x05,0x06,0x07,0x08,0x09,0x0a,0x0b,0x0c,0x0d,0x0e,0x0f,
  0x10,0x11,0x12,0x13,0x14,0x15,0x16,0x17,
  0x20,0x21,0x22,0x23,0x24,
  0x30,0x31,0x32,0x33,
  0x40,0x41,0x42,
  0x50,0x51, 0x60,0x61, 0x70,0x71,
  0x80,0x90,0xa0,0xb0,0xc0,0xd0,0xe0,0xf0,
  0xff,0xff,0xff,0xff,0xff,0xff};

template <int N>
__device__ __forceinline__ void sort_desc(unsigned (&a)[N]) {
#pragma unroll
  for (int k = 2; k <= N; k <<= 1) {
#pragma unroll
    for (int j = k >> 1; j > 0; j >>= 1) {
#pragma unroll
      for (int i = 0; i < N; ++i) {
        const int m = i ^ j;
        if (m > i) {
          const unsigned x = a[i], y = a[m];
          const unsigned hi = x > y ? x : y, lo = x > y ? y : x;
          if ((i & k) == 0) { a[i] = hi; a[m] = lo; } else { a[i] = lo; a[m] = hi; }
        }
      }
    }
  }
}
template <int CTRL> __device__ __forceinline__ unsigned dpp_mov_u(unsigned x) {
  return (unsigned)__builtin_amdgcn_update_dpp(0, (int)x, CTRL, 0xf, 0xf, true);
}
__device__ __forceinline__ unsigned group8_max(unsigned v) {
  unsigned o = dpp_mov_u<0xB1>(v); v = o > v ? o : v;
  o = dpp_mov_u<0x4E>(v); v = o > v ? o : v;
  o = dpp_mov_u<0x141>(v); v = o > v ? o : v;
  return v;
}

__device__ __forceinline__ void select_load_keys(const Params& p, int l, int h, char* Ks, int tid) {
#pragma unroll
  for (int ph = 0; ph < 2; ++ph) {
    const float* kbase = p.peer_keys + ((size_t)(l * 8 + h) * 2 + ph) * 128 * 128;
#pragma unroll
    for (int i = 0; i < 4; ++i) {
      const int c = tid + i * NTHREADS, row = c >> 4, kc = c & 15;
      const float4 a = *(const float4*)(kbase + row * 128 + kc * 8), b = *(const float4*)(kbase + row * 128 + kc * 8 + 4);
      uint4 v;
      v.x = pk_bf16(a.x, a.y); v.y = pk_bf16(a.z, a.w); v.z = pk_bf16(b.x, b.y); v.w = pk_bf16(b.z, b.w);
      *(uint4*)(Ks + ph * 32768 + row * 256 + ((kc ^ (row & 15)) << 4)) = v;
    }
  }
}
#define SEL_BAR() { asm volatile("s_waitcnt lgkmcnt(0)" ::: "memory"); __builtin_amdgcn_s_barrier(); asm volatile("" ::: "memory"); }
__device__ __forceinline__ void select_qload(const Params& p, int tb, int h, int ph, int tid, uint4& q0, uint4& q1) {
  const bf16_t* Qg = peerQ(p);
  { const int c = tid, row = c >> 4, kc = c & 15; q0 = *(const uint4*)(Qg + (size_t)(tb * 64 + row) * 2048 + h * 256 + ph * 128 + kc * 8); }
  { const int c = tid + NTHREADS, row = c >> 4, kc = c & 15; q1 = *(const uint4*)(Qg + (size_t)(tb * 64 + row) * 2048 + h * 256 + ph * 128 + kc * 8); }
}
__device__ __forceinline__ void select_tile(const Params& p, int tb, int tbn, int h, char* smem, int tid, uint4& q0, uint4& q1) {
  const int tok0 = tb * 64;
  char* Ks = smem;
  char* Qs = smem + 65536;
  float* Sc = (float*)(smem + 81920);
  unsigned* tops = (unsigned*)(smem + 115712);
  const int lane = tid & 63, w = tid >> 6, l15 = lane & 15, lq = lane >> 4;
  const int tok = tid >> 3, g = tid & 7;
#pragma unroll
  for (int ph = 0; ph < 2; ++ph) {
    { const int c = tid, row = c >> 4, kc = c & 15; *(uint4*)(Qs + row * 256 + ((kc ^ (row & 15)) << 4)) = q0; }
    { const int c = tid + NTHREADS, row = c >> 4, kc = c & 15; *(uint4*)(Qs + row * 256 + ((kc ^ (row & 15)) << 4)) = q1; }
    if (ph == 0) select_qload(p, tb, h, 1, tid, q0, q1); else select_qload(p, tbn, h, 0, tid, q0, q1);
    SEL_BAR();
    {
      f32x4 acc[4];
#pragma unroll
      for (int j = 0; j < 4; ++j) acc[j] = f32x4{0.f, 0.f, 0.f, 0.f};
#pragma unroll
      for (int ks = 0; ks < 4; ++ks) {
        const int koff = ((ks * 4 + lq) ^ l15) << 4;
        bf16x8 af = *(const bf16x8*)(Ks + ph * 32768 + (16 * w + l15) * 256 + koff);
#pragma unroll
        for (int j = 0; j < 4; ++j) {
          bf16x8 bfr = *(const bf16x8*)(Qs + (16 * j + l15) * 256 + koff);
          acc[j] = __builtin_amdgcn_mfma_f32_16x16x32_bf16(af, bfr, acc[j], 0, 0, 0);
        }
      }
#pragma unroll
      for (int j = 0; j < 4; ++j)
        *(float4*)(Sc + (16 * j + l15) * 132 + 16 * w + lq * 4) = make_float4(acc[j][0], acc[j][1], acc[j][2], acc[j][3]);
    }
    SEL_BAR();
    {
      unsigned lst[16];
      const float* sr = Sc + tok * 132 + g * 16;
#pragma unroll
      for (int q4 = 0; q4 < 4; ++q4) {
        float4 v = *(const float4*)(sr + q4 * 4);
        const unsigned base = 127u - (unsigned)(g * 16 + q4 * 4);
        lst[q4 * 4 + 0] = (f2ord(v.x) & ~127u) | (base);
        lst[q4 * 4 + 1] = (f2ord(v.y) & ~127u) | (base - 1);
        lst[q4 * 4 + 2] = (f2ord(v.z) & ~127u) | (base - 2);
        lst[q4 * 4 + 3] = (f2ord(v.w) & ~127u) | (base - 3);
      }
      sort_desc<16>(lst);
      unsigned* tp = tops + (tok * 2 + ph) * 16;
#pragma unroll
      for (int it = 0; it < 16; ++it) {
        const unsigned mx = group8_max(lst[0]);
        const bool own = lst[0] == mx;
#pragma unroll
        for (int k = 0; k < 15; ++k) lst[k] = own ? lst[k + 1] : lst[k];
        lst[15] = own ? 0u : lst[15];
        if (g == 0) tp[it] = mx;
      }
    }
  }
  SEL_BAR();
  {
    const unsigned* t0 = tops + (tok * 2) * 16;
    const unsigned* t1 = t0 + 16;
    unsigned lst[8];
#pragma unroll
    for (int s_ = 0; s_ < 7; ++s_) {
      const unsigned c = PEER_CAND[g + 8 * s_];
      unsigned key = 0u;
      if (c != 0xff) {
        const float sc = ord2f(t0[c >> 4] & ~127u) + ord2f(t1[c & 15] & ~127u);
        key = (f2ord(sc) & ~63u) | (63u - (unsigned)(g + 8 * s_));
      }
      lst[s_] = key;
    }
    lst[7] = 0u;
    sort_desc<8>(lst);
    float bs[16]; unsigned bc[16];
#pragma unroll
    for (int it = 0; it < 16; ++it) {
      const unsigned mx = group8_max(lst[0]);
      const bool own = lst[0] == mx;
#pragma unroll
      for (int k = 0; k < 7; ++k) lst[k] = own ? lst[k + 1] : lst[k];
      lst[7] = own ? 0u : lst[7];
      bs[it] = ord2f(mx & ~63u);
      bc[it] = 63u - (mx & 63u);
    }
    const float mx0 = bs[0];
    float sum = 0.f;
#pragma unroll
    for (int it = 0; it < 16; ++it) { bs[it] = FEXP(bs[it] - mx0); sum += bs[it]; }
    const float inv = 1.0f / sum;
    int* oi = sel2i(p) + ((size_t)(tok0 + tok) * 8 + h) * 16;
    float* og = sel2g(p) + ((size_t)(tok0 + tok) * 8 + h) * 16;
#pragma unroll
    for (int it = 0; it < 16; ++it) {
      if ((it & 7) == g) {
        const unsigned c = PEER_CAND[bc[it]];
        const unsigned i0 = 127u - (t0[c >> 4] & 127u), i1 = 127u - (t1[c & 15] & 127u);
        oi[it] = (int)(i0 * 128 + i1);
        og[it] = bs[it] * inv;
      }
    }
  }
  SEL_BAR();
}

__device__ __forceinline__ void select_phase(const Params& p, int l, int nr, char* smem, int wave_s) {
  const int ntb = nr / 64, nb = gridDim.x;
  int cur_h = -1;
  if (nb % 8 == 0) {
    const int bph = nb / 8, h = blockIdx.x / bph;
    uint4 q0, q1;
    {
      const int tid = make_tid(wave_s);
      select_qload(p, min((int)(blockIdx.x % bph), ntb - 1), h, 0, tid, q0, q1);
    }
    for (int tb = blockIdx.x % bph; tb < ntb; tb += bph) {
      const int tid = make_tid(wave_s);
      if (cur_h != h) { select_load_keys(p, l, h, smem, tid); cur_h = h; }
      select_tile(p, tb, min(tb + bph, ntb - 1), h, smem, tid, q0, q1);
    }
  } else {
    for (int t = blockIdx.x; t < ntb * 8; t += nb) {
      const int tid = make_tid(wave_s);
      const int h = t & 7;
      __syncthreads();
      select_load_keys(p, l, h, smem, tid);
      uint4 q0, q1;
      select_qload(p, t >> 3, h, 0, tid, q0, q1);
      select_tile(p, t >> 3, t >> 3, h, smem, tid, q0, q1);
    }
  }
}

__device__ __forceinline__ float dot16_fp8(const float (&x)[16], uint4 u, float acc) {
  f32x2v t;
  t = __builtin_amdgcn_cvt_pk_f32_fp8(u.x, false); acc += x[0] * t[0]; acc += x[1] * t[1];
  t = __builtin_amdgcn_cvt_pk_f32_fp8(u.x, true);  acc += x[2] * t[0]; acc += x[3] * t[1];
  t = __builtin_amdgcn_cvt_pk_f32_fp8(u.y, false); acc += x[4] * t[0]; acc += x[5] * t[1];
  t = __builtin_amdgcn_cvt_pk_f32_fp8(u.y, true);  acc += x[6] * t[0]; acc += x[7] * t[1];
  t = __builtin_amdgcn_cvt_pk_f32_fp8(u.z, false); acc += x[8] * t[0]; acc += x[9] * t[1];
  t = __builtin_amdgcn_cvt_pk_f32_fp8(u.z, true);  acc += x[10] * t[0]; acc += x[11] * t[1];
  t = __builtin_amdgcn_cvt_pk_f32_fp8(u.w, false); acc += x[12] * t[0]; acc += x[13] * t[1];
  t = __builtin_amdgcn_cvt_pk_f32_fp8(u.w, true);  acc += x[14] * t[0]; acc += x[15] * t[1];
  return acc;
}
__device__ __forceinline__ void axpy16_fp8(float c, uint4 v, float (&acc)[16]) {
  f32x2v t;
  t = __builtin_amdgcn_cvt_pk_f32_fp8(v.x, false); acc[0] += c * t[0]; acc[1] += c * t[1];
  t = __builtin_amdgcn_cvt_pk_f32_fp8(v.x, true);  acc[2] += c * t[0]; acc[3] += c * t[1];
  t = __builtin_amdgcn_cvt_pk_f32_fp8(v.y, false); acc[4] += c * t[0]; acc[5] += c * t[1];
  t = __builtin_amdgcn_cvt_pk_f32_fp8(v.y, true);  acc[6] += c * t[0]; acc[7] += c * t[1];
  t = __builtin_amdgcn_cvt_pk_f32_fp8(v.z, false); acc[8] += c * t[0]; acc[9] += c * t[1];
  t = __builtin_amdgcn_cvt_pk_f32_fp8(v.z, true);  acc[10] += c * t[0]; acc[11] += c * t[1];
  t = __builtin_amdgcn_cvt_pk_f32_fp8(v.w, false); acc[12] += c * t[0]; acc[13] += c * t[1];
  t = __builtin_amdgcn_cvt_pk_f32_fp8(v.w, true);  acc[14] += c * t[0]; acc[15] += c * t[1];
}
__device__ __forceinline__ f32x2v fma2(f32x2v a, f32x2v b, f32x2v c) { return __builtin_elementwise_fma(a, b, c); }
__device__ __forceinline__ float dot16p_fp8(const f32x2v (&x)[8], uint4 u) {
  f32x2v a = x[0] * __builtin_amdgcn_cvt_pk_f32_fp8(u.x, false);
  a = fma2(x[1], __builtin_amdgcn_cvt_pk_f32_fp8(u.x, true), a);
  a = fma2(x[2], __builtin_amdgcn_cvt_pk_f32_fp8(u.y, false), a);
  a = fma2(x[3], __builtin_amdgcn_cvt_pk_f32_fp8(u.y, true), a);
  a = fma2(x[4], __builtin_amdgcn_cvt_pk_f32_fp8(u.z, false), a);
  a = fma2(x[5], __builtin_amdgcn_cvt_pk_f32_fp8(u.z, true), a);
  a = fma2(x[6], __builtin_amdgcn_cvt_pk_f32_fp8(u.w, false), a);
  a = fma2(x[7], __builtin_amdgcn_cvt_pk_f32_fp8(u.w, true), a);
  return a[0] + a[1];
}
__device__ __forceinline__ void axpy16p_fp8(float c, uint4 v, f32x2v (&acc)[8]) {
  const f32x2v c2 = {c, c};
  acc[0] = fma2(c2, __builtin_amdgcn_cvt_pk_f32_fp8(v.x, false), acc[0]);
  acc[1] = fma2(c2, __builtin_amdgcn_cvt_pk_f32_fp8(v.x, true), acc[1]);
  acc[2] = fma2(c2, __builtin_amdgcn_cvt_pk_f32_fp8(v.y, false), acc[2]);
  acc[3] = fma2(c2, __builtin_amdgcn_cvt_pk_f32_fp8(v.y, true), acc[3]);
  acc[4] = fma2(c2, __builtin_amdgcn_cvt_pk_f32_fp8(v.z, false), acc[4]);
  acc[5] = fma2(c2, __builtin_amdgcn_cvt_pk_f32_fp8(v.z, true), acc[5]);
  acc[6] = fma2(c2, __builtin_amdgcn_cvt_pk_f32_fp8(v.w, false), acc[6]);
  acc[7] = fma2(c2, __builtin_amdgcn_cvt_pk_f32_fp8(v.w, true), acc[7]);
}
__device__ __forceinline__ f32x2v bf2_to_f2(unsigned w) {
  f32x2v r; r[0] = __builtin_bit_cast(float, w << 16); r[1] = __builtin_bit_cast(float, w & 0xffff0000u); return r;
}
typedef __attribute__((ext_vector_type(4))) float f32x4u;
typedef __attribute__((ext_vector_type(2))) long i64x2u;
struct UPre { int idxA, idxB; float gA, gB; i64x2u xh; };
__device__ __forceinline__ void u_load_pre(const Params& p, int row, int lane, UPre& P) {
  P.idxA = sel2i(p)[(size_t)row * 128 + lane]; P.idxB = sel2i(p)[(size_t)row * 128 + 64 + lane];
  P.gA = sel2g(p)[(size_t)row * 128 + lane]; P.gB = sel2g(p)[(size_t)row * 128 + 64 + lane];
  P.xh = *(const i64x2u*)(xqbuf(p) + (size_t)row * 1024 + lane * 16);
}
__device__ __forceinline__ float trace_dot(i64x2u u, i64x2u xh, bool b0, bool b1, bool ondiag) {
  const f32x4u z = {0.f, 0.f, 0.f, 0.f};
  f32x4u a0 = __builtin_amdgcn_mfma_f32_16x16x32_fp8_fp8(u[0], xh[0], z, 0, 0, 0);
  a0 = __builtin_amdgcn_mfma_f32_16x16x32_fp8_fp8(u[1], xh[1], a0, 0, 0, 0);
  const float t01 = b0 ? a0[1] : a0[0], t23 = b0 ? a0[3] : a0[2];
  const float t = b1 ? t23 : t01;
  return ondiag ? t : 0.f;
}
__device__ __forceinline__ float gelu_as(float x) {
  const float z = fabsf(x) * 0.70710678118654752f;
  const float t = __builtin_amdgcn_rcpf(fmaf(0.3275911f, z, 1.0f));
  float q = fmaf(1.061405429f, t, -1.453152027f);
  q = fmaf(q, t, 1.421413741f); q = fmaf(q, t, -0.284496736f); q = fmaf(q, t, 0.254829592f);
  const float e = 1.0f - q * t * __builtin_amdgcn_exp2f(-1.4426950408889634f * z * z);
  return 0.5f * x * (1.0f + copysignf(e, x));
}
__device__ __forceinline__ void u_gather(const unsigned char* TBu, const int2* L, int lane, int b0, int cnt, i64x2u (&ub)[16]) {
  const int2 ent = L[min(b0 + (lane & 15), max(cnt - 1, 0))];
#pragma unroll
  for (int qd = 0; qd < 4; ++qd) {
    if (qd == 0 || b0 + 4 * qd < cnt) {
#pragma unroll
      for (int e = 4 * qd; e < 4 * qd + 4; ++e) {
        const int ie = __builtin_amdgcn_readlane(ent.x, e) & 0x3fff;
        ub[e] = *(const i64x2u*)(TBu + (size_t)ie * 1024 + lane * 16);
      }
    }
  }
}
__device__ __forceinline__ void u_dots(const int2* L, int lane, int b0, int cnt, const i64x2u (&ub)[16], i64x2u xh, float* cfr) {
  const bool db0 = lane & 1, db1 = lane & 2, ondiag = ((lane >> 2) & 3) == (lane >> 4);
  float d[16];
#pragma unroll
  for (int qd = 0; qd < 4; ++qd) {
    if (qd == 0 || b0 + 4 * qd < cnt) {
#pragma unroll
      for (int e = 4 * qd; e < 4 * qd + 4; ++e) d[e] = trace_dot(ub[e], xh, db0, db1, ondiag);
    } else {
#pragma unroll
      for (int e = 4 * qd; e < 4 * qd + 4; ++e) d[e] = 0.f;
    }
  }
  float r8[8], r4[4], r2[2], r1;
  {
    const bool up = lane & 32;
#pragma unroll
    for (int i = 0; i < 8; ++i) { float snd = up ? d[i] : d[i + 8]; float kp = up ? d[i + 8] : d[i]; r8[i] = kp + __shfl_xor(snd, 32); }
  }
  {
    const bool up = lane & 16;
#pragma unroll
    for (int i = 0; i < 4; ++i) { float snd = up ? r8[i] : r8[i + 4]; float kp = up ? r8[i + 4] : r8[i]; r4[i] = kp + __shfl_xor(snd, 16); }
  }
  {
    const bool up = lane & 8;
#pragma unroll
    for (int i = 0; i < 2; ++i) { float snd = up ? r4[i] : r4[i + 2]; float kp = up ? r4[i + 2] : r4[i]; r2[i] = kp + __shfl_xor(snd, 8); }
  }
  {
    const bool up = lane & 4;
    float snd = up ? r2[0] : r2[1]; float kp = up ? r2[1] : r2[0];
    r1 = kp + __shfl_xor(snd, 4);
  }
  r1 += dppx<0xB1>(r1);
  r1 += dppx<0x4E>(r1);
  r1 *= (1.0f / (U8_SCALE * XQ_SCALE));
  const int my_e = ((lane & 32) ? 8 : 0) + ((lane & 16) ? 4 : 0) + ((lane & 8) ? 2 : 0) + ((lane & 4) ? 1 : 0);
  const int pos = b0 + my_e;
  const int2 e2 = L[min(pos, max(cnt - 1, 0))];
  const float coef = __builtin_bit_cast(float, e2.y) * gelu_as(r1) * (1.0f / V8_SCALE);
  if (pos < cnt && (lane & 3) == 0) cfr[e2.x >> 16] = coef;
}
__device__ __forceinline__ int u_compact(const UPre& P, int2* L, int lane, int part) {
  const int idxA = P.idxA, idxB = P.idxB; const float gA = P.gA, gB = P.gB;
  const bool mA = (idxA >> 11) == part, mB = (idxB >> 11) == part;
  const unsigned long long maskA = __ballot(mA), maskB = __ballot(mB);
  const int cntA = __popcll(maskA), cnt = cntA + __popcll(maskB);
  const int rnkA = (int)__builtin_amdgcn_mbcnt_hi((unsigned)(maskA >> 32), __builtin_amdgcn_mbcnt_lo((unsigned)maskA, 0u));
  const int rnkB = cntA + (int)__builtin_amdgcn_mbcnt_hi((unsigned)(maskB >> 32), __builtin_amdgcn_mbcnt_lo((unsigned)maskB, 0u));
  if (mA) L[rnkA] = make_int2(idxA | (lane << 16), __builtin_bit_cast(int, gA));
  if (mB) L[rnkB] = make_int2(idxB | ((lane + 64) << 16), __builtin_bit_cast(int, gB));
  return cnt;
}
__device__ __forceinline__ void u_pair(const Params& p, const unsigned char* TBu, char* W, int lane, int unA, int unB, int total,
                                       int sh, bool even, int prowA_next, int prowB_next, UPre& PA, UPre& PB) {
  int2* LA = (int2*)W; int2* LB = (int2*)(W + 1024);
  const int cntA = u_compact(PA, LA, lane, even ? (int)(blockIdx.x & 7) : (unA & 7));
  const int cntB = (unB < total) ? u_compact(PB, LB, lane, even ? (int)(blockIdx.x & 7) : (unB & 7)) : 0;
  const i64x2u xhA = PA.xh, xhB = PB.xh;
  float* cfA = coefb(p) + (size_t)(unA >> sh) * 128;
  float* cfB = coefb(p) + (size_t)(min(unB, total - 1) >> sh) * 128;
  i64x2u ubA[16], ubB[16];
  for (int b0 = ((cntA - 1) >> 4) << 4; b0 >= 32; b0 -= 16) { u_gather(TBu, LA, lane, b0, cntA, ubA); u_dots(LA, lane, b0, cntA, ubA, xhA, cfA); }
  for (int b0 = ((cntB - 1) >> 4) << 4; b0 >= 32; b0 -= 16) { u_gather(TBu, LB, lane, b0, cntB, ubB); u_dots(LB, lane, b0, cntB, ubB, xhB, cfB); }
  if (cntA > 16 || cntB > 16) {
    if (cntA > 16) u_gather(TBu, LA, lane, 16, cntA, ubA);
    if (cntB > 16) u_gather(TBu, LB, lane, 16, cntB, ubB);
    __builtin_amdgcn_sched_barrier(0);
    if (cntA > 16) u_dots(LA, lane, 16, cntA, ubA, xhA, cfA);
    if (cntB > 16) u_dots(LB, lane, 16, cntB, ubB, xhB, cfB);
  }
  u_gather(TBu, LA, lane, 0, cntA, ubA);
  u_gather(TBu, LB, lane, 0, cntB, ubB);
  __builtin_amdgcn_sched_barrier(0);
  u_load_pre(p, prowA_next, lane, PA);
  u_load_pre(p, prowB_next, lane, PB);
  __builtin_amdgcn_sched_barrier(0);
  u_dots(LA, lane, 0, cntA, ubA, xhA, cfA);
  u_dots(LB, lane, 0, cntB, ubB, xhB, cfB);
}
__device__ __forceinline__ void expert_u_phase(const Params& p, int l, int nr, int wave_s, char* smem) {
  const unsigned char* TBu = (const unsigned char*)p.TB();
  char* W = smem + wave_s * 2048;
  const int nb = gridDim.x;
  const bool even = (nb & 7) == 0;
  const int sh = even ? 0 : 3;
  const int total = nr << sh;
  const int stride = (even ? (nb >> 3) : nb) * 8;
  int un = (even ? (int)(blockIdx.x >> 3) : (int)blockIdx.x) * 8 + wave_s;
  UPre P0, P1, P2, P3;
  {
    const int lane = make_tid(wave_s) & 63;
    u_load_pre(p, min(un, total - 1) >> sh, lane, P0);
    u_load_pre(p, min(un + stride, total - 1) >> sh, lane, P1);
    u_load_pre(p, min(un + 2 * stride, total - 1) >> sh, lane, P2);
    u_load_pre(p, min(un + 3 * stride, total - 1) >> sh, lane, P3);
  }
  while (un < total) {
    {
      const int lane = make_tid(wave_s) & 63;
      u_pair(p, TBu, W, lane, un, un + stride, total, sh, even,
             min(un + 4 * stride, total - 1) >> sh, min(un + 5 * stride, total - 1) >> sh, P0, P1);
    }
    un += 2 * stride;
    if (un >= total) break;
    {
      const int lane = make_tid(wave_s) & 63;
      u_pair(p, TBu, W, lane, un, un + stride, total, sh, even,
             min(un + 4 * stride, total - 1) >> sh, min(un + 5 * stride, total - 1) >> sh, P2, P3);
    }
    un += 2 * stride;
  }
}

#define VLOAD(buf_, idxv_, base_) _Pragma("unroll") for (int e = 0; e < 16; ++e) { \
    const int ie = __builtin_amdgcn_readlane(idxv_, (base_) + e); buf_[e] = *(const uint4*)(TBv + (size_t)ie * 1024 + lane * 16); }
#define VAXPY(buf_, cfv_, base_) _Pragma("unroll") for (int e = 0; e < 16; ++e) { \
    const float c = __builtin_bit_cast(float, __builtin_amdgcn_readlane(__builtin_bit_cast(int, cfv_), (base_) + e)); axpy16p_fp8(c, buf_[e], acc2); }
__device__ __forceinline__ void expert_phase(const Params& p, int l, int nr, int wave_s) {
  const unsigned char* TBv = (const unsigned char*)p.TB() + (size_t)16384 * 1024;
  for (int row = blockIdx.x * 8 + wave_s; row < nr; row += gridDim.x * 8) {
    const int lane = make_tid(wave_s) & 63;
    const int* idxr = sel2i(p) + (size_t)row * 128;
    const float* cfr = coefb(p) + (size_t)row * 128;
    const int iA = idxr[lane], iB = idxr[64 + lane];
    const float cA = cfr[lane], cB = cfr[64 + lane];
    f32x2v acc2[8];
#pragma unroll
    for (int i = 0; i < 8; ++i) { acc2[i][0] = 0.f; acc2[i][1] = 0.f; }
    uint4 va[16], vb[16];
    VLOAD(va, iA, 0)
    VLOAD(vb, iA, 16) LOAD_FENCE(); VAXPY(va, cA, 0)
    VLOAD(va, iA, 32) LOAD_FENCE(); VAXPY(vb, cA, 16)
    VLOAD(vb, iA, 48) LOAD_FENCE(); VAXPY(va, cA, 32)
    VLOAD(va, iB, 0)  LOAD_FENCE(); VAXPY(vb, cA, 48)
    VLOAD(vb, iB, 16) LOAD_FENCE(); VAXPY(va, cB, 0)
    VLOAD(va, iB, 32) LOAD_FENCE(); VAXPY(vb, cB, 16)
    VLOAD(vb, iB, 48) LOAD_FENCE(); VAXPY(va, cB, 32)
    LOAD_FENCE(); VAXPY(vb, cB, 48)
    float acc[16];
#pragma unroll
    for (int i = 0; i < 8; ++i) { acc[2 * i] = acc2[i][0]; acc[2 * i + 1] = acc2[i][1]; }
    const float* m = p.mod() + ((size_t)l * NMODV + modv_of_row(row)) * 6144;
    float hx[16], g[16], bb[16];
    float* hd = hdst_row(p, row);
    ldrow16_f32(hd, lane, hx);
    ldrow16_f32(m + 5120, lane, g);
#pragma unroll
    for (int i = 0; i < 16; ++i) { asm volatile("" : "+v"(acc[i])); hx[i] = fmaf(g[i], acc[i], DN_ALPHA * hx[i]); }
    float mean, rstd;
    row_ln_stats(hx, mean, rstd);
    ldrow16_f32(p.ln_ffn_g + l * DM, lane, g); ldrow16_f32(p.ln_ffn_b + l * DM, lane, bb);
#pragma unroll
    for (int i = 0; i < 16; ++i) hx[i] = (hx[i] - mean) * rstd * g[i] + bb[i];
    strow16_f32(hd, lane, hx);
    if (l == 0) {
      const float* m1 = p.mod() + ((size_t)1 * NMODV + modv_of_row(row)) * 6144;
      row_ln_stats(hx, mean, rstd);
      ldrow16_f32(m1 + 1024, lane, g); ldrow16_f32(m1, lane, bb);
#pragma unroll
      for (int i = 0; i < 16; ++i) hx[i] = (hx[i] - mean) * rstd * (1.0f + g[i]) + bb[i];
      strow16_bf16(p.Y() + (size_t)row * DM, lane, hx);
    }
  }
}

__device__ __forceinline__ float reduce32(float x) {
  x += dppx<0xB1>(x);
  x += dppx<0x4E>(x);
  x += dppx<0x141>(x);
  x += dppx<0x140>(x);
  float a = x, b = x;
  asm volatile("s_nop 1\n\tv_permlane16_swap_b32 %0, %1" : "+v"(a), "+v"(b));
  return a + b;
}

__device__ __forceinline__ float reduce16(float x) {
  x += dppx<0xB1>(x);
  x += dppx<0x4E>(x);
  x += dppx<0x141>(x);
  x += dppx<0x140>(x);
  return x;
}

__device__ __forceinline__ float wsum(float x) {
  x = reduce16(x);
  float a = x, b = x;
  asm volatile("s_nop 1\n\tv_permlane16_swap_b32 %0, %1" : "+v"(a), "+v"(b));
  x = a + b; a = x; b = x;
  asm volatile("s_nop 1\n\tv_permlane32_swap_b32 %0, %1" : "+v"(a), "+v"(b));
  return a + b;
}

__device__ __forceinline__ void fast_rwprep(const Params& p, int l, char* smem, int wave_s) {
  int tid = make_tid(wave_s);
  float* Cv = (float*)smem;
  const float* mu = p.rwkv_mu + (size_t)l * 2 * 1152;
  const int c = tid & 255, tg = tid >> 8, lane = tid & 63, h = c >> 6;
  for (int tile = blockIdx.x; tile < NTOK / 16; tile += gridDim.x) {
    const int r0 = tile * 16;
#pragma unroll
    for (int q = 0; q < 5; ++q) {
      const int idx = tid + q * NTHREADS;
      if (idx < 16 * 144) {
        const int tk = idx / 144, ch = idx - tk * 144, col = ch * 8;
        const int row = r0 + tk;
        int t, len; seq_pos(row, t, len);
        const bf16_t* src = p.P() + (size_t)row * INC + OFF_B + col;
        const uint4 zero4 = make_uint4(0u, 0u, 0u, 0u);
        const uint4 cu = *(const uint4*)src;
        const uint4 pu = t > 0 ? *(const uint4*)(src - INC) : zero4;
        const uint4 nu = t < len - 1 ? *(const uint4*)(src + INC) : zero4;
        float xc[8], xp[8], xn[8], m0[8], m1[8];
        unpack8(cu, xc); unpack8(pu, xp); unpack8(nu, xn);
        *(float4*)m0 = *(const float4*)(mu + col); *(float4*)(m0 + 4) = *(const float4*)(mu + col + 4);
        *(float4*)m1 = *(const float4*)(mu + 1152 + col); *(float4*)(m1 + 4) = *(const float4*)(mu + 1152 + col + 4);
        float o[8];
#pragma unroll
        for (int e = 0; e < 8; ++e) {
          float v = xc[e] * (1.0f - m0[e] - m1[e]) + xp[e] * m0[e] + xn[e] * m1[e];
          if (col >= 768 && col < 896) v = tanhf_(v);
          else if (col >= 1024) v = sigmoidf_(v);
          o[e] = v;
        }
        *(float4*)(Cv + tk * 1152 + col) = make_float4(o[0], o[1], o[2], o[3]);
        *(float4*)(Cv + tk * 1152 + col + 4) = make_float4(o[4], o[5], o[6], o[7]);
      }
    }
    __syncthreads();
    float aw0[8], aw1[8], aa0[8], aa1[8], ag[8];
#pragma unroll
    for (int t = 0; t < 8; ++t) { aw0[t] = 0.f; aw1[t] = 0.f; aa0[t] = 0.f; aa1[t] = 0.f; ag[t] = 0.f; }
    const float* cvb = Cv + (tg * 8) * 1152;
    const float* w2a = p.rwkv_w2 + (size_t)(l * 2 + 0) * 64 * 256 + c;
    const float* w2b = p.rwkv_w2 + (size_t)(l * 2 + 1) * 64 * 256 + c;
    const float* a2a = p.rwkv_a2 + (size_t)(l * 2 + 0) * 64 * 256 + c;
    const float* a2b = p.rwkv_a2 + (size_t)(l * 2 + 1) * 64 * 256 + c;
    const float* g2p = p.rwkv_g2 + (size_t)l * 128 * 256 + c;
    for (int rr = 0; rr < 64; rr += 4) {
      float wa[4], wb[4], xa[4], xb[4];
#pragma unroll
      for (int q = 0; q < 4; ++q) { wa[q] = w2a[(rr + q) * 256]; wb[q] = w2b[(rr + q) * 256]; xa[q] = a2a[(rr + q) * 256]; xb[q] = a2b[(rr + q) * 256]; }
#pragma unroll
      for (int t = 0; t < 8; ++t) {
        float4 d0 = *(const float4*)(cvb + t * 1152 + 768 + rr), d1 = *(const float4*)(cvb + t * 1152 + 832 + rr);
        float4 e0 = *(const float4*)(cvb + t * 1152 + 896 + rr), e1 = *(const float4*)(cvb + t * 1152 + 960 + rr);
        aw0[t] += d0.x * wa[0] + d0.y * wa[1] + d0.z * wa[2] + d0.w * wa[3];
        aw1[t] += d1.x * wb[0] + d1.y * wb[1] + d1.z * wb[2] + d1.w * wb[3];
        aa0[t] += e0.x * xa[0] + e0.y * xa[1] + e0.z * xa[2] + e0.w * xa[3];
        aa1[t] += e1.x * xb[0] + e1.y * xb[1] + e1.z * xb[2] + e1.w * xb[3];
      }
    }
    for (int rr = 0; rr < 128; rr += 4) {
      float gg[4];
#pragma unroll
      for (int q = 0; q < 4; ++q) gg[q] = g2p[(rr + q) * 256];
#pragma unroll
      for (int t = 0; t < 8; ++t) {
        float4 d0 = *(const float4*)(cvb + t * 1152 + 1024 + rr);
        ag[t] += d0.x * gg[0] + d0.y * gg[1] + d0.z * gg[2] + d0.w * gg[3];
      }
    }
    const float w00 = p.rwkv_w0[(l * 2 + 0) * 256 + c], w01 = p.rwkv_w0[(l * 2 + 1) * 256 + c];
    const float a00 = p.rwkv_a0[(l * 2 + 0) * 256 + c], a01 = p.rwkv_a0[(l * 2 + 1) * 256 + c];
    const float kkc = p.rwkv_kk[l * 256 + c], kac = p.rwkv_ka[l * 256 + c], rkc = p.rwkv_rk[l * 256 + c];
#pragma unroll
    for (int t = 0; t < 8; ++t) {
      const int row = r0 + tg * 8 + t;
      const float r = cvb[t * 1152 + c], k = cvb[t * 1152 + 256 + c], v = cvb[t * 1152 + 512 + c];
      const float wd0 = FEXP(-sigmoidf_(w00 + aw0[t]) * 0.6065306597126334f);
      const float wd1 = FEXP(-sigmoidf_(w01 + aw1[t]) * 0.6065306597126334f);
      const float ad0 = sigmoidf_(a00 + aa0[t]), ad1 = sigmoidf_(a01 + aa1[t]);
      const float kr = k * kkc;
      const float kk = kr * (1.0f / sqrtf(wsum(kr * kr) + 1e-6f));
      const float kd0 = k * (1.0f + (ad0 - 1.0f) * kac), kd1 = k * (1.0f + (ad1 - 1.0f) * kac);
      const float ka0 = kk * ad0, ka1 = kk * ad1;
      const float c10 = wsum(kd0 * r), c20 = wsum(ka0 * r), c11 = wsum(kd1 * r), c21 = wsum(ka1 * r);
      const float bonus = wsum(r * (kd0 + kd1) * rkc);
      float* rec = p.RW() + ((size_t)row * 4 + h) * RWREC;
      rec[lane] = kk; rec[64 + lane] = v;
      rec[128 + lane] = wd0 * r; rec[192 + lane] = wd0; rec[256 + lane] = kd0; rec[320 + lane] = ka0;
      rec[384 + lane] = wd1 * r; rec[448 + lane] = wd1; rec[512 + lane] = kd1; rec[576 + lane] = ka1;
      if (lane == 0) { *(float4*)(rec + 640) = make_float4(c10, c20, bonus, 0.f); *(float4*)(rec + 644) = make_float4(c11, c21, 0.f, 0.f); }
      p.G16()[(size_t)row * 256 + c] = f2bf(ag[t]);
    }
    __syncthreads();
  }
}

__device__ __forceinline__ void fast_gdprep(const Params& p, int l, int wave_s) {
  int tid = make_tid(wave_s);
  const int c = tid & 255, lane = tid & 63, h = c >> 6, tg = tid >> 8;
  const float* cw = p.gdn_conv + (size_t)l * 3 * 768;
  float w0[3], w1[3], w2[3];
#pragma unroll
  for (int j = 0; j < 3; ++j) { w0[j] = cw[j * 256 + c]; w1[j] = cw[768 + j * 256 + c]; w2[j] = cw[1536 + j * 256 + c]; }
  for (int r0 = blockIdx.x * 8; r0 < NTOK; r0 += gridDim.x * 8) {
    float raw[4][3][3];
#pragma unroll
    for (int i = 0; i < 4; ++i) {
      const int row = r0 + tg * 4 + i;
      int t, len; seq_pos(row, t, len);
#pragma unroll
      for (int j = 0; j < 3; ++j) {
        const bf16_t* src = p.P() + (size_t)row * INC + OFF_C + j * 256 + c;
        raw[i][j][1] = bf2f(src[0]);
        raw[i][j][0] = t > 0 ? bf2f(src[-INC]) : 0.f;
        raw[i][j][2] = t < len - 1 ? bf2f(src[INC]) : 0.f;
      }
    }
#pragma unroll
    for (int i = 0; i < 4; ++i) {
      const int row = r0 + tg * 4 + i;
      float qkv[3];
#pragma unroll
      for (int j = 0; j < 3; ++j) qkv[j] = siluf_(raw[i][j][0] * w0[j] + raw[i][j][1] * w1[j] + raw[i][j][2] * w2[j]);
      const float qn = qkv[0] * FRSQ(wsum(qkv[0] * qkv[0]) + 1e-6f) * 0.125f;
      const float kn = qkv[1] * FRSQ(wsum(qkv[1] * qkv[1]) + 1e-6f);
      const float qk = wsum(qn * kn);
      float* rec = p.GP() + ((size_t)row * 4 + h) * GDREC;
      rec[lane] = qn; rec[64 + lane] = kn; rec[128 + lane] = qkv[2];
      if (lane < 2) {
        const int d = lane;
        const bf16_t* ab = p.P() + (size_t)row * INC + OFF_C + 1024;
        const float la = -FEXP(p.gdn_a_log[(l * 2 + d) * 4 + h]) * softplusf_(bf2f(ab[d * 4 + h]) + p.gdn_dt_bias[(l * 2 + d) * 4 + h]);
        *(float4*)(rec + 192 + d * 4) = make_float4(FEXP(la), sigmoidf_(bf2f(ab[8 + d * 4 + h])), qk, 0.f);
      }
    }
  }
}

constexpr int SCH = 16;
template <bool RWKV>
__device__ __forceinline__ void scan_pair(const Params& p, bool last, int task0, char* smem, int tid) {
  constexpr int STEPF = RWKV ? 340 : 148;
  constexpr int NF4 = STEPF / 4;
  constexpr int NLD = (SCH * NF4 + 255) / 256;
  const int hb = tid >> 8, ht = tid & 255;
  const int task = task0 + hb, chain = task >> 2, qr = task & 3;
  const int d = chain / (NB * 4), b = (chain / 4) % NB, h = chain % 4;
  const int v0 = qr * 16;
  float* buf = (float*)(smem + hb * 45056);
  float* ybuf = buf + 2 * SCH * STEPF;
  const int rl = ht >> 4, seg = ht & 15;
  const float* recbase = RWKV ? p.RW() : p.GP();
  constexpr int REC = RWKV ? RWREC : GDREC;
  float S0 = 0.f, S1 = 0.f, S2 = 0.f, S3 = 0.f;
  float4 st0, st1, st2, st3, st4, st5;
  const int nch = (NCX + NTL) / SCH;
#define SCAN_LOAD1(ch, q, dst)                                                                         \
  if ((q) < NLD) {                                                                                     \
    int idx = ht + (q) * 256;                                                                          \
    if (idx < SCH * NF4) {                                                                             \
      int i = idx / NF4, e4 = idx - i * NF4;                                                           \
      int row = scan_row(b, d, (ch) * SCH + i);                                                        \
      const float* rec = recbase + ((size_t)row * 4 + h) * REC;                                        \
      int off;                                                                                         \
      if (RWKV) off = e4 < 16 ? e4 * 4 : (e4 < 80 ? 128 + d * 256 + (e4 - 16) * 4 : (e4 < 84 ? 64 + v0 + (e4 - 80) * 4 : 640 + d * 4)); \
      else off = e4 < 16 ? 64 + e4 * 4 : (e4 < 32 ? (e4 - 16) * 4 : (e4 < 36 ? 128 + v0 + (e4 - 32) * 4 : 192 + d * 4)); \
      dst = *(const float4*)(rec + off);                                                               \
    }                                                                                                  \
  }
#define SCAN_LOAD(ch) { SCAN_LOAD1(ch, 0, st0) SCAN_LOAD1(ch, 1, st1) SCAN_LOAD1(ch, 2, st2) SCAN_LOAD1(ch, 3, st3) SCAN_LOAD1(ch, 4, st4) SCAN_LOAD1(ch, 5, st5) }
#define SCAN_STORE1(bi, q, srcv)                                                                       \
  if ((q) < NLD) {                                                                                     \
    int idx = ht + (q) * 256;                                                                          \
    if (idx < SCH * NF4) *(float4*)(buf + (bi) * SCH * STEPF + idx * 4) = srcv;                        \
  }
#define SCAN_STORE(bi) { SCAN_STORE1(bi, 0, st0) SCAN_STORE1(bi, 1, st1) SCAN_STORE1(bi, 2, st2) SCAN_STORE1(bi, 3, st3) SCAN_STORE1(bi, 4, st4) SCAN_STORE1(bi, 5, st5) }
  SCAN_LOAD(0); SCAN_STORE(0);
  __syncthreads();
  for (int ch = 0; ch < nch; ++ch) {
    const int cur = ch & 1;
    if (ch + 1 < nch) SCAN_LOAD(ch + 1);
    const float* sb = buf + cur * SCH * STEPF;
    float yk = 0.f;
    if (RWKV) {
      float4 kkA, wrA, wA, kdA, kaA, kkB, wrB, wB, kdB, kaB; float2 ccA, ccB; float vA, vB;
#define RW_LD(sp, X) { kk##X = *(const float4*)((sp) + seg * 4); wr##X = *(const float4*)((sp) + 64 + seg * 4); w##X = *(const float4*)((sp) + 128 + seg * 4); \
        kd##X = *(const float4*)((sp) + 192 + seg * 4); ka##X = *(const float4*)((sp) + 256 + seg * 4); v##X = (sp)[320 + rl]; cc##X = *(const float2*)((sp) + 336); }
#define RW_STEP(X, i) { float sa = (S0 * kk##X.x + S1 * kk##X.y) + (S2 * kk##X.z + S3 * kk##X.w); float z = (S0 * wr##X.x + S1 * wr##X.y) + (S2 * wr##X.z + S3 * wr##X.w); \
        sa = reduce16(sa); z = reduce16(z); \
        S0 = S0 * w##X.x + (v##X * kd##X.x - sa * ka##X.x); S1 = S1 * w##X.y + (v##X * kd##X.y - sa * ka##X.y); \
        S2 = S2 * w##X.z + (v##X * kd##X.z - sa * ka##X.z); S3 = S3 * w##X.w + (v##X * kd##X.w - sa * ka##X.w); \
        const float y_ = z + v##X * cc##X.x - sa * cc##X.y; yk = (seg == (i)) ? y_ : yk; }
      RW_LD(sb, A);
#pragma unroll 1
      for (int i = 0; i < SCH; i += 2) {
        RW_LD(sb + (i + 1) * STEPF, B);
        RW_STEP(A, i);
        if (i + 2 < SCH) RW_LD(sb + (i + 2) * STEPF, A);
        RW_STEP(B, i + 1);
      }
#undef RW_LD
#undef RW_STEP
    } else {
      float4 kA, qA, kB, qB, sA, sB; float vA, vB;
#define GD_LD(sp, X) { k##X = *(const float4*)((sp) + seg * 4); q##X = *(const float4*)((sp) + 64 + seg * 4); v##X = (sp)[128 + rl]; s##X = *(const float4*)((sp) + 144); }
#define GD_STEP(X, i) { float ks = (S0 * k##X.x + S1 * k##X.y) + (S2 * k##X.z + S3 * k##X.w); float qs = (S0 * q##X.x + S1 * q##X.y) + (S2 * q##X.z + S3 * q##X.w); \
        ks = reduce16(ks); qs = reduce16(qs); \
        const float vn = s##X.y * (v##X - s##X.x * ks); \
        S0 = S0 * s##X.x + k##X.x * vn; S1 = S1 * s##X.x + k##X.y * vn; S2 = S2 * s##X.x + k##X.z * vn; S3 = S3 * s##X.x + k##X.w * vn; \
        const float y_ = s##X.x * qs + s##X.z * vn; yk = (seg == (i)) ? y_ : yk; }
      GD_LD(sb, A);
#pragma unroll 1
      for (int i = 0; i < SCH; i += 2) {
        GD_LD(sb + (i + 1) * STEPF, B);
        GD_STEP(A, i);
        if (i + 2 < SCH) GD_LD(sb + (i + 2) * STEPF, A);
        GD_STEP(B, i + 1);
      }
#undef GD_LD
#undef GD_STEP
    }
    ybuf[seg * 16 + rl] = yk;
    __syncthreads();
    {
      const int i = ht >> 4, j = ht & 15;
      const int row = scan_row(b, d, ch * SCH + i);
      if (!(last && row >= NLAT)) p.YS()[(size_t)row * 1024 + (RWKV ? 0 : 512) + d * 256 + h * 64 + v0 + j] = f2bf(ybuf[i * 16 + j]);
    }
    if (ch + 1 < nch) SCAN_STORE(cur ^ 1);
    __syncthreads();
  }
#undef SCAN_LOAD
#undef SCAN_STORE
#undef SCAN_LOAD1
#undef SCAN_STORE1
}
__device__ __forceinline__ int scan_npairs() { return 2 * (2 * NB * 4) * 4 / 2; }
__device__ __forceinline__ void scan_run_pair(const Params& p, bool last, int pair, char* smem, int tid) {
  const int nrw = (2 * NB * 4) * 4;
  const int task0 = pair * 2;
  if (task0 < nrw) scan_pair<true>(p, last, task0, smem, tid);
  else scan_pair<false>(p, last, task0 - nrw, smem, tid);
}

__device__ __forceinline__ void fast_post(const Params& p, int l, int nr, int wave_s) {
  int tid = make_tid(wave_s);
  const int lane = tid & 63;
  for (int row = blockIdx.x * 8 + (tid >> 6); row < nr; row += gridDim.x * 8) {
    const bf16_t* ys = p.YS() + (size_t)row * 1024;
    bf16_t* yo = p.Y() + (size_t)row * DM;
#pragma unroll
    for (int h = 0; h < 4; ++h) {
      const int c = h * 64 + lane;
      {
        const float* rec = p.RW() + ((size_t)row * 4 + h) * RWREC;
        const float y = bf2f(ys[c]) + bf2f(ys[256 + c]);
        const float m = wave_sum(y) * (1.0f / 64);
        const float dd = y - m;
        const float rstd = 1.0f / sqrtf(wave_sum(dd * dd) * (1.0f / 64) + 64e-5f);
        const float yn = dd * rstd * p.rwkv_ln_g[l * 256 + c] + p.rwkv_ln_b[l * 256 + c];
        yo[256 + c] = f2bf((yn + rec[642] * rec[64 + lane]) * bf2f(p.G16()[(size_t)row * 256 + c]));
      }
      {
        const float o = bf2f(ys[512 + c]) + bf2f(ys[768 + c]);
        const float rs = 1.0f / sqrtf(wave_sum(o * o) * (1.0f / 64) + 1e-6f);
        const float gate = bf2f(p.P()[(size_t)row * INC + OFF_C + 768 + c]);
        yo[512 + c] = f2bf(o * rs * p.gdn_norm_g[l * 64 + lane] * siluf_(gate));
      }
    }
  }
}

constexpr int NKEY = NTL + NCX;
__device__ __forceinline__ int key_row(int b, int j) { return j < NTL ? b * NTL + j : NLAT + b * NCX + (j - NTL); }

__device__ __forceinline__ void fast_attprep(const Params& p, char* smem, int wave_s) {
  int tid = make_tid(wave_s);
  for (int it = blockIdx.x * NTHREADS + tid; it < NLAT * 32; it += gridDim.x * NTHREADS) {
    const int token = it >> 5, j = it & 31;
    const int blk = j & 3;
    const int t = token % NTL;
    const int pos = (blk & 1) ? (t & 63) : (t >> 6);
    bf16_t* base = p.P() + (size_t)token * INC + OFF_A + (j >> 4) * 256 + ((j >> 2) & 3) * 64 + blk * 16;
    uint4 a = *(const uint4*)base, b = *(const uint4*)(base + 8);
    float x1[8], x2[8];
    unpack8(a, x1); unpack8(b, x2);
#pragma unroll
    for (int i = 0; i < 8; ++i) {
      const float ang = (float)pos * FEXP(-(float)i * (9.210340371976184f / 8.0f));
      const float cs = FCOS(ang), sn = FSIN(ang);
      const float y1 = x1[i] * cs - x2[i] * sn, y2 = x1[i] * sn + x2[i] * cs;
      x1[i] = y1; x2[i] = y2;
    }
    a.x = pk_bf16(x1[0], x1[1]); a.y = pk_bf16(x1[2], x1[3]); a.z = pk_bf16(x1[4], x1[5]); a.w = pk_bf16(x1[6], x1[7]);
    b.x = pk_bf16(x2[0], x2[1]); b.y = pk_bf16(x2[2], x2[3]); b.z = pk_bf16(x2[4], x2[5]); b.w = pk_bf16(x2[6], x2[7]);
    *(uint4*)base = a; *(uint4*)(base + 8) = b;
  }
  bf16_t* Ts = (bf16_t*)smem;
  const int ntile = NKEY / 64;
  const int nt_all = 2 * NB * 4 * ntile;
#define VT_SRC(tix_) (p.P() + (size_t)key_row((((tix_) % (NB * 4 * ntile)) / ntile) >> 2, (((tix_) % (NB * 4 * ntile)) % ntile) * 64 + (tid >> 3)) * INC \
      + (((tix_) / (NB * 4 * ntile)) ? OFF_D : OFF_A) + 512 + ((((tix_) % (NB * 4 * ntile)) / ntile) & 3) * 64 + (tid & 7) * 8)
  uint4 vnext = make_uint4(0u, 0u, 0u, 0u);
  if ((int)blockIdx.x < nt_all) vnext = *(const uint4*)VT_SRC(min((int)blockIdx.x, nt_all - 1));
  for (int tix = blockIdx.x; tix < nt_all; tix += gridDim.x) {
    const int mixer = tix / (NB * 4 * ntile), rem = tix % (NB * 4 * ntile);
    const int bh = rem / ntile, kt = rem % ntile;
    const uint4 v = vnext;
    {
      const int tn = min(tix + (int)gridDim.x, nt_all - 1);
      vnext = *(const uint4*)VT_SRC(tn);
    }
    {
      const int key = tid >> 3, dc = tid & 7;
      const int pos = (key & 32) | ((key & 12) << 1) | ((key & 16) >> 2) | (key & 3);
      bf16_t e[8];
      *(uint4*)e = v;
#pragma unroll
      for (int i = 0; i < 8; ++i) Ts[(dc * 8 + i) * 72 + pos] = e[i];
    }
    LDS_BAR();
    {
      const int d = tid >> 3, pc = tid & 7;
      const uint4 vv = *(const uint4*)(Ts + d * 72 + pc * 8);
      *(uint4*)(p.VT() + (((size_t)mixer * NB * 4 + bh) * 64 + d) * NKEY + kt * 64 + pc * 8) = vv;
    }
    LDS_BAR();
  }
#undef VT_SRC
}

__device__ __forceinline__ float xmax_16_32(float x) {
  float a = x, b = x;
  asm volatile("s_nop 1\n\tv_permlane16_swap_b32 %0, %1" : "+v"(a), "+v"(b));
  x = fmaxf(a, b); a = x; b = x;
  asm volatile("s_nop 1\n\tv_permlane32_swap_b32 %0, %1" : "+v"(a), "+v"(b));
  return fmaxf(a, b);
}
__device__ __forceinline__ float xsum_16_32(float x) {
  float a = x, b = x;
  asm volatile("s_nop 1\n\tv_permlane16_swap_b32 %0, %1" : "+v"(a), "+v"(b));
  x = a + b; a = x; b = x;
  asm volatile("s_nop 1\n\tv_permlane32_swap_b32 %0, %1" : "+v"(a), "+v"(b));
  return a + b;
}
__device__ __forceinline__ bf16x8 pack_p8(const f32x4& lo, const f32x4& hi) {
  uint4 u;
  u.x = pk_bf16(lo[0], lo[1]); u.y = pk_bf16(lo[2], lo[3]); u.z = pk_bf16(hi[0], hi[1]); u.w = pk_bf16(hi[2], hi[3]);
  return __builtin_bit_cast(bf16x8, u);
}

__device__ __forceinline__ void attnA_task(const Params& p, int l, int task, char* smem, int tid) {
  const int nlat_tasks = NB * 4 * (NTL / 256);
  const bool lat = task < nlat_tasks;
  int b, h, qrow0, kt0;
  if (lat) { const int bh = task / (NTL / 256), qb = task % (NTL / 256); b = bh >> 2; h = bh & 3; qrow0 = b * NTL + qb * 256; kt0 = 0; }
  else { const int t2 = task - nlat_tasks; const int bh = t2 / (NCX / 256), qb = t2 % (NCX / 256); b = bh >> 2; h = bh & 3; qrow0 = NLAT + b * NCX + qb * 256; kt0 = NTL / 64; }
  const int nkt = NKEY / 64;
  const int lane = tid & 63, w = tid >> 6, l15 = lane & 15, lq = lane >> 4, sw = l15 & 7;
  char* Ks = smem;
  char* Vs = smem + 16384;
  const float c = 0.17677669529663687f * 1.4426950408889634f;
  bf16x8 qf[2][2];
#pragma unroll
  for (int qt = 0; qt < 2; ++qt)
#pragma unroll
    for (int br = 0; br < 2; ++br)
      qf[br][qt] = *(const bf16x8*)(p.P() + (size_t)(qrow0 + w * 32 + qt * 16 + l15) * INC + OFF_A + h * 64 + br * 32 + lq * 8);
  f32x4 O[2][2][4], L[2][2];
  float m_[2][2];
  const uint4 ones_u = make_uint4(0x3f803f80u, 0x3f803f80u, 0x3f803f80u, 0x3f803f80u);
  const bf16x8 ones8 = __builtin_bit_cast(bf16x8, ones_u);
#pragma unroll
  for (int br = 0; br < 2; ++br)
#pragma unroll
    for (int qt = 0; qt < 2; ++qt) {
      m_[br][qt] = -1e30f; L[br][qt] = f32x4{0.f, 0.f, 0.f, 0.f};
#pragma unroll
      for (int dt = 0; dt < 4; ++dt) O[br][qt][dt] = f32x4{0.f, 0.f, 0.f, 0.f};
    }
  const int srow = tid >> 3, sch = tid & 7;
  const int soff = srow * 128 + ((sch ^ (srow & 7)) << 4);
  const bf16_t* vtbase = p.VT() + (((size_t)0 * NB * 4 + b * 4 + h) * 64 + srow) * NKEY + sch * 8;
  uint4 rk, rv;
#define ATT_LOAD(kt) { rk = *(const uint4*)(p.P() + (size_t)key_row(b, (kt) * 64 + srow) * INC + OFF_A + 256 + h * 64 + sch * 8); rv = *(const uint4*)(vtbase + (kt) * 64); }
#define ATT_STORE(bi) { *(uint4*)(Ks + (bi) * 8192 + soff) = rk; *(uint4*)(Vs + (bi) * 8192 + soff) = rv; }
  ATT_LOAD(kt0);
  ATT_STORE(0);
  LDS_BAR();
  for (int kt = kt0; kt < nkt; ++kt) {
    const int cur = (kt - kt0) & 1;
    if (kt + 1 < nkt) ATT_LOAD(kt + 1);
    const char* kb = Ks + cur * 8192;
    const char* vb = Vs + cur * 8192;
    bf16x8 vf[4][2];
#pragma unroll
    for (int dt = 0; dt < 4; ++dt)
#pragma unroll
      for (int ks = 0; ks < 2; ++ks) vf[dt][ks] = *(const bf16x8*)(vb + (16 * dt + l15) * 128 + (((ks * 4 + lq) ^ sw) << 4));
#pragma unroll
    for (int br = 0; br < 2; ++br) {
      f32x4 S[2][4];
      {
        bf16x8 kf[4];
#pragma unroll
        for (int a = 0; a < 4; ++a) kf[a] = *(const bf16x8*)(kb + (16 * a + l15) * 128 + (((br * 4 + lq) ^ sw) << 4));
#pragma unroll
        for (int qt = 0; qt < 2; ++qt)
#pragma unroll
          for (int a = 0; a < 4; ++a) S[qt][a] = __builtin_amdgcn_mfma_f32_16x16x32_bf16(kf[a], qf[br][qt], f32x4{0.f, 0.f, 0.f, 0.f}, 0, 0, 0);
      }
      float mx[2];
#pragma unroll
      for (int qt = 0; qt < 2; ++qt) {
        float m0 = fmaxf(fmaxf(S[qt][0][0], S[qt][0][1]), fmaxf(S[qt][0][2], S[qt][0][3]));
#pragma unroll
        for (int a = 1; a < 4; ++a) m0 = fmaxf(m0, fmaxf(fmaxf(S[qt][a][0], S[qt][a][1]), fmaxf(S[qt][a][2], S[qt][a][3])));
        mx[qt] = m0 * c;
      }
      if (__any((mx[0] > m_[br][0] + 8.0f) || (mx[1] > m_[br][1] + 8.0f))) {
#pragma unroll
        for (int qt = 0; qt < 2; ++qt) {
          const float mxx = xmax_16_32(mx[qt]);
          const float mn = fmaxf(m_[br][qt], mxx);
          const float alpha = __builtin_amdgcn_exp2f(m_[br][qt] - mn);
          m_[br][qt] = mn;
          L[br][qt] *= alpha;
#pragma unroll
          for (int dt = 0; dt < 4; ++dt) O[br][qt][dt] *= alpha;
        }
      }
#pragma unroll
      for (int qt = 0; qt < 2; ++qt) {
        const float mcur = m_[br][qt];
#pragma unroll
        for (int a = 0; a < 4; ++a)
#pragma unroll
          for (int r = 0; r < 4; ++r) S[qt][a][r] = __builtin_amdgcn_exp2f(S[qt][a][r] * c - mcur);
        const bf16x8 p0 = pack_p8(S[qt][0], S[qt][1]), p1 = pack_p8(S[qt][2], S[qt][3]);
#pragma unroll
        for (int dt = 0; dt < 4; ++dt) {
          O[br][qt][dt] = __builtin_amdgcn_mfma_f32_16x16x32_bf16(vf[dt][0], p0, O[br][qt][dt], 0, 0, 0);
          O[br][qt][dt] = __builtin_amdgcn_mfma_f32_16x16x32_bf16(vf[dt][1], p1, O[br][qt][dt], 0, 0, 0);
        }
        L[br][qt] = __builtin_amdgcn_mfma_f32_16x16x32_bf16(ones8, p0, L[br][qt], 0, 0, 0);
        L[br][qt] = __builtin_amdgcn_mfma_f32_16x16x32_bf16(ones8, p1, L[br][qt], 0, 0, 0);
      }
    }
    if (kt + 1 < nkt) ATT_STORE(cur ^ 1);
    LDS_BAR();
  }
#undef ATT_LOAD
#undef ATT_STORE
  const float* lv = p.diff_lam + l * 128;
  float d01 = 0.f, d23 = 0.f;
#pragma unroll 4
  for (int i = 0; i < 32; ++i) { d01 += lv[i] * lv[32 + i]; d23 += lv[64 + i] * lv[96 + i]; }
  const float lam_init = 0.8f - 0.6f * FEXP(-0.3f * (float)l);
  const float lam = FEXP(d01) - FEXP(d23) + lam_init;
#pragma unroll
  for (int qt = 0; qt < 2; ++qt) {
    const float i1 = 1.0f / L[0][qt][0], i2 = lam / L[1][qt][0];
    float ss = 0.f;
    f32x4 o[4];
#pragma unroll
    for (int dt = 0; dt < 4; ++dt)
#pragma unroll
      for (int r = 0; r < 4; ++r) { o[dt][r] = O[0][qt][dt][r] * i1 - O[1][qt][dt][r] * i2; ss += o[dt][r] * o[dt][r]; }
    ss = xsum_16_32(ss);
    const float rs = (1.0f / sqrtf(ss * (1.0f / 64) + 1e-6f)) * (1.0f - lam_init);
    bf16_t* yp = p.Y() + (size_t)(qrow0 + w * 32 + qt * 16 + l15) * DM + h * 64;
#pragma unroll
    for (int dt = 0; dt < 4; ++dt) {
      const float4 g = *(const float4*)(p.diff_norm_g + l * 64 + dt * 16 + lq * 4);
      uint2 v;
      v.x = pk_bf16(o[dt][0] * rs * g.x, o[dt][1] * rs * g.y);
      v.y = pk_bf16(o[dt][2] * rs * g.z, o[dt][3] * rs * g.w);
      *(uint2*)(yp + dt * 16 + lq * 4) = v;
    }
  }
  LDS_BAR();
}
__device__ __forceinline__ void fast_attnA(const Params& p, int l, char* smem, int wave_s, int vb, int nvb) {
  int tid = make_tid(wave_s);
  const int ntask = NB * 4 * (NTL / 256) + (l == 0 ? NB * 4 * (NCX / 256) : 0);
  for (int t = vb; t < ntask; t += nvb) { const int tid2 = make_tid(wave_s); attnA_task(p, l, t, smem, tid2); }
}

__device__ __forceinline__ void attnD_pair(const Params& p, int l, int pair, char* smem, int tid) {
  const int nlat = NB * 4 * GROWS;
  const int hb = tid >> 8;
  const int task = pair * 2 + hb;
  const bool lat = task < nlat;
  int b, h, qrow0, rq = 0, rs = 0, ntile;
  if (lat) {
    const int bh = task / GROWS; rq = task % GROWS; b = bh >> 2; h = bh & 3;
    qrow0 = b * NTL + rq * 64;
    rs = rq - 4; rs = rs < 0 ? 0 : (rs > GROWS - 8 ? GROWS - 8 : rs);
    ntile = 8 + NCX / 64;
  } else {
    const int t2 = task - nlat; const int bh = t2 / (NCX / 64), sub = t2 % (NCX / 64); b = bh >> 2; h = bh & 3;
    qrow0 = NLAT + b * NCX + sub * 64;
    ntile = NCX / 64;
  }
  const int ht = tid & 255, lane = tid & 63, wq = (tid >> 6) & 3, l15 = lane & 15, lq = lane >> 4, sw = l15 & 7;
  char* Ks = smem + hb * 34816;
  char* Vs = Ks + 16384;
  float* tbl = (float*)(Ks + 32768);
  for (int i = ht; i < 15 * 31; i += 256) tbl[i] = p.nat_rpb[((size_t)l * 4 + h) * 465 + i];
  const float LOG2E = 1.4426950408889634f;
  bf16x8 qf[2];
#pragma unroll
  for (int ks = 0; ks < 2; ++ks)
    qf[ks] = *(const bf16x8*)(p.P() + (size_t)(qrow0 + wq * 16 + l15) * INC + OFF_D + h * 64 + ks * 32 + lq * 8);
  f32x4 O[4];
#pragma unroll
  for (int dt = 0; dt < 4; ++dt) O[dt] = f32x4{0.f, 0.f, 0.f, 0.f};
  float m_ = -1e30f;
  f32x4 Ls = f32x4{0.f, 0.f, 0.f, 0.f};
  const uint4 ones_u = make_uint4(0x3f803f80u, 0x3f803f80u, 0x3f803f80u, 0x3f803f80u);
  const bf16x8 ones8 = __builtin_bit_cast(bf16x8, ones_u);
  const int cq = wq * 16 + l15;
  int cs = cq - 8; cs = cs < 0 ? 0 : (cs > 48 ? 48 : cs);
  const int srow = ht >> 2, sch = (ht & 3) * 2;
  const int soff0 = srow * 128 + ((sch ^ (srow & 7)) << 4), soff1 = srow * 128 + (((sch + 1) ^ (srow & 7)) << 4);
  const bf16_t* vtb = p.VT() + (((size_t)1 * NB * 4 + b * 4 + h) * 64 + srow) * NKEY + sch * 8;
  uint4 rk0, rk1, rv0, rv1;
#define ATD_KEY0(j) (lat ? ((j) < 8 ? (rs + (j)) * 64 : NTL + ((j) - 8) * 64) : NTL + (j) * 64)
#define ATD_LOAD(j) { const int k0_ = ATD_KEY0(j); const bf16_t* kp_ = p.P() + (size_t)key_row(b, k0_ + srow) * INC + OFF_D + 256 + h * 64 + sch * 8; \
    rk0 = *(const uint4*)kp_; rk1 = *(const uint4*)(kp_ + 8); rv0 = *(const uint4*)(vtb + k0_); rv1 = *(const uint4*)(vtb + k0_ + 8); }
#define ATD_STORE(bi) { *(uint4*)(Ks + (bi) * 8192 + soff0) = rk0; *(uint4*)(Ks + (bi) * 8192 + soff1) = rk1; \
    *(uint4*)(Vs + (bi) * 8192 + soff0) = rv0; *(uint4*)(Vs + (bi) * 8192 + soff1) = rv1; }
  ATD_LOAD(0);
  ATD_STORE(0);
  LDS_BAR();
  for (int j = 0; j < ntile; ++j) {
    const int cur = j & 1;
    if (j + 1 < ntile) ATD_LOAD(j + 1);
    const char* kb = Ks + cur * 8192;
    const char* vb = Vs + cur * 8192;
    f32x4 S[4];
#pragma unroll
    for (int a = 0; a < 4; ++a) {
      S[a] = f32x4{0.f, 0.f, 0.f, 0.f};
#pragma unroll
      for (int ks = 0; ks < 2; ++ks) {
        const bf16x8 kf = *(const bf16x8*)(kb + (16 * a + l15) * 128 + (((ks * 4 + lq) ^ sw) << 4));
        S[a] = __builtin_amdgcn_mfma_f32_16x16x32_bf16(kf, qf[ks], S[a], 0, 0, 0);
      }
    }
    const bool win = lat && j < 8;
    const float* trow = tbl + (rs + j - rq + 7) * 31 - cq + 15;
    float mx = -1e30f;
#pragma unroll
    for (int a = 0; a < 4; ++a)
#pragma unroll
      for (int r = 0; r < 4; ++r) {
        float v = S[a][r] * (0.125f * LOG2E);
        if (win) {
          const int ck = 16 * a + 4 * lq + r;
          const bool ok = (unsigned)(ck - cs) < 16u;
          v = ok ? v + trow[ok ? ck : cq] * LOG2E : -1e30f;
        }
        S[a][r] = v;
        mx = fmaxf(mx, v);
      }
    if (__any(mx > m_ + 8.0f)) {
      mx = xmax_16_32(mx);
      const float mn = fmaxf(m_, mx);
      const float alpha = __builtin_amdgcn_exp2f(m_ - mn);
      m_ = mn;
      Ls *= alpha;
#pragma unroll
      for (int dt = 0; dt < 4; ++dt) O[dt] *= alpha;
    }
#pragma unroll
    for (int a = 0; a < 4; ++a)
#pragma unroll
      for (int r = 0; r < 4; ++r) S[a][r] = __builtin_amdgcn_exp2f(S[a][r] - m_);
    const bf16x8 p0 = pack_p8(S[0], S[1]), p1 = pack_p8(S[2], S[3]);
#pragma unroll
    for (int dt = 0; dt < 4; ++dt) {
      const bf16x8 v0 = *(const bf16x8*)(vb + (16 * dt + l15) * 128 + (((0 * 4 + lq) ^ sw) << 4));
      const bf16x8 v1 = *(const bf16x8*)(vb + (16 * dt + l15) * 128 + (((1 * 4 + lq) ^ sw) << 4));
      O[dt] = __builtin_amdgcn_mfma_f32_16x16x32_bf16(v0, p0, O[dt], 0, 0, 0);
      O[dt] = __builtin_amdgcn_mfma_f32_16x16x32_bf16(v1, p1, O[dt], 0, 0, 0);
    }
    Ls = __builtin_amdgcn_mfma_f32_16x16x32_bf16(ones8, p0, Ls, 0, 0, 0);
    Ls = __builtin_amdgcn_mfma_f32_16x16x32_bf16(ones8, p1, Ls, 0, 0, 0);
    if (j + 1 < ntile) ATD_STORE(cur ^ 1);
    LDS_BAR();
  }
#undef ATD_KEY0
#undef ATD_LOAD
#undef ATD_STORE
  const float inv = 1.0f / Ls[0];
  bf16_t* yp = p.Y() + (size_t)(qrow0 + wq * 16 + l15) * DM + 768 + h * 64;
#pragma unroll
  for (int dt = 0; dt < 4; ++dt) {
    uint2 v;
    v.x = pk_bf16(O[dt][0] * inv, O[dt][1] * inv);
    v.y = pk_bf16(O[dt][2] * inv, O[dt][3] * inv);
    *(uint2*)(yp + dt * 16 + lq * 4) = v;
  }
  LDS_BAR();
}
__device__ __forceinline__ void fast_attnD(const Params& p, int l, char* smem, int wave_s, int vb, int nvb) {
  int tid = make_tid(wave_s);
  const int npair = (NB * 4 * GROWS + (l == 0 ? NB * 4 * (NCX / 64) : 0)) / 2;
  for (int t = vb; t < npair; t += nvb) { const int tid2 = make_tid(wave_s); attnD_pair(p, l, t, smem, tid2); }
}

__device__ __forceinline__ void fast_ada(const Params& p, char* smem, int wave_s) {
  int tid = make_tid(wave_s);
  float* red = (float*)smem;
  const int jc = tid & 31, ks = tid >> 5;
  for (int t = blockIdx.x; t < 2 * (6144 / 32); t += gridDim.x) {
    const int l = t / (6144 / 32), j = (t % (6144 / 32)) * 32 + jc;
    float acc[NMODV];
#pragma unroll
    for (int v = 0; v < NMODV; ++v) acc[v] = 0.f;
    for (int i = ks * 64; i < ks * 64 + 64; ++i) {
      const float w = p.w_ada[((size_t)l * DM + i) * 6144 + j];
#pragma unroll
      for (int v = 0; v < NB; ++v) acc[v] += siluf_(p.c[v * DM + i]) * w;
      acc[NB] += siluf_(p.c_ctx[i]) * w;
    }
#pragma unroll
    for (int v = 0; v < NMODV; ++v) red[(ks * NMODV + v) * 32 + jc] = acc[v];
    __syncthreads();
    if (tid < NMODV * 32) {
      const int v = tid >> 5;
      float sacc = p.b_ada[l * 6144 + j];
#pragma unroll
      for (int k2 = 0; k2 < 16; ++k2) sacc += red[(k2 * NMODV + v) * 32 + jc];
      p.mod()[((size_t)l * NMODV + v) * 6144 + j] = sacc;
    }
    __syncthreads();
  }
}

constexpr int CL = 16;
constexpr int NCHK = (NTL + NCX) / CL;
constexpr int IMG_KK = 0, IMG_RT = 2048, IMG_TR = 4096, IMG_BK = 6144, IMG_WL = 10240, IMG_VV = 10496, IMG_BYTES = 12544;
__device__ __forceinline__ char* img_ptr(const Params& p, int mixer, int d, int b, int h, int cidx) {
  return (char*)p.RW() + ((size_t)((((mixer * 2 + d) * NB + b) * 4 + h)) * NCHK + cidx) * IMG_BYTES;
}
__device__ __forceinline__ bf16_t* rv16(const Params& p) { return (bf16_t*)((char*)p.RW() + (size_t)2 * 2 * NB * 4 * NCHK * IMG_BYTES); }
__device__ __forceinline__ float* bonbuf(const Params& p) { return (float*)(rv16(p) + (size_t)NTOK * 256); }
constexpr int LORAT_LAYER = 2 * 256 * 64 * 2 + 256 * 128;
__device__ __forceinline__ bf16_t* lorat(const Params& p, int l) { return (bf16_t*)(bonbuf(p) + (size_t)NTOK * 4) + (size_t)l * LORAT_LAYER; }
__device__ __forceinline__ void conv_lora(const Params& p, int wave_s) {
  const int tid = make_tid(wave_s);
  for (int idx = blockIdx.x * NTHREADS + tid; idx < 2 * LORAT_LAYER; idx += gridDim.x * NTHREADS) {
    const int l = idx / LORAT_LAYER, e = idx % LORAT_LAYER;
    float v;
    if (e < 2 * 256 * 64) { const int d = e / (256 * 64), c = (e / 64) % 256, k = e % 64; v = p.rwkv_w2[((size_t)(l * 2 + d) * 64 + k) * 256 + c]; }
    else if (e < 4 * 256 * 64) { const int e2 = e - 2 * 256 * 64; const int d = e2 / (256 * 64), c = (e2 / 64) % 256, k = e2 % 64; v = p.rwkv_a2[((size_t)(l * 2 + d) * 64 + k) * 256 + c]; }
    else { const int e2 = e - 4 * 256 * 64; const int c = e2 / 128, k = e2 % 128; v = p.rwkv_g2[((size_t)l * 128 + k) * 256 + c]; }
    lorat(p, l)[e] = f2bf(v);
  }
}
__device__ __forceinline__ int colp(int pp) { return 16 * (2 * (pp >> 5) + ((pp & 7) >> 2)) + 4 * ((pp >> 3) & 3) + (pp & 3); }
__device__ __forceinline__ int tile_cidx(bool is_ctx, int t0, int d) {
  const int j = t0 >> 4;
  if (is_ctx) return d == 0 ? j : NCX / 16 - 1 - j;
  return NCX / 16 + (d == 0 ? j : NTL / 16 - 1 - j);
}
constexpr int VEC_OFF = 77824;
constexpr int VS = 258;
constexpr int WCS = 65, MS = 17;
constexpr int VEC_W0 = 0, VEC_W1 = 16384, VEC_KK = 32768, VEC_R = VEC_KK + 16 * VS * 2, VEC_B0 = VEC_R + 16 * VS * 2, VEC_B1 = VEC_B0 + 16 * VS * 2,
              VEC_KD0 = VEC_B1 + 16 * VS * 2, VEC_KD1 = VEC_KD0 + 16 * VS * 2;
constexpr int SCR_WC = 0, SCR_T6 = 8192, SCR_MAT = 57344;

template <bool NOWRITE>
__device__ __forceinline__ void chunk_prep_head(const Params& p, int mixer, int b, bool is_ctx, int t0, int h, char* smem, int tid) {
  const char* vec = smem + VEC_OFF;
  float* Wc = (float*)(smem + SCR_WC);
  float* T6 = (float*)(smem + SCR_T6);
  float* MAT = (float*)(smem + SCR_MAT);
  if (tid < 128) {
    const int d = tid >> 6, k = tid & 63;
    const float* wv = (const float*)(vec + (d ? VEC_W1 : VEC_W0));
    float acc = 1.f;
#pragma unroll
    for (int s_ = 0; s_ < 16; ++s_) {
      const int tok = d ? 15 - s_ : s_;
      acc *= wv[tok * 256 + h * 64 + k];
      Wc[(d * 16 + s_) * 64 + k] = acc;
    }
  }
  __syncthreads();
#pragma unroll
  for (int q = 0; q < 4; ++q) {
    const int idx = tid + q * NTHREADS;
    const int d = idx >> 10, s_ = (idx >> 6) & 15, k = idx & 63;
    const int tok = d ? 15 - s_ : s_;
    const int vi = tok * 256 + h * 64 + k;
    const float W = Wc[(d * 16 + s_) * 64 + k];
    const float Wp = s_ ? Wc[(d * 16 + s_ - 1) * 64 + k] : 1.f;
    const float WL = Wc[(d * 16 + 15) * 64 + k];
    const float iW = 1.0f / W;
    const float kk = bf2f(((const bf16_t*)(vec + VEC_KK))[vi]), r = bf2f(((const bf16_t*)(vec + VEC_R))[vi]);
    const float bb = bf2f(((const bf16_t*)(vec + (d ? VEC_B1 : VEC_B0)))[vi]), kd = bf2f(((const bf16_t*)(vec + (d ? VEC_KD1 : VEC_KD0)))[vi]);
    float* t6 = T6 + (size_t)d * 6 * 1024 + s_ * 64 + k;
    t6[0] = kk * Wp; t6[1024] = r * W; t6[2048] = bb * iW; t6[3072] = kd * iW; t6[4096] = bb * (WL * iW); t6[5120] = kd * (WL * iW);
  }
  __syncthreads();
  {
    const int lane = tid & 63, w = tid >> 6, d = w >> 2, mat = w & 3, i = lane & 15, g = lane >> 4;
    const float* X = T6 + (size_t)d * 6 * 1024 + (mat < 2 ? 0 : 1024) + i * 64 + g;
    const float* Yv = T6 + (size_t)d * 6 * 1024 + ((mat & 1) ? 3072 : 2048) + i * 64 + g;
    float xa[16], ya[16];
#pragma unroll
    for (int k4 = 0; k4 < 16; ++k4) { xa[k4] = X[4 * k4]; ya[k4] = Yv[4 * k4]; }
    f32x4 ac4[4];
#pragma unroll
    for (int q = 0; q < 4; ++q) ac4[q] = f32x4{0.f, 0.f, 0.f, 0.f};
#pragma unroll
    for (int k4 = 0; k4 < 16; ++k4) ac4[k4 & 3] = __builtin_amdgcn_mfma_f32_16x16x4f32(xa[k4], ya[k4], ac4[k4 & 3], 0, 0, 0);
    const f32x4 acc = (ac4[0] + ac4[1]) + (ac4[2] + ac4[3]);
#pragma unroll
    for (int r_ = 0; r_ < 4; ++r_) {
      const int s_ = 4 * g + r_;
      const bool keep = mat < 2 ? (i < s_) : (i <= s_);
      MAT[((d * 6 + mat) * 16 + s_) * 16 + i] = keep ? acc[r_] : 0.f;
    }
  }
  __syncthreads();
  {
    const int d = tid >> 8, col = (tid >> 4) & 15, j = tid & 15;
    const float* A = MAT + (d * 6 + 0) * 256 + j;
    float a[16];
#pragma unroll
    for (int i = 0; i < 16; ++i) a[i] = A[i * 16];
    float xj = 0.f;
#pragma unroll
    for (int i = 0; i < 16; ++i) {
      const float part = (j < i) ? a[i] * xj : 0.f;
      const float sum = reduce16(part);
      const float xi = ((i == col) ? 1.f : 0.f) - sum;
      xj = (j == i) ? xi : xj;
    }
    MAT[(d * 6 + 4) * 256 + j * 16 + col] = xj;
  }
  __syncthreads();
  {
    const int d = tid >> 8, s_ = (tid >> 4) & 15, j = tid & 15;
    const float* Ti = MAT + (d * 6 + 4) * 256 + s_ * 16;
    const float* Ak = MAT + (d * 6 + 1) * 256 + j;
    float acc = 0.f;
#pragma unroll
    for (int u = 0; u < 16; ++u) acc += Ti[u] * Ak[u * 16];
    MAT[(d * 6 + 5) * 256 + s_ * 16 + j] = acc;
  }
  __syncthreads();
#pragma unroll
  for (int q = 0; q < 3; ++q) {
    const int idx = tid + q * NTHREADS;
    if (!NOWRITE && idx < 2 * 656) {
      const int d = idx / 656, c = idx - d * 656;
      char* img = img_ptr(p, mixer, d, b, h, tile_cidx(is_ctx, t0, d));
      const float* t6 = T6 + (size_t)d * 6 * 1024;
      const float* mt = MAT + d * 6 * 256;
      if (c < 640) {
        float e[8];
        int off;
        if (c < 256) {
          const int which = c >> 7, cc = c & 127, s_ = cc >> 3, ch = cc & 7;
          const float* src = t6 + which * 1024 + s_ * 64;
#pragma unroll
          for (int e_ = 0; e_ < 8; ++e_) e[e_] = src[colp(ch * 8 + e_)];
          off = (which ? IMG_RT : IMG_KK) + s_ * 128 + ((ch ^ (s_ & 7)) << 4);
        } else if (c < 384) {
          const int cc = c - 256, s_ = cc >> 3, ch = cc & 7, g = ch & 3;
          const float* m0 = mt + (ch < 4 ? 4 : 2) * 256 + s_ * 16 + 4 * g;
          const float* m1 = mt + (ch < 4 ? 5 : 3) * 256 + s_ * 16 + 4 * g;
#pragma unroll
          for (int e_ = 0; e_ < 4; ++e_) { e[e_] = m0[e_]; e[4 + e_] = m1[e_]; }
          off = IMG_TR + s_ * 128 + ((ch ^ (s_ & 7)) << 4);
        } else {
          const int cc = c - 384, kc = cc >> 2, g = cc & 3;
#pragma unroll
          for (int e_ = 0; e_ < 4; ++e_) { e[e_] = t6[4096 + (4 * g + e_) * 64 + kc]; e[4 + e_] = t6[5120 + (4 * g + e_) * 64 + kc]; }
          const int row = kc & 31, ch = (kc >> 5) * 4 + g;
          off = IMG_BK + row * 128 + ((ch ^ (row & 7)) << 4);
        }
        uint4 v;
        v.x = pk_bf16(e[0], e[1]); v.y = pk_bf16(e[2], e[3]); v.z = pk_bf16(e[4], e[5]); v.w = pk_bf16(e[6], e[7]);
        *(uint4*)(img + off) = v;
      } else {
        const int k0 = (c - 640) * 4;
        *(float4*)(img + IMG_WL + k0 * 4) = *(const float4*)(Wc + (d * 16 + 15) * 64 + k0);
      }
    }
  }
  __syncthreads();
}

__device__ __forceinline__ float4 ld4f(const float* q) { return make_float4(q[0], q[1], q[2], q[3]); }
__device__ __forceinline__ f32x4 mm16(const float* X, const float* Y, int i, int g, bool neg_x_plus_eye) {
  f32x4 acc = f32x4{0.f, 0.f, 0.f, 0.f};
#pragma unroll
  for (int k4 = 0; k4 < 4; ++k4) {
    float a = X[i * MS + 4 * k4 + g];
    if (neg_x_plus_eye) a = ((i == 4 * k4 + g) ? 1.f : 0.f) - a;
    const float b = Y[(4 * k4 + g) * MS + i];
    acc = __builtin_amdgcn_mfma_f32_16x16x4f32(a, b, acc, 0, 0, 0);
  }
  return acc;
}
__device__ __forceinline__ void st16(float* M, const f32x4& v, int i, int g) {
#pragma unroll
  for (int r_ = 0; r_ < 4; ++r_) M[(4 * g + r_) * MS + i] = v[r_];
}
__device__ __forceinline__ void chunk_prep_wave(const Params& p, int mixer, int b, bool is_ctx, int t0, char* smem, int tid) {
  const int lane = tid & 63, w = tid >> 6, h = w & 3, d = w >> 2, i = lane & 15, g = lane >> 4;
  const char* vec = smem + VEC_OFF;
  float* Wc = (float*)(smem + w * 9728);
  float* M0 = Wc + 16 * WCS;
  float* M1 = M0 + 16 * MS;
  float* M2 = M1 + 16 * MS;
  float* M3 = M2 + 16 * MS;
  float* M4 = M3 + 16 * MS;
  char* img = img_ptr(p, mixer, d, b, h, tile_cidx(is_ctx, t0, d));
  const float* wv = (const float*)(vec + (d ? VEC_W1 : VEC_W0)) + h * 64;
  const bf16_t* vkk = (const bf16_t*)(vec + VEC_KK) + h * 64;
  const bf16_t* vr = (const bf16_t*)(vec + VEC_R) + h * 64;
  const bf16_t* vb = (const bf16_t*)(vec + (d ? VEC_B1 : VEC_B0)) + h * 64;
  const bf16_t* vkd = (const bf16_t*)(vec + (d ? VEC_KD1 : VEC_KD0)) + h * 64;
  {
    float acc = 1.f;
#pragma unroll
    for (int s_ = 0; s_ < 16; ++s_) {
      const int tok = d ? 15 - s_ : s_;
      acc *= wv[tok * 256 + lane];
      Wc[s_ * WCS + lane] = acc;
    }
  }
  {
    const int tok = d ? 15 - i : i;
    float KKT[16], RT[16], BT[16], KDT[16];
#pragma unroll
    for (int k4 = 0; k4 < 16; ++k4) {
      const int k = 4 * k4 + g;
      const float W = Wc[i * WCS + k];
      const float Wp = i ? Wc[(i - 1) * WCS + k] : 1.f;
      const float iW = __builtin_amdgcn_rcpf(W);
      KKT[k4] = bf2f(vkk[tok * VS + k]) * Wp;
      RT[k4] = bf2f(vr[tok * VS + k]) * W;
      BT[k4] = bf2f(vb[tok * VS + k]) * iW;
      KDT[k4] = bf2f(vkd[tok * VS + k]) * iW;
    }
    f32x4 aab = f32x4{0.f, 0.f, 0.f, 0.f}, aak = aab, rbb = aab, rkk = aab;
#pragma unroll
    for (int k4 = 0; k4 < 16; ++k4) {
      aab = __builtin_amdgcn_mfma_f32_16x16x4f32(KKT[k4], BT[k4], aab, 0, 0, 0);
      aak = __builtin_amdgcn_mfma_f32_16x16x4f32(KKT[k4], KDT[k4], aak, 0, 0, 0);
      rbb = __builtin_amdgcn_mfma_f32_16x16x4f32(RT[k4], BT[k4], rbb, 0, 0, 0);
      rkk = __builtin_amdgcn_mfma_f32_16x16x4f32(RT[k4], KDT[k4], rkk, 0, 0, 0);
    }
#pragma unroll
    for (int r_ = 0; r_ < 4; ++r_) {
      const int s_ = 4 * g + r_;
      const bool st = i < s_, inc = i <= s_;
      M0[s_ * MS + i] = st ? aab[r_] : 0.f;
      M1[s_ * MS + i] = st ? aak[r_] : 0.f;
      M2[s_ * MS + i] = inc ? rbb[r_] : 0.f;
      M3[s_ * MS + i] = inc ? rkk[r_] : 0.f;
    }
  }
  {
    const int s_ = lane >> 2, gg = lane & 3;
    const float4 x0 = ld4f(M2 + s_ * MS + 4 * gg), x1 = ld4f(M3 + s_ * MS + 4 * gg);
    uint4 v;
    v.x = pk_bf16(x0.x, x0.y); v.y = pk_bf16(x0.z, x0.w); v.z = pk_bf16(x1.x, x1.y); v.w = pk_bf16(x1.z, x1.w);
    *(uint4*)(img + IMG_TR + s_ * 128 + (((4 + gg) ^ (s_ & 7)) << 4)) = v;
  }
  {
    f32x4 P;
#pragma unroll
    for (int r_ = 0; r_ < 4; ++r_) { const int s_ = 4 * g + r_; P[r_] = ((s_ == i) ? 1.f : 0.f) - M0[s_ * MS + i]; }
    f32x4 X2 = mm16(M0, M0, i, g, false);
    st16(M2, X2, i, g);
    st16(M3, P, i, g);
    P += mm16(M3, M2, i, g, false);
    f32x4 X4 = mm16(M2, M2, i, g, false);
    st16(M4, X4, i, g);
    st16(M3, P, i, g);
    P += mm16(M3, M4, i, g, false);
    f32x4 X8 = mm16(M4, M4, i, g, false);
    st16(M2, X8, i, g);
    st16(M3, P, i, g);
    P += mm16(M3, M2, i, g, false);
    st16(M3, P, i, g);
    f32x4 Mm = mm16(M3, M1, i, g, false);
    st16(M2, Mm, i, g);
  }
  {
    const int s_ = lane >> 2, gg = lane & 3;
    const float4 x0 = ld4f(M3 + s_ * MS + 4 * gg), x1 = ld4f(M2 + s_ * MS + 4 * gg);
    uint4 v;
    v.x = pk_bf16(x0.x, x0.y); v.y = pk_bf16(x0.z, x0.w); v.z = pk_bf16(x1.x, x1.y); v.w = pk_bf16(x1.z, x1.w);
    *(uint4*)(img + IMG_TR + s_ * 128 + ((gg ^ (s_ & 7)) << 4)) = v;
  }
#pragma unroll
  for (int q = 0; q < 2; ++q) {
    const int cc = lane + 64 * q, s_ = cc >> 3, ch = cc & 7;
    const int tok = d ? 15 - s_ : s_;
    float ek[8], er[8];
#pragma unroll
    for (int e_ = 0; e_ < 8; ++e_) {
      const int k = colp(ch * 8 + e_);
      const float W = Wc[s_ * WCS + k];
      const float Wp = s_ ? Wc[(s_ - 1) * WCS + k] : 1.f;
      ek[e_] = bf2f(vkk[tok * VS + k]) * Wp;
      er[e_] = bf2f(vr[tok * VS + k]) * W;
    }
    uint4 v;
    v.x = pk_bf16(ek[0], ek[1]); v.y = pk_bf16(ek[2], ek[3]); v.z = pk_bf16(ek[4], ek[5]); v.w = pk_bf16(ek[6], ek[7]);
    *(uint4*)(img + IMG_KK + s_ * 128 + ((ch ^ (s_ & 7)) << 4)) = v;
    v.x = pk_bf16(er[0], er[1]); v.y = pk_bf16(er[2], er[3]); v.z = pk_bf16(er[4], er[5]); v.w = pk_bf16(er[6], er[7]);
    *(uint4*)(img + IMG_RT + s_ * 128 + ((ch ^ (s_ & 7)) << 4)) = v;
  }
#pragma unroll
  for (int q = 0; q < 4; ++q) {
    const int cc = lane + 64 * q, kc = cc >> 2, gg = cc & 3;
    const float WL = Wc[15 * WCS + kc];
    float e[8];
#pragma unroll
    for (int e_ = 0; e_ < 4; ++e_) {
      const int s_ = 4 * gg + e_, tok = d ? 15 - s_ : s_;
      const float f = WL * __builtin_amdgcn_rcpf(Wc[s_ * WCS + kc]);
      e[e_] = bf2f(vb[tok * VS + kc]) * f;
      e[4 + e_] = bf2f(vkd[tok * VS + kc]) * f;
    }
    const int row = kc & 31, ch = (kc >> 5) * 4 + gg;
    uint4 v;
    v.x = pk_bf16(e[0], e[1]); v.y = pk_bf16(e[2], e[3]); v.z = pk_bf16(e[4], e[5]); v.w = pk_bf16(e[6], e[7]);
    *(uint4*)(img + IMG_BK + row * 128 + ((ch ^ (row & 7)) << 4)) = v;
  }
  if (lane < 16) *(float4*)(img + IMG_WL + lane * 16) = ld4f(Wc + 15 * WCS + lane * 4);
}

constexpr int CVS = 1156;
__device__ __forceinline__ bf16x8 cv_frag(const float* q) {
  const float4 a = *(const float4*)q, b = *(const float4*)(q + 4);
  uint4 u; u.x = pk_bf16(a.x, a.y); u.y = pk_bf16(a.z, a.w); u.z = pk_bf16(b.x, b.y); u.w = pk_bf16(b.z, b.w);
  return __builtin_bit_cast(bf16x8, u);
}
struct RwFill { uint4 cu, pu, nu; float4 m0a, m0b, m1a, m1b; };
__device__ __forceinline__ void rw_fill_load(const Params& p, const float* mu, int r0, int tk, int ch, RwFill& f) {
  const int col = ch * 8;
  const int row = r0 + tk;
  int t, len; seq_pos(row, t, len);
  const bf16_t* src = p.P() + (size_t)row * INC + OFF_B + col;
  const uint4 zero4 = make_uint4(0u, 0u, 0u, 0u);
  f.cu = *(const uint4*)src;
  const bool hp = t > 0, hn = t < len - 1;
  const uint4 pu = *(const uint4*)(src - (hp ? INC : 0)), nu = *(const uint4*)(src + (hn ? INC : 0));
  f.pu = hp ? pu : zero4;
  f.nu = hn ? nu : zero4;
  f.m0a = *(const float4*)(mu + col); f.m0b = *(const float4*)(mu + col + 4);
  f.m1a = *(const float4*)(mu + 1152 + col); f.m1b = *(const float4*)(mu + 1152 + col + 4);
}
template <int ACT>
__device__ __forceinline__ void rw_fill_store(float* Cv, int tk, int ch, const RwFill& f) {
  const int col = ch * 8;
  float xc[8], xp[8], xn[8];
  unpack8(f.cu, xc); unpack8(f.pu, xp); unpack8(f.nu, xn);
  const float m0[8] = {f.m0a.x, f.m0a.y, f.m0a.z, f.m0a.w, f.m0b.x, f.m0b.y, f.m0b.z, f.m0b.w};
  const float m1[8] = {f.m1a.x, f.m1a.y, f.m1a.z, f.m1a.w, f.m1b.x, f.m1b.y, f.m1b.z, f.m1b.w};
  float o[8];
#pragma unroll
  for (int e = 0; e < 8; ++e) {
    float v = xc[e] * (1.0f - m0[e] - m1[e]) + xp[e] * m0[e] + xn[e] * m1[e];
    if (ACT == 1) v = tanhf_(v);
    if (ACT == 2) v = sigmoidf_(v);
    o[e] = v;
  }
  *(float4*)(Cv + tk * CVS + col) = make_float4(o[0], o[1], o[2], o[3]);
  *(float4*)(Cv + tk * CVS + col + 4) = make_float4(o[4], o[5], o[6], o[7]);
}
template <int RPM = 0>
__device__ __forceinline__ void chunk_rwprep(const Params& p, int l, char* smem, int wave_s) {
  const int tid0 = make_tid(wave_s);
  float* Cv = (float*)smem;
  char* vec = smem + VEC_OFF;
  const float* mu = p.rwkv_mu + (size_t)l * 2 * 1152;
  const bf16_t* LT = lorat(p, l);
  for (int tile = blockIdx.x; tile < NTOK / 16; tile += gridDim.x) {
    int tid = tid0; asm volatile("" : "+v"(tid));
    const int lane = tid & 63, w = tid >> 6, h = w & 3, i = lane & 15, g = lane >> 4;
    const int r0 = tile * 16;
    const bool is_ctx = r0 >= NLAT;
    const int b = is_ctx ? (r0 - NLAT) / NCX : r0 / NTL;
    const int t0 = is_ctx ? (r0 - NLAT) % NCX : r0 % NTL;
    {
      const int wu = __builtin_amdgcn_readfirstlane(tid >> 6);
      const int cidx = tid & 255;
      const int tkA = cidx >> 4, chA = (wu < 4 ? 96 : 128) + (cidx & 15);
      int tkP[4], chP[4];
#pragma unroll
      for (int q = 0; q < 4; ++q) { const int idx = min(tid + q * NTHREADS, 1791); tkP[q] = idx / 112; const int c = idx - tkP[q] * 112; chP[q] = c < 96 ? c : c + 16; }
      RwFill fa, f0, f1, f2, f3;
      rw_fill_load(p, mu, r0, tkA, chA, fa);
      rw_fill_load(p, mu, r0, tkP[0], chP[0], f0); rw_fill_load(p, mu, r0, tkP[1], chP[1], f1);
      rw_fill_load(p, mu, r0, tkP[2], chP[2], f2); rw_fill_load(p, mu, r0, tkP[3], chP[3], f3);
      __builtin_amdgcn_sched_barrier(0);
      if (wu < 4) rw_fill_store<1>(Cv, tkA, chA, fa); else rw_fill_store<2>(Cv, tkA, chA, fa);
      rw_fill_store<0>(Cv, tkP[0], chP[0], f0); rw_fill_store<0>(Cv, tkP[1], chP[1], f1);
      rw_fill_store<0>(Cv, tkP[2], chP[2], f2);
      if (wu < 4) rw_fill_store<0>(Cv, tkP[3], chP[3], f3);
    }
    const bool gate_wave = __builtin_amdgcn_readfirstlane(tid >> 6) >= 4;
    LDS_BAR();
    __builtin_amdgcn_sched_barrier(0);
    if (gate_wave) {
      f32x4 ag[4];
#pragma unroll
      for (int nt = 0; nt < 4; ++nt) ag[nt] = f32x4{0.f, 0.f, 0.f, 0.f};
      bf16x8 lf[16];
#pragma unroll
      for (int ks = 0; ks < 4; ++ks)
#pragma unroll
        for (int nt = 0; nt < 4; ++nt)
          lf[ks * 4 + nt] = *(const bf16x8*)(LT + 4 * 256 * 64 + (size_t)(h * 64 + nt * 16 + i) * 128 + ks * 32 + g * 8);
      __builtin_amdgcn_sched_barrier(0);
#pragma unroll
      for (int ks = 0; ks < 4; ++ks) {
        const bf16x8 af = cv_frag(Cv + i * CVS + 1024 + ks * 32 + g * 8);
#pragma unroll
        for (int nt = 0; nt < 4; ++nt) {
          ag[nt] = __builtin_amdgcn_mfma_f32_16x16x32_bf16(af, lf[ks * 4 + nt], ag[nt], 0, 0, 0);
        }
      }
#pragma unroll
      for (int nt = 0; nt < 4; ++nt)
#pragma unroll
        for (int r_ = 0; r_ < 4; ++r_) p.G16()[(size_t)(r0 + 4 * g + r_) * 256 + h * 64 + nt * 16 + i] = f2bf(ag[nt][r_]);
    } else {
      f32x4 aw0[4], aw1[4], aa0[4], aa1[4];
#pragma unroll
      for (int nt = 0; nt < 4; ++nt) { aw0[nt] = f32x4{0.f, 0.f, 0.f, 0.f}; aw1[nt] = aw0[nt]; aa0[nt] = aw0[nt]; aa1[nt] = aw0[nt]; }
#pragma unroll
      for (int ks = 0; ks < 2; ++ks) {
        bf16x8 lf[16];
#pragma unroll
        for (int nt = 0; nt < 4; ++nt) {
          const size_t co = (size_t)(h * 64 + nt * 16 + i) * 64 + ks * 32 + g * 8;
          lf[nt * 4 + 0] = *(const bf16x8*)(LT + co);
          lf[nt * 4 + 1] = *(const bf16x8*)(LT + 256 * 64 + co);
          lf[nt * 4 + 2] = *(const bf16x8*)(LT + 2 * 256 * 64 + co);
          lf[nt * 4 + 3] = *(const bf16x8*)(LT + 3 * 256 * 64 + co);
        }
        __builtin_amdgcn_sched_barrier(0);
        const bf16x8 fw0 = cv_frag(Cv + i * CVS + 768 + ks * 32 + g * 8), fw1 = cv_frag(Cv + i * CVS + 832 + ks * 32 + g * 8);
        const bf16x8 fa0 = cv_frag(Cv + i * CVS + 896 + ks * 32 + g * 8), fa1 = cv_frag(Cv + i * CVS + 960 + ks * 32 + g * 8);
#pragma unroll
        for (int nt = 0; nt < 4; ++nt) {
          aw0[nt] = __builtin_amdgcn_mfma_f32_16x16x32_bf16(fw0, lf[nt * 4 + 0], aw0[nt], 0, 0, 0);
          aw1[nt] = __builtin_amdgcn_mfma_f32_16x16x32_bf16(fw1, lf[nt * 4 + 1], aw1[nt], 0, 0, 0);
          aa0[nt] = __builtin_amdgcn_mfma_f32_16x16x32_bf16(fa0, lf[nt * 4 + 2], aa0[nt], 0, 0, 0);
          aa1[nt] = __builtin_amdgcn_mfma_f32_16x16x32_bf16(fa1, lf[nt * 4 + 3], aa1[nt], 0, 0, 0);
        }
        __builtin_amdgcn_sched_barrier(0);
      }
      if (RPM == 2) {
        float z = 0.f;
#pragma unroll
        for (int nt = 0; nt < 4; ++nt) z += aw0[nt][0] + aw1[nt][1] + aa0[nt][2] + aa1[nt][3];
        if (z == 123.456f) bonbuf(p)[0] = z;
      } else {
      float n2[4], bon[4];
#pragma unroll
      for (int r_ = 0; r_ < 4; ++r_) { n2[r_] = 0.f; bon[r_] = 0.f; }
#pragma unroll
      for (int nt = 0; nt < 4; ++nt) {
        const int c = h * 64 + nt * 16 + i;
        const float kkc = p.rwkv_kk[l * 256 + c];
#pragma unroll
        for (int r_ = 0; r_ < 4; ++r_) { const float kr = Cv[(4 * g + r_) * CVS + 256 + c] * kkc; n2[r_] += kr * kr; }
      }
#pragma unroll
      for (int r_ = 0; r_ < 4; ++r_) n2[r_] = FRSQ(reduce16(n2[r_]) + 1e-6f);
      char* vv0 = img_ptr(p, 0, 0, b, h, tile_cidx(is_ctx, t0, 0)) + IMG_VV;
      char* vv1 = img_ptr(p, 0, 1, b, h, tile_cidx(is_ctx, t0, 1)) + IMG_VV;
#pragma unroll
      for (int nt = 0; nt < 4; ++nt) {
        const int c = h * 64 + nt * 16 + i;
        const float w00 = p.rwkv_w0[(l * 2 + 0) * 256 + c], w01 = p.rwkv_w0[(l * 2 + 1) * 256 + c];
        const float a00 = p.rwkv_a0[(l * 2 + 0) * 256 + c], a01 = p.rwkv_a0[(l * 2 + 1) * 256 + c];
        const float kkc = p.rwkv_kk[l * 256 + c], kac = p.rwkv_ka[l * 256 + c], rkc = p.rwkv_rk[l * 256 + c];
#pragma unroll
        for (int r_ = 0; r_ < 4; ++r_) {
          const int tok = 4 * g + r_;
          const float r = Cv[tok * CVS + c], k = Cv[tok * CVS + 256 + c], v = Cv[tok * CVS + 512 + c];
          const float wd0 = FEXP(-sigmoidf_(w00 + aw0[nt][r_]) * 0.6065306597126334f);
          const float wd1 = FEXP(-sigmoidf_(w01 + aw1[nt][r_]) * 0.6065306597126334f);
          const float ad0 = sigmoidf_(a00 + aa0[nt][r_]), ad1 = sigmoidf_(a01 + aa1[nt][r_]);
          const float kk = k * kkc * n2[r_];
          const float kd0 = k * (1.0f + (ad0 - 1.0f) * kac), kd1 = k * (1.0f + (ad1 - 1.0f) * kac);
          bon[r_] += r * (kd0 + kd1) * rkc;
          ((float*)(vec + VEC_W0))[tok * 256 + c] = wd0; ((float*)(vec + VEC_W1))[tok * 256 + c] = wd1;
          ((bf16_t*)(vec + VEC_KK))[tok * VS + c] = f2bf(kk); ((bf16_t*)(vec + VEC_R))[tok * VS + c] = f2bf(r);
          ((bf16_t*)(vec + VEC_B0))[tok * VS + c] = f2bf(kk * ad0); ((bf16_t*)(vec + VEC_B1))[tok * VS + c] = f2bf(kk * ad1);
          ((bf16_t*)(vec + VEC_KD0))[tok * VS + c] = f2bf(kd0); ((bf16_t*)(vec + VEC_KD1))[tok * VS + c] = f2bf(kd1);
          const bf16_t vb = f2bf(v);
          *(bf16_t*)(vv0 + ((nt * 16 + i) * 16 + tok) * 2) = vb;
          *(bf16_t*)(vv1 + ((nt * 16 + i) * 16 + 15 - tok) * 2) = vb;
          rv16(p)[(size_t)(r0 + tok) * 256 + c] = vb;
        }
      }
#pragma unroll
      for (int r_ = 0; r_ < 4; ++r_) {
        const float bs = reduce16(bon[r_]);
        if (i == 0) bonbuf(p)[(size_t)(r0 + 4 * g + r_) * 4 + h] = bs;
      }
      }
    }
    LDS_BAR();
    if (RPM == 0) chunk_prep_wave(p, 0, b, is_ctx, t0, smem, tid);
    LDS_BAR();
  }
}

template <int PMODE = 0>
__device__ __forceinline__ void chunk_gdprep(const Params& p, int l, char* smem, int wave_s) {
  const int tid0 = make_tid(wave_s);
  char* vec = smem + VEC_OFF;
  const float* cw = p.gdn_conv + (size_t)l * 3 * 768;
  for (int tile = (int)((blockIdx.x + gridDim.x - (NTOK / 16) % gridDim.x) % gridDim.x); tile < NTOK / 16; tile += gridDim.x) {
    int tid = tid0; asm volatile("" : "+v"(tid));
    const int c = tid & 255, lane = tid & 63, h = c >> 6, tg = tid >> 8;
    float w0[3], w1[3], w2[3];
#pragma unroll
    for (int j = 0; j < 3; ++j) { w0[j] = cw[j * 256 + c]; w1[j] = cw[768 + j * 256 + c]; w2[j] = cw[1536 + j * 256 + c]; }
    const float nal0 = -FEXP(p.gdn_a_log[(l * 2 + 0) * 4 + h]), nal1 = -FEXP(p.gdn_a_log[(l * 2 + 1) * 4 + h]);
    const float dtb0 = p.gdn_dt_bias[(l * 2 + 0) * 4 + h], dtb1 = p.gdn_dt_bias[(l * 2 + 1) * 4 + h];
    const int r0 = tile * 16;
    const bool is_ctx = r0 >= NLAT;
    const int b = is_ctx ? (r0 - NLAT) / NCX : r0 / NTL;
    const int t0 = is_ctx ? (r0 - NLAT) % NCX : r0 % NTL;
    char* vv0 = img_ptr(p, 1, 0, b, h, tile_cidx(is_ctx, t0, 0)) + IMG_VV + lane * 32;
    char* vv1 = img_ptr(p, 1, 1, b, h, tile_cidx(is_ctx, t0, 1)) + IMG_VV + lane * 32;
    char* vbf = vec + (tg * 8 * 256 + c) * 4;
    char* vbh = vec + VEC_KK + (tg * 8 * VS + c) * 2;
    asm volatile("" : "+v"(vbf), "+v"(vbh));
    bf16_t* rawP = (bf16_t*)smem;
    constexpr int RPS = 792;
    {
      const int slen = is_ctx ? NCX : NTL;
#pragma unroll
      for (int q = 0; q < 4; ++q) {
        const int idx = tid + q * NTHREADS;
        if (idx < 18 * 98) {
          const int rr = idx / 98, ch = idx - rr * 98;
          const int t = t0 + rr - 1;
          uint4 v = make_uint4(0u, 0u, 0u, 0u);
          if (t >= 0 && t < slen) v = *(const uint4*)(p.P() + (size_t)(r0 + rr - 1) * INC + OFF_C + (ch < 96 ? ch * 8 : 1024 + (ch - 96) * 8));
          *(uint4*)(rawP + rr * RPS + ch * 8) = v;
        }
      }
    }
    LDS_BAR();
#pragma unroll
    for (int tt = 0; tt < (PMODE >= 2 ? 0 : 8); ++tt) {
      const int tok = tg * 8 + tt;
      const bf16_t* rp = rawP + (tok + 1) * RPS;
      float qkv[3];
#pragma unroll
      for (int j = 0; j < 3; ++j)
        qkv[j] = siluf_(bf2f(rp[-RPS + j * 256 + c]) * w0[j] + bf2f(rp[j * 256 + c]) * w1[j] + bf2f(rp[RPS + j * 256 + c]) * w2[j]);
      const float ab0 = bf2f(rp[768 + 0 * 4 + h]), ab1 = bf2f(rp[768 + 1 * 4 + h]), ab2 = bf2f(rp[768 + 8 + 0 * 4 + h]), ab3 = bf2f(rp[768 + 8 + 1 * 4 + h]);
      const float qn = qkv[0] * FRSQ(wsum(qkv[0] * qkv[0]) + 1e-6f) * 0.125f;
      const float kn = qkv[1] * FRSQ(wsum(qkv[1] * qkv[1]) + 1e-6f);
      const float eg0 = FEXP(nal0 * softplusf_(ab0 + dtb0)), eg1 = FEXP(nal1 * softplusf_(ab1 + dtb1));
      const float be0 = sigmoidf_(ab2), be1 = sigmoidf_(ab3);
      *(float*)(vbf + VEC_W0 + tt * 1024) = eg0; *(float*)(vbf + VEC_W1 + tt * 1024) = eg1;
      *(bf16_t*)(vbh + tt * (VS * 2)) = f2bf(kn); *(bf16_t*)(vbh + (VEC_R - VEC_KK) + tt * (VS * 2)) = f2bf(qn);
      *(bf16_t*)(vbh + (VEC_B0 - VEC_KK) + tt * (VS * 2)) = f2bf(be0 * eg0 * kn); *(bf16_t*)(vbh + (VEC_B1 - VEC_KK) + tt * (VS * 2)) = f2bf(be1 * eg1 * kn);
      *(bf16_t*)(vbh + (VEC_KD0 - VEC_KK) + tt * (VS * 2)) = f2bf(be0 * kn); *(bf16_t*)(vbh + (VEC_KD1 - VEC_KK) + tt * (VS * 2)) = f2bf(be1 * kn);
      const bf16_t vb = f2bf(qkv[2]);
      *(bf16_t*)(vv0 + tok * 2) = vb;
      *(bf16_t*)(vv1 + (15 - tok) * 2) = vb;
    }
    LDS_BAR();
    if (PMODE != 1) chunk_prep_wave(p, 1, b, is_ctx, t0, smem, tid);
    LDS_BAR();
  }
}

constexpr int SGRP = 4;
constexpr int SGRP_BYTES = SGRP * IMG_BYTES;
__device__ __forceinline__ void cs_group(const Params& p, bool last, const char* buf, int gi, f32x4 (&Sd)[4],
                                         int mixer, int d, int b, int h, int lane, int rho0) {
  const int i = lane & 15, g = lane >> 4, sw = i & 7;
#pragma unroll
    for (int cc = 0; cc < SGRP; ++cc) {
      const char* im = buf + cc * IMG_BYTES;
      const int cidx = gi * SGRP + cc;
      const bf16x8 bs0 = pack_p8(Sd[0], Sd[1]), bs1 = pack_p8(Sd[2], Sd[3]);
      const bf16x8 kk0 = *(const bf16x8*)(im + IMG_KK + i * 128 + (((0 + g) ^ sw) << 4));
      const bf16x8 kk1 = *(const bf16x8*)(im + IMG_KK + i * 128 + (((4 + g) ^ sw) << 4));
      const bf16x8 rt0 = *(const bf16x8*)(im + IMG_RT + i * 128 + (((0 + g) ^ sw) << 4));
      const bf16x8 rt1 = *(const bf16x8*)(im + IMG_RT + i * 128 + (((4 + g) ^ sw) << 4));
      const bf16x8 tm = *(const bf16x8*)(im + IMG_TR + i * 128 + (((0 + g) ^ sw) << 4));
      const bf16x8 rb = *(const bf16x8*)(im + IMG_TR + i * 128 + (((4 + g) ^ sw) << 4));
      const uint2 vraw = *(const uint2*)(im + IMG_VV + ((rho0 + i) * 16 + 4 * g) * 2);
      f32x4 zt = __builtin_amdgcn_mfma_f32_16x16x32_bf16(kk0, bs0, f32x4{0.f, 0.f, 0.f, 0.f}, 0, 0, 0);
      zt = __builtin_amdgcn_mfma_f32_16x16x32_bf16(kk1, bs1, zt, 0, 0, 0);
      f32x4 yt = __builtin_amdgcn_mfma_f32_16x16x32_bf16(rt0, bs0, f32x4{0.f, 0.f, 0.f, 0.f}, 0, 0, 0);
      yt = __builtin_amdgcn_mfma_f32_16x16x32_bf16(rt1, bs1, yt, 0, 0, 0);
      uint4 zv; zv.x = pk_bf16(zt[0], zt[1]); zv.y = pk_bf16(zt[2], zt[3]); zv.z = vraw.x; zv.w = vraw.y;
      f32x4 pt = __builtin_amdgcn_mfma_f32_16x16x32_bf16(tm, __builtin_bit_cast(bf16x8, zv), f32x4{0.f, 0.f, 0.f, 0.f}, 0, 0, 0);
      uint4 pv; pv.x = pk_bf16(-pt[0], -pt[1]); pv.y = pk_bf16(-pt[2], -pt[3]); pv.z = vraw.x; pv.w = vraw.y;
      const bf16x8 pvf = __builtin_bit_cast(bf16x8, pv);
      yt = __builtin_amdgcn_mfma_f32_16x16x32_bf16(rb, pvf, yt, 0, 0, 0);
#pragma unroll
      for (int m = 0; m < 4; ++m) {
        const int row = (16 * m + i) & 31, ch = (m >> 1) * 4 + g;
        const bf16x8 bk = *(const bf16x8*)(im + IMG_BK + row * 128 + ((ch ^ (row & 7)) << 4));
        const float4 wl = *(const float4*)(im + IMG_WL + (16 * m + 4 * g) * 4);
        f32x4 cin = Sd[m];
        cin[0] *= wl.x; cin[1] *= wl.y; cin[2] *= wl.z; cin[3] *= wl.w;
        Sd[m] = __builtin_amdgcn_mfma_f32_16x16x32_bf16(bk, pvf, cin, 0, 0, 0);
      }
      const bool is_ctx = cidx < NCX / 16;
      {
        const int j = is_ctx ? cidx : cidx - NCX / 16;
        const int tile = d == 0 ? j : (is_ctx ? NCX / 16 : NTL / 16) - 1 - j;
        const int rbase = (is_ctx ? NLAT + b * NCX : b * NTL) + tile * 16;
#pragma unroll
        for (int r_ = 0; r_ < 4; ++r_) {
          const int s_ = 4 * g + r_, tok = d ? 15 - s_ : s_;
          p.YS()[(size_t)(rbase + tok) * 1024 + mixer * 512 + d * 256 + h * 64 + rho0 + i] = f2bf(yt[r_]);
        }
      }
    }
}
__device__ __forceinline__ void chunk_scan(const Params& p, bool last, int task, char* smem, int tid) {
  const int mixer = task / (2 * NB * 4), rem = task % (2 * NB * 4);
  const int d = rem / (NB * 4), b = (rem / 4) % NB, h = rem % 4;
  const char* gimg = img_ptr(p, mixer, d, b, h, 0);
  const int lane = tid & 63, w = tid >> 6;
  const int rho0 = (w & 3) * 16;
  const bool computes = __builtin_amdgcn_readfirstlane(tid >> 6) < 4;
  f32x4 Sd[4];
#pragma unroll
  for (int m = 0; m < 4; ++m) Sd[m] = f32x4{0.f, 0.f, 0.f, 0.f};
  uint4 sa0, sa1, sa2, sa3, sa4, sa5, sa6, sb0, sb1, sb2, sb3, sb4, sb5, sb6;
  const int ngrp = NCHK / SGRP;
#define CS_PC(q) min(tid + (q) * NTHREADS, SGRP_BYTES / 16 - 1)
#define CS_LD1(gi, q, dst) dst = *(const uint4*)(gimg + (size_t)min((gi), ngrp - 1) * SGRP_BYTES + CS_PC(q) * 16);
#define CS_ST1(bi, q, srcv) *(uint4*)(smem + (bi) * SGRP_BYTES + CS_PC(q) * 16) = srcv;
#define CS_LOAD(gi, s_) { CS_LD1(gi, 0, s_##0) CS_LD1(gi, 1, s_##1) CS_LD1(gi, 2, s_##2) CS_LD1(gi, 3, s_##3) CS_LD1(gi, 4, s_##4) CS_LD1(gi, 5, s_##5) CS_LD1(gi, 6, s_##6) }
#define CS_STORE(bi, s_) { CS_ST1(bi, 0, s_##0) CS_ST1(bi, 1, s_##1) CS_ST1(bi, 2, s_##2) CS_ST1(bi, 3, s_##3) CS_ST1(bi, 4, s_##4) CS_ST1(bi, 5, s_##5) CS_ST1(bi, 6, s_##6) }
#define CS_BAR() { asm volatile("s_waitcnt lgkmcnt(0)" ::: "memory"); __builtin_amdgcn_s_barrier(); asm volatile("" ::: "memory"); }
#define CS_LOOP(COMPUTE_) { \
    CS_LOAD(0, sa); CS_LOAD(1, sb); CS_STORE(0, sa); CS_BAR(); \
    for (int gi = 0; gi < ngrp; gi += 2) { \
      CS_LOAD(gi + 2, sa); __builtin_amdgcn_sched_barrier(0); \
      COMPUTE_(gi) \
      __builtin_amdgcn_sched_barrier(0); CS_STORE((gi + 1) % 3, sb); CS_BAR(); \
      CS_LOAD(gi + 3, sb); __builtin_amdgcn_sched_barrier(0); \
      COMPUTE_(gi + 1) \
      __builtin_amdgcn_sched_barrier(0); CS_STORE((gi + 2) % 3, sa); CS_BAR(); \
    } }
#define CS_DO(g_) cs_group(p, last, smem + ((g_) % 3) * SGRP_BYTES, (g_), Sd, mixer, d, b, h, lane, rho0);
#define CS_SKIP(g_)
  static_assert((NCHK / SGRP) % 2 == 0, "group loop is unrolled by two");
  if (computes) CS_LOOP(CS_DO) else CS_LOOP(CS_SKIP)
#undef CS_LOOP
#undef CS_DO
#undef CS_SKIP
#undef CS_PC
#undef CS_LOAD
#undef CS_STORE
#undef CS_LD1
#undef CS_ST1
#undef CS_BAR
}

__device__ __forceinline__ void chunk_post(const Params& p, int l, int nr, int wave_s) {
  for (int row = blockIdx.x * 8 + wave_s; row < nr; row += gridDim.x * 8) {
    const int lane = make_tid(wave_s) & 63;
    const int c0 = lane * 4, h = lane >> 4;
    const bf16_t* ys = p.YS() + (size_t)row * 1024;
    bf16_t* yo = p.Y() + (size_t)row * DM;
    {
      const float4 y0 = ld4(ys + c0), y1 = ld4(ys + 256 + c0);
      const float4 gq = ld4(p.G16() + (size_t)row * 256 + c0), vq = ld4(rv16(p) + (size_t)row * 256 + c0);
      const float4 lg = *(const float4*)(p.rwkv_ln_g + l * 256 + c0), lb = *(const float4*)(p.rwkv_ln_b + l * 256 + c0);
      const float bon = bonbuf(p)[(size_t)row * 4 + h];
      float y[4] = {y0.x + y1.x, y0.y + y1.y, y0.z + y1.z, y0.w + y1.w};
      const float m = reduce16((y[0] + y[1]) + (y[2] + y[3])) * (1.0f / 64);
      float dd[4] = {y[0] - m, y[1] - m, y[2] - m, y[3] - m};
      const float rstd = 1.0f / sqrtf(reduce16((dd[0] * dd[0] + dd[1] * dd[1]) + (dd[2] * dd[2] + dd[3] * dd[3])) * (1.0f / 64) + 64e-5f);
      uint2 o;
      o.x = pk_bf16((dd[0] * rstd * lg.x + lb.x + bon * vq.x) * gq.x, (dd[1] * rstd * lg.y + lb.y + bon * vq.y) * gq.y);
      o.y = pk_bf16((dd[2] * rstd * lg.z + lb.z + bon * vq.z) * gq.z, (dd[3] * rstd * lg.w + lb.w + bon * vq.w) * gq.w);
      *(uint2*)(yo + 256 + c0) = o;
    }
    {
      const float4 o0 = ld4(ys + 512 + c0), o1 = ld4(ys + 768 + c0);
      const float4 gt = ld4(p.P() + (size_t)row * INC + OFF_C + 768 + c0);
      const float4 ng = *(const float4*)(p.gdn_norm_g + l * 64 + (c0 & 63));
      float o[4] = {o0.x + o1.x, o0.y + o1.y, o0.z + o1.z, o0.w + o1.w};
      const float rs = 1.0f / sqrtf(reduce16((o[0] * o[0] + o[1] * o[1]) + (o[2] * o[2] + o[3] * o[3])) * (1.0f / 64) + 1e-6f);
      uint2 r;
      r.x = pk_bf16(o[0] * rs * ng.x * siluf_(gt.x), o[1] * rs * ng.y * siluf_(gt.y));
      r.y = pk_bf16(o[2] * rs * ng.z * siluf_(gt.z), o[3] * rs * ng.w * siluf_(gt.w));
      *(uint2*)(yo + 512 + c0) = r;
    }
  }
}

template <int MMODE = 0>
__device__ __forceinline__ void fast_mixers(const Params& p, int l, char* smem, int wave_s) {
  const int np = 2 * (2 * NB * 4);
  const int nb = gridDim.x;
  if (MMODE != 2) {
    for (int t = blockIdx.x; t < np; t += nb) { int tid = make_tid(wave_s); chunk_scan(p, l == 1, t, smem, tid); }
  }
  if (MMODE != 1) {
    const int nA = NB * 4 * (NTL / 256) + (l == 0 ? NB * 4 * (NCX / 256) : 0);
    const int nD = (NB * 4 * GROWS + (l == 0 ? NB * 4 * (NCX / 64) : 0)) / 2;
    unsigned* ctr = p.bar() + 16 + 16 * l + (MMODE == 2 ? 8 : 0);
    volatile int* slot = (volatile int*)(smem + 160256 + 8);
    for (;;) {
      LDS_BAR();
      if (make_tid(wave_s) == 0) *slot = (int)xb_add(ctr, 1u);
      LDS_BAR();
      const int t = __builtin_amdgcn_readfirstlane(*slot);
      if (t >= nA + nD) break;
      const int tid = make_tid(wave_s);
      if (t < nA) attnA_task(p, l, t, smem, tid);
      else attnD_pair(p, l, t - nA, smem, tid);
    }
  }
}

template <int PH>
__device__ __forceinline__ void run_phase(const Params& p, int l) {
  long n = phase_items(PH, l);
  int tid = threadIdx.x;
  long gtid = (long)(blockIdx.x * NTHREADS + tid);
  long nth = (long)(gridDim.x * NTHREADS);
  for (long i = gtid; i < n; i += nth) phase_item<PH>(p, l, i);
}

#define ITEM_LOOP(n_, ...)                                            \
  {                                                                  \
    int tid_ = threadIdx.x;                                          \
    asm volatile("" : "+v"(tid_));                                   \
    long nth_ = (long)(gridDim.x * NTHREADS);                        \
    for (long i = (long)(blockIdx.x * NTHREADS + tid_); i < (n_); i += nth_) __VA_ARGS__ \
  }
#if MEGA == 1
__global__ void __launch_bounds__(NTHREADS) fwd_megakernel(Params p) {
  __shared__ __attribute__((aligned(16))) char smem[160256 + 16];
#define xb_words (*(uint4*)(smem + 160256))
  cg::grid_group grid = cg::this_grid();
  const int wave_s = __builtin_amdgcn_readfirstlane((int)(threadIdx.x >> 6));
  if (threadIdx.x == 0) xb_words = make_uint4(0u, 0u, 0u, 0u);
  __syncthreads();
  (void)xcd_barrier_post(p.bar(), (volatile LAS unsigned*)&xb_words);
#define GSYNC() { XcdBarrier xb_; xb_.bar = p.bar(); xb_.x = xb_xcc_id(); xb_.st = (volatile LAS unsigned*)&xb_words; xcd_barrier(xb_, wave_s); }
  fast_ada(p, smem, wave_s);
  conv_lora(p, wave_s);
  conv_weights(p, smem, wave_s);
  conv_tables(p, 0, wave_s);
#if PROBE_DUP & 16384
  conv_tables(p, 0, wave_s);
#endif
#if PROBE_DUP & 32768
  conv_weights(p, smem, wave_s);
  fast_ada(p, smem, wave_s);
#endif
  grid.sync();
  fast_ln1(p, 0, wave_s); GSYNC();
  for (int l = 0; l < 2; ++l) {
    const int nr = rows_out(l);
    if (l == 1) conv_tables(p, 1, wave_s);
    gemm_phase<256>(p.Y(), DM, wbt_in(p, l), INC, p.P(), INC, NTOK, smem, wave_s); GSYNC();
#if PROBE_DUP & 1
    gemm_phase<256>(p.Y(), DM, wbt_in(p, l), INC, p.P(), INC, NTOK, smem, wave_s); GSYNC();
#endif
    fast_attprep(p, smem, wave_s);
    chunk_rwprep(p, l, smem, wave_s);
    chunk_gdprep(p, l, smem, wave_s);
#if PROBE_DUP & 32
    chunk_rwprep<1>(p, l, smem, wave_s);
#endif
#if PROBE_DUP & 524288
    chunk_rwprep<2>(p, l, smem, wave_s);
#endif
#if PROBE_DUP & 64
    chunk_gdprep(p, l, smem, wave_s);
#endif
#if PROBE_DUP & 128
    chunk_gdprep<1>(p, l, smem, wave_s);
#endif
#if PROBE_DUP & 256
    chunk_gdprep<2>(p, l, smem, wave_s);
#endif
#if PROBE_DUP & 512
    chunk_gdprep<3>(p, l, smem, wave_s);
#endif
    GSYNC();
    fast_mixers(p, l, smem, wave_s); GSYNC();
#if PROBE_DUP & 2
    fast_mixers(p, l, smem, wave_s); GSYNC();
#endif
#if PROBE_DUP & 1024
    fast_mixers<1>(p, l, smem, wave_s); GSYNC();
#endif
#if PROBE_DUP & 2048
    fast_mixers<2>(p, l, smem, wave_s); GSYNC();
#endif
    chunk_post(p, l, nr, wave_s); GSYNC();
#if PROBE_DUP & 4096
    chunk_post(p, l, nr, wave_s); GSYNC();
#endif
#if PROBE_DUP & 8192
    GSYNC(); GSYNC(); GSYNC(); GSYNC();
#endif
    gemm_phase<128>(p.Y(), DM, wbt_out(p, l), DM, (bf16_t*)p.RW(), DM, nr, smem, wave_s); GSYNC();
    fast_pn1(p, l, nr, wave_s); GSYNC();
    gemm_phase<128>(p.Y(), DM, wbt_q(p, l), 2048, peerQ(p), 2048, nr, smem, wave_s); GSYNC();
#if PROBE_DUP & 8
    gemm_phase<128>(p.Y(), DM, wbt_q(p, l), 2048, peerQ(p), 2048, nr, smem, wave_s); GSYNC();
#endif
    select_phase(p, l, nr, smem, wave_s); GSYNC();
#if PROBE_DUP & 16
    select_phase(p, l, nr, smem, wave_s); GSYNC();
#endif
    expert_u_phase(p, l, nr, wave_s, smem); GSYNC();
#if PROBE_DUP & 65536
    expert_u_phase(p, l, nr, wave_s, smem); GSYNC();
#endif
    expert_phase(p, l, nr, wave_s); GSYNC();
  }
}
#elif MEGA == 0
template <int PH>
__global__ void __launch_bounds__(256) phase_kernel(Params p, int l) {
  run_phase<PH>(p, l);
}
template <int PH>
static void launch_phase(const Params& p, int l, hipStream_t stream) {
  long n = phase_items(PH, l);
  if (n <= 0) return;
  long blocks = (n + 255) / 256;
  if (blocks > 8192) blocks = 8192;
  hipLaunchKernelGGL(phase_kernel<PH>, dim3((unsigned)blocks), dim3(256), 0, stream, p, l);
}
#endif

extern "C" void kernel_launch(void* const* d_in, const int* in_sizes, int n_in, void* d_out, int out_size, void* d_ws,
                              size_t ws_size, hipStream_t stream) {
  Params p{};
  const float** pin = (const float**)&p;
  for (int i = 0; i < 34; ++i) pin[i] = (const float*)d_in[i];
  p.out = (float*)d_out;
  if (ws_size < WS_END) return;
  p.ws = (char*)d_ws;
#if MEGA == 1
  static int grid_blocks = 0;
  if (!grid_blocks) {
    int dev = 0, cus = 0, per_cu = 0;
    hipGetDevice(&dev);
    hipDeviceGetAttribute(&cus, hipDeviceAttributeMultiprocessorCount, dev);
    hipOccupancyMaxActiveBlocksPerMultiprocessor(&per_cu, fwd_megakernel, NTHREADS, 0);
    if (per_cu > 1) per_cu = 1;
    grid_blocks = cus * per_cu;
  }
  (void)hipMemsetAsync(p.bar(), 0, WS_BAR_BYTES, stream);
  void* args[] = {&p};
  (void)hipLaunchCooperativeKernel((void*)fwd_megakernel, dim3(grid_blocks), dim3(NTHREADS), args, 0, stream);
#elif MEGA == 0
  launch_phase<PH_ADA>(p, 0, stream);
  for (int l = 0; l < 2; ++l) {
    launch_phase<PH_LN1>(p, l, stream);
    launch_phase<PH_GEMM_IN>(p, l, stream);
    launch_phase<PH_ROPE>(p, l, stream);
    launch_phase<PH_MIX>(p, l, stream);
    launch_phase<PH_GDPREP>(p, l, stream);
    launch_phase<PH_SCAN>(p, l, stream);
    launch_phase<PH_POST>(p, l, stream);
    launch_phase<PH_GEMM_OUT>(p, l, stream);
    launch_phase<PH_PN1>(p, l, stream);
    launch_phase<PH_GEMM_Q>(p, l, stream);
    launch_phase<PH_TOPK1>(p, l, stream);
    launch_phase<PH_TOPK2>(p, l, stream);
    launch_phase<PH_ACT>(p, l, stream);
    launch_phase<PH_FFN>(p, l, stream);
    launch_phase<PH_PN2>(p, l, stream);
  }
#endif
}
#endif
```

```cpp
#ifndef CPU_EMU
#include <hip/hip_runtime.h>
#include <hip/hip_cooperative_groups.h>
namespace cg = cooperative_groups;
#define DEVFN __device__ __forceinline__
#define HDFN __host__ __device__ __forceinline__
#define MEMFN __host__ __device__ __forceinline__
#define LOAD_FENCE() asm volatile("" ::: "memory")
#define LDS_BAR() { asm volatile("s_waitcnt lgkmcnt(0)" ::: "memory"); __builtin_amdgcn_s_barrier(); asm volatile("" ::: "memory"); }
#else
#include <cmath>
#include <cstdio>
#include <cstdlib>
#include <cstring>
#define DEVFN static inline
#define HDFN static inline
#define MEMFN inline
#define LOAD_FENCE()
struct float4 { float x, y, z, w; };
static inline float4 make_float4(float a, float b, float c, float d) { float4 r{a, b, c, d}; return r; }
#endif

#ifndef MEGA
#define MEGA 1
#endif
#ifndef PROBE_DUP
#define PROBE_DUP 0
#endif
#ifndef K_B
#define K_B 4
#define K_T 4096
#define K_C 256
#endif

typedef unsigned short bf16_t;
constexpr int NB = K_B, NTL = K_T, NCX = K_C;
constexpr int DM = 1024;
constexpr int NLAT = NB * NTL, NCTX = NB * NCX, NTOK = NLAT + NCTX;
constexpr int GROWS = NTL / 64;
constexpr int INC = 3728;
constexpr int OFF_A = 0, OFF_B = 768, OFF_C = 1920, OFF_D = 2960;
constexpr int RWS = 2560;
constexpr int GPS = 784;
constexpr int RWREC = 648;
constexpr int GDREC = 200;
constexpr int NMODV = NB + 1;
constexpr float DN_ALPHA = 1.4142135623730951f;
constexpr float LN_EPS = 1e-5f;

constexpr size_t al256(size_t x) { return (x + 255) & ~(size_t)255; }
constexpr size_t WS_MOD = 0;
constexpr size_t WS_HCTX = al256(WS_MOD + (size_t)2 * NMODV * 6144 * 4);
constexpr size_t WS_Y = al256(WS_HCTX + (size_t)NCTX * DM * 4);
constexpr size_t WS_P = al256(WS_Y + (size_t)NTOK * DM * 2);
constexpr size_t WS_RW = al256(WS_P + (size_t)NTOK * INC * 2);
constexpr size_t WS_GP = al256(WS_RW + (size_t)NTOK * (RWS > 4 * RWREC ? RWS : 4 * RWREC) * 4);
constexpr size_t WS_YS = al256(WS_GP + (size_t)NTOK * (GPS > 4 * GDREC ? GPS : 4 * GDREC) * 4);
constexpr size_t WS_TB = al256(WS_YS + (size_t)NTOK * 1024 * 2);
constexpr size_t WS_G16 = al256(WS_TB + (size_t)2 * 16384 * 1024 * 2);
constexpr size_t WS_VT = al256(WS_G16 + (size_t)NTOK * 256 * 2);
constexpr size_t WS_BAR = al256(WS_VT + (size_t)2 * NB * 4 * 64 * (NTL + NCX) * 2);
constexpr size_t WS_BAR_BYTES = 3456 * 4;
constexpr size_t WS_END = al256(WS_BAR + WS_BAR_BYTES);
struct Params {
  const float *x, *c, *ctx, *c_ctx, *w_ada, *b_ada, *w_in, *w_out, *ln_mix_g, *ln_mix_b, *ln_ffn_g, *ln_ffn_b;
  const float *diff_lam, *diff_norm_g, *rwkv_mu, *rwkv_w0, *rwkv_w2, *rwkv_a0, *rwkv_a2, *rwkv_g2;
  const float *rwkv_kk, *rwkv_ka, *rwkv_rk, *rwkv_ln_g, *rwkv_ln_b, *gdn_conv, *gdn_a_log, *gdn_dt_bias;
  const float *gdn_norm_g, *nat_rpb, *peer_wq, *peer_keys, *peer_u, *peer_v;
  float *out;
  char *ws;
  MEMFN float* mod() const { return (float*)(ws + WS_MOD); }
  MEMFN float* hctx() const { return (float*)(ws + WS_HCTX); }
  MEMFN float* RW() const { return (float*)(ws + WS_RW); }
  MEMFN float* GP() const { return (float*)(ws + WS_GP); }
  MEMFN bf16_t* Y() const { return (bf16_t*)(ws + WS_Y); }
  MEMFN bf16_t* P() const { return (bf16_t*)(ws + WS_P); }
  MEMFN bf16_t* YS() const { return (bf16_t*)(ws + WS_YS); }
  MEMFN bf16_t* TB() const { return (bf16_t*)(ws + WS_TB); }
  MEMFN bf16_t* WBT() const { return (bf16_t*)(ws + WS_TB + (size_t)2 * 16384 * 1024); }
  MEMFN bf16_t* G16() const { return (bf16_t*)(ws + WS_G16); }
  MEMFN bf16_t* VT() const { return (bf16_t*)(ws + WS_VT); }
  MEMFN unsigned* bar() const { return (unsigned*)(ws + WS_BAR); }
};

DEVFN float bf2f(bf16_t v) {
  unsigned u = (unsigned)v << 16; float f;
#ifdef CPU_EMU
  memcpy(&f, &u, 4);
#else
  f = __uint_as_float(u);
#endif
  return f;
}
DEVFN bf16_t f2bf(float f) {
#if !defined(CPU_EMU) && defined(__HIP_DEVICE_COMPILE__)
  typedef __attribute__((ext_vector_type(2))) float f2bf_f2; typedef __attribute__((ext_vector_type(2))) __bf16 f2bf_b2;
  const f2bf_f2 v = {f, 0.f};
  return (bf16_t)(__builtin_bit_cast(unsigned, __builtin_convertvector(v, f2bf_b2)) & 0xffffu);
#else
  unsigned u;
#ifdef CPU_EMU
  memcpy(&u, &f, 4);
#else
  u = __float_as_uint(f);
#endif
  u += 0x7fffu + ((u >> 16) & 1u);
  return (bf16_t)(u >> 16);
#endif
}
DEVFN float4 ld4(const bf16_t* p) {
  const unsigned* q = (const unsigned*)p;
  unsigned a = q[0], b = q[1];
  unsigned x0 = a << 16, x1 = a & 0xffff0000u, x2 = b << 16, x3 = b & 0xffff0000u;
  float4 r;
#ifdef CPU_EMU
  memcpy(&r.x, &x0, 4); memcpy(&r.y, &x1, 4); memcpy(&r.z, &x2, 4); memcpy(&r.w, &x3, 4);
#else
  r.x = __uint_as_float(x0); r.y = __uint_as_float(x1); r.z = __uint_as_float(x2); r.w = __uint_as_float(x3);
#endif
  return r;
}

#ifdef CPU_EMU
#define FEXP expf
#define FLOG logf
#define FSIN sinf
#define FCOS cosf
#define FRCP(x) (1.0f / (x))
#define FRSQ(x) (1.0f / sqrtf(x))
#else
#define FEXP __expf
#define FLOG __logf
#define FSIN __sinf
#define FCOS __cosf
#define FRCP(x) __builtin_amdgcn_rcpf(x)
#define FRSQ(x) __builtin_amdgcn_rsqf(x)
#endif
DEVFN float sigmoidf_(float x) { return FRCP(1.0f + FEXP(-x)); }
DEVFN float siluf_(float x) { return x * FRCP(1.0f + FEXP(-x)); }
DEVFN float softplusf_(float x) { return fmaxf(x, 0.f) + FLOG(1.0f + FEXP(-fabsf(x))); }
DEVFN float tanhf_(float x) { float e = FEXP(2.0f * x); return 1.0f - 2.0f * FRCP(e + 1.0f); }
DEVFN float geluf_(float x) { return 0.5f * x * (1.0f + erff(x * 0.70710678118654752f)); }

DEVFN int modv_of_row(int row) { return row < NLAT ? row / NTL : NB; }
DEVFN const float* hsrc_row(const Params& p, int l, int row) {
  if (row < NLAT) return (l == 0 ? p.x : p.out) + (size_t)row * DM;
  return (l == 0 ? p.ctx : p.hctx()) + (size_t)(row - NLAT) * DM;
}
DEVFN float* hdst_row(const Params& p, int row) {
  if (row < NLAT) return p.out + (size_t)row * DM;
  return p.hctx() + (size_t)(row - NLAT) * DM;
}
DEVFN void seq_pos(int row, int& t, int& len) {
  if (row < NLAT) { t = row % NTL; len = NTL; } else { t = (row - NLAT) % NCX; len = NCX; }
}

DEVFN void ph_ada(const Params& p, long item) {
  int l = (int)(item / 6144), j = (int)(item % 6144);
  float acc[NMODV];
#pragma unroll
  for (int v = 0; v < NMODV; ++v) acc[v] = 0.f;
  for (int i = 0; i < DM; ++i) {
    float w = p.w_ada[((size_t)l * DM + i) * 6144 + j];
#pragma unroll
    for (int v = 0; v < NB; ++v) acc[v] += siluf_(p.c[v * DM + i]) * w;
    acc[NB] += siluf_(p.c_ctx[i]) * w;
  }
  float bb = p.b_ada[l * 6144 + j];
#pragma unroll
  for (int v = 0; v < NMODV; ++v) p.mod()[((size_t)l * NMODV + v) * 6144 + j] = acc[v] + bb;
}

DEVFN void row_stats(const float* r, float& mu, float& rstd) {
  float s = 0.f;
  for (int i = 0; i < DM; ++i) s += r[i];
  mu = s * (1.0f / DM);
  float v = 0.f;
  for (int i = 0; i < DM; ++i) { float d = r[i] - mu; v += d * d; }
  rstd = 1.0f / sqrtf(v * (1.0f / DM) + LN_EPS);
}

DEVFN void ph_ln1(const Params& p, int l, long item) {
  int row = (int)item;
  const float* src = hsrc_row(p, l, row);
  const float* m = p.mod() + ((size_t)l * NMODV + modv_of_row(row)) * 6144;
  float mu, rstd;
  row_stats(src, mu, rstd);
  bf16_t* dst = p.Y() + (size_t)row * DM;
  for (int i = 0; i < DM; ++i) dst[i] = f2bf((src[i] - mu) * rstd * (1.0f + m[1024 + i]) + m[i]);
}

DEVFN void gemm_item(const bf16_t* A, int lda, const float* Bw, int ldb, bf16_t* C, int ldc, int N, int K, long item) {
  int ntn = N / 4;
  int mt = (int)(item / ntn), nt = (int)(item % ntn);
  int r0 = mt * 4, c0 = nt * 4;
  float acc[4][4];
#pragma unroll
  for (int i = 0; i < 4; ++i)
#pragma unroll
    for (int j = 0; j < 4; ++j) acc[i][j] = 0.f;
  for (int k = 0; k < K; k += 4) {
    float4 a[4], b[4];
#pragma unroll
    for (int i = 0; i < 4; ++i) a[i] = ld4(A + (size_t)(r0 + i) * lda + k);
#pragma unroll
    for (int kk = 0; kk < 4; ++kk) b[kk] = *(const float4*)(Bw + (size_t)(k + kk) * ldb + c0);
#pragma unroll
    for (int i = 0; i < 4; ++i) {
      float av[4] = {a[i].x, a[i].y, a[i].z, a[i].w};
#pragma unroll
      for (int kk = 0; kk < 4; ++kk) {
        acc[i][0] += av[kk] * b[kk].x;
        acc[i][1] += av[kk] * b[kk].y;
        acc[i][2] += av[kk] * b[kk].z;
        acc[i][3] += av[kk] * b[kk].w;
      }
    }
  }
#pragma unroll
  for (int i = 0; i < 4; ++i)
#pragma unroll
    for (int j = 0; j < 4; ++j) C[(size_t)(r0 + i) * ldc + c0 + j] = f2bf(acc[i][j]);
}

DEVFN void ph_rope(const Params& p, long item) {
  int token = (int)(item / 256), j = (int)(item % 256);
  int which = j / 128, jj = j % 128, h = jj / 32, pr = jj % 32, blk = pr / 8, i = pr % 8;
  int t = token % NTL;
  int pos = (blk & 1) ? (t % 64) : (t / 64);
  float inv = expf(-(float)i * (9.210340371976184f / 8.0f));
  float ang = (float)pos * inv;
  float cs = FCOS(ang), sn = FSIN(ang);
  bf16_t* base = p.P() + (size_t)token * INC + OFF_A + which * 256 + h * 64 + blk * 16;
  float x1 = bf2f(base[i]), x2 = bf2f(base[i + 8]);
  base[i] = f2bf(x1 * cs - x2 * sn);
  base[i + 8] = f2bf(x1 * sn + x2 * cs);
}

DEVFN float dot32(const bf16_t* q, const bf16_t* k) {
  float s = 0.f;
#pragma unroll
  for (int d = 0; d < 32; d += 4) {
    float4 kv = ld4(k + d);
    float4 qv = ld4(q + d);
    s += qv.x * kv.x + qv.y * kv.y + qv.z * kv.z + qv.w * kv.w;
    if ((d & 15) == 12) LOAD_FENCE();
  }
  return s;
}

DEVFN void mixA_item(const Params& p, int l, int b, int h, int qrow, bool lat) {
  const float* lv = p.diff_lam + l * 128;
  float d01 = 0.f, d23 = 0.f;
#pragma unroll 4
  for (int i = 0; i < 32; ++i) { d01 += lv[i] * lv[32 + i]; d23 += lv[64 + i] * lv[96 + i]; }
  float lam_init = 0.8f - 0.6f * expf(-0.3f * (float)l);
  float lam = expf(d01) - expf(d23) + lam_init;
  const float scale = 0.17677669529663687f;
  const bf16_t* q = p.P() + (size_t)qrow * INC + OFF_A + h * 64;
  int nlat = lat ? NTL : 0;
  int nk = nlat + NCX;
  float m1 = -1e30f, l1 = 0.f, m2 = -1e30f, l2 = 0.f;
  for (int j = 0; j < nk; ++j) {
    int krow = j < nlat ? b * NTL + j : NLAT + b * NCX + (j - nlat);
    const bf16_t* kp = p.P() + (size_t)krow * INC + OFF_A + 256 + h * 64;
    float s1 = dot32(q, kp) * scale, s2 = dot32(q + 32, kp + 32) * scale;
    float n1 = fmaxf(m1, s1); l1 = l1 * expf(m1 - n1) + expf(s1 - n1); m1 = n1;
    float n2 = fmaxf(m2, s2); l2 = l2 * expf(m2 - n2) + expf(s2 - n2); m2 = n2;
  }
  float i1 = 1.0f / l1, i2 = lam / l2;
  bf16_t* yp = p.Y() + (size_t)qrow * DM + 0 + h * 64;
  float ss = 0.f;
  for (int dh = 0; dh < 2; ++dh) {
    float o[32];
#pragma unroll
    for (int d = 0; d < 32; ++d) o[d] = 0.f;
    for (int j = 0; j < nk; ++j) {
      int krow = j < nlat ? b * NTL + j : NLAT + b * NCX + (j - nlat);
      const bf16_t* kp = p.P() + (size_t)krow * INC + OFF_A + 256 + h * 64;
      float s1 = dot32(q, kp) * scale, s2 = dot32(q + 32, kp + 32) * scale;
      float pw = expf(s1 - m1) * i1 - expf(s2 - m2) * i2;
      const bf16_t* vp = kp + 256 + dh * 32;
#pragma unroll
      for (int d = 0; d < 32; d += 4) {
        float4 vv = ld4(vp + d);
        o[d] += pw * vv.x; o[d + 1] += pw * vv.y; o[d + 2] += pw * vv.z; o[d + 3] += pw * vv.w;
      }
    }
#pragma unroll
    for (int d = 0; d < 32; ++d) { ss += o[d] * o[d]; yp[dh * 32 + d] = f2bf(o[d]); }
  }
  float rs = (1.0f / sqrtf(ss * (1.0f / 64) + 1e-6f)) * (1.0f - lam_init);
  const float* g = p.diff_norm_g + l * 64;
#pragma unroll 4
  for (int d = 0; d < 64; ++d) yp[d] = f2bf(bf2f(yp[d]) * rs * g[d]);
}

DEVFN float dot64s(const bf16_t* q, const bf16_t* k) {
  float s = 0.f;
#pragma unroll
  for (int d = 0; d < 64; d += 4) {
    float4 kv = ld4(k + d);
    float4 qv = ld4(q + d);
    s += qv.x * kv.x + qv.y * kv.y + qv.z * kv.z + qv.w * kv.w;
    if ((d & 15) == 12) LOAD_FENCE();
  }
  return s;
}

DEVFN void mixD_item(const Params& p, int l, int b, int h, int qrow, bool lat, int t) {
  const bf16_t* q = p.P() + (size_t)qrow * INC + OFF_D + h * 64;
  int r = t / 64, cq = t % 64;
  int rs = r - 4; rs = rs < 0 ? 0 : (rs > GROWS - 8 ? GROWS - 8 : rs);
  int cs = cq - 8; cs = cs < 0 ? 0 : (cs > 48 ? 48 : cs);
  const float* rpb = p.nat_rpb + ((size_t)l * 4 + h) * 15 * 31;
  int nwin = lat ? 128 : 0;
  int nk = nwin + NCX;
  float m = -1e30f, ls = 0.f;
  bf16_t* yp = p.Y() + (size_t)qrow * DM + 768 + h * 64;
  for (int pass = 0; pass < 3; ++pass) {
    float inv = pass ? 1.0f / ls : 0.f;
    float o[32];
#pragma unroll
    for (int d = 0; d < 32; ++d) o[d] = 0.f;
    for (int j = 0; j < nk; ++j) {
      int krow; float bias = 0.f;
      if (j < nwin) {
        int i = j / 16, jj = j % 16;
        krow = b * NTL + (rs + i) * 64 + cs + jj;
        int dr = rs + i - r + 7;
        int dc = cs + jj - cq; dc = dc < -15 ? -15 : (dc > 15 ? 15 : dc); dc += 15;
        bias = rpb[dr * 31 + dc];
      } else {
        krow = NLAT + b * NCX + (j - nwin);
      }
      const bf16_t* kp = p.P() + (size_t)krow * INC + OFF_D + 256 + h * 64;
      float s = dot64s(q, kp) * 0.125f + bias;
      if (!pass) {
        float n = fmaxf(m, s); ls = ls * expf(m - n) + expf(s - n); m = n;
      } else {
        float pw = expf(s - m) * inv;
        const bf16_t* vp = kp + 256 + (pass - 1) * 32;
#pragma unroll
        for (int d = 0; d < 32; d += 4) {
          float4 vv = ld4(vp + d);
          o[d] += pw * vv.x; o[d + 1] += pw * vv.y; o[d + 2] += pw * vv.z; o[d + 3] += pw * vv.w;
        }
      }
    }
    if (pass) {
#pragma unroll
      for (int d = 0; d < 32; ++d) yp[(pass - 1) * 32 + d] = f2bf(o[d]);
    }
  }
}

DEVFN float rw_conv(const Params& p, int l, int row, int col, bool hp, bool hn) {
  const float* mu = p.rwkv_mu + (size_t)l * 2 * 1152;
  float m0 = mu[col], m1 = mu[1152 + col];
  const bf16_t* c = p.P() + (size_t)row * INC + OFF_B + col;
  float v = bf2f(c[0]) * (1.0f - m0 - m1);
  if (hp) v += bf2f(c[-INC]) * m0;
  if (hn) v += bf2f(c[INC]) * m1;
  return v;
}
DEVFN void rwprep_item(const Params& p, int l, long item) {
  int row = (int)(item / 256), c = (int)(item % 256);
  int h = c / 64;
  int t, len; seq_pos(row, t, len);
  bool hp = t > 0, hn = t < len - 1;
  float r = rw_conv(p, l, row, c, hp, hn);
  float k = rw_conv(p, l, row, 256 + c, hp, hn);
  float v = rw_conv(p, l, row, 512 + c, hp, hn);
  float wr[2], ar[2];
#pragma unroll
  for (int d = 0; d < 2; ++d) {
    float aw = p.rwkv_w0[(l * 2 + d) * 256 + c];
    float aa = p.rwkv_a0[(l * 2 + d) * 256 + c];
#pragma unroll 2
    for (int rr = 0; rr < 64; ++rr) {
      aw += tanhf_(rw_conv(p, l, row, 768 + d * 64 + rr, hp, hn)) * p.rwkv_w2[((size_t)(l * 2 + d) * 64 + rr) * 256 + c];
      aa += rw_conv(p, l, row, 896 + d * 64 + rr, hp, hn) * p.rwkv_a2[((size_t)(l * 2 + d) * 64 + rr) * 256 + c];
    }
    wr[d] = FEXP(-sigmoidf_(aw) * 0.6065306597126334f);
    ar[d] = sigmoidf_(aa);
  }
  float g = 0.f;
#pragma unroll 2
  for (int rr = 0; rr < 128; ++rr)
    g += sigmoidf_(rw_conv(p, l, row, 1024 + rr, hp, hn)) * p.rwkv_g2[((size_t)l * 128 + rr) * 256 + c];
  float n2 = 0.f;
#pragma unroll 2
  for (int cc = h * 64; cc < h * 64 + 64; ++cc) {
    float kc = rw_conv(p, l, row, 256 + cc, hp, hn) * p.rwkv_kk[l * 256 + cc];
    n2 += kc * kc;
  }
  float kk = k * p.rwkv_kk[l * 256 + c] * (1.0f / sqrtf(n2 + 1e-6f));
  float ka = p.rwkv_ka[l * 256 + c];
  float* o = p.RW() + (size_t)row * RWS;
  o[c] = r; o[256 + c] = v; o[512 + c] = g; o[768 + c] = kk;
  o[1024 + c] = wr[0]; o[1280 + c] = wr[1];
  o[1536 + c] = kk * ar[0]; o[1792 + c] = kk * ar[1];
  o[2048 + c] = k * (1.0f + (ar[0] - 1.0f) * ka);
  o[2304 + c] = k * (1.0f + (ar[1] - 1.0f) * ka);
}

DEVFN float gd_conv(const Params& p, int l, int row, int col, bool hp, bool hn) {
  const float* cw = p.gdn_conv + (size_t)l * 3 * 768;
  const bf16_t* c = p.P() + (size_t)row * INC + OFF_C + col;
  float v = bf2f(c[0]) * cw[768 + col];
  if (hp) v += bf2f(c[-INC]) * cw[col];
  if (hn) v += bf2f(c[INC]) * cw[1536 + col];
  return siluf_(v);
}
DEVFN void gdprep_item(const Params& p, int l, long item) {
  int row = (int)(item / 256), c = (int)(item % 256);
  int h = c / 64;
  int t, len; seq_pos(row, t, len);
  bool hp = t > 0, hn = t < len - 1;
  float q = gd_conv(p, l, row, c, hp, hn);
  float k = gd_conv(p, l, row, 256 + c, hp, hn);
  float v = gd_conv(p, l, row, 512 + c, hp, hn);
  float nq = 0.f, nk = 0.f;
#pragma unroll 2
  for (int cc = h * 64; cc < h * 64 + 64; ++cc) {
    float a = gd_conv(p, l, row, cc, hp, hn); nq += a * a;
    float bq = gd_conv(p, l, row, 256 + cc, hp, hn); nk += bq * bq;
  }
  float* o = p.GP() + (size_t)row * GPS;
  o[c] = q * (1.0f / sqrtf(nq + 1e-6f)) * 0.125f;
  o[256 + c] = k * (1.0f / sqrtf(nk + 1e-6f));
  o[512 + c] = v;
  if (c < 8) {
    int d = c / 4, hh = c % 4;
    const bf16_t* ab = p.P() + (size_t)row * INC + OFF_C + 1024;
    float la = -FEXP(p.gdn_a_log[(l * 2 + d) * 4 + hh]) * softplusf_(bf2f(ab[d * 4 + hh]) + p.gdn_dt_bias[(l * 2 + d) * 4 + hh]);
    o[768 + c] = la;
    o[776 + c] = sigmoidf_(bf2f(ab[8 + d * 4 + hh]));
  }
}

DEVFN int scan_row(int b, int d, int step) {
  if (step < NCX) return NLAT + b * NCX + (d ? NCX - 1 - step : step);
  int s2 = step - NCX;
  return b * NTL + (d ? NTL - 1 - s2 : s2);
}
DEVFN void rwscan_item(const Params& p, bool last, long item) {
  int v = (int)(item % 64), h = (int)((item / 64) % 4), b = (int)((item / 256) % NB), d = (int)(item / (256 * NB));
  float s[64];
#pragma unroll
  for (int k = 0; k < 64; ++k) s[k] = 0.f;
  for (int step = 0; step < NCX + NTL; ++step) {
    int row = scan_row(b, d, step);
    const float* base = p.RW() + (size_t)row * RWS + h * 64;
    const float* kkp = base + 768;
    const float* wp = base + 1024 + d * 256;
    const float* kap = base + 1536 + d * 256;
    const float* kdp = base + 2048 + d * 256;
    float vv = base[256 + v];
    float sa = 0.f;
#pragma unroll
    for (int k = 0; k < 64; ++k) sa += s[k] * kkp[k];
    float y = 0.f;
#pragma unroll
    for (int k = 0; k < 64; ++k) {
      s[k] = s[k] * wp[k] - sa * kap[k] + vv * kdp[k];
      y += s[k] * base[k];
    }
    if (!(last && row >= NLAT)) p.YS()[(size_t)row * 1024 + d * 256 + h * 64 + v] = f2bf(y);
  }
}
DEVFN void gdscan_item(const Params& p, bool last, long item) {
  int dv = (int)(item % 64), h = (int)((item / 64) % 4), b = (int)((item / 256) % NB), d = (int)(item / (256 * NB));
  float s[64];
#pragma unroll
  for (int k = 0; k < 64; ++k) s[k] = 0.f;
  for (int step = 0; step < NCX + NTL; ++step) {
    int row = scan_row(b, d, step);
    const float* base = p.GP() + (size_t)row * GPS;
    const float* qp = base + h * 64;
    const float* kp = base + 256 + h * 64;
    float vv = base[512 + h * 64 + dv];
    float eg = FEXP(base[768 + d * 4 + h]);
    float beta = base[776 + d * 4 + h];
    float ks = 0.f;
#pragma unroll
    for (int k = 0; k < 64; ++k) { s[k] *= eg; ks += kp[k] * s[k]; }
    float vn = beta * (vv - ks);
    float o = 0.f;
#pragma unroll
    for (int k = 0; k < 64; ++k) { s[k] += kp[k] * vn; o += qp[k] * s[k]; }
    if (!(last && row >= NLAT)) p.YS()[(size_t)row * 1024 + 512 + d * 256 + h * 64 + dv] = f2bf(o);
  }
}

DEVFN void rwpost_item(const Params& p, int l, int row, int h) {
  const bf16_t* y0 = p.YS() + (size_t)row * 1024 + h * 64;
  const float* rw = p.RW() + (size_t)row * RWS + h * 64;
  float y[64];
  float m = 0.f;
#pragma unroll
  for (int k = 0; k < 64; ++k) { y[k] = bf2f(y0[k]) + bf2f(y0[256 + k]); m += y[k]; if ((k & 7) == 7) LOAD_FENCE(); }
  m *= (1.0f / 64);
  float var = 0.f;
#pragma unroll
  for (int k = 0; k < 64; ++k) { float dd = y[k] - m; var += dd * dd; }
  float rstd = 1.0f / sqrtf(var * (1.0f / 64) + 64e-5f);
  float bonus = 0.f;
  const float* rk = p.rwkv_rk + (l * 4 + h) * 64;
#pragma unroll
  for (int k = 0; k < 64; ++k) { bonus += rw[k] * (rw[2048 + k] + rw[2304 + k]) * rk[k]; if ((k & 7) == 7) LOAD_FENCE(); }
  bf16_t* yp = p.Y() + (size_t)row * DM + 256 + h * 64;
  const float* lg = p.rwkv_ln_g + l * 256 + h * 64;
  const float* lb = p.rwkv_ln_b + l * 256 + h * 64;
#pragma unroll
  for (int k = 0; k < 64; ++k) { yp[k] = f2bf(((y[k] - m) * rstd * lg[k] + lb[k] + bonus * rw[256 + k]) * rw[512 + k]); if ((k & 7) == 7) LOAD_FENCE(); }
}
DEVFN void gdpost_item(const Params& p, int l, int row, int h) {
  const bf16_t* o0 = p.YS() + (size_t)row * 1024 + 512 + h * 64;
  const bf16_t* gate = p.P() + (size_t)row * INC + OFF_C + 768 + h * 64;
  float o[64];
  float ss = 0.f;
#pragma unroll
  for (int k = 0; k < 64; ++k) { o[k] = bf2f(o0[k]) + bf2f(o0[256 + k]); ss += o[k] * o[k]; if ((k & 7) == 7) LOAD_FENCE(); }
  float rs = 1.0f / sqrtf(ss * (1.0f / 64) + 1e-6f);
  const float* g = p.gdn_norm_g + l * 64;
  bf16_t* yp = p.Y() + (size_t)row * DM + 512 + h * 64;
#pragma unroll
  for (int k = 0; k < 64; ++k) { yp[k] = f2bf(o[k] * rs * g[k] * siluf_(bf2f(gate[k]))); if ((k & 7) == 7) LOAD_FENCE(); }
}

DEVFN void ph_pn1(const Params& p, int l, long item) {
  int row = (int)item;
  const float* hs = hsrc_row(p, l, row);
  float* hd = hdst_row(p, row);
  const float* m = p.mod() + ((size_t)l * NMODV + modv_of_row(row)) * 6144;
  const bf16_t* mix = (const bf16_t*)p.RW() + (size_t)row * DM;
  float s = 0.f;
  for (int i = 0; i < DM; ++i) s += DN_ALPHA * hs[i] + m[2048 + i] * bf2f(mix[i]);
  float mu = s * (1.0f / DM);
  float v = 0.f;
  for (int i = 0; i < DM; ++i) { float z = DN_ALPHA * hs[i] + m[2048 + i] * bf2f(mix[i]) - mu; v += z * z; }
  float rstd = 1.0f / sqrtf(v * (1.0f / DM) + LN_EPS);
  const float* g = p.ln_mix_g + l * DM;
  const float* bb = p.ln_mix_b + l * DM;
  float s2 = 0.f;
  for (int i = 0; i < DM; ++i) {
    float z = DN_ALPHA * hs[i] + m[2048 + i] * bf2f(mix[i]);
    float hn = (z - mu) * rstd * g[i] + bb[i];
    hd[i] = hn;
    s2 += hn;
  }
  float mu2 = s2 * (1.0f / DM);
  float v2 = 0.f;
  for (int i = 0; i < DM; ++i) { float dd = hd[i] - mu2; v2 += dd * dd; }
  float rstd2 = 1.0f / sqrtf(v2 * (1.0f / DM) + LN_EPS);
  bf16_t* x2 = p.Y() + (size_t)row * DM;
  for (int i = 0; i < DM; ++i) x2[i] = f2bf((hd[i] - mu2) * rstd2 * (1.0f + m[4096 + i]) + m[3072 + i]);
}
DEVFN void ph_pn2(const Params& p, int l, long item) {
  int row = (int)item;
  float* hd = hdst_row(p, row);
  const float* m = p.mod() + ((size_t)l * NMODV + modv_of_row(row)) * 6144;
  const float* ffn = p.RW() + (size_t)row * DM;
  float s = 0.f;
  for (int i = 0; i < DM; ++i) s += DN_ALPHA * hd[i] + m[5120 + i] * ffn[i];
  float mu = s * (1.0f / DM);
  float v = 0.f;
  for (int i = 0; i < DM; ++i) { float z = DN_ALPHA * hd[i] + m[5120 + i] * ffn[i] - mu; v += z * z; }
  float rstd = 1.0f / sqrtf(v * (1.0f / DM) + LN_EPS);
  const float* g = p.ln_ffn_g + l * DM;
  const float* bb = p.ln_ffn_b + l * DM;
  for (int i = 0; i < DM; ++i) {
    float z = DN_ALPHA * hd[i] + m[5120 + i] * ffn[i];
    hd[i] = (z - mu) * rstd * g[i] + bb[i];
  }
}

DEVFN bf16_t* peerQ(const Params& p) { return p.P(); }
DEVFN float* selbase(const Params& p) { return p.RW() + (size_t)NTOK * 1024; }
DEVFN float* sel1s(const Params& p) { return selbase(p); }
DEVFN int* sel1i(const Params& p) { return (int*)(selbase(p) + (size_t)NTOK * 256); }
DEVFN int* sel2i(const Params& p) { return (int*)(selbase(p) + (size_t)NTOK * 512); }
DEVFN float* sel2g(const Params& p) { return selbase(p) + (size_t)NTOK * 640; }
DEVFN float* coefb(const Params& p) { return selbase(p) + (size_t)NTOK * 768; }

#define TOPK_INSERT(ts, ti, xs, xi)                                      \
  {                                                                      \
    float cs_ = (xs); int ci_ = (xi);                                    \
    _Pragma("unroll") for (int z_ = 0; z_ < 16; ++z_) {                  \
      bool gt_ = cs_ > ts[z_];                                           \
      float os_ = ts[z_]; int oi_ = ti[z_];                              \
      ts[z_] = gt_ ? cs_ : os_; ti[z_] = gt_ ? ci_ : oi_;                \
      cs_ = gt_ ? os_ : cs_; ci_ = gt_ ? oi_ : ci_;                      \
    }                                                                    \
  }

DEVFN void ph_topk1(const Params& p, int l, int nrows, long item) {
  int hp = (int)(item / nrows), row = (int)(item % nrows);
  const bf16_t* q = peerQ(p) + (size_t)row * 2048 + hp * 128;
  const float* keys = p.peer_keys + ((size_t)l * 16 + hp) * 128 * 128;
  float ts[16]; int ti[16];
#pragma unroll
  for (int z = 0; z < 16; ++z) { ts[z] = -3e38f; ti[z] = 0; }
  for (int n = 0; n < 128; ++n) {
    const float* kr = keys + n * 128;
    float s = 0.f;
#pragma unroll 8
    for (int d = 0; d < 128; d += 4) {
      float4 qa = ld4(q + d), kb = *(const float4*)(kr + d);
      s += qa.x * kb.x; s += qa.y * kb.y; s += qa.z * kb.z; s += qa.w * kb.w;
    }
    TOPK_INSERT(ts, ti, s, n);
  }
  float* os = sel1s(p) + ((size_t)row * 16 + hp) * 16;
  int* oi = sel1i(p) + ((size_t)row * 16 + hp) * 16;
#pragma unroll
  for (int z = 0; z < 16; ++z) { os[z] = ts[z]; oi[z] = ti[z]; }
}
DEVFN void ph_topk2(const Params& p, int nrows, long item) {
  int h = (int)(item / nrows), row = (int)(item % nrows);
  const float* s0 = sel1s(p) + ((size_t)row * 16 + h * 2) * 16;
  const int* i0 = sel1i(p) + ((size_t)row * 16 + h * 2) * 16;
  float s1[16]; int i1[16];
#pragma unroll
  for (int z = 0; z < 16; ++z) { s1[z] = s0[16 + z]; i1[z] = i0[16 + z]; }
  float ts[16]; int ti[16];
#pragma unroll
  for (int z = 0; z < 16; ++z) { ts[z] = -3e38f; ti[z] = 0; }
  for (int i = 0; i < 16; ++i) {
    float a = s0[i]; int ai = i0[i] * 128;
#pragma unroll
    for (int j = 0; j < 16; ++j) TOPK_INSERT(ts, ti, a + s1[j], ai + i1[j]);
  }
  float sum = 0.f;
  float mx = ts[0];
#pragma unroll
  for (int z = 0; z < 16; ++z) { ts[z] = expf(ts[z] - mx); }
#pragma unroll
  for (int z = 0; z < 16; ++z) sum += ts[z];
  float inv = 1.0f / sum;
  int* oi = sel2i(p) + ((size_t)row * 8 + h) * 16;
  float* og = sel2g(p) + ((size_t)row * 8 + h) * 16;
#pragma unroll
  for (int z = 0; z < 16; ++z) { oi[z] = ti[z]; og[z] = ts[z] * inv; }
}
DEVFN void ph_act(const Params& p, int l, long item) {
  int row = (int)(item / 128);
  int idx = sel2i(p)[item];
  const bf16_t* x2 = p.Y() + (size_t)row * DM;
  const float* u = p.peer_u + ((size_t)l * 16384 + idx) * DM;
  float s = 0.f;
  for (int i = 0; i < DM; i += 4) {
    float4 a = ld4(x2 + i), b = *(const float4*)(u + i);
    s += a.x * b.x + a.y * b.y + a.z * b.z + a.w * b.w;
  }
  coefb(p)[item] = sel2g(p)[item] * geluf_(s);
}
DEVFN void ph_ffn(const Params& p, int l, long item) {
  int row = (int)(item / 256), c4 = (int)(item % 256);
  const int* idx = sel2i(p) + (size_t)row * 128;
  const float* cf = coefb(p) + (size_t)row * 128;
  float4 acc = make_float4(0.f, 0.f, 0.f, 0.f);
  for (int j = 0; j < 128; ++j) {
    float4 vv = *(const float4*)(p.peer_v + ((size_t)l * 16384 + idx[j]) * DM + c4 * 4);
    float c = cf[j];
    acc.x += c * vv.x; acc.y += c * vv.y; acc.z += c * vv.z; acc.w += c * vv.w;
  }
  *(float4*)(p.RW() + (size_t)row * DM + c4 * 4) = acc;
}

enum { PH_ADA = 0, PH_LN1, PH_GEMM_IN, PH_ROPE, PH_MIX, PH_GDPREP, PH_SCAN, PH_POST, PH_GEMM_OUT, PH_PN1, PH_GEMM_Q,
       PH_TOPK1, PH_TOPK2, PH_ACT, PH_FFN, PH_PN2, PH_COUNT };

HDFN int rows_out(int l) { return l == 1 ? NLAT : NTOK; }

HDFN long phase_items(int ph, int l) {
  bool last = l == 1;
  long nr = rows_out(l);
  switch (ph) {
    case PH_ADA: return l == 0 ? 2 * 6144 : 0;
    case PH_LN1: return NTOK;
    case PH_GEMM_IN: return (long)(NTOK / 4) * (INC / 4);
    case PH_ROPE: return (long)NLAT * 256;
    case PH_MIX: return 2L * NB * 4 * NTL + (last ? 0 : 2L * NB * 4 * NCX) + (long)NTOK * 256;
    case PH_GDPREP: return (long)NTOK * 256;
    case PH_SCAN: return 2L * 2 * NB * 4 * 64;
    case PH_POST: return nr * 4 * 2;
    case PH_GEMM_OUT: return (nr / 4) * (DM / 4);
    case PH_PN1: return nr;
    case PH_GEMM_Q: return (nr / 4) * (2048 / 4);
    case PH_TOPK1: return nr * 16;
    case PH_TOPK2: return nr * 8;
    case PH_ACT: return nr * 128;
    case PH_FFN: return nr * 256;
    case PH_PN2: return nr;
  }
  return 0;
}

template <int PH>
DEVFN void phase_item(const Params& p, int l, long item) {
  bool last = l == 1;
  int nr = rows_out(l);
  if (PH == PH_ADA) ph_ada(p, item);
  else if (PH == PH_LN1) ph_ln1(p, l, item);
  else if (PH == PH_GEMM_IN) gemm_item(p.Y(), DM, p.w_in + (size_t)l * DM * INC, INC, p.P(), INC, INC, DM, item);
  else if (PH == PH_ROPE) ph_rope(p, item);
  else if (PH == PH_MIX) {
    long nAl = (long)NB * 4 * NTL, nAc = last ? 0 : (long)NB * 4 * NCX;
    if (item < nAl) {
      int bh = (int)(item / NTL), t = (int)(item % NTL);
      mixA_item(p, l, bh / 4, bh % 4, (bh / 4) * NTL + t, true);
    } else if (item < nAl + nAc) {
      long it = item - nAl; int bh = (int)(it / NCX), t = (int)(it % NCX);
      mixA_item(p, l, bh / 4, bh % 4, NLAT + (bh / 4) * NCX + t, false);
    } else if (item < 2 * nAl + nAc) {
      long it = item - nAl - nAc; int bh = (int)(it / NTL), t = (int)(it % NTL);
      mixD_item(p, l, bh / 4, bh % 4, (bh / 4) * NTL + t, true, t);
    } else if (item < 2 * nAl + 2 * nAc) {
      long it = item - 2 * nAl - nAc; int bh = (int)(it / NCX), t = (int)(it % NCX);
      mixD_item(p, l, bh / 4, bh % 4, NLAT + (bh / 4) * NCX + t, false, 0);
    } else {
      rwprep_item(p, l, item - 2 * nAl - 2 * nAc);
    }
  } else if (PH == PH_GDPREP) gdprep_item(p, l, item);
  else if (PH == PH_SCAN) {
    long n1 = 2L * NB * 4 * 64;
    if (item < n1) rwscan_item(p, last, item); else gdscan_item(p, last, item - n1);
  } else if (PH == PH_POST) {
    long n1 = (long)nr * 4;
    if (item < n1) rwpost_item(p, l, (int)(item / 4), (int)(item % 4));
    else { long it = item - n1; gdpost_item(p, l, (int)(it / 4), (int)(it % 4)); }
  } else if (PH == PH_GEMM_OUT) gemm_item(p.Y(), DM, p.w_out + (size_t)l * DM * DM, DM, (bf16_t*)p.RW(), DM, DM, DM, item);
  else if (PH == PH_PN1) ph_pn1(p, l, item);
  else if (PH == PH_GEMM_Q) gemm_item(p.Y(), DM, p.peer_wq + (size_t)l * DM * 2048, 2048, peerQ(p), 2048, 2048, DM, item);
  else if (PH == PH_TOPK1) ph_topk1(p, l, nr, item);
  else if (PH == PH_TOPK2) ph_topk2(p, nr, item);
  else if (PH == PH_ACT) ph_act(p, l, item);
  else if (PH == PH_FFN) ph_ffn(p, l, item);
  else if (PH == PH_PN2) ph_pn2(p, l, item);
}


#ifndef CPU_EMU
__device__ __forceinline__ int make_tid(int wave_s) {
  int lane;
  asm volatile("v_mbcnt_lo_u32_b32 %0, -1, 0\n\tv_mbcnt_hi_u32_b32 %0, -1, %0" : "=v"(lane));
  return wave_s * 64 + lane;
}
#define XB_TMO      128
#define XB_XCNT(j)  (256  + 64 * (j))
#define XB_XSUB(j)  (1280 + 64 * (j))
#define XB_XGEN(j)  (2304 + 64 * (j))
#define XB_TOP      3328
#define XB_TOPGEN   3392
#define XCD_BAR_WORDS 3456
#define XB_SPIN_CAP (1u << 18)
#define LAS __attribute__((address_space(3)))

__device__ __forceinline__ unsigned xb_ld(unsigned* p)              { return __hip_atomic_load(p, __ATOMIC_RELAXED, __HIP_MEMORY_SCOPE_AGENT); }
__device__ __forceinline__ unsigned xb_add(unsigned* p, unsigned v) { return __hip_atomic_fetch_add(p, v, __ATOMIC_RELAXED, __HIP_MEMORY_SCOPE_AGENT); }
__device__ __forceinline__ unsigned xb_xcc_id() { return (unsigned)__builtin_amdgcn_s_getreg((3 << 11) | 20) & 0xFu; }
#define XB_SPIN(cond, bar) do { unsigned _sp = 0; while (cond) { __builtin_amdgcn_s_sleep(1); \
    if ((++_sp & 255u) == 0u) { if (xb_ld(&(bar)[XB_TMO])) break; if (_sp > XB_SPIN_CAP) { atomicAdd(&(bar)[XB_TMO], 1u); break; } } } } while (0)

struct XcdBarrier {
    unsigned* bar; unsigned x;
    volatile LAS unsigned* st;
};

__device__ __forceinline__ XcdBarrier xcd_barrier_post(unsigned* bar, volatile LAS unsigned* st) {
    XcdBarrier b; b.bar = bar; b.x = xb_xcc_id(); b.st = st;
    if (threadIdx.x == 0) (void)xb_add(&bar[XB_XCNT(b.x)], 1u);
    return b;
}
__device__ __forceinline__ void xcd_barrier_complete(unsigned* bar, unsigned x, unsigned& nloc, unsigned& nx) {
    const unsigned G = gridDim.x * gridDim.y * gridDim.z;
    unsigned sum, cnt, mine, sp = 0u;
    for (;;) {
        sum = 0u; cnt = 0u; mine = 0u;
#pragma unroll
        for (unsigned j = 0; j < 16; ++j) { const unsigned c = xb_ld(&bar[XB_XCNT(j)]); sum += c; cnt += (c > 0u) ? 1u : 0u; mine = (j == x) ? c : mine; }
        if (sum == G) break;
        __builtin_amdgcn_s_sleep(1);
        if ((++sp & 255u) == 0u) { if (xb_ld(&bar[XB_TMO])) break; if (sp > XB_SPIN_CAP) { atomicAdd(&bar[XB_TMO], 1u); break; } }
    }
    nloc = mine > 0u ? mine : 1u; nx = cnt > 0u ? cnt : 1u;
}

__device__ __forceinline__ void xcd_barrier(const XcdBarrier& b, int wave_s) {
    asm volatile("s_waitcnt vmcnt(0)" ::: "memory");
    __syncthreads();
    if (make_tid(wave_s) == 0) {
        unsigned* bar = b.bar;
        __builtin_amdgcn_s_waitcnt(0);
        unsigned nloc = b.st[0], nx = b.st[1];
        if (nloc == 0u) { xcd_barrier_complete(bar, b.x, nloc, nx); b.st[0] = nloc; b.st[1] = nx; }
        const unsigned old = xb_add(&bar[XB_XSUB(b.x)], 1u);
        const unsigned gen = old / nloc;
        if (old + 1u == (gen + 1u) * nloc) {
            __builtin_amdgcn_fence(__ATOMIC_RELEASE, "agent");
            asm volatile("s_waitcnt vmcnt(0)" ::: "memory");
            const unsigned og = xb_add(&bar[XB_TOP], 1u);
            const unsigned tg = og / nx;
            if (og + 1u == (tg + 1u) * nx) xb_add(&bar[XB_TOPGEN], 1u);
            else XB_SPIN(xb_ld(&bar[XB_TOPGEN]) == tg, bar);
            __builtin_amdgcn_fence(__ATOMIC_ACQUIRE, "agent");
            xb_add(&bar[XB_XGEN(b.x)], 1u);
            asm volatile("s_waitcnt vmcnt(0)" ::: "memory");
        } else {
            XB_SPIN(xb_ld(&bar[XB_XGEN(b.x)]) == gen, bar);
            __builtin_amdgcn_fence(__ATOMIC_ACQUIRE, "agent");
            asm volatile("s_waitcnt vmcnt(0)" ::: "memory");
        }
    }
    __syncthreads();
}


constexpr int NTHREADS = 512;
typedef __attribute__((ext_vector_type(8))) __bf16 bf16x8;
typedef __attribute__((ext_vector_type(2))) __bf16 bf16x2;
typedef __attribute__((ext_vector_type(2))) float f32x2;
typedef __attribute__((ext_vector_type(4))) float f32x4;

__device__ __forceinline__ unsigned pk_bf16(float a, float b) {
  f32x2 v = {a, b};
  return __builtin_bit_cast(unsigned, __builtin_convertvector(v, bf16x2));
}

constexpr int NPAD_IN = 3840;
constexpr size_t WBT_LAYER = (size_t)(NPAD_IN + 1024 + 2048) * 1024;
__device__ __forceinline__ bf16_t* wbt_in(const Params& p, int l) { return p.WBT() + (size_t)l * WBT_LAYER; }
__device__ __forceinline__ bf16_t* wbt_out(const Params& p, int l) { return p.WBT() + (size_t)l * WBT_LAYER + (size_t)NPAD_IN * 1024; }
__device__ __forceinline__ bf16_t* wbt_q(const Params& p, int l) { return p.WBT() + (size_t)l * WBT_LAYER + (size_t)(NPAD_IN + 1024) * 1024; }

__device__ __forceinline__ void conv_weight_tiles(const float* W, int N, int npad, bf16_t* Bt, char* smem, int tid) {
  bf16_t* T = (bf16_t*)smem;
  const int ntn = npad / 64, ntiles = 16 * ntn;
  for (int t0 = blockIdx.x * 4; t0 < ntiles; t0 += gridDim.x * 4) {
    float4 v[4][2];
#pragma unroll
    for (int q = 0; q < 4; ++q) {
      const int tt = t0 + q, kt = tt / ntn, nt = tt % ntn;
#pragma unroll
      for (int j = 0; j < 2; ++j) {
        const int k = (tid >> 4) + 32 * j, n = nt * 64 + (tid & 15) * 4;
        const bool ok = tt < ntiles && n < N;
        v[q][j] = *(const float4*)(W + (size_t)((ok ? kt : 0) * 64 + k) * N + (ok ? n : 0));
      }
    }
#pragma unroll
    for (int q = 0; q < 4; ++q) {
      const int tt = t0 + q, nt = tt % ntn;
      const bool ok = tt < ntiles && nt * 64 + (tid & 15) * 4 < N;
#pragma unroll
      for (int j = 0; j < 2; ++j) if (!ok) v[q][j] = make_float4(0.f, 0.f, 0.f, 0.f);
    }
#pragma unroll
    for (int q = 0; q < 4; ++q)
#pragma unroll
      for (int j = 0; j < 2; ++j) {
        const int k = (tid >> 4) + 32 * j, n4 = (tid & 15) * 4;
        bf16_t* Tq = T + q * 64 * 72;
        Tq[(n4 + 0) * 72 + k] = f2bf(v[q][j].x); Tq[(n4 + 1) * 72 + k] = f2bf(v[q][j].y);
        Tq[(n4 + 2) * 72 + k] = f2bf(v[q][j].z); Tq[(n4 + 3) * 72 + k] = f2bf(v[q][j].w);
      }
    LDS_BAR();
#pragma unroll
    for (int q = 0; q < 4; ++q) {
      const int tt = t0 + q, kt = tt / ntn, nt = tt % ntn;
      const int n = tid >> 3, kc = tid & 7;
      if (tt < ntiles) *(uint4*)(Bt + (size_t)(nt * 64 + n) * 1024 + kt * 64 + kc * 8) = *(const uint4*)(T + q * 64 * 72 + n * 72 + kc * 8);
    }
    LDS_BAR();
  }
}
__device__ __forceinline__ void conv_weights(const Params& p, char* smem, int wave_s) {
  int tid = make_tid(wave_s);
  for (int l = 0; l < 2; ++l) {
    conv_weight_tiles(p.w_in + (size_t)l * DM * INC, INC, NPAD_IN, wbt_in(p, l), smem, tid);
    conv_weight_tiles(p.w_out + (size_t)l * DM * DM, DM, DM, wbt_out(p, l), smem, tid);
    conv_weight_tiles(p.peer_wq + (size_t)l * DM * 2048, 2048, 2048, wbt_q(p, l), smem, tid);
  }
}

template <int BM>
__device__ __forceinline__ void gemm_tile(const bf16_t* __restrict__ A, int lda, const bf16_t* __restrict__ Bt, int N,
                                          bf16_t* __restrict__ C, int ldc, int m0, int n0, char* smem, int tid,
                                          bool staged, bool has_next, int m0n, int n0n) {
  constexpr int WM = BM / 4, MJ = WM / 16, ACH = BM * 8 / NTHREADS;
  constexpr int ABYTES = BM * 128, BBYTES = 128 * 128;
  const int lane = tid & 63, w = tid >> 6, wm = w >> 1, wn = w & 1;
  char* As = smem;
  char* Bs = smem + 3 * ABYTES;
  f32x4 acc[4][MJ];
#pragma unroll
  for (int i = 0; i < 4; ++i)
#pragma unroll
    for (int j = 0; j < MJ; ++j) acc[i][j] = f32x4{0.f, 0.f, 0.f, 0.f};
  typedef __attribute__((address_space(3))) void* lds_ptr;
  const int srow = lane >> 3, schunk = (lane & 7) ^ (lane >> 3);
  const bf16_t* aptr[ACH];
  const bf16_t* bptr[2];
#pragma unroll
  for (int i = 0; i < ACH; ++i) aptr[i] = A + (size_t)(m0 + (w + 8 * i) * 8 + srow) * lda + schunk * 8;
#pragma unroll
  for (int i = 0; i < 2; ++i) bptr[i] = Bt + (size_t)(n0 + (w + 8 * i) * 8 + srow) * 1024 + schunk * 8;
#define GEMM_STAGE(kt, buf)                                                                                   \
  {                                                                                                           \
    _Pragma("unroll") for (int i = 0; i < ACH; ++i)                                                           \
      __builtin_amdgcn_global_load_lds((const void*)(aptr[i] + (kt) * 64), (lds_ptr)(As + (buf) * ABYTES + (w + 8 * i) * 1024 + lane * 16), 16, 0, 0); \
    _Pragma("unroll") for (int i = 0; i < 2; ++i)                                                             \
      __builtin_amdgcn_global_load_lds((const void*)(bptr[i] + (kt) * 64), (lds_ptr)(Bs + (buf) * BBYTES + (w + 8 * i) * 1024 + lane * 16), 16, 0, 0); \
  }
  const int l15 = lane & 15, lq = lane >> 4, sw = lane & 7;
  const int bbase = (wn * 64 + l15) * 128, abase = (wm * WM + l15) * 128;
  if (!staged) { GEMM_STAGE(0, 0); GEMM_STAGE(1, 1); }
  int buf = 0;
  for (int kt = 0; kt < 16; ++kt) {
    if (kt < 15) { if (ACH == 4) asm volatile("s_waitcnt vmcnt(6)" ::: "memory"); else asm volatile("s_waitcnt vmcnt(4)" ::: "memory"); }
    else asm volatile("s_waitcnt vmcnt(0)" ::: "memory");
    __builtin_amdgcn_s_barrier();
    if (kt < 14) { const int nb_ = buf == 0 ? 2 : buf - 1; GEMM_STAGE(kt + 2, nb_); }
#pragma unroll
    for (int ks = 0; ks < 2; ++ks) {
      const int koff = ((ks * 4 + lq) ^ sw) << 4;
      bf16x8 af[4], bf[MJ];
#pragma unroll
      for (int i = 0; i < 4; ++i) af[i] = *(const bf16x8*)(Bs + buf * BBYTES + bbase + i * 2048 + koff);
#pragma unroll
      for (int j = 0; j < MJ; ++j) bf[j] = *(const bf16x8*)(As + buf * ABYTES + abase + j * 2048 + koff);
#pragma unroll
      for (int i = 0; i < 4; ++i)
#pragma unroll
        for (int j = 0; j < MJ; ++j) acc[i][j] = __builtin_amdgcn_mfma_f32_16x16x32_bf16(af[i], bf[j], acc[i][j], 0, 0, 0);
    }
    buf = buf == 2 ? 0 : buf + 1;
  }
  asm volatile("s_waitcnt lgkmcnt(0)" ::: "memory");
  __builtin_amdgcn_s_barrier();
  if (has_next) {
#pragma unroll
    for (int i = 0; i < ACH; ++i) aptr[i] = A + (size_t)(m0n + (w + 8 * i) * 8 + srow) * lda + schunk * 8;
#pragma unroll
    for (int i = 0; i < 2; ++i) bptr[i] = Bt + (size_t)(n0n + (w + 8 * i) * 8 + srow) * 1024 + schunk * 8;
    GEMM_STAGE(0, 0); GEMM_STAGE(1, 1);
  }
#undef GEMM_STAGE
#pragma unroll
  for (int i = 0; i < 4; ++i) {
    int n = n0 + wn * 64 + i * 16 + lq * 4;
    if (n < N) {
#pragma unroll
      for (int j = 0; j < MJ; ++j) {
        int m = m0 + wm * WM + j * 16 + l15;
        uint2 v;
        v.x = pk_bf16(acc[i][j][0], acc[i][j][1]);
        v.y = pk_bf16(acc[i][j][2], acc[i][j][3]);
        *(uint2*)(C + (size_t)m * ldc + n) = v;
      }
    }
  }
}

template <int BM>
__device__ __forceinline__ void gemm_phase(const bf16_t* A, int lda, const bf16_t* Bt, int N, bf16_t* C, int ldc, int M, char* smem, int wave_s) {
  const int ntn = (N + 127) / 128, ntm = M / BM;
  const int ntiles = ntm * ntn;
  int tid = make_tid(wave_s);
  const int nb = gridDim.x;
  const int vid = (nb % 8 == 0) ? (int)((blockIdx.x % 8) * (nb / 8) + blockIdx.x / 8) : (int)blockIdx.x;
#define GEMM_TILE_MN(t_, mt_, nt_) { const int grp = (t_) / (8 * ntn), fm = grp * 8; const int gsz = (ntm - fm) < 8 ? (ntm - fm) : 8; \
    const int r = (t_) - grp * 8 * ntn; mt_ = fm + (r % gsz); nt_ = r / gsz; }
  bool staged = false;
  for (int t = vid; t < ntiles; t += nb) {
    int mt, nt, mtn = 0, ntn_ = 0;
    GEMM_TILE_MN(t, mt, nt)
    const bool has_next = t + nb < ntiles;
    if (has_next) GEMM_TILE_MN(t + nb, mtn, ntn_)
    const int tid2 = make_tid(wave_s);
    gemm_tile<BM>(A, lda, Bt, N, C, ldc, mt * BM, nt * 128, smem, tid2, staged, has_next, mtn * BM, ntn_ * 128);
    staged = has_next;
  }
#undef GEMM_TILE_MN
  asm volatile("s_waitcnt vmcnt(0)" ::: "memory");
}

__device__ __forceinline__ float wave_sum(float v) {
#pragma unroll
  for (int o = 32; o >= 1; o >>= 1) v += __shfl_xor(v, o);
  return v;
}
__device__ __forceinline__ void unpack8(uint4 v, float* x) {
  x[0] = __uint_as_float(v.x << 16); x[1] = __uint_as_float(v.x & 0xffff0000u);
  x[2] = __uint_as_float(v.y << 16); x[3] = __uint_as_float(v.y & 0xffff0000u);
  x[4] = __uint_as_float(v.z << 16); x[5] = __uint_as_float(v.z & 0xffff0000u);
  x[6] = __uint_as_float(v.w << 16); x[7] = __uint_as_float(v.w & 0xffff0000u);
}
__device__ __forceinline__ void ldrow_f32(const float* r, int lane, float (&x)[16]) {
  float4 a = *(const float4*)(r + lane * 8), b = *(const float4*)(r + lane * 8 + 4);
  float4 c = *(const float4*)(r + 512 + lane * 8), d = *(const float4*)(r + 512 + lane * 8 + 4);
  x[0] = a.x; x[1] = a.y; x[2] = a.z; x[3] = a.w; x[4] = b.x; x[5] = b.y; x[6] = b.z; x[7] = b.w;
  x[8] = c.x; x[9] = c.y; x[10] = c.z; x[11] = c.w; x[12] = d.x; x[13] = d.y; x[14] = d.z; x[15] = d.w;
}
__device__ __forceinline__ void ldrow_bf16(const bf16_t* r, int lane, float (&x)[16]) {
  uint4 a = *(const uint4*)(r + lane * 8), b = *(const uint4*)(r + 512 + lane * 8);
  unpack8(a, x); unpack8(b, x + 8);
}
__device__ __forceinline__ void strow_f32(float* r, int lane, const float (&x)[16]) {
  *(float4*)(r + lane * 8) = make_float4(x[0], x[1], x[2], x[3]);
  *(float4*)(r + lane * 8 + 4) = make_float4(x[4], x[5], x[6], x[7]);
  *(float4*)(r + 512 + lane * 8) = make_float4(x[8], x[9], x[10], x[11]);
  *(float4*)(r + 512 + lane * 8 + 4) = make_float4(x[12], x[13], x[14], x[15]);
}
__device__ __forceinline__ void strow_bf16(bf16_t* r, int lane, const float (&x)[16]) {
  uint4 a, b;
  a.x = pk_bf16(x[0], x[1]); a.y = pk_bf16(x[2], x[3]); a.z = pk_bf16(x[4], x[5]); a.w = pk_bf16(x[6], x[7]);
  b.x = pk_bf16(x[8], x[9]); b.y = pk_bf16(x[10], x[11]); b.z = pk_bf16(x[12], x[13]); b.w = pk_bf16(x[14], x[15]);
  *(uint4*)(r + lane * 8) = a;
  *(uint4*)(r + 512 + lane * 8) = b;
}
__device__ __forceinline__ void ldrow16_f32(const float* r, int lane, float (&x)[16]) {
  const float4 a = *(const float4*)(r + lane * 16), b = *(const float4*)(r + lane * 16 + 4);
  const float4 c = *(const float4*)(r + lane * 16 + 8), d = *(const float4*)(r + lane * 16 + 12);
  x[0] = a.x; x[1] = a.y; x[2] = a.z; x[3] = a.w; x[4] = b.x; x[5] = b.y; x[6] = b.z; x[7] = b.w;
  x[8] = c.x; x[9] = c.y; x[10] = c.z; x[11] = c.w; x[12] = d.x; x[13] = d.y; x[14] = d.z; x[15] = d.w;
}
__device__ __forceinline__ void ldrow16_bf16(const bf16_t* r, int lane, float (&x)[16]) {
  const uint4 a = *(const uint4*)(r + lane * 16), b = *(const uint4*)(r + lane * 16 + 8);
  unpack8(a, x); unpack8(b, x + 8);
}
__device__ __forceinline__ void strow16_f32(float* r, int lane, const float (&x)[16]) {
  *(float4*)(r + lane * 16) = make_float4(x[0], x[1], x[2], x[3]);
  *(float4*)(r + lane * 16 + 4) = make_float4(x[4], x[5], x[6], x[7]);
  *(float4*)(r + lane * 16 + 8) = make_float4(x[8], x[9], x[10], x[11]);
  *(float4*)(r + lane * 16 + 12) = make_float4(x[12], x[13], x[14], x[15]);
}
__device__ __forceinline__ void strow16_bf16(bf16_t* r, int lane, const float (&x)[16]) {
  uint4 a, b;
  a.x = pk_bf16(x[0], x[1]); a.y = pk_bf16(x[2], x[3]); a.z = pk_bf16(x[4], x[5]); a.w = pk_bf16(x[6], x[7]);
  b.x = pk_bf16(x[8], x[9]); b.y = pk_bf16(x[10], x[11]); b.z = pk_bf16(x[12], x[13]); b.w = pk_bf16(x[14], x[15]);
  *(uint4*)(r + lane * 16) = a;
  *(uint4*)(r + lane * 16 + 8) = b;
}
__device__ __forceinline__ void row_ln_stats(const float (&x)[16], float& mean, float& rstd) {
  float s = 0.f;
#pragma unroll
  for (int i = 0; i < 16; ++i) s += x[i];
  mean = wave_sum(s) * (1.0f / DM);
  float v = 0.f;
#pragma unroll
  for (int i = 0; i < 16; ++i) { float d = x[i] - mean; v += d * d; }
  rstd = 1.0f / sqrtf(wave_sum(v) * (1.0f / DM) + LN_EPS);
}
__device__ __forceinline__ void row_modulate(float (&x)[16], const float* sh, const float* sc, int lane) {
  float mean, rstd; row_ln_stats(x, mean, rstd);
  float a[16], b[16];
  ldrow_f32(sc, lane, a); ldrow_f32(sh, lane, b);
#pragma unroll
  for (int i = 0; i < 16; ++i) x[i] = (x[i] - mean) * rstd * (1.0f + a[i]) + b[i];
}
__device__ __forceinline__ void row_affine_ln(float (&x)[16], const float* g, const float* bb, int lane) {
  float mean, rstd; row_ln_stats(x, mean, rstd);
  float a[16], b[16];
  ldrow_f32(g, lane, a); ldrow_f32(bb, lane, b);
#pragma unroll
  for (int i = 0; i < 16; ++i) x[i] = (x[i] - mean) * rstd * a[i] + b[i];
}

__device__ __forceinline__ void fast_ln1(const Params& p, int l, int wave_s) {
  for (int row = blockIdx.x * 8 + wave_s; row < NTOK; row += gridDim.x * 8) {
    const int lane = make_tid(wave_s) & 63;
    const float* m = p.mod() + ((size_t)l * NMODV + modv_of_row(row)) * 6144;
    float x[16];
    ldrow_f32(hsrc_row(p, l, row), lane, x);
    row_modulate(x, m, m + 1024, lane);
    strow_bf16(p.Y() + (size_t)row * DM, lane, x);
  }
}
template <int CTRL> __device__ __forceinline__ float dppx(float x) {
  return __builtin_bit_cast(float, __builtin_amdgcn_update_dpp(0, __builtin_bit_cast(int, x), CTRL, 0xf, 0xf, true));
}
typedef __attribute__((ext_vector_type(2))) float f32x2v;
constexpr float XQ_SCALE = 8.0f;
DEVFN unsigned char* xqbuf(const Params& p) { return (unsigned char*)p.P() + (size_t)NTOK * 4096; }
__device__ __forceinline__ void fast_pn1(const Params& p, int l, int nr, int wave_s) {
  for (int row = blockIdx.x * 8 + wave_s; row < nr; row += gridDim.x * 8) {
    const int lane = make_tid(wave_s) & 63;
    const float* m = p.mod() + ((size_t)l * NMODV + modv_of_row(row)) * 6144;
    float x[16], y[16], g[16];
    ldrow_f32(hsrc_row(p, l, row), lane, x);
    ldrow_bf16((const bf16_t*)p.RW() + (size_t)row * DM, lane, y);
    ldrow_f32(m + 2048, lane, g);
#pragma unroll
    for (int i = 0; i < 16; ++i) x[i] = DN_ALPHA * x[i] + g[i] * y[i];
    row_affine_ln(x, p.ln_mix_g + l * DM, p.ln_mix_b + l * DM, lane);
    strow_f32(hdst_row(p, row), lane, x);
    row_modulate(x, m + 3072, m + 4096, lane);
    strow_bf16(p.Y() + (size_t)row * DM, lane, x);
    unsigned char* xq = xqbuf(p) + (size_t)row * 1024;
#pragma unroll
    for (int hf = 0; hf < 2; ++hf) {
      uint2 hi = make_uint2(0u, 0u);
#define XQ_PAIR(k_, hw_, sel_) { \
        const float a = fminf(fmaxf(x[hf * 8 + 2 * (k_)] * XQ_SCALE, -448.f), 448.f); \
        const float b = fminf(fmaxf(x[hf * 8 + 2 * (k_) + 1] * XQ_SCALE, -448.f), 448.f); \
        hw_ = __builtin_amdgcn_cvt_pk_fp8_f32(a, b, hw_, sel_); }
      XQ_PAIR(0, hi.x, false) XQ_PAIR(1, hi.x, true) XQ_PAIR(2, hi.y, false) XQ_PAIR(3, hi.y, true)
      *(uint2*)(xq + (hf * 64 + lane) * 8) = hi;
    }
  }
}

constexpr float U8_SCALE = 64.0f, V8_SCALE = 4.0f;
__device__ __forceinline__ void conv_tables(const Params& p, int l, int wave_s) {
  int tid = make_tid(wave_s);
  const size_t nch = (size_t)16384 * 1024 / 16;
  const size_t nth = (size_t)gridDim.x * NTHREADS;
  const float* su = p.peer_u + (size_t)l * 16384 * 1024;
  const float* sv = p.peer_v + (size_t)l * 16384 * 1024;
  unsigned char* dst = (unsigned char*)p.TB();
  size_t c = (size_t)blockIdx.x * NTHREADS + tid;
  for (; c + 3 * nth < 2 * nch; c += 4 * nth) {
    float4 f[4][4];
#pragma unroll
    for (int q = 0; q < 4; ++q) {
      const size_t cq = c + q * nth;
      const float* src = cq < nch ? su + cq * 16 : sv + (cq - nch) * 16;
#pragma unroll
      for (int j = 0; j < 4; ++j) f[q][j] = *(const float4*)(src + 4 * j);
    }
#pragma unroll
    for (int q = 0; q < 4; ++q) {
      const size_t cq = c + q * nth;
      const float sc = cq < nch ? U8_SCALE : V8_SCALE;
      unsigned w[4];
#pragma unroll
      for (int j = 0; j < 4; ++j) {
        w[j] = __builtin_amdgcn_cvt_pk_fp8_f32(f[q][j].x * sc, f[q][j].y * sc, 0, false);
        w[j] = __builtin_amdgcn_cvt_pk_fp8_f32(f[q][j].z * sc, f[q][j].w * sc, w[j], true);
      }
      *(uint4*)(dst + cq * 16) = make_uint4(w[0], w[1], w[2], w[3]);
    }
  }
  for (; c < 2 * nch; c += nth) {
    const bool isu = c < nch;
    const float* src = isu ? su + c * 16 : sv + (c - nch) * 16;
    const float sc = isu ? U8_SCALE : V8_SCALE;
    const float4 f0 = *(const float4*)src, f1 = *(const float4*)(src + 4), f2 = *(const float4*)(src + 8), f3 = *(const float4*)(src + 12);
    uint4 v;
    v.x = __builtin_amdgcn_cvt_pk_fp8_f32(f0.x * sc, f0.y * sc, 0, false); v.x = __builtin_amdgcn_cvt_pk_fp8_f32(f0.z * sc, f0.w * sc, v.x, true);
    v.y = __builtin_amdgcn_cvt_pk_fp8_f32(f1.x * sc, f1.y * sc, 0, false); v.y = __builtin_amdgcn_cvt_pk_fp8_f32(f1.z * sc, f1.w * sc, v.y, true);
    v.z = __builtin_amdgcn_cvt_pk_fp8_f32(f2.x * sc, f2.y * sc, 0, false); v.z = __builtin_amdgcn_cvt_pk_fp8_f32(f2.z * sc, f2.w * sc, v.z, true);
    v.w = __builtin_amdgcn_cvt_pk_fp8_f32(f3.x * sc, f3.y * sc, 0, false); v.w = __builtin_amdgcn_cvt_pk_fp8_f32(f3.z * sc, f3.w * sc, v.w, true);
    *(uint4*)(dst + c * 16) = v;
  }
}

typedef unsigned long long u64;
__device__ __forceinline__ unsigned f2ord(float f) { unsigned u = __float_as_uint(f); return u ^ ((u >> 31) ? 0xffffffffu : 0x80000000u); }
__device__ __forceinline__ float ord2f(unsigned u) { return __uint_as_float(u ^ ((u >> 31) ? 0x80000000u : 0xffffffffu)); }
__device__ const unsigned char PEER_CAND[56] = {
  0x00,0x01,0x02,0x03,0x04,0x05,0x06,0x07,0x08,0x09,0x0a,0x0b,0x0c,0x0d,0x0e,0x0f,
  0x10,0x11,0x12,0x13,0x14,0x15,0x16,0x17,
  0x20,0x21,0x22,0x23,0x24,
  0x30,0x31,0x32,0x33,
  0x40,0x41,0x42,
  0x50,0x51, 0x60,0x61, 0x70,0x71,
  0x80,0x90,0xa0,0xb0,0xc0,0xd0,0xe0,0xf0,
  0xff,0xff,0xff,0xff,0xff,0xff};

template <int N>
__device__ __forceinline__ void sort_desc(unsigned (&a)[N]) {
#pragma unroll
  for (int k = 2; k <= N; k <<= 1) {
#pragma unroll
    for (int j = k >> 1; j > 0; j >>= 1) {
#pragma unroll
      for (int i = 0; i < N; ++i) {
        const int m = i ^ j;
        if (m > i) {
          const unsigned x = a[i], y = a[m];
          const unsigned hi = x > y ? x : y, lo = x > y ? y : x;
          if ((i & k) == 0) { a[i] = hi; a[m] = lo; } else { a[i] = lo; a[m] = hi; }
        }
      }
    }
  }
}
template <int CTRL> __device__ __forceinline__ unsigned dpp_mov_u(unsigned x) {
  return (unsigned)__builtin_amdgcn_update_dpp(0, (int)x, CTRL, 0xf, 0xf, true);
}
__device__ __forceinline__ unsigned group8_max(unsigned v) {
  unsigned o = dpp_mov_u<0xB1>(v); v = o > v ? o : v;
  o = dpp_mov_u<0x4E>(v); v = o > v ? o : v;
  o = dpp_mov_u<0x141>(v); v = o > v ? o : v;
  return v;
}

__device__ __forceinline__ void select_load_keys(const Params& p, int l, int h, char* Ks, int tid) {
#pragma unroll
  for (int ph = 0; ph < 2; ++ph) {
    const float* kbase = p.peer_keys + ((size_t)(l * 8 + h) * 2 + ph) * 128 * 128;
#pragma unroll
    for (int i = 0; i < 4; ++i) {
      const int c = tid + i * NTHREADS, row = c >> 4, kc = c & 15;
      const float4 a = *(const float4*)(kbase + row * 128 + kc * 8), b = *(const float4*)(kbase + row * 128 + kc * 8 + 4);
      uint4 v;
      v.x = pk_bf16(a.x, a.y); v.y = pk_bf16(a.z, a.w); v.z = pk_bf16(b.x, b.y); v.w = pk_bf16(b.z, b.w);
      *(uint4*)(Ks + ph * 32768 + row * 256 + ((kc ^ (row & 15)) << 4)) = v;
    }
  }
}
#define SEL_BAR() { asm volatile("s_waitcnt lgkmcnt(0)" ::: "memory"); __builtin_amdgcn_s_barrier(); asm volatile("" ::: "memory"); }
__device__ __forceinline__ void select_qload(const Params& p, int tb, int h, int ph, int tid, uint4& q0, uint4& q1) {
  const bf16_t* Qg = peerQ(p);
  { const int c = tid, row = c >> 4, kc = c & 15; q0 = *(const uint4*)(Qg + (size_t)(tb * 64 + row) * 2048 + h * 256 + ph * 128 + kc * 8); }
  { const int c = tid + NTHREADS, row = c >> 4, kc = c & 15; q1 = *(const uint4*)(Qg + (size_t)(tb * 64 + row) * 2048 + h * 256 + ph * 128 + kc * 8); }
}
__device__ __forceinline__ void select_tile(const Params& p, int tb, int tbn, int h, char* smem, int tid, uint4& q0, uint4& q1) {
  const int tok0 = tb * 64;
  char* Ks = smem;
  char* Qs = smem + 65536;
  float* Sc = (float*)(smem + 81920);
  unsigned* tops = (unsigned*)(smem + 115712);
  const int lane = tid & 63, w = tid >> 6, l15 = lane & 15, lq = lane >> 4;
  const int tok = tid >> 3, g = tid & 7;
#pragma unroll
  for (int ph = 0; ph < 2; ++ph) {
    { const int c = tid, row = c >> 4, kc = c & 15; *(uint4*)(Qs + row * 256 + ((kc ^ (row & 15)) << 4)) = q0; }
    { const int c = tid + NTHREADS, row = c >> 4, kc = c & 15; *(uint4*)(Qs + row * 256 + ((kc ^ (row & 15)) << 4)) = q1; }
    if (ph == 0) select_qload(p, tb, h, 1, tid, q0, q1); else select_qload(p, tbn, h, 0, tid, q0, q1);
    SEL_BAR();
    {
      f32x4 acc[4];
#pragma unroll
      for (int j = 0; j < 4; ++j) acc[j] = f32x4{0.f, 0.f, 0.f, 0.f};
#pragma unroll
      for (int ks = 0; ks < 4; ++ks) {
        const int koff = ((ks * 4 + lq) ^ l15) << 4;
        bf16x8 af = *(const bf16x8*)(Ks + ph * 32768 + (16 * w + l15) * 256 + koff);
#pragma unroll
        for (int j = 0; j < 4; ++j) {
          bf16x8 bfr = *(const bf16x8*)(Qs + (16 * j + l15) * 256 + koff);
          acc[j] = __builtin_amdgcn_mfma_f32_16x16x32_bf16(af, bfr, acc[j], 0, 0, 0);
        }
      }
#pragma unroll
      for (int j = 0; j < 4; ++j)
        *(float4*)(Sc + (16 * j + l15) * 132 + 16 * w + lq * 4) = make_float4(acc[j][0], acc[j][1], acc[j][2], acc[j][3]);
    }
    SEL_BAR();
    {
      unsigned lst[16];
      const float* sr = Sc + tok * 132 + g * 16;
#pragma unroll
      for (int q4 = 0; q4 < 4; ++q4) {
        float4 v = *(const float4*)(sr + q4 * 4);
        const unsigned base = 127u - (unsigned)(g * 16 + q4 * 4);
        lst[q4 * 4 + 0] = (f2ord(v.x) & ~127u) | (base);
        lst[q4 * 4 + 1] = (f2ord(v.y) & ~127u) | (base - 1);
        lst[q4 * 4 + 2] = (f2ord(v.z) & ~127u) | (base - 2);
        lst[q4 * 4 + 3] = (f2ord(v.w) & ~127u) | (base - 3);
      }
      sort_desc<16>(lst);
      unsigned* tp = tops + (tok * 2 + ph) * 16;
#pragma unroll
      for (int it = 0; it < 16; ++it) {
        const unsigned mx = group8_max(lst[0]);
        const bool own = lst[0] == mx;
#pragma unroll
        for (int k = 0; k < 15; ++k) lst[k] = own ? lst[k + 1] : lst[k];
        lst[15] = own ? 0u : lst[15];
        if (g == 0) tp[it] = mx;
      }
    }
  }
  SEL_BAR();
  {
    const unsigned* t0 = tops + (tok * 2) * 16;
    const unsigned* t1 = t0 + 16;
    unsigned lst[8];
#pragma unroll
    for (int s_ = 0; s_ < 7; ++s_) {
      const unsigned c = PEER_CAND[g + 8 * s_];
      unsigned key = 0u;
      if (c != 0xff) {
        const float sc = ord2f(t0[c >> 4] & ~127u) + ord2f(t1[c & 15] & ~127u);
        key = (f2ord(sc) & ~63u) | (63u - (unsigned)(g + 8 * s_));
      }
      lst[s_] = key;
    }
    lst[7] = 0u;
    sort_desc<8>(lst);
    float bs[16]; unsigned bc[16];
#pragma unroll
    for (int it = 0; it < 16; ++it) {
      const unsigned mx = group8_max(lst[0]);
      const bool own = lst[0] == mx;
#pragma unroll
      for (int k = 0; k < 7; ++k) lst[k] = own ? lst[k + 1] : lst[k];
      lst[7] = own ? 0u : lst[7];
      bs[it] = ord2f(mx & ~63u);
      bc[it] = 63u - (mx & 63u);
    }
    const float mx0 = bs[0];
    float sum = 0.f;
#pragma unroll
    for (int it = 0; it < 16; ++it) { bs[it] = FEXP(bs[it] - mx0); sum += bs[it]; }
    const float inv = 1.0f / sum;
    int* oi = sel2i(p) + ((size_t)(tok0 + tok) * 8 + h) * 16;
    float* og = sel2g(p) + ((size_t)(tok0 + tok) * 8 + h) * 16;
#pragma unroll
    for (int it = 0; it < 16; ++it) {
      if ((it & 7) == g) {
        const unsigned c = PEER_CAND[bc[it]];
        const unsigned i0 = 127u - (t0[c >> 4] & 127u), i1 = 127u - (t1[c & 15] & 127u);
        oi[it] = (int)(i0 * 128 + i1);
        og[it] = bs[it] * inv;
      }
    }
  }
  SEL_BAR();
}

__device__ __forceinline__ void select_phase(const Params& p, int l, int nr, char* smem, int wave_s) {
  const int ntb = nr / 64, nb = gridDim.x;
  int cur_h = -1;
  if (nb % 8 == 0) {
    const int bph = nb / 8, h = blockIdx.x / bph;
    uint4 q0, q1;
    {
      const int tid = make_tid(wave_s);
      select_qload(p, min((int)(blockIdx.x % bph), ntb - 1), h, 0, tid, q0, q1);
    }
    for (int tb = blockIdx.x % bph; tb < ntb; tb += bph) {
      const int tid = make_tid(wave_s);
      if (cur_h != h) { select_load_keys(p, l, h, smem, tid); cur_h = h; }
      select_tile(p, tb, min(tb + bph, ntb - 1), h, smem, tid, q0, q1);
    }
  } else {
    for (int t = blockIdx.x; t < ntb * 8; t += nb) {
      const int tid = make_tid(wave_s);
      const int h = t & 7;
      __syncthreads();
      select_load_keys(p, l, h, smem, tid);
      uint4 q0, q1;
      select_qload(p, t >> 3, h, 0, tid, q0, q1);
      select_tile(p, t >> 3, t >> 3, h, smem, tid, q0, q1);
    }
  }
}

__device__ __forceinline__ float dot16_fp8(const float (&x)[16], uint4 u, float acc) {
  f32x2v t;
  t = __builtin_amdgcn_cvt_pk_f32_fp8(u.x, false); acc += x[0] * t[0]; acc += x[1] * t[1];
  t = __builtin_amdgcn_cvt_pk_f32_fp8(u.x, true);  acc += x[2] * t[0]; acc += x[3] * t[1];
  t = __builtin_amdgcn_cvt_pk_f32_fp8(u.y, false); acc += x[4] * t[0]; acc += x[5] * t[1];
  t = __builtin_amdgcn_cvt_pk_f32_fp8(u.y, true);  acc += x[6] * t[0]; acc += x[7] * t[1];
  t = __builtin_amdgcn_cvt_pk_f32_fp8(u.z, false); acc += x[8] * t[0]; acc += x[9] * t[1];
  t = __builtin_amdgcn_cvt_pk_f32_fp8(u.z, true);  acc += x[10] * t[0]; acc += x[11] * t[1];
  t = __builtin_amdgcn_cvt_pk_f32_fp8(u.w, false); acc += x[12] * t[0]; acc += x[13] * t[1];
  t = __builtin_amdgcn_cvt_pk_f32_fp8(u.w, true);  acc += x[14] * t[0]; acc += x[15] * t[1];
  return acc;
}
__device__ __forceinline__ void axpy16_fp8(float c, uint4 v, float (&acc)[16]) {
  f32x2v t;
  t = __builtin_amdgcn_cvt_pk_f32_fp8(v.x, false); acc[0] += c * t[0]; acc[1] += c * t[1];
  t = __builtin_amdgcn_cvt_pk_f32_fp8(v.x, true);  acc[2] += c * t[0]; acc[3] += c * t[1];
  t = __builtin_amdgcn_cvt_pk_f32_fp8(v.y, false); acc[4] += c * t[0]; acc[5] += c * t[1];
  t = __builtin_amdgcn_cvt_pk_f32_fp8(v.y, true);  acc[6] += c * t[0]; acc[7] += c * t[1];
  t = __builtin_amdgcn_cvt_pk_f32_fp8(v.z, false); acc[8] += c * t[0]; acc[9] += c * t[1];
  t = __builtin_amdgcn_cvt_pk_f32_fp8(v.z, true);  acc[10] += c * t[0]; acc[11] += c * t[1];
  t = __builtin_amdgcn_cvt_pk_f32_fp8(v.w, false); acc[12] += c * t[0]; acc[13] += c * t[1];
  t = __builtin_amdgcn_cvt_pk_f32_fp8(v.w, true);  acc[14] += c * t[0]; acc[15] += c * t[1];
}
__device__ __forceinline__ f32x2v fma2(f32x2v a, f32x2v b, f32x2v c) { return __builtin_elementwise_fma(a, b, c); }
__device__ __forceinline__ float dot16p_fp8(const f32x2v (&x)[8], uint4 u) {
  f32x2v a = x[0] * __builtin_amdgcn_cvt_pk_f32_fp8(u.x, false);
  a = fma2(x[1], __builtin_amdgcn_cvt_pk_f32_fp8(u.x, true), a);
  a = fma2(x[2], __builtin_amdgcn_cvt_pk_f32_fp8(u.y, false), a);
  a = fma2(x[3], __builtin_amdgcn_cvt_pk_f32_fp8(u.y, true), a);
  a = fma2(x[4], __builtin_amdgcn_cvt_pk_f32_fp8(u.z, false), a);
  a = fma2(x[5], __builtin_amdgcn_cvt_pk_f32_fp8(u.z, true), a);
  a = fma2(x[6], __builtin_amdgcn_cvt_pk_f32_fp8(u.w, false), a);
  a = fma2(x[7], __builtin_amdgcn_cvt_pk_f32_fp8(u.w, true), a);
  return a[0] + a[1];
}
__device__ __forceinline__ void axpy16p_fp8(float c, uint4 v, f32x2v (&acc)[8]) {
  const f32x2v c2 = {c, c};
  acc[0] = fma2(c2, __builtin_amdgcn_cvt_pk_f32_fp8(v.x, false), acc[0]);
  acc[1] = fma2(c2, __builtin_amdgcn_cvt_pk_f32_fp8(v.x, true), acc[1]);
  acc[2] = fma2(c2, __builtin_amdgcn_cvt_pk_f32_fp8(v.y, false), acc[2]);
  acc[3] = fma2(c2, __builtin_amdgcn_cvt_pk_f32_fp8(v.y, true), acc[3]);
  acc[4] = fma2(c2, __builtin_amdgcn_cvt_pk_f32_fp8(v.z, false), acc[4]);
  acc[5] = fma2(c2, __builtin_amdgcn_cvt_pk_f32_fp8(v.z, true), acc[5]);
  acc[6] = fma2(c2, __builtin_amdgcn_cvt_pk_f32_fp8(v.w, false), acc[6]);
  acc[7] = fma2(c2, __builtin_amdgcn_cvt_pk_f32_fp8(v.w, true), acc[7]);
}
__device__ __forceinline__ f32x2v bf2_to_f2(unsigned w) {
  f32x2v r; r[0] = __builtin_bit_cast(float, w << 16); r[1] = __builtin_bit_cast(float, w & 0xffff0000u); return r;
}
typedef __attribute__((ext_vector_type(4))) float f32x4u;
typedef __attribute__((ext_vector_type(2))) long i64x2u;
struct UPre { int idxA, idxB; float gA, gB; i64x2u xh; };
__device__ __forceinline__ void u_load_pre(const Params& p, int row, int lane, UPre& P) {
  P.idxA = sel2i(p)[(size_t)row * 128 + lane]; P.idxB = sel2i(p)[(size_t)row * 128 + 64 + lane];
  P.gA = sel2g(p)[(size_t)row * 128 + lane]; P.gB = sel2g(p)[(size_t)row * 128 + 64 + lane];
  P.xh = *(const i64x2u*)(xqbuf(p) + (size_t)row * 1024 + lane * 16);
}
__device__ __forceinline__ float trace_dot(i64x2u u, i64x2u xh, bool b0, bool b1, bool ondiag) {
  const f32x4u z = {0.f, 0.f, 0.f, 0.f};
  f32x4u a0 = __builtin_amdgcn_mfma_f32_16x16x32_fp8_fp8(u[0], xh[0], z, 0, 0, 0);
  a0 = __builtin_amdgcn_mfma_f32_16x16x32_fp8_fp8(u[1], xh[1], a0, 0, 0, 0);
  const float t01 = b0 ? a0[1] : a0[0], t23 = b0 ? a0[3] : a0[2];
  const float t = b1 ? t23 : t01;
  return ondiag ? t : 0.f;
}
__device__ __forceinline__ float gelu_as(float x) {
  const float z = fabsf(x) * 0.70710678118654752f;
  const float t = __builtin_amdgcn_rcpf(fmaf(0.3275911f, z, 1.0f));
  float q = fmaf(1.061405429f, t, -1.453152027f);
  q = fmaf(q, t, 1.421413741f); q = fmaf(q, t, -0.284496736f); q = fmaf(q, t, 0.254829592f);
  const float e = 1.0f - q * t * __builtin_amdgcn_exp2f(-1.4426950408889634f * z * z);
  return 0.5f * x * (1.0f + copysignf(e, x));
}
__device__ __forceinline__ void u_gather(const unsigned char* TBu, const int2* L, int lane, int b0, int cnt, i64x2u (&ub)[16]) {
  const int2 ent = L[min(b0 + (lane & 15), max(cnt - 1, 0))];
#pragma unroll
  for (int qd = 0; qd < 4; ++qd) {
    if (qd == 0 || b0 + 4 * qd < cnt) {
#pragma unroll
      for (int e = 4 * qd; e < 4 * qd + 4; ++e) {
        const int ie = __builtin_amdgcn_readlane(ent.x, e) & 0x3fff;
        ub[e] = *(const i64x2u*)(TBu + (size_t)ie * 1024 + lane * 16);
      }
    }
  }
}
__device__ __forceinline__ void u_dots(const int2* L, int lane, int b0, int cnt, const i64x2u (&ub)[16], i64x2u xh, float* cfr) {
  const bool db0 = lane & 1, db1 = lane & 2, ondiag = ((lane >> 2) & 3) == (lane >> 4);
  float d[16];
#pragma unroll
  for (int qd = 0; qd < 4; ++qd) {
    if (qd == 0 || b0 + 4 * qd < cnt) {
#pragma unroll
      for (int e = 4 * qd; e < 4 * qd + 4; ++e) d[e] = trace_dot(ub[e], xh, db0, db1, ondiag);
    } else {
#pragma unroll
      for (int e = 4 * qd; e < 4 * qd + 4; ++e) d[e] = 0.f;
    }
  }
  float r8[8], r4[4], r2[2], r1;
  {
    const bool up = lane & 32;
#pragma unroll
    for (int i = 0; i < 8; ++i) { float snd = up ? d[i] : d[i + 8]; float kp = up ? d[i + 8] : d[i]; r8[i] = kp + __shfl_xor(snd, 32); }
  }
  {
    const bool up = lane & 16;
#pragma unroll
    for (int i = 0; i < 4; ++i) { float snd = up ? r8[i] : r8[i + 4]; float kp = up ? r8[i + 4] : r8[i]; r4[i] = kp + __shfl_xor(snd, 16); }
  }
  {
    const bool up = lane & 8;
#pragma unroll
    for (int i = 0; i < 2; ++i) { float snd = up ? r4[i] : r4[i + 2]; float kp = up ? r4[i + 2] : r4[i]; r2[i] = kp + __shfl_xor(snd, 8); }
  }
  {
    const bool up = lane & 4;
    float snd = up ? r2[0] : r2[1]; float kp = up ? r2[1] : r2[0];
    r1 = kp + __shfl_xor(snd, 4);
  }
  r1 += dppx<0xB1>(r1);
  r1 += dppx<0x4E>(r1);
  r1 *= (1.0f / (U8_SCALE * XQ_SCALE));
  const int my_e = ((lane & 32) ? 8 : 0) + ((lane & 16) ? 4 : 0) + ((lane & 8) ? 2 : 0) + ((lane & 4) ? 1 : 0);
  const int pos = b0 + my_e;
  const int2 e2 = L[min(pos, max(cnt - 1, 0))];
  const float coef = __builtin_bit_cast(float, e2.y) * gelu_as(r1) * (1.0f / V8_SCALE);
  if (pos < cnt && (lane & 3) == 0) cfr[e2.x >> 16] = coef;
}
__device__ __forceinline__ int u_compact(const UPre& P, int2* L, int lane, int part) {
  const int idxA = P.idxA, idxB = P.idxB; const float gA = P.gA, gB = P.gB;
  const bool mA = (idxA >> 11) == part, mB = (idxB >> 11) == part;
  const unsigned long long maskA = __ballot(mA), maskB = __ballot(mB);
  const int cntA = __popcll(maskA), cnt = cntA + __popcll(maskB);
  const int rnkA = (int)__builtin_amdgcn_mbcnt_hi((unsigned)(maskA >> 32), __builtin_amdgcn_mbcnt_lo((unsigned)maskA, 0u));
  const int rnkB = cntA + (int)__builtin_amdgcn_mbcnt_hi((unsigned)(maskB >> 32), __builtin_amdgcn_mbcnt_lo((unsigned)maskB, 0u));
  if (mA) L[rnkA] = make_int2(idxA | (lane << 16), __builtin_bit_cast(int, gA));
  if (mB) L[rnkB] = make_int2(idxB | ((lane + 64) << 16), __builtin_bit_cast(int, gB));
  return cnt;
}
__device__ __forceinline__ void u_pair(const Params& p, const unsigned char* TBu, char* W, int lane, int unA, int unB, int total,
                                       int sh, bool even, int prowA_next, int prowB_next, UPre& PA, UPre& PB) {
  int2* LA = (int2*)W; int2* LB = (int2*)(W + 1024);
  const int cntA = u_compact(PA, LA, lane, even ? (int)(blockIdx.x & 7) : (unA & 7));
  const int cntB = (unB < total) ? u_compact(PB, LB, lane, even ? (int)(blockIdx.x & 7) : (unB & 7)) : 0;
  const i64x2u xhA = PA.xh, xhB = PB.xh;
  float* cfA = coefb(p) + (size_t)(unA >> sh) * 128;
  float* cfB = coefb(p) + (size_t)(min(unB, total - 1) >> sh) * 128;
  i64x2u ubA[16], ubB[16];
  for (int b0 = ((cntA - 1) >> 4) << 4; b0 >= 32; b0 -= 16) { u_gather(TBu, LA, lane, b0, cntA, ubA); u_dots(LA, lane, b0, cntA, ubA, xhA, cfA); }
  for (int b0 = ((cntB - 1) >> 4) << 4; b0 >= 32; b0 -= 16) { u_gather(TBu, LB, lane, b0, cntB, ubB); u_dots(LB, lane, b0, cntB, ubB, xhB, cfB); }
  if (cntA > 16 || cntB > 16) {
    if (cntA > 16) u_gather(TBu, LA, lane, 16, cntA, ubA);
    if (cntB > 16) u_gather(TBu, LB, lane, 16, cntB, ubB);
    __builtin_amdgcn_sched_barrier(0);
    if (cntA > 16) u_dots(LA, lane, 16, cntA, ubA, xhA, cfA);
    if (cntB > 16) u_dots(LB, lane, 16, cntB, ubB, xhB, cfB);
  }
  u_gather(TBu, LA, lane, 0, cntA, ubA);
  u_gather(TBu, LB, lane, 0, cntB, ubB);
  __builtin_amdgcn_sched_barrier(0);
  u_load_pre(p, prowA_next, lane, PA);
  u_load_pre(p, prowB_next, lane, PB);
  __builtin_amdgcn_sched_barrier(0);
  u_dots(LA, lane, 0, cntA, ubA, xhA, cfA);
  u_dots(LB, lane, 0, cntB, ubB, xhB, cfB);
}
__device__ __forceinline__ void expert_u_phase(const Params& p, int l, int nr, int wave_s, char* smem) {
  const unsigned char* TBu = (const unsigned char*)p.TB();
  char* W = smem + wave_s * 2048;
  const int nb = gridDim.x;
  const bool even = (nb & 7) == 0;
  const int sh = even ? 0 : 3;
  const int total = nr << sh;
  const int stride = (even ? (nb >> 3) : nb) * 8;
  int un = (even ? (int)(blockIdx.x >> 3) : (int)blockIdx.x) * 8 + wave_s;
  UPre P0, P1, P2, P3;
  {
    const int lane = make_tid(wave_s) & 63;
    u_load_pre(p, min(un, total - 1) >> sh, lane, P0);
    u_load_pre(p, min(un + stride, total - 1) >> sh, lane, P1);
    u_load_pre(p, min(un + 2 * stride, total - 1) >> sh, lane, P2);
    u_load_pre(p, min(un + 3 * stride, total - 1) >> sh, lane, P3);
  }
  while (un < total) {
    {
      const int lane = make_tid(wave_s) & 63;
      u_pair(p, TBu, W, lane, un, un + stride, total, sh, even,
             min(un + 4 * stride, total - 1) >> sh, min(un + 5 * stride, total - 1) >> sh, P0, P1);
    }
    un += 2 * stride;
    if (un >= total) break;
    {
      const int lane = make_tid(wave_s) & 63;
      u_pair(p, TBu, W, lane, un, un + stride, total, sh, even,
             min(un + 4 * stride, total - 1) >> sh, min(un + 5 * stride, total - 1) >> sh, P2, P3);
    }
    un += 2 * stride;
  }
}

#define VLOAD(buf_, idxv_, base_) _Pragma("unroll") for (int e = 0; e < 16; ++e) { \
    const int ie = __builtin_amdgcn_readlane(idxv_, (base_) + e); buf_[e] = *(const uint4*)(TBv + (size_t)ie * 1024 + lane * 16); }
#define VAXPY(buf_, cfv_, base_) _Pragma("unroll") for (int e = 0; e < 16; ++e) { \
    const float c = __builtin_bit_cast(float, __builtin_amdgcn_readlane(__builtin_bit_cast(int, cfv_), (base_) + e)); axpy16p_fp8(c, buf_[e], acc2); }
__device__ __forceinline__ void expert_phase(const Params& p, int l, int nr, int wave_s) {
  const unsigned char* TBv = (const unsigned char*)p.TB() + (size_t)16384 * 1024;
  for (int row = blockIdx.x * 8 + wave_s; row < nr; row += gridDim.x * 8) {
    const int lane = make_tid(wave_s) & 63;
    const int* idxr = sel2i(p) + (size_t)row * 128;
    const float* cfr = coefb(p) + (size_t)row * 128;
    const int iA = idxr[lane], iB = idxr[64 + lane];
    const float cA = cfr[lane], cB = cfr[64 + lane];
    f32x2v acc2[8];
#pragma unroll
    for (int i = 0; i < 8; ++i) { acc2[i][0] = 0.f; acc2[i][1] = 0.f; }
    uint4 va[16], vb[16];
    VLOAD(va, iA, 0)
    VLOAD(vb, iA, 16) LOAD_FENCE(); VAXPY(va, cA, 0)
    VLOAD(va, iA, 32) LOAD_FENCE(); VAXPY(vb, cA, 16)
    VLOAD(vb, iA, 48) LOAD_FENCE(); VAXPY(va, cA, 32)
    VLOAD(va, iB, 0)  LOAD_FENCE(); VAXPY(vb, cA, 48)
    VLOAD(vb, iB, 16) LOAD_FENCE(); VAXPY(va, cB, 0)
    VLOAD(va, iB, 32) LOAD_FENCE(); VAXPY(vb, cB, 16)
    VLOAD(vb, iB, 48) LOAD_FENCE(); VAXPY(va, cB, 32)
    LOAD_FENCE(); VAXPY(vb, cB, 48)
    float acc[16];
#pragma unroll
    for (int i = 0; i < 8; ++i) { acc[2 * i] = acc2[i][0]; acc[2 * i + 1] = acc2[i][1]; }
    const float* m = p.mod() + ((size_t)l * NMODV + modv_of_row(row)) * 6144;
    float hx[16], g[16], bb[16];
    float* hd = hdst_row(p, row);
    ldrow16_f32(hd, lane, hx);
    ldrow16_f32(m + 5120, lane, g);
#pragma unroll
    for (int i = 0; i < 16; ++i) { asm volatile("" : "+v"(acc[i])); hx[i] = fmaf(g[i], acc[i], DN_ALPHA * hx[i]); }
    float mean, rstd;
    row_ln_stats(hx, mean, rstd);
    ldrow16_f32(p.ln_ffn_g + l * DM, lane, g); ldrow16_f32(p.ln_ffn_b + l * DM, lane, bb);
#pragma unroll
    for (int i = 0; i < 16; ++i) hx[i] = (hx[i] - mean) * rstd * g[i] + bb[i];
    strow16_f32(hd, lane, hx);
    if (l == 0) {
      const float* m1 = p.mod() + ((size_t)1 * NMODV + modv_of_row(row)) * 6144;
      row_ln_stats(hx, mean, rstd);
      ldrow16_f32(m1 + 1024, lane, g); ldrow16_f32(m1, lane, bb);
#pragma unroll
      for (int i = 0; i < 16; ++i) hx[i] = (hx[i] - mean) * rstd * (1.0f + g[i]) + bb[i];
      strow16_bf16(p.Y() + (size_t)row * DM, lane, hx);
    }
  }
}

__device__ __forceinline__ float reduce32(float x) {
  x += dppx<0xB1>(x);
  x += dppx<0x4E>(x);
  x += dppx<0x141>(x);
  x += dppx<0x140>(x);
  float a = x, b = x;
  asm volatile("s_nop 1\n\tv_permlane16_swap_b32 %0, %1" : "+v"(a), "+v"(b));
  return a + b;
}

__device__ __forceinline__ float reduce16(float x) {
  x += dppx<0xB1>(x);
  x += dppx<0x4E>(x);
  x += dppx<0x141>(x);
  x += dppx<0x140>(x);
  return x;
}

__device__ __forceinline__ float wsum(float x) {
  x = reduce16(x);
  float a = x, b = x;
  asm volatile("s_nop 1\n\tv_permlane16_swap_b32 %0, %1" : "+v"(a), "+v"(b));
  x = a + b; a = x; b = x;
  asm volatile("s_nop 1\n\tv_permlane32_swap_b32 %0, %1" : "+v"(a), "+v"(b));
  return a + b;
}

__device__ __forceinline__ void fast_rwprep(const Params& p, int l, char* smem, int wave_s) {
  int tid = make_tid(wave_s);
  float* Cv = (float*)smem;
  const float* mu = p.rwkv_mu + (size_t)l * 2 * 1152;
  const int c = tid & 255, tg = tid >> 8, lane = tid & 63, h = c >> 6;
  for (int tile = blockIdx.x; tile < NTOK / 16; tile += gridDim.x) {
    const int r0 = tile * 16;
#pragma unroll
    for (int q = 0; q < 5; ++q) {
      const int idx = tid + q * NTHREADS;
      if (idx < 16 * 144) {
        const int tk = idx / 144, ch = idx - tk * 144, col = ch * 8;
        const int row = r0 + tk;
        int t, len; seq_pos(row, t, len);
        const bf16_t* src = p.P() + (size_t)row * INC + OFF_B + col;
        const uint4 zero4 = make_uint4(0u, 0u, 0u, 0u);
        const uint4 cu = *(const uint4*)src;
        const uint4 pu = t > 0 ? *(const uint4*)(src - INC) : zero4;
        const uint4 nu = t < len - 1 ? *(const uint4*)(src + INC) : zero4;
        float xc[8], xp[8], xn[8], m0[8], m1[8];
        unpack8(cu, xc); unpack8(pu, xp); unpack8(nu, xn);
        *(float4*)m0 = *(const float4*)(mu + col); *(float4*)(m0 + 4) = *(const float4*)(mu + col + 4);
        *(float4*)m1 = *(const float4*)(mu + 1152 + col); *(float4*)(m1 + 4) = *(const float4*)(mu + 1152 + col + 4);
        float o[8];
#pragma unroll
        for (int e = 0; e < 8; ++e) {
          float v = xc[e] * (1.0f - m0[e] - m1[e]) + xp[e] * m0[e] + xn[e] * m1[e];
          if (col >= 768 && col < 896) v = tanhf_(v);
          else if (col >= 1024) v = sigmoidf_(v);
          o[e] = v;
        }
        *(float4*)(Cv + tk * 1152 + col) = make_float4(o[0], o[1], o[2], o[3]);
        *(float4*)(Cv + tk * 1152 + col + 4) = make_float4(o[4], o[5], o[6], o[7]);
      }
    }
    __syncthreads();
    float aw0[8], aw1[8], aa0[8], aa1[8], ag[8];
#pragma unroll
    for (int t = 0; t < 8; ++t) { aw0[t] = 0.f; aw1[t] = 0.f; aa0[t] = 0.f; aa1[t] = 0.f; ag[t] = 0.f; }
    const float* cvb = Cv + (tg * 8) * 1152;
    const float* w2a = p.rwkv_w2 + (size_t)(l * 2 + 0) * 64 * 256 + c;
    const float* w2b = p.rwkv_w2 + (size_t)(l * 2 + 1) * 64 * 256 + c;
    const float* a2a = p.rwkv_a2 + (size_t)(l * 2 + 0) * 64 * 256 + c;
    const float* a2b = p.rwkv_a2 + (size_t)(l * 2 + 1) * 64 * 256 + c;
    const float* g2p = p.rwkv_g2 + (size_t)l * 128 * 256 + c;
    for (int rr = 0; rr < 64; rr += 4) {
      float wa[4], wb[4], xa[4], xb[4];
#pragma unroll
      for (int q = 0; q < 4; ++q) { wa[q] = w2a[(rr + q) * 256]; wb[q] = w2b[(rr + q) * 256]; xa[q] = a2a[(rr + q) * 256]; xb[q] = a2b[(rr + q) * 256]; }
#pragma unroll
      for (int t = 0; t < 8; ++t) {
        float4 d0 = *(const float4*)(cvb + t * 1152 + 768 + rr), d1 = *(const float4*)(cvb + t * 1152 + 832 + rr);
        float4 e0 = *(const float4*)(cvb + t * 1152 + 896 + rr), e1 = *(const float4*)(cvb + t * 1152 + 960 + rr);
        aw0[t] += d0.x * wa[0] + d0.y * wa[1] + d0.z * wa[2] + d0.w * wa[3];
        aw1[t] += d1.x * wb[0] + d1.y * wb[1] + d1.z * wb[2] + d1.w * wb[3];
        aa0[t] += e0.x * xa[0] + e0.y * xa[1] + e0.z * xa[2] + e0.w * xa[3];
        aa1[t] += e1.x * xb[0] + e1.y * xb[1] + e1.z * xb[2] + e1.w * xb[3];
      }
    }
    for (int rr = 0; rr < 128; rr += 4) {
      float gg[4];
#pragma unroll
      for (int q = 0; q < 4; ++q) gg[q] = g2p[(rr + q) * 256];
#pragma unroll
      for (int t = 0; t < 8; ++t) {
        float4 d0 = *(const float4*)(cvb + t * 1152 + 1024 + rr);
        ag[t] += d0.x * gg[0] + d0.y * gg[1] + d0.z * gg[2] + d0.w * gg[3];
      }
    }
    const float w00 = p.rwkv_w0[(l * 2 + 0) * 256 + c], w01 = p.rwkv_w0[(l * 2 + 1) * 256 + c];
    const float a00 = p.rwkv_a0[(l * 2 + 0) * 256 + c], a01 = p.rwkv_a0[(l * 2 + 1) * 256 + c];
    const float kkc = p.rwkv_kk[l * 256 + c], kac = p.rwkv_ka[l * 256 + c], rkc = p.rwkv_rk[l * 256 + c];
#pragma unroll
    for (int t = 0; t < 8; ++t) {
      const int row = r0 + tg * 8 + t;
      const float r = cvb[t * 1152 + c], k = cvb[t * 1152 + 256 + c], v = cvb[t * 1152 + 512 + c];
      const float wd0 = FEXP(-sigmoidf_(w00 + aw0[t]) * 0.6065306597126334f);
      const float wd1 = FEXP(-sigmoidf_(w01 + aw1[t]) * 0.6065306597126334f);
      const float ad0 = sigmoidf_(a00 + aa0[t]), ad1 = sigmoidf_(a01 + aa1[t]);
      const float kr = k * kkc;
      const float kk = kr * (1.0f / sqrtf(wsum(kr * kr) + 1e-6f));
      const float kd0 = k * (1.0f + (ad0 - 1.0f) * kac), kd1 = k * (1.0f + (ad1 - 1.0f) * kac);
      const float ka0 = kk * ad0, ka1 = kk * ad1;
      const float c10 = wsum(kd0 * r), c20 = wsum(ka0 * r), c11 = wsum(kd1 * r), c21 = wsum(ka1 * r);
      const float bonus = wsum(r * (kd0 + kd1) * rkc);
      float* rec = p.RW() + ((size_t)row * 4 + h) * RWREC;
      rec[lane] = kk; rec[64 + lane] = v;
      rec[128 + lane] = wd0 * r; rec[192 + lane] = wd0; rec[256 + lane] = kd0; rec[320 + lane] = ka0;
      rec[384 + lane] = wd1 * r; rec[448 + lane] = wd1; rec[512 + lane] = kd1; rec[576 + lane] = ka1;
      if (lane == 0) { *(float4*)(rec + 640) = make_float4(c10, c20, bonus, 0.f); *(float4*)(rec + 644) = make_float4(c11, c21, 0.f, 0.f); }
      p.G16()[(size_t)row * 256 + c] = f2bf(ag[t]);
    }
    __syncthreads();
  }
}

__device__ __forceinline__ void fast_gdprep(const Params& p, int l, int wave_s) {
  int tid = make_tid(wave_s);
  const int c = tid & 255, lane = tid & 63, h = c >> 6, tg = tid >> 8;
  const float* cw = p.gdn_conv + (size_t)l * 3 * 768;
  float w0[3], w1[3], w2[3];
#pragma unroll
  for (int j = 0; j < 3; ++j) { w0[j] = cw[j * 256 + c]; w1[j] = cw[768 + j * 256 + c]; w2[j] = cw[1536 + j * 256 + c]; }
  for (int r0 = blockIdx.x * 8; r0 < NTOK; r0 += gridDim.x * 8) {
    float raw[4][3][3];
#pragma unroll
    for (int i = 0; i < 4; ++i) {
      const int row = r0 + tg * 4 + i;
      int t, len; seq_pos(row, t, len);
#pragma unroll
      for (int j = 0; j < 3; ++j) {
        const bf16_t* src = p.P() + (size_t)row * INC + OFF_C + j * 256 + c;
        raw[i][j][1] = bf2f(src[0]);
        raw[i][j][0] = t > 0 ? bf2f(src[-INC]) : 0.f;
        raw[i][j][2] = t < len - 1 ? bf2f(src[INC]) : 0.f;
      }
    }
#pragma unroll
    for (int i = 0; i < 4; ++i) {
      const int row = r0 + tg * 4 + i;
      float qkv[3];
#pragma unroll
      for (int j = 0; j < 3; ++j) qkv[j] = siluf_(raw[i][j][0] * w0[j] + raw[i][j][1] * w1[j] + raw[i][j][2] * w2[j]);
      const float qn = qkv[0] * FRSQ(wsum(qkv[0] * qkv[0]) + 1e-6f) * 0.125f;
      const float kn = qkv[1] * FRSQ(wsum(qkv[1] * qkv[1]) + 1e-6f);
      const float qk = wsum(qn * kn);
      float* rec = p.GP() + ((size_t)row * 4 + h) * GDREC;
      rec[lane] = qn; rec[64 + lane] = kn; rec[128 + lane] = qkv[2];
      if (lane < 2) {
        const int d = lane;
        const bf16_t* ab = p.P() + (size_t)row * INC + OFF_C + 1024;
        const float la = -FEXP(p.gdn_a_log[(l * 2 + d) * 4 + h]) * softplusf_(bf2f(ab[d * 4 + h]) + p.gdn_dt_bias[(l * 2 + d) * 4 + h]);
        *(float4*)(rec + 192 + d * 4) = make_float4(FEXP(la), sigmoidf_(bf2f(ab[8 + d * 4 + h])), qk, 0.f);
      }
    }
  }
}

constexpr int SCH = 16;
template <bool RWKV>
__device__ __forceinline__ void scan_pair(const Params& p, bool last, int task0, char* smem, int tid) {
  constexpr int STEPF = RWKV ? 340 : 148;
  constexpr int NF4 = STEPF / 4;
  constexpr int NLD = (SCH * NF4 + 255) / 256;
  const int hb = tid >> 8, ht = tid & 255;
  const int task = task0 + hb, chain = task >> 2, qr = task & 3;
  const int d = chain / (NB * 4), b = (chain / 4) % NB, h = chain % 4;
  const int v0 = qr * 16;
  float* buf = (float*)(smem + hb * 45056);
  float* ybuf = buf + 2 * SCH * STEPF;
  const int rl = ht >> 4, seg = ht & 15;
  const float* recbase = RWKV ? p.RW() : p.GP();
  constexpr int REC = RWKV ? RWREC : GDREC;
  float S0 = 0.f, S1 = 0.f, S2 = 0.f, S3 = 0.f;
  float4 st0, st1, st2, st3, st4, st5;
  const int nch = (NCX + NTL) / SCH;
#define SCAN_LOAD1(ch, q, dst)                                                                         \
  if ((q) < NLD) {                                                                                     \
    int idx = ht + (q) * 256;                                                                          \
    if (idx < SCH * NF4) {                                                                             \
      int i = idx / NF4, e4 = idx - i * NF4;                                                           \
      int row = scan_row(b, d, (ch) * SCH + i);                                                        \
      const float* rec = recbase + ((size_t)row * 4 + h) * REC;                                        \
      int off;                                                                                         \
      if (RWKV) off = e4 < 16 ? e4 * 4 : (e4 < 80 ? 128 + d * 256 + (e4 - 16) * 4 : (e4 < 84 ? 64 + v0 + (e4 - 80) * 4 : 640 + d * 4)); \
      else off = e4 < 16 ? 64 + e4 * 4 : (e4 < 32 ? (e4 - 16) * 4 : (e4 < 36 ? 128 + v0 + (e4 - 32) * 4 : 192 + d * 4)); \
      dst = *(const float4*)(rec + off);                                                               \
    }                                                                                                  \
  }
#define SCAN_LOAD(ch) { SCAN_LOAD1(ch, 0, st0) SCAN_LOAD1(ch, 1, st1) SCAN_LOAD1(ch, 2, st2) SCAN_LOAD1(ch, 3, st3) SCAN_LOAD1(ch, 4, st4) SCAN_LOAD1(ch, 5, st5) }
#define SCAN_STORE1(bi, q, srcv)                                                                       \
  if ((q) < NLD) {                                                                                     \
    int idx = ht + (q) * 256;                                                                          \
    if (idx < SCH * NF4) *(float4*)(buf + (bi) * SCH * STEPF + idx * 4) = srcv;                        \
  }
#define SCAN_STORE(bi) { SCAN_STORE1(bi, 0, st0) SCAN_STORE1(bi, 1, st1) SCAN_STORE1(bi, 2, st2) SCAN_STORE1(bi, 3, st3) SCAN_STORE1(bi, 4, st4) SCAN_STORE1(bi, 5, st5) }
  SCAN_LOAD(0); SCAN_STORE(0);
  __syncthreads();
  for (int ch = 0; ch < nch; ++ch) {
    const int cur = ch & 1;
    if (ch + 1 < nch) SCAN_LOAD(ch + 1);
    const float* sb = buf + cur * SCH * STEPF;
    float yk = 0.f;
    if (RWKV) {
      float4 kkA, wrA, wA, kdA, kaA, kkB, wrB, wB, kdB, kaB; float2 ccA, ccB; float vA, vB;
#define RW_LD(sp, X) { kk##X = *(const float4*)((sp) + seg * 4); wr##X = *(const float4*)((sp) + 64 + seg * 4); w##X = *(const float4*)((sp) + 128 + seg * 4); \
        kd##X = *(const float4*)((sp) + 192 + seg * 4); ka##X = *(const float4*)((sp) + 256 + seg * 4); v##X = (sp)[320 + rl]; cc##X = *(const float2*)((sp) + 336); }
#define RW_STEP(X, i) { float sa = (S0 * kk##X.x + S1 * kk##X.y) + (S2 * kk##X.z + S3 * kk##X.w); float z = (S0 * wr##X.x + S1 * wr##X.y) + (S2 * wr##X.z + S3 * wr##X.w); \
        sa = reduce16(sa); z = reduce16(z); \
        S0 = S0 * w##X.x + (v##X * kd##X.x - sa * ka##X.x); S1 = S1 * w##X.y + (v##X * kd##X.y - sa * ka##X.y); \
        S2 = S2 * w##X.z + (v##X * kd##X.z - sa * ka##X.z); S3 = S3 * w##X.w + (v##X * kd##X.w - sa * ka##X.w); \
        const float y_ = z + v##X * cc##X.x - sa * cc##X.y; yk = (seg == (i)) ? y_ : yk; }
      RW_LD(sb, A);
#pragma unroll 1
      for (int i = 0; i < SCH; i += 2) {
        RW_LD(sb + (i + 1) * STEPF, B);
        RW_STEP(A, i);
        if (i + 2 < SCH) RW_LD(sb + (i + 2) * STEPF, A);
        RW_STEP(B, i + 1);
      }
#undef RW_LD
#undef RW_STEP
    } else {
      float4 kA, qA, kB, qB, sA, sB; float vA, vB;
#define GD_LD(sp, X) { k##X = *(const float4*)((sp) + seg * 4); q##X = *(const float4*)((sp) + 64 + seg * 4); v##X = (sp)[128 + rl]; s##X = *(const float4*)((sp) + 144); }
#define GD_STEP(X, i) { float ks = (S0 * k##X.x + S1 * k##X.y) + (S2 * k##X.z + S3 * k##X.w); float qs = (S0 * q##X.x + S1 * q##X.y) + (S2 * q##X.z + S3 * q##X.w); \
        ks = reduce16(ks); qs = reduce16(qs); \
        const float vn = s##X.y * (v##X - s##X.x * ks); \
        S0 = S0 * s##X.x + k##X.x * vn; S1 = S1 * s##X.x + k##X.y * vn; S2 = S2 * s##X.x + k##X.z * vn; S3 = S3 * s##X.x + k##X.w * vn; \
        const float y_ = s##X.x * qs + s##X.z * vn; yk = (seg == (i)) ? y_ : yk; }
      GD_LD(sb, A);
#pragma unroll 1
      for (int i = 0; i < SCH; i += 2) {
        GD_LD(sb + (i + 1) * STEPF, B);
        GD_STEP(A, i);
        if (i + 2 < SCH) GD_LD(sb + (i + 2) * STEPF, A);
        GD_STEP(B, i + 1);
      }
#undef GD_LD
#undef GD_STEP
    }
    ybuf[seg * 16 + rl] = yk;
    __syncthreads();
    {
      const int i = ht >> 4, j = ht & 15;
      const int row = scan_row(b, d, ch * SCH + i);
      if (!(last && row >= NLAT)) p.YS()[(size_t)row * 1024 + (RWKV ? 0 : 512) + d * 256 + h * 64 + v0 + j] = f2bf(ybuf[i * 16 + j]);
    }
    if (ch + 1 < nch) SCAN_STORE(cur ^ 1);
    __syncthreads();
  }
#undef SCAN_LOAD
#undef SCAN_STORE
#undef SCAN_LOAD1
#undef SCAN_STORE1
}
__device__ __forceinline__ int scan_npairs() { return 2 * (2 * NB * 4) * 4 / 2; }
__device__ __forceinline__ void scan_run_pair(const Params& p, bool last, int pair, char* smem, int tid) {
  const int nrw = (2 * NB * 4) * 4;
  const int task0 = pair * 2;
  if (task0 < nrw) scan_pair<true>(p, last, task0, smem, tid);
  else scan_pair<false>(p, last, task0 - nrw, smem, tid);
}

__device__ __forceinline__ void fast_post(const Params& p, int l, int nr, int wave_s) {
  int tid = make_tid(wave_s);
  const int lane = tid & 63;
  for (int row = blockIdx.x * 8 + (tid >> 6); row < nr; row += gridDim.x * 8) {
    const bf16_t* ys = p.YS() + (size_t)row * 1024;
    bf16_t* yo = p.Y() + (size_t)row * DM;
#pragma unroll
    for (int h = 0; h < 4; ++h) {
      const int c = h * 64 + lane;
      {
        const float* rec = p.RW() + ((size_t)row * 4 + h) * RWREC;
        const float y = bf2f(ys[c]) + bf2f(ys[256 + c]);
        const float m = wave_sum(y) * (1.0f / 64);
        const float dd = y - m;
        const float rstd = 1.0f / sqrtf(wave_sum(dd * dd) * (1.0f / 64) + 64e-5f);
        const float yn = dd * rstd * p.rwkv_ln_g[l * 256 + c] + p.rwkv_ln_b[l * 256 + c];
        yo[256 + c] = f2bf((yn + rec[642] * rec[64 + lane]) * bf2f(p.G16()[(size_t)row * 256 + c]));
      }
      {
        const float o = bf2f(ys[512 + c]) + bf2f(ys[768 + c]);
        const float rs = 1.0f / sqrtf(wave_sum(o * o) * (1.0f / 64) + 1e-6f);
        const float gate = bf2f(p.P()[(size_t)row * INC + OFF_C + 768 + c]);
        yo[512 + c] = f2bf(o * rs * p.gdn_norm_g[l * 64 + lane] * siluf_(gate));
      }
    }
  }
}

constexpr int NKEY = NTL + NCX;
__device__ __forceinline__ int key_row(int b, int j) { return j < NTL ? b * NTL + j : NLAT + b * NCX + (j - NTL); }

__device__ __forceinline__ void fast_attprep(const Params& p, char* smem, int wave_s) {
  int tid = make_tid(wave_s);
  for (int it = blockIdx.x * NTHREADS + tid; it < NLAT * 32; it += gridDim.x * NTHREADS) {
    const int token = it >> 5, j = it & 31;
    const int blk = j & 3;
    const int t = token % NTL;
    const int pos = (blk & 1) ? (t & 63) : (t >> 6);
    bf16_t* base = p.P() + (size_t)token * INC + OFF_A + (j >> 4) * 256 + ((j >> 2) & 3) * 64 + blk * 16;
    uint4 a = *(const uint4*)base, b = *(const uint4*)(base + 8);
    float x1[8], x2[8];
    unpack8(a, x1); unpack8(b, x2);
#pragma unroll
    for (int i = 0; i < 8; ++i) {
      const float ang = (float)pos * FEXP(-(float)i * (9.210340371976184f / 8.0f));
      const float cs = FCOS(ang), sn = FSIN(ang);
      const float y1 = x1[i] * cs - x2[i] * sn, y2 = x1[i] * sn + x2[i] * cs;
      x1[i] = y1; x2[i] = y2;
    }
    a.x = pk_bf16(x1[0], x1[1]); a.y = pk_bf16(x1[2], x1[3]); a.z = pk_bf16(x1[4], x1[5]); a.w = pk_bf16(x1[6], x1[7]);
    b.x = pk_bf16(x2[0], x2[1]); b.y = pk_bf16(x2[2], x2[3]); b.z = pk_bf16(x2[4], x2[5]); b.w = pk_bf16(x2[6], x2[7]);
    *(uint4*)base = a; *(uint4*)(base + 8) = b;
  }
  bf16_t* Ts = (bf16_t*)smem;
  const int ntile = NKEY / 64;
  const int nt_all = 2 * NB * 4 * ntile;
#define VT_SRC(tix_) (p.P() + (size_t)key_row((((tix_) % (NB * 4 * ntile)) / ntile) >> 2, (((tix_) % (NB * 4 * ntile)) % ntile) * 64 + (tid >> 3)) * INC \
      + (((tix_) / (NB * 4 * ntile)) ? OFF_D : OFF_A) + 512 + ((((tix_) % (NB * 4 * ntile)) / ntile) & 3) * 64 + (tid & 7) * 8)
  uint4 vnext = make_uint4(0u, 0u, 0u, 0u);
  if ((int)blockIdx.x < nt_all) vnext = *(const uint4*)VT_SRC(min((int)blockIdx.x, nt_all - 1));
  for (int tix = blockIdx.x; tix < nt_all; tix += gridDim.x) {
    const int mixer = tix / (NB * 4 * ntile), rem = tix % (NB * 4 * ntile);
    const int bh = rem / ntile, kt = rem % ntile;
    const uint4 v = vnext;
    {
      const int tn = min(tix + (int)gridDim.x, nt_all - 1);
      vnext = *(const uint4*)VT_SRC(tn);
    }
    {
      const int key = tid >> 3, dc = tid & 7;
      const int pos = (key & 32) | ((key & 12) << 1) | ((key & 16) >> 2) | (key & 3);
      bf16_t e[8];
      *(uint4*)e = v;
#pragma unroll
      for (int i = 0; i < 8; ++i) Ts[(dc * 8 + i) * 72 + pos] = e[i];
    }
    LDS_BAR();
    {
      const int d = tid >> 3, pc = tid & 7;
      const uint4 vv = *(const uint4*)(Ts + d * 72 + pc * 8);
      *(uint4*)(p.VT() + (((size_t)mixer * NB * 4 + bh) * 64 + d) * NKEY + kt * 64 + pc * 8) = vv;
    }
    LDS_BAR();
  }
#undef VT_SRC
}

__device__ __forceinline__ float xmax_16_32(float x) {
  float a = x, b = x;
  asm volatile("s_nop 1\n\tv_permlane16_swap_b32 %0, %1" : "+v"(a), "+v"(b));
  x = fmaxf(a, b); a = x; b = x;
  asm volatile("s_nop 1\n\tv_permlane32_swap_b32 %0, %1" : "+v"(a), "+v"(b));
  return fmaxf(a, b);
}
__device__ __forceinline__ float xsum_16_32(float x) {
  float a = x, b = x;
  asm volatile("s_nop 1\n\tv_permlane16_swap_b32 %0, %1" : "+v"(a), "+v"(b));
  x = a + b; a = x; b = x;
  asm volatile("s_nop 1\n\tv_permlane32_swap_b32 %0, %1" : "+v"(a), "+v"(b));
  return a + b;
}
__device__ __forceinline__ bf16x8 pack_p8(const f32x4& lo, const f32x4& hi) {
  uint4 u;
  u.x = pk_bf16(lo[0], lo[1]); u.y = pk_bf16(lo[2], lo[3]); u.z = pk_bf16(hi[0], hi[1]); u.w = pk_bf16(hi[2], hi[3]);
  return __builtin_bit_cast(bf16x8, u);
}

__device__ __forceinline__ void attnA_task(const Params& p, int l, int task, char* smem, int tid) {
  const int nlat_tasks = NB * 4 * (NTL / 256);
  const bool lat = task < nlat_tasks;
  int b, h, qrow0, kt0;
  if (lat) { const int bh = task / (NTL / 256), qb = task % (NTL / 256); b = bh >> 2; h = bh & 3; qrow0 = b * NTL + qb * 256; kt0 = 0; }
  else { const int t2 = task - nlat_tasks; const int bh = t2 / (NCX / 256), qb = t2 % (NCX / 256); b = bh >> 2; h = bh & 3; qrow0 = NLAT + b * NCX + qb * 256; kt0 = NTL / 64; }
  const int nkt = NKEY / 64;
  const int lane = tid & 63, w = tid >> 6, l15 = lane & 15, lq = lane >> 4, sw = l15 & 7;
  char* Ks = smem;
  char* Vs = smem + 16384;
  const float c = 0.17677669529663687f * 1.4426950408889634f;
  bf16x8 qf[2][2];
#pragma unroll
  for (int qt = 0; qt < 2; ++qt)
#pragma unroll
    for (int br = 0; br < 2; ++br)
      qf[br][qt] = *(const bf16x8*)(p.P() + (size_t)(qrow0 + w * 32 + qt * 16 + l15) * INC + OFF_A + h * 64 + br * 32 + lq * 8);
  f32x4 O[2][2][4], L[2][2];
  float m_[2][2];
  const uint4 ones_u = make_uint4(0x3f803f80u, 0x3f803f80u, 0x3f803f80u, 0x3f803f80u);
  const bf16x8 ones8 = __builtin_bit_cast(bf16x8, ones_u);
#pragma unroll
  for (int br = 0; br < 2; ++br)
#pragma unroll
    for (int qt = 0; qt < 2; ++qt) {
      m_[br][qt] = -1e30f; L[br][qt] = f32x4{0.f, 0.f, 0.f, 0.f};
#pragma unroll
      for (int dt = 0; dt < 4; ++dt) O[br][qt][dt] = f32x4{0.f, 0.f, 0.f, 0.f};
    }
  const int srow = tid >> 3, sch = tid & 7;
  const int soff = srow * 128 + ((sch ^ (srow & 7)) << 4);
  const bf16_t* vtbase = p.VT() + (((size_t)0 * NB * 4 + b * 4 + h) * 64 + srow) * NKEY + sch * 8;
  uint4 rk, rv;
#define ATT_LOAD(kt) { rk = *(const uint4*)(p.P() + (size_t)key_row(b, (kt) * 64 + srow) * INC + OFF_A + 256 + h * 64 + sch * 8); rv = *(const uint4*)(vtbase + (kt) * 64); }
#define ATT_STORE(bi) { *(uint4*)(Ks + (bi) * 8192 + soff) = rk; *(uint4*)(Vs + (bi) * 8192 + soff) = rv; }
  ATT_LOAD(kt0);
  ATT_STORE(0);
  LDS_BAR();
  for (int kt = kt0; kt < nkt; ++kt) {
    const int cur = (kt - kt0) & 1;
    if (kt + 1 < nkt) ATT_LOAD(kt + 1);
    const char* kb = Ks + cur * 8192;
    const char* vb = Vs + cur * 8192;
    bf16x8 vf[4][2];
#pragma unroll
    for (int dt = 0; dt < 4; ++dt)
#pragma unroll
      for (int ks = 0; ks < 2; ++ks) vf[dt][ks] = *(const bf16x8*)(vb + (16 * dt + l15) * 128 + (((ks * 4 + lq) ^ sw) << 4));
#pragma unroll
    for (int br = 0; br < 2; ++br) {
      f32x4 S[2][4];
      {
        bf16x8 kf[4];
#pragma unroll
        for (int a = 0; a < 4; ++a) kf[a] = *(const bf16x8*)(kb + (16 * a + l15) * 128 + (((br * 4 + lq) ^ sw) << 4));
#pragma unroll
        for (int qt = 0; qt < 2; ++qt)
#pragma unroll
          for (int a = 0; a < 4; ++a) S[qt][a] = __builtin_amdgcn_mfma_f32_16x16x32_bf16(kf[a], qf[br][qt], f32x4{0.f, 0.f, 0.f, 0.f}, 0, 0, 0);
      }
      float mx[2];
#pragma unroll
      for (int qt = 0; qt < 2; ++qt) {
        float m0 = fmaxf(fmaxf(S[qt][0][0], S[qt][0][1]), fmaxf(S[qt][0][2], S[qt][0][3]));
#pragma unroll
        for (int a = 1; a < 4; ++a) m0 = fmaxf(m0, fmaxf(fmaxf(S[qt][a][0], S[qt][a][1]), fmaxf(S[qt][a][2], S[qt][a][3])));
        mx[qt] = m0 * c;
      }
      if (__any((mx[0] > m_[br][0] + 8.0f) || (mx[1] > m_[br][1] + 8.0f))) {
#pragma unroll
        for (int qt = 0; qt < 2; ++qt) {
          const float mxx = xmax_16_32(mx[qt]);
          const float mn = fmaxf(m_[br][qt], mxx);
          const float alpha = __builtin_amdgcn_exp2f(m_[br][qt] - mn);
          m_[br][qt] = mn;
          L[br][qt] *= alpha;
#pragma unroll
          for (int dt = 0; dt < 4; ++dt) O[br][qt][dt] *= alpha;
        }
      }
#pragma unroll
      for (int qt = 0; qt < 2; ++qt) {
        const float mcur = m_[br][qt];
#pragma unroll
        for (int a = 0; a < 4; ++a)
#pragma unroll
          for (int r = 0; r < 4; ++r) S[qt][a][r] = __builtin_amdgcn_exp2f(S[qt][a][r] * c - mcur);
        const bf16x8 p0 = pack_p8(S[qt][0], S[qt][1]), p1 = pack_p8(S[qt][2], S[qt][3]);
#pragma unroll
        for (int dt = 0; dt < 4; ++dt) {
          O[br][qt][dt] = __builtin_amdgcn_mfma_f32_16x16x32_bf16(vf[dt][0], p0, O[br][qt][dt], 0, 0, 0);
          O[br][qt][dt] = __builtin_amdgcn_mfma_f32_16x16x32_bf16(vf[dt][1], p1, O[br][qt][dt], 0, 0, 0);
        }
        L[br][qt] = __builtin_amdgcn_mfma_f32_16x16x32_bf16(ones8, p0, L[br][qt], 0, 0, 0);
        L[br][qt] = __builtin_amdgcn_mfma_f32_16x16x32_bf16(ones8, p1, L[br][qt], 0, 0, 0);
      }
    }
    if (kt + 1 < nkt) ATT_STORE(cur ^ 1);
    LDS_BAR();
  }
#undef ATT_LOAD
#undef ATT_STORE
  const float* lv = p.diff_lam + l * 128;
  float d01 = 0.f, d23 = 0.f;
#pragma unroll 4
  for (int i = 0; i < 32; ++i) { d01 += lv[i] * lv[32 + i]; d23 += lv[64 + i] * lv[96 + i]; }
  const float lam_init = 0.8f - 0.6f * FEXP(-0.3f * (float)l);
  const float lam = FEXP(d01) - FEXP(d23) + lam_init;
#pragma unroll
  for (int qt = 0; qt < 2; ++qt) {
    const float i1 = 1.0f / L[0][qt][0], i2 = lam / L[1][qt][0];
    float ss = 0.f;
    f32x4 o[4];
#pragma unroll
    for (int dt = 0; dt < 4; ++dt)
#pragma unroll
      for (int r = 0; r < 4; ++r) { o[dt][r] = O[0][qt][dt][r] * i1 - O[1][qt][dt][r] * i2; ss += o[dt][r] * o[dt][r]; }
    ss = xsum_16_32(ss);
    const float rs = (1.0f / sqrtf(ss * (1.0f / 64) + 1e-6f)) * (1.0f - lam_init);
    bf16_t* yp = p.Y() + (size_t)(qrow0 + w * 32 + qt * 16 + l15) * DM + h * 64;
#pragma unroll
    for (int dt = 0; dt < 4; ++dt) {
      const float4 g = *(const float4*)(p.diff_norm_g + l * 64 + dt * 16 + lq * 4);
      uint2 v;
      v.x = pk_bf16(o[dt][0] * rs * g.x, o[dt][1] * rs * g.y);
      v.y = pk_bf16(o[dt][2] * rs * g.z, o[dt][3] * rs * g.w);
      *(uint2*)(yp + dt * 16 + lq * 4) = v;
    }
  }
  LDS_BAR();
}
__device__ __forceinline__ void fast_attnA(const Params& p, int l, char* smem, int wave_s, int vb, int nvb) {
  int tid = make_tid(wave_s);
  const int ntask = NB * 4 * (NTL / 256) + (l == 0 ? NB * 4 * (NCX / 256) : 0);
  for (int t = vb; t < ntask; t += nvb) { const int tid2 = make_tid(wave_s); attnA_task(p, l, t, smem, tid2); }
}

__device__ __forceinline__ void attnD_pair(const Params& p, int l, int pair, char* smem, int tid) {
  const int nlat = NB * 4 * GROWS;
  const int hb = tid >> 8;
  const int task = pair * 2 + hb;
  const bool lat = task < nlat;
  int b, h, qrow0, rq = 0, rs = 0, ntile;
  if (lat) {
    const int bh = task / GROWS; rq = task % GROWS; b = bh >> 2; h = bh & 3;
    qrow0 = b * NTL + rq * 64;
    rs = rq - 4; rs = rs < 0 ? 0 : (rs > GROWS - 8 ? GROWS - 8 : rs);
    ntile = 8 + NCX / 64;
  } else {
    const int t2 = task - nlat; const int bh = t2 / (NCX / 64), sub = t2 % (NCX / 64); b = bh >> 2; h = bh & 3;
    qrow0 = NLAT + b * NCX + sub * 64;
    ntile = NCX / 64;
  }
  const int ht = tid & 255, lane = tid & 63, wq = (tid >> 6) & 3, l15 = lane & 15, lq = lane >> 4, sw = l15 & 7;
  char* Ks = smem + hb * 34816;
  char* Vs = Ks + 16384;
  float* tbl = (float*)(Ks + 32768);
  for (int i = ht; i < 15 * 31; i += 256) tbl[i] = p.nat_rpb[((size_t)l * 4 + h) * 465 + i];
  const float LOG2E = 1.4426950408889634f;
  bf16x8 qf[2];
#pragma unroll
  for (int ks = 0; ks < 2; ++ks)
    qf[ks] = *(const bf16x8*)(p.P() + (size_t)(qrow0 + wq * 16 + l15) * INC + OFF_D + h * 64 + ks * 32 + lq * 8);
  f32x4 O[4];
#pragma unroll
  for (int dt = 0; dt < 4; ++dt) O[dt] = f32x4{0.f, 0.f, 0.f, 0.f};
  float m_ = -1e30f;
  f32x4 Ls = f32x4{0.f, 0.f, 0.f, 0.f};
  const uint4 ones_u = make_uint4(0x3f803f80u, 0x3f803f80u, 0x3f803f80u, 0x3f803f80u);
  const bf16x8 ones8 = __builtin_bit_cast(bf16x8, ones_u);
  const int cq = wq * 16 + l15;
  int cs = cq - 8; cs = cs < 0 ? 0 : (cs > 48 ? 48 : cs);
  const int srow = ht >> 2, sch = (ht & 3) * 2;
  const int soff0 = srow * 128 + ((sch ^ (srow & 7)) << 4), soff1 = srow * 128 + (((sch + 1) ^ (srow & 7)) << 4);
  const bf16_t* vtb = p.VT() + (((size_t)1 * NB * 4 + b * 4 + h) * 64 + srow) * NKEY + sch * 8;
  uint4 rk0, rk1, rv0, rv1;
#define ATD_KEY0(j) (lat ? ((j) < 8 ? (rs + (j)) * 64 : NTL + ((j) - 8) * 64) : NTL + (j) * 64)
#define ATD_LOAD(j) { const int k0_ = ATD_KEY0(j); const bf16_t* kp_ = p.P() + (size_t)key_row(b, k0_ + srow) * INC + OFF_D + 256 + h * 64 + sch * 8; \
    rk0 = *(const uint4*)kp_; rk1 = *(const uint4*)(kp_ + 8); rv0 = *(const uint4*)(vtb + k0_); rv1 = *(const uint4*)(vtb + k0_ + 8); }
#define ATD_STORE(bi) { *(uint4*)(Ks + (bi) * 8192 + soff0) = rk0; *(uint4*)(Ks + (bi) * 8192 + soff1) = rk1; \
    *(uint4*)(Vs + (bi) * 8192 + soff0) = rv0; *(uint4*)(Vs + (bi) * 8192 + soff1) = rv1; }
  ATD_LOAD(0);
  ATD_STORE(0);
  LDS_BAR();
  for (int j = 0; j < ntile; ++j) {
    const int cur = j & 1;
    if (j + 1 < ntile) ATD_LOAD(j + 1);
    const char* kb = Ks + cur * 8192;
    const char* vb = Vs + cur * 8192;
    f32x4 S[4];
#pragma unroll
    for (int a = 0; a < 4; ++a) {
      S[a] = f32x4{0.f, 0.f, 0.f, 0.f};
#pragma unroll
      for (int ks = 0; ks < 2; ++ks) {
        const bf16x8 kf = *(const bf16x8*)(kb + (16 * a + l15) * 128 + (((ks * 4 + lq) ^ sw) << 4));
        S[a] = __builtin_amdgcn_mfma_f32_16x16x32_bf16(kf, qf[ks], S[a], 0, 0, 0);
      }
    }
    const bool win = lat && j < 8;
    const float* trow = tbl + (rs + j - rq + 7) * 31 - cq + 15;
    float mx = -1e30f;
#pragma unroll
    for (int a = 0; a < 4; ++a)
#pragma unroll
      for (int r = 0; r < 4; ++r) {
        float v = S[a][r] * (0.125f * LOG2E);
        if (win) {
          const int ck = 16 * a + 4 * lq + r;
          const bool ok = (unsigned)(ck - cs) < 16u;
          v = ok ? v + trow[ok ? ck : cq] * LOG2E : -1e30f;
        }
        S[a][r] = v;
        mx = fmaxf(mx, v);
      }
    if (__any(mx > m_ + 8.0f)) {
      mx = xmax_16_32(mx);
      const float mn = fmaxf(m_, mx);
      const float alpha = __builtin_amdgcn_exp2f(m_ - mn);
      m_ = mn;
      Ls *= alpha;
#pragma unroll
      for (int dt = 0; dt < 4; ++dt) O[dt] *= alpha;
    }
#pragma unroll
    for (int a = 0; a < 4; ++a)
#pragma unroll
      for (int r = 0; r < 4; ++r) S[a][r] = __builtin_amdgcn_exp2f(S[a][r] - m_);
    const bf16x8 p0 = pack_p8(S[0], S[1]), p1 = pack_p8(S[2], S[3]);
#pragma unroll
    for (int dt = 0; dt < 4; ++dt) {
      const bf16x8 v0 = *(const bf16x8*)(vb + (16 * dt + l15) * 128 + (((0 * 4 + lq) ^ sw) << 4));
      const bf16x8 v1 = *(const bf16x8*)(vb + (16 * dt + l15) * 128 + (((1 * 4 + lq) ^ sw) << 4));
      O[dt] = __builtin_amdgcn_mfma_f32_16x16x32_bf16(v0, p0, O[dt], 0, 0, 0);
      O[dt] = __builtin_amdgcn_mfma_f32_16x16x32_bf16(v1, p1, O[dt], 0, 0, 0);
    }
    Ls = __builtin_amdgcn_mfma_f32_16x16x32_bf16(ones8, p0, Ls, 0, 0, 0);
    Ls = __builtin_amdgcn_mfma_f32_16x16x32_bf16(ones8, p1, Ls, 0, 0, 0);
    if (j + 1 < ntile) ATD_STORE(cur ^ 1);
    LDS_BAR();
  }
#undef ATD_KEY0
#undef ATD_LOAD
#undef ATD_STORE
  const float inv = 1.0f / Ls[0];
  bf16_t* yp = p.Y() + (size_t)(qrow0 + wq * 16 + l15) * DM + 768 + h * 64;
#pragma unroll
  for (int dt = 0; dt < 4; ++dt) {
    uint2 v;
    v.x = pk_bf16(O[dt][0] * inv, O[dt][1] * inv);
    v.y = pk_bf16(O[dt][2] * inv, O[dt][3] * inv);
    *(uint2*)(yp + dt * 16 + lq * 4) = v;
  }
  LDS_BAR();
}
__device__ __forceinline__ void fast_attnD(const Params& p, int l, char* smem, int wave_s, int vb, int nvb) {
  int tid = make_tid(wave_s);
  const int npair = (NB * 4 * GROWS + (l == 0 ? NB * 4 * (NCX / 64) : 0)) / 2;
  for (int t = vb; t < npair; t += nvb) { const int tid2 = make_tid(wave_s); attnD_pair(p, l, t, smem, tid2); }
}

__device__ __forceinline__ void fast_ada(const Params& p, char* smem, int wave_s) {
  int tid = make_tid(wave_s);
  float* red = (float*)smem;
  const int jc = tid & 31, ks = tid >> 5;
  for (int t = blockIdx.x; t < 2 * (6144 / 32); t += gridDim.x) {
    const int l = t / (6144 / 32), j = (t % (6144 / 32)) * 32 + jc;
    float acc[NMODV];
#pragma unroll
    for (int v = 0; v < NMODV; ++v) acc[v] = 0.f;
    for (int i = ks * 64; i < ks * 64 + 64; ++i) {
      const float w = p.w_ada[((size_t)l * DM + i) * 6144 + j];
#pragma unroll
      for (int v = 0; v < NB; ++v) acc[v] += siluf_(p.c[v * DM + i]) * w;
      acc[NB] += siluf_(p.c_ctx[i]) * w;
    }
#pragma unroll
    for (int v = 0; v < NMODV; ++v) red[(ks * NMODV + v) * 32 + jc] = acc[v];
    __syncthreads();
    if (tid < NMODV * 32) {
      const int v = tid >> 5;
      float sacc = p.b_ada[l * 6144 + j];
#pragma unroll
      for (int k2 = 0; k2 < 16; ++k2) sacc += red[(k2 * NMODV + v) * 32 + jc];
      p.mod()[((size_t)l * NMODV + v) * 6144 + j] = sacc;
    }
    __syncthreads();
  }
}

constexpr int CL = 16;
constexpr int NCHK = (NTL + NCX) / CL;
constexpr int IMG_KK = 0, IMG_RT = 2048, IMG_TR = 4096, IMG_BK = 6144, IMG_WL = 10240, IMG_VV = 10496, IMG_BYTES = 12544;
__device__ __forceinline__ char* img_ptr(const Params& p, int mixer, int d, int b, int h, int cidx) {
  return (char*)p.RW() + ((size_t)((((mixer * 2 + d) * NB + b) * 4 + h)) * NCHK + cidx) * IMG_BYTES;
}
__device__ __forceinline__ bf16_t* rv16(const Params& p) { return (bf16_t*)((char*)p.RW() + (size_t)2 * 2 * NB * 4 * NCHK * IMG_BYTES); }
__device__ __forceinline__ float* bonbuf(const Params& p) { return (float*)(rv16(p) + (size_t)NTOK * 256); }
constexpr int LORAT_LAYER = 2 * 256 * 64 * 2 + 256 * 128;
__device__ __forceinline__ bf16_t* lorat(const Params& p, int l) { return (bf16_t*)(bonbuf(p) + (size_t)NTOK * 4) + (size_t)l * LORAT_LAYER; }
__device__ __forceinline__ void conv_lora(const Params& p, int wave_s) {
  const int tid = make_tid(wave_s);
  for (int idx = blockIdx.x * NTHREADS + tid; idx < 2 * LORAT_LAYER; idx += gridDim.x * NTHREADS) {
    const int l = idx / LORAT_LAYER, e = idx % LORAT_LAYER;
    float v;
    if (e < 2 * 256 * 64) { const int d = e / (256 * 64), c = (e / 64) % 256, k = e % 64; v = p.rwkv_w2[((size_t)(l * 2 + d) * 64 + k) * 256 + c]; }
    else if (e < 4 * 256 * 64) { const int e2 = e - 2 * 256 * 64; const int d = e2 / (256 * 64), c = (e2 / 64) % 256, k = e2 % 64; v = p.rwkv_a2[((size_t)(l * 2 + d) * 64 + k) * 256 + c]; }
    else { const int e2 = e - 4 * 256 * 64; const int c = e2 / 128, k = e2 % 128; v = p.rwkv_g2[((size_t)l * 128 + k) * 256 + c]; }
    lorat(p, l)[e] = f2bf(v);
  }
}
__device__ __forceinline__ int colp(int pp) { return 16 * (2 * (pp >> 5) + ((pp & 7) >> 2)) + 4 * ((pp >> 3) & 3) + (pp & 3); }
__device__ __forceinline__ int tile_cidx(bool is_ctx, int t0, int d) {
  const int j = t0 >> 4;
  if (is_ctx) return d == 0 ? j : NCX / 16 - 1 - j;
  return NCX / 16 + (d == 0 ? j : NTL / 16 - 1 - j);
}
constexpr int VEC_OFF = 77824;
constexpr int VS = 258;
constexpr int WCS = 65, MS = 17;
constexpr int VEC_W0 = 0, VEC_W1 = 16384, VEC_KK = 32768, VEC_R = VEC_KK + 16 * VS * 2, VEC_B0 = VEC_R + 16 * VS * 2, VEC_B1 = VEC_B0 + 16 * VS * 2,
              VEC_KD0 = VEC_B1 + 16 * VS * 2, VEC_KD1 = VEC_KD0 + 16 * VS * 2;
constexpr int SCR_WC = 0, SCR_T6 = 8192, SCR_MAT = 57344;

template <bool NOWRITE>
__device__ __forceinline__ void chunk_prep_head(const Params& p, int mixer, int b, bool is_ctx, int t0, int h, char* smem, int tid) {
  const char* vec = smem + VEC_OFF;
  float* Wc = (float*)(smem + SCR_WC);
  float* T6 = (float*)(smem + SCR_T6);
  float* MAT = (float*)(smem + SCR_MAT);
  if (tid < 128) {
    const int d = tid >> 6, k = tid & 63;
    const float* wv = (const float*)(vec + (d ? VEC_W1 : VEC_W0));
    float acc = 1.f;
#pragma unroll
    for (int s_ = 0; s_ < 16; ++s_) {
      const int tok = d ? 15 - s_ : s_;
      acc *= wv[tok * 256 + h * 64 + k];
      Wc[(d * 16 + s_) * 64 + k] = acc;
    }
  }
  __syncthreads();
#pragma unroll
  for (int q = 0; q < 4; ++q) {
    const int idx = tid + q * NTHREADS;
    const int d = idx >> 10, s_ = (idx >> 6) & 15, k = idx & 63;
    const int tok = d ? 15 - s_ : s_;
    const int vi = tok * 256 + h * 64 + k;
    const float W = Wc[(d * 16 + s_) * 64 + k];
    const float Wp = s_ ? Wc[(d * 16 + s_ - 1) * 64 + k] : 1.f;
    const float WL = Wc[(d * 16 + 15) * 64 + k];
    const float iW = 1.0f / W;
    const float kk = bf2f(((const bf16_t*)(vec + VEC_KK))[vi]), r = bf2f(((const bf16_t*)(vec + VEC_R))[vi]);
    const float bb = bf2f(((const bf16_t*)(vec + (d ? VEC_B1 : VEC_B0)))[vi]), kd = bf2f(((const bf16_t*)(vec + (d ? VEC_KD1 : VEC_KD0)))[vi]);
    float* t6 = T6 + (size_t)d * 6 * 1024 + s_ * 64 + k;
    t6[0] = kk * Wp; t6[1024] = r * W; t6[2048] = bb * iW; t6[3072] = kd * iW; t6[4096] = bb * (WL * iW); t6[5120] = kd * (WL * iW);
  }
  __syncthreads();
  {
    const int lane = tid & 63, w = tid >> 6, d = w >> 2, mat = w & 3, i = lane & 15, g = lane >> 4;
    const float* X = T6 + (size_t)d * 6 * 1024 + (mat < 2 ? 0 : 1024) + i * 64 + g;
    const float* Yv = T6 + (size_t)d * 6 * 1024 + ((mat & 1) ? 3072 : 2048) + i * 64 + g;
    float xa[16], ya[16];
#pragma unroll
    for (int k4 = 0; k4 < 16; ++k4) { xa[k4] = X[4 * k4]; ya[k4] = Yv[4 * k4]; }
    f32x4 ac4[4];
#pragma unroll
    for (int q = 0; q < 4; ++q) ac4[q] = f32x4{0.f, 0.f, 0.f, 0.f};
#pragma unroll
    for (int k4 = 0; k4 < 16; ++k4) ac4[k4 & 3] = __builtin_amdgcn_mfma_f32_16x16x4f32(xa[k4], ya[k4], ac4[k4 & 3], 0, 0, 0);
    const f32x4 acc = (ac4[0] + ac4[1]) + (ac4[2] + ac4[3]);
#pragma unroll
    for (int r_ = 0; r_ < 4; ++r_) {
      const int s_ = 4 * g + r_;
      const bool keep = mat < 2 ? (i < s_) : (i <= s_);
      MAT[((d * 6 + mat) * 16 + s_) * 16 + i] = keep ? acc[r_] : 0.f;
    }
  }
  __syncthreads();
  {
    const int d = tid >> 8, col = (tid >> 4) & 15, j = tid & 15;
    const float* A = MAT + (d * 6 + 0) * 256 + j;
    float a[16];
#pragma unroll
    for (int i = 0; i < 16; ++i) a[i] = A[i * 16];
    float xj = 0.f;
#pragma unroll
    for (int i = 0; i < 16; ++i) {
      const float part = (j < i) ? a[i] * xj : 0.f;
      const float sum = reduce16(part);
      const float xi = ((i == col) ? 1.f : 0.f) - sum;
      xj = (j == i) ? xi : xj;
    }
    MAT[(d * 6 + 4) * 256 + j * 16 + col] = xj;
  }
  __syncthreads();
  {
    const int d = tid >> 8, s_ = (tid >> 4) & 15, j = tid & 15;
    const float* Ti = MAT + (d * 6 + 4) * 256 + s_ * 16;
    const float* Ak = MAT + (d * 6 + 1) * 256 + j;
    float acc = 0.f;
#pragma unroll
    for (int u = 0; u < 16; ++u) acc += Ti[u] * Ak[u * 16];
    MAT[(d * 6 + 5) * 256 + s_ * 16 + j] = acc;
  }
  __syncthreads();
#pragma unroll
  for (int q = 0; q < 3; ++q) {
    const int idx = tid + q * NTHREADS;
    if (!NOWRITE && idx < 2 * 656) {
      const int d = idx / 656, c = idx - d * 656;
      char* img = img_ptr(p, mixer, d, b, h, tile_cidx(is_ctx, t0, d));
      const float* t6 = T6 + (size_t)d * 6 * 1024;
      const float* mt = MAT + d * 6 * 256;
      if (c < 640) {
        float e[8];
        int off;
        if (c < 256) {
          const int which = c >> 7, cc = c & 127, s_ = cc >> 3, ch = cc & 7;
          const float* src = t6 + which * 1024 + s_ * 64;
#pragma unroll
          for (int e_ = 0; e_ < 8; ++e_) e[e_] = src[colp(ch * 8 + e_)];
          off = (which ? IMG_RT : IMG_KK) + s_ * 128 + ((ch ^ (s_ & 7)) << 4);
        } else if (c < 384) {
          const int cc = c - 256, s_ = cc >> 3, ch = cc & 7, g = ch & 3;
          const float* m0 = mt + (ch < 4 ? 4 : 2) * 256 + s_ * 16 + 4 * g;
          const float* m1 = mt + (ch < 4 ? 5 : 3) * 256 + s_ * 16 + 4 * g;
#pragma unroll
          for (int e_ = 0; e_ < 4; ++e_) { e[e_] = m0[e_]; e[4 + e_] = m1[e_]; }
          off = IMG_TR + s_ * 128 + ((ch ^ (s_ & 7)) << 4);
        } else {
          const int cc = c - 384, kc = cc >> 2, g = cc & 3;
#pragma unroll
          for (int e_ = 0; e_ < 4; ++e_) { e[e_] = t6[4096 + (4 * g + e_) * 64 + kc]; e[4 + e_] = t6[5120 + (4 * g + e_) * 64 + kc]; }
          const int row = kc & 31, ch = (kc >> 5) * 4 + g;
          off = IMG_BK + row * 128 + ((ch ^ (row & 7)) << 4);
        }
        uint4 v;
        v.x = pk_bf16(e[0], e[1]); v.y = pk_bf16(e[2], e[3]); v.z = pk_bf16(e[4], e[5]); v.w = pk_bf16(e[6], e[7]);
        *(uint4*)(img + off) = v;
      } else {
        const int k0 = (c - 640) * 4;
        *(float4*)(img + IMG_WL + k0 * 4) = *(const float4*)(Wc + (d * 16 + 15) * 64 + k0);
      }
    }
  }
  __syncthreads();
}

__device__ __forceinline__ float4 ld4f(const float* q) { return make_float4(q[0], q[1], q[2], q[3]); }
__device__ __forceinline__ f32x4 mm16(const float* X, const float* Y, int i, int g, bool neg_x_plus_eye) {
  f32x4 acc = f32x4{0.f, 0.f, 0.f, 0.f};
#pragma unroll
  for (int k4 = 0; k4 < 4; ++k4) {
    float a = X[i * MS + 4 * k4 + g];
    if (neg_x_plus_eye) a = ((i == 4 * k4 + g) ? 1.f : 0.f) - a;
    const float b = Y[(4 * k4 + g) * MS + i];
    acc = __builtin_amdgcn_mfma_f32_16x16x4f32(a, b, acc, 0, 0, 0);
  }
  return acc;
}
__device__ __forceinline__ void st16(float* M, const f32x4& v, int i, int g) {
#pragma unroll
  for (int r_ = 0; r_ < 4; ++r_) M[(4 * g + r_) * MS + i] = v[r_];
}
__device__ __forceinline__ void chunk_prep_wave(const Params& p, int mixer, int b, bool is_ctx, int t0, char* smem, int tid) {
  const int lane = tid & 63, w = tid >> 6, h = w & 3, d = w >> 2, i = lane & 15, g = lane >> 4;
  const char* vec = smem + VEC_OFF;
  float* Wc = (float*)(smem + w * 9728);
  float* M0 = Wc + 16 * WCS;
  float* M1 = M0 + 16 * MS;
  float* M2 = M1 + 16 * MS;
  float* M3 = M2 + 16 * MS;
  float* M4 = M3 + 16 * MS;
  char* img = img_ptr(p, mixer, d, b, h, tile_cidx(is_ctx, t0, d));
  const float* wv = (const float*)(vec + (d ? VEC_W1 : VEC_W0)) + h * 64;
  const bf16_t* vkk = (const bf16_t*)(vec + VEC_KK) + h * 64;
  const bf16_t* vr = (const bf16_t*)(vec + VEC_R) + h * 64;
  const bf16_t* vb = (const bf16_t*)(vec + (d ? VEC_B1 : VEC_B0)) + h * 64;
  const bf16_t* vkd = (const bf16_t*)(vec + (d ? VEC_KD1 : VEC_KD0)) + h * 64;
  {
    float acc = 1.f;
#pragma unroll
    for (int s_ = 0; s_ < 16; ++s_) {
      const int tok = d ? 15 - s_ : s_;
      acc *= wv[tok * 256 + lane];
      Wc[s_ * WCS + lane] = acc;
    }
  }
  {
    const int tok = d ? 15 - i : i;
    float KKT[16], RT[16], BT[16], KDT[16];
#pragma unroll
    for (int k4 = 0; k4 < 16; ++k4) {
      const int k = 4 * k4 + g;
      const float W = Wc[i * WCS + k];
      const float Wp = i ? Wc[(i - 1) * WCS + k] : 1.f;
      const float iW = __builtin_amdgcn_rcpf(W);
      KKT[k4] = bf2f(vkk[tok * VS + k]) * Wp;
      RT[k4] = bf2f(vr[tok * VS + k]) * W;
      BT[k4] = bf2f(vb[tok * VS + k]) * iW;
      KDT[k4] = bf2f(vkd[tok * VS + k]) * iW;
    }
    f32x4 aab = f32x4{0.f, 0.f, 0.f, 0.f}, aak = aab, rbb = aab, rkk = aab;
#pragma unroll
    for (int k4 = 0; k4 < 16; ++k4) {
      aab = __builtin_amdgcn_mfma_f32_16x16x4f32(KKT[k4], BT[k4], aab, 0, 0, 0);
      aak = __builtin_amdgcn_mfma_f32_16x16x4f32(KKT[k4], KDT[k4], aak, 0, 0, 0);
      rbb = __builtin_amdgcn_mfma_f32_16x16x4f32(RT[k4], BT[k4], rbb, 0, 0, 0);
      rkk = __builtin_amdgcn_mfma_f32_16x16x4f32(RT[k4], KDT[k4], rkk, 0, 0, 0);
    }
#pragma unroll
    for (int r_ = 0; r_ < 4; ++r_) {
      const int s_ = 4 * g + r_;
      const bool st = i < s_, inc = i <= s_;
      M0[s_ * MS + i] = st ? aab[r_] : 0.f;
      M1[s_ * MS + i] = st ? aak[r_] : 0.f;
      M2[s_ * MS + i] = inc ? rbb[r_] : 0.f;
      M3[s_ * MS + i] = inc ? rkk[r_] : 0.f;
    }
  }
  {
    const int s_ = lane >> 2, gg = lane & 3;
    const float4 x0 = ld4f(M2 + s_ * MS + 4 * gg), x1 = ld4f(M3 + s_ * MS + 4 * gg);
    uint4 v;
    v.x = pk_bf16(x0.x, x0.y); v.y = pk_bf16(x0.z, x0.w); v.z = pk_bf16(x1.x, x1.y); v.w = pk_bf16(x1.z, x1.w);
    *(uint4*)(img + IMG_TR + s_ * 128 + (((4 + gg) ^ (s_ & 7)) << 4)) = v;
  }
  {
    f32x4 P;
#pragma unroll
    for (int r_ = 0; r_ < 4; ++r_) { const int s_ = 4 * g + r_; P[r_] = ((s_ == i) ? 1.f : 0.f) - M0[s_ * MS + i]; }
    f32x4 X2 = mm16(M0, M0, i, g, false);
    st16(M2, X2, i, g);
    st16(M3, P, i, g);
    P += mm16(M3, M2, i, g, false);
    f32x4 X4 = mm16(M2, M2, i, g, false);
    st16(M4, X4, i, g);
    st16(M3, P, i, g);
    P += mm16(M3, M4, i, g, false);
    f32x4 X8 = mm16(M4, M4, i, g, false);
    st16(M2, X8, i, g);
    st16(M3, P, i, g);
    P += mm16(M3, M2, i, g, false);
    st16(M3, P, i, g);
    f32x4 Mm = mm16(M3, M1, i, g, false);
    st16(M2, Mm, i, g);
  }
  {
    const int s_ = lane >> 2, gg = lane & 3;
    const float4 x0 = ld4f(M3 + s_ * MS + 4 * gg), x1 = ld4f(M2 + s_ * MS + 4 * gg);
    uint4 v;
    v.x = pk_bf16(x0.x, x0.y); v.y = pk_bf16(x0.z, x0.w); v.z = pk_bf16(x1.x, x1.y); v.w = pk_bf16(x1.z, x1.w);
    *(uint4*)(img + IMG_TR + s_ * 128 + ((gg ^ (s_ & 7)) << 4)) = v;
  }
#pragma unroll
  for (int q = 0; q < 2; ++q) {
    const int cc = lane + 64 * q, s_ = cc >> 3, ch = cc & 7;
    const int tok = d ? 15 - s_ : s_;
    float ek[8], er[8];
#pragma unroll
    for (int e_ = 0; e_ < 8; ++e_) {
      const int k = colp(ch * 8 + e_);
      const float W = Wc[s_ * WCS + k];
      const float Wp = s_ ? Wc[(s_ - 1) * WCS + k] : 1.f;
      ek[e_] = bf2f(vkk[tok * VS + k]) * Wp;
      er[e_] = bf2f(vr[tok * VS + k]) * W;
    }
    uint4 v;
    v.x = pk_bf16(ek[0], ek[1]); v.y = pk_bf16(ek[2], ek[3]); v.z = pk_bf16(ek[4], ek[5]); v.w = pk_bf16(ek[6], ek[7]);
    *(uint4*)(img + IMG_KK + s_ * 128 + ((ch ^ (s_ & 7)) << 4)) = v;
    v.x = pk_bf16(er[0], er[1]); v.y = pk_bf16(er[2], er[3]); v.z = pk_bf16(er[4], er[5]); v.w = pk_bf16(er[6], er[7]);
    *(uint4*)(img + IMG_RT + s_ * 128 + ((ch ^ (s_ & 7)) << 4)) = v;
  }
#pragma unroll
  for (int q = 0; q < 4; ++q) {
    const int cc = lane + 64 * q, kc = cc >> 2, gg = cc & 3;
    const float WL = Wc[15 * WCS + kc];
    float e[8];
#pragma unroll
    for (int e_ = 0; e_ < 4; ++e_) {
      const int s_ = 4 * gg + e_, tok = d ? 15 - s_ : s_;
      const float f = WL * __builtin_amdgcn_rcpf(Wc[s_ * WCS + kc]);
      e[e_] = bf2f(vb[tok * VS + kc]) * f;
      e[4 + e_] = bf2f(vkd[tok * VS + kc]) * f;
    }
    const int row = kc & 31, ch = (kc >> 5) * 4 + gg;
    uint4 v;
    v.x = pk_bf16(e[0], e[1]); v.y = pk_bf16(e[2], e[3]); v.z = pk_bf16(e[4], e[5]); v.w = pk_bf16(e[6], e[7]);
    *(uint4*)(img + IMG_BK + row * 128 + ((ch ^ (row & 7)) << 4)) = v;
  }
  if (lane < 16) *(float4*)(img + IMG_WL + lane * 16) = ld4f(Wc + 15 * WCS + lane * 4);
}

constexpr int CVS = 1156;
__device__ __forceinline__ bf16x8 cv_frag(const float* q) {
  const float4 a = *(const float4*)q, b = *(const float4*)(q + 4);
  uint4 u; u.x = pk_bf16(a.x, a.y); u.y = pk_bf16(a.z, a.w); u.z = pk_bf16(b.x, b.y); u.w = pk_bf16(b.z, b.w);
  return __builtin_bit_cast(bf16x8, u);
}
struct RwFill { uint4 cu, pu, nu; float4 m0a, m0b, m1a, m1b; };
__device__ __forceinline__ void rw_fill_load(const Params& p, const float* mu, int r0, int tk, int ch, RwFill& f) {
  const int col = ch * 8;
  const int row = r0 + tk;
  int t, len; seq_pos(row, t, len);
  const bf16_t* src = p.P() + (size_t)row * INC + OFF_B + col;
  const uint4 zero4 = make_uint4(0u, 0u, 0u, 0u);
  f.cu = *(const uint4*)src;
  const bool hp = t > 0, hn = t < len - 1;
  const uint4 pu = *(const uint4*)(src - (hp ? INC : 0)), nu = *(const uint4*)(src + (hn ? INC : 0));
  f.pu = hp ? pu : zero4;
  f.nu = hn ? nu : zero4;
  f.m0a = *(const float4*)(mu + col); f.m0b = *(const float4*)(mu + col + 4);
  f.m1a = *(const float4*)(mu + 1152 + col); f.m1b = *(const float4*)(mu + 1152 + col + 4);
}
template <int ACT>
__device__ __forceinline__ void rw_fill_store(float* Cv, int tk, int ch, const RwFill& f) {
  const int col = ch * 8;
  float xc[8], xp[8], xn[8];
  unpack8(f.cu, xc); unpack8(f.pu, xp); unpack8(f.nu, xn);
  const float m0[8] = {f.m0a.x, f.m0a.y, f.m0a.z, f.m0a.w, f.m0b.x, f.m0b.y, f.m0b.z, f.m0b.w};
  const float m1[8] = {f.m1a.x, f.m1a.y, f.m1a.z, f.m1a.w, f.m1b.x, f.m1b.y, f.m1b.z, f.m1b.w};
  float o[8];
#pragma unroll
  for (int e = 0; e < 8; ++e) {
    float v = xc[e] * (1.0f - m0[e] - m1[e]) + xp[e] * m0[e] + xn[e] * m1[e];
    if (ACT == 1) v = tanhf_(v);
    if (ACT == 2) v = sigmoidf_(v);
    o[e] = v;
  }
  *(float4*)(Cv + tk * CVS + col) = make_float4(o[0], o[1], o[2], o[3]);
  *(float4*)(Cv + tk * CVS + col + 4) = make_float4(o[4], o[5], o[6], o[7]);
}
template <int RPM = 0>
__device__ __forceinline__ void chunk_rwprep(const Params& p, int l, char* smem, int wave_s) {
  const int tid0 = make_tid(wave_s);
  float* Cv = (float*)smem;
  char* vec = smem + VEC_OFF;
  const float* mu = p.rwkv_mu + (size_t)l * 2 * 1152;
  const bf16_t* LT = lorat(p, l);
  for (int tile = blockIdx.x; tile < NTOK / 16; tile += gridDim.x) {
    int tid = tid0; asm volatile("" : "+v"(tid));
    const int lane = tid & 63, w = tid >> 6, h = w & 3, i = lane & 15, g = lane >> 4;
    const int r0 = tile * 16;
    const bool is_ctx = r0 >= NLAT;
    const int b = is_ctx ? (r0 - NLAT) / NCX : r0 / NTL;
    const int t0 = is_ctx ? (r0 - NLAT) % NCX : r0 % NTL;
    {
      const int wu = __builtin_amdgcn_readfirstlane(tid >> 6);
      const int cidx = tid & 255;
      const int tkA = cidx >> 4, chA = (wu < 4 ? 96 : 128) + (cidx & 15);
      int tkP[4], chP[4];
#pragma unroll
      for (int q = 0; q < 4; ++q) { const int idx = min(tid + q * NTHREADS, 1791); tkP[q] = idx / 112; const int c = idx - tkP[q] * 112; chP[q] = c < 96 ? c : c + 16; }
      RwFill fa, f0, f1, f2, f3;
      rw_fill_load(p, mu, r0, tkA, chA, fa);
      rw_fill_load(p, mu, r0, tkP[0], chP[0], f0); rw_fill_load(p, mu, r0, tkP[1], chP[1], f1);
      rw_fill_load(p, mu, r0, tkP[2], chP[2], f2); rw_fill_load(p, mu, r0, tkP[3], chP[3], f3);
      __builtin_amdgcn_sched_barrier(0);
      if (wu < 4) rw_fill_store<1>(Cv, tkA, chA, fa); else rw_fill_store<2>(Cv, tkA, chA, fa);
      rw_fill_store<0>(Cv, tkP[0], chP[0], f0); rw_fill_store<0>(Cv, tkP[1], chP[1], f1);
      rw_fill_store<0>(Cv, tkP[2], chP[2], f2);
      if (wu < 4) rw_fill_store<0>(Cv, tkP[3], chP[3], f3);
    }
    const bool gate_wave = __builtin_amdgcn_readfirstlane(tid >> 6) >= 4;
    LDS_BAR();
    __builtin_amdgcn_sched_barrier(0);
    if (gate_wave) {
      f32x4 ag[4];
#pragma unroll
      for (int nt = 0; nt < 4; ++nt) ag[nt] = f32x4{0.f, 0.f, 0.f, 0.f};
      bf16x8 lf[16];
#pragma unroll
      for (int ks = 0; ks < 4; ++ks)
#pragma unroll
        for (int nt = 0; nt < 4; ++nt)
          lf[ks * 4 + nt] = *(const bf16x8*)(LT + 4 * 256 * 64 + (size_t)(h * 64 + nt * 16 + i) * 128 + ks * 32 + g * 8);
      __builtin_amdgcn_sched_barrier(0);
#pragma unroll
      for (int ks = 0; ks < 4; ++ks) {
        const bf16x8 af = cv_frag(Cv + i * CVS + 1024 + ks * 32 + g * 8);
#pragma unroll
        for (int nt = 0; nt < 4; ++nt) {
          ag[nt] = __builtin_amdgcn_mfma_f32_16x16x32_bf16(af, lf[ks * 4 + nt], ag[nt], 0, 0, 0);
        }
      }
#pragma unroll
      for (int nt = 0; nt < 4; ++nt)
#pragma unroll
        for (int r_ = 0; r_ < 4; ++r_) p.G16()[(size_t)(r0 + 4 * g + r_) * 256 + h * 64 + nt * 16 + i] = f2bf(ag[nt][r_]);
    } else {
      f32x4 aw0[4], aw1[4], aa0[4], aa1[4];
#pragma unroll
      for (int nt = 0; nt < 4; ++nt) { aw0[nt] = f32x4{0.f, 0.f, 0.f, 0.f}; aw1[nt] = aw0[nt]; aa0[nt] = aw0[nt]; aa1[nt] = aw0[nt]; }
#pragma unroll
      for (int ks = 0; ks < 2; ++ks) {
        bf16x8 lf[16];
#pragma unroll
        for (int nt = 0; nt < 4; ++nt) {
          const size_t co = (size_t)(h * 64 + nt * 16 + i) * 64 + ks * 32 + g * 8;
          lf[nt * 4 + 0] = *(const bf16x8*)(LT + co);
          lf[nt * 4 + 1] = *(const bf16x8*)(LT + 256 * 64 + co);
          lf[nt * 4 + 2] = *(const bf16x8*)(LT + 2 * 256 * 64 + co);
          lf[nt * 4 + 3] = *(const bf16x8*)(LT + 3 * 256 * 64 + co);
        }
        __builtin_amdgcn_sched_barrier(0);
        const bf16x8 fw0 = cv_frag(Cv + i * CVS + 768 + ks * 32 + g * 8), fw1 = cv_frag(Cv + i * CVS + 832 + ks * 32 + g * 8);
        const bf16x8 fa0 = cv_frag(Cv + i * CVS + 896 + ks * 32 + g * 8), fa1 = cv_frag(Cv + i * CVS + 960 + ks * 32 + g * 8);
#pragma unroll
        for (int nt = 0; nt < 4; ++nt) {
          aw0[nt] = __builtin_amdgcn_mfma_f32_16x16x32_bf16(fw0, lf[nt * 4 + 0], aw0[nt], 0, 0, 0);
          aw1[nt] = __builtin_amdgcn_mfma_f32_16x16x32_bf16(fw1, lf[nt * 4 + 1], aw1[nt], 0, 0, 0);
          aa0[nt] = __builtin_amdgcn_mfma_f32_16x16x32_bf16(fa0, lf[nt * 4 + 2], aa0[nt], 0, 0, 0);
          aa1[nt] = __builtin_amdgcn_mfma_f32_16x16x32_bf16(fa1, lf[nt * 4 + 3], aa1[nt], 0, 0, 0);
        }
        __builtin_amdgcn_sched_barrier(0);
      }
      if (RPM == 2) {
        float z = 0.f;
#pragma unroll
        for (int nt = 0; nt < 4; ++nt) z += aw0[nt][0] + aw1[nt][1] + aa0[nt][2] + aa1[nt][3];
        if (z == 123.456f) bonbuf(p)[0] = z;
      } else {
      float n2[4], bon[4];
#pragma unroll
      for (int r_ = 0; r_ < 4; ++r_) { n2[r_] = 0.f; bon[r_] = 0.f; }
#pragma unroll
      for (int nt = 0; nt < 4; ++nt) {
        const int c = h * 64 + nt * 16 + i;
        const float kkc = p.rwkv_kk[l * 256 + c];
#pragma unroll
        for (int r_ = 0; r_ < 4; ++r_) { const float kr = Cv[(4 * g + r_) * CVS + 256 + c] * kkc; n2[r_] += kr * kr; }
      }
#pragma unroll
      for (int r_ = 0; r_ < 4; ++r_) n2[r_] = FRSQ(reduce16(n2[r_]) + 1e-6f);
      char* vv0 = img_ptr(p, 0, 0, b, h, tile_cidx(is_ctx, t0, 0)) + IMG_VV;
      char* vv1 = img_ptr(p, 0, 1, b, h, tile_cidx(is_ctx, t0, 1)) + IMG_VV;
#pragma unroll
      for (int nt = 0; nt < 4; ++nt) {
        const int c = h * 64 + nt * 16 + i;
        const float w00 = p.rwkv_w0[(l * 2 + 0) * 256 + c], w01 = p.rwkv_w0[(l * 2 + 1) * 256 + c];
        const float a00 = p.rwkv_a0[(l * 2 + 0) * 256 + c], a01 = p.rwkv_a0[(l * 2 + 1) * 256 + c];
        const float kkc = p.rwkv_kk[l * 256 + c], kac = p.rwkv_ka[l * 256 + c], rkc = p.rwkv_rk[l * 256 + c];
#pragma unroll
        for (int r_ = 0; r_ < 4; ++r_) {
          const int tok = 4 * g + r_;
          const float r = Cv[tok * CVS + c], k = Cv[tok * CVS + 256 + c], v = Cv[tok * CVS + 512 + c];
          const float wd0 = FEXP(-sigmoidf_(w00 + aw0[nt][r_]) * 0.6065306597126334f);
          const float wd1 = FEXP(-sigmoidf_(w01 + aw1[nt][r_]) * 0.6065306597126334f);
          const float ad0 = sigmoidf_(a00 + aa0[nt][r_]), ad1 = sigmoidf_(a01 + aa1[nt][r_]);
          const float kk = k * kkc * n2[r_];
          const float kd0 = k * (1.0f + (ad0 - 1.0f) * kac), kd1 = k * (1.0f + (ad1 - 1.0f) * kac);
          bon[r_] += r * (kd0 + kd1) * rkc;
          ((float*)(vec + VEC_W0))[tok * 256 + c] = wd0; ((float*)(vec + VEC_W1))[tok * 256 + c] = wd1;
          ((bf16_t*)(vec + VEC_KK))[tok * VS + c] = f2bf(kk); ((bf16_t*)(vec + VEC_R))[tok * VS + c] = f2bf(r);
          ((bf16_t*)(vec + VEC_B0))[tok * VS + c] = f2bf(kk * ad0); ((bf16_t*)(vec + VEC_B1))[tok * VS + c] = f2bf(kk * ad1);
          ((bf16_t*)(vec + VEC_KD0))[tok * VS + c] = f2bf(kd0); ((bf16_t*)(vec + VEC_KD1))[tok * VS + c] = f2bf(kd1);
          const bf16_t vb = f2bf(v);
          *(bf16_t*)(vv0 + ((nt * 16 + i) * 16 + tok) * 2) = vb;
          *(bf16_t*)(vv1 + ((nt * 16 + i) * 16 + 15 - tok) * 2) = vb;
          rv16(p)[(size_t)(r0 + tok) * 256 + c] = vb;
        }
      }
#pragma unroll
      for (int r_ = 0; r_ < 4; ++r_) {
        const float bs = reduce16(bon[r_]);
        if (i == 0) bonbuf(p)[(size_t)(r0 + 4 * g + r_) * 4 + h] = bs;
      }
      }
    }
    LDS_BAR();
    if (RPM == 0) chunk_prep_wave(p, 0, b, is_ctx, t0, smem, tid);
    LDS_BAR();
  }
}

template <int PMODE = 0>
__device__ __forceinline__ void chunk_gdprep(const Params& p, int l, char* smem, int wave_s) {
  const int tid0 = make_tid(wave_s);
  char* vec = smem + VEC_OFF;
  const float* cw = p.gdn_conv + (size_t)l * 3 * 768;
  for (int tile = (int)((blockIdx.x + gridDim.x - (NTOK / 16) % gridDim.x) % gridDim.x); tile < NTOK / 16; tile += gridDim.x) {
    int tid = tid0; asm volatile("" : "+v"(tid));
    const int c = tid & 255, lane = tid & 63, h = c >> 6, tg = tid >> 8;
    float w0[3], w1[3], w2[3];
#pragma unroll
    for (int j = 0; j < 3; ++j) { w0[j] = cw[j * 256 + c]; w1[j] = cw[768 + j * 256 + c]; w2[j] = cw[1536 + j * 256 + c]; }
    const float nal0 = -FEXP(p.gdn_a_log[(l * 2 + 0) * 4 + h]), nal1 = -FEXP(p.gdn_a_log[(l * 2 + 1) * 4 + h]);
    const float dtb0 = p.gdn_dt_bias[(l * 2 + 0) * 4 + h], dtb1 = p.gdn_dt_bias[(l * 2 + 1) * 4 + h];
    const int r0 = tile * 16;
    const bool is_ctx = r0 >= NLAT;
    const int b = is_ctx ? (r0 - NLAT) / NCX : r0 / NTL;
    const int t0 = is_ctx ? (r0 - NLAT) % NCX : r0 % NTL;
    char* vv0 = img_ptr(p, 1, 0, b, h, tile_cidx(is_ctx, t0, 0)) + IMG_VV + lane * 32;
    char* vv1 = img_ptr(p, 1, 1, b, h, tile_cidx(is_ctx, t0, 1)) + IMG_VV + lane * 32;
    char* vbf = vec + (tg * 8 * 256 + c) * 4;
    char* vbh = vec + VEC_KK + (tg * 8 * VS + c) * 2;
    asm volatile("" : "+v"(vbf), "+v"(vbh));
    bf16_t* rawP = (bf16_t*)smem;
    constexpr int RPS = 792;
    {
      const int slen = is_ctx ? NCX : NTL;
#pragma unroll
      for (int q = 0; q < 4; ++q) {
        const int idx = tid + q * NTHREADS;
        if (idx < 18 * 98) {
          const int rr = idx / 98, ch = idx - rr * 98;
          const int t = t0 + rr - 1;
          uint4 v = make_uint4(0u, 0u, 0u, 0u);
          if (t >= 0 && t < slen) v = *(const uint4*)(p.P() + (size_t)(r0 + rr - 1) * INC + OFF_C + (ch < 96 ? ch * 8 : 1024 + (ch - 96) * 8));
          *(uint4*)(rawP + rr * RPS + ch * 8) = v;
        }
      }
    }
    LDS_BAR();
#pragma unroll
    for (int tt = 0; tt < (PMODE >= 2 ? 0 : 8); ++tt) {
      const int tok = tg * 8 + tt;
      const bf16_t* rp = rawP + (tok + 1) * RPS;
      float qkv[3];
#pragma unroll
      for (int j = 0; j < 3; ++j)
        qkv[j] = siluf_(bf2f(rp[-RPS + j * 256 + c]) * w0[j] + bf2f(rp[j * 256 + c]) * w1[j] + bf2f(rp[RPS + j * 256 + c]) * w2[j]);
      const float ab0 = bf2f(rp[768 + 0 * 4 + h]), ab1 = bf2f(rp[768 + 1 * 4 + h]), ab2 = bf2f(rp[768 + 8 + 0 * 4 + h]), ab3 = bf2f(rp[768 + 8 + 1 * 4 + h]);
      const float qn = qkv[0] * FRSQ(wsum(qkv[0] * qkv[0]) + 1e-6f) * 0.125f;
      const float kn = qkv[1] * FRSQ(wsum(qkv[1] * qkv[1]) + 1e-6f);
      const float eg0 = FEXP(nal0 * softplusf_(ab0 + dtb0)), eg1 = FEXP(nal1 * softplusf_(ab1 + dtb1));
      const float be0 = sigmoidf_(ab2), be1 = sigmoidf_(ab3);
      *(float*)(vbf + VEC_W0 + tt * 1024) = eg0; *(float*)(vbf + VEC_W1 + tt * 1024) = eg1;
      *(bf16_t*)(vbh + tt * (VS * 2)) = f2bf(kn); *(bf16_t*)(vbh + (VEC_R - VEC_KK) + tt * (VS * 2)) = f2bf(qn);
      *(bf16_t*)(vbh + (VEC_B0 - VEC_KK) + tt * (VS * 2)) = f2bf(be0 * eg0 * kn); *(bf16_t*)(vbh + (VEC_B1 - VEC_KK) + tt * (VS * 2)) = f2bf(be1 * eg1 * kn);
      *(bf16_t*)(vbh + (VEC_KD0 - VEC_KK) + tt * (VS * 2)) = f2bf(be0 * kn); *(bf16_t*)(vbh + (VEC_KD1 - VEC_KK) + tt * (VS * 2)) = f2bf(be1 * kn);
      const bf16_t vb = f2bf(qkv[2]);
      *(bf16_t*)(vv0 + tok * 2) = vb;
      *(bf16_t*)(vv1 + (15 - tok) * 2) = vb;
    }
    LDS_BAR();
    if (PMODE != 1) chunk_prep_wave(p, 1, b, is_ctx, t0, smem, tid);
    LDS_BAR();
  }
}

constexpr int SGRP = 4;
constexpr int SGRP_BYTES = SGRP * IMG_BYTES;
__device__ __forceinline__ void cs_group(const Params& p, bool last, const char* buf, int gi, f32x4 (&Sd)[4],
                                         int mixer, int d, int b, int h, int lane, int rho0) {
  const int i = lane & 15, g = lane >> 4, sw = i & 7;
#pragma unroll
    for (int cc = 0; cc < SGRP; ++cc) {
      const char* im = buf + cc * IMG_BYTES;
      const int cidx = gi * SGRP + cc;
      const bf16x8 bs0 = pack_p8(Sd[0], Sd[1]), bs1 = pack_p8(Sd[2], Sd[3]);
      const bf16x8 kk0 = *(const bf16x8*)(im + IMG_KK + i * 128 + (((0 + g) ^ sw) << 4));
      const bf16x8 kk1 = *(const bf16x8*)(im + IMG_KK + i * 128 + (((4 + g) ^ sw) << 4));
      const bf16x8 rt0 = *(const bf16x8*)(im + IMG_RT + i * 128 + (((0 + g) ^ sw) << 4));
      const bf16x8 rt1 = *(const bf16x8*)(im + IMG_RT + i * 128 + (((4 + g) ^ sw) << 4));
      const bf16x8 tm = *(const bf16x8*)(im + IMG_TR + i * 128 + (((0 + g) ^ sw) << 4));
      const bf16x8 rb = *(const bf16x8*)(im + IMG_TR + i * 128 + (((4 + g) ^ sw) << 4));
      const uint2 vraw = *(const uint2*)(im + IMG_VV + ((rho0 + i) * 16 + 4 * g) * 2);
      f32x4 zt = __builtin_amdgcn_mfma_f32_16x16x32_bf16(kk0, bs0, f32x4{0.f, 0.f, 0.f, 0.f}, 0, 0, 0);
      zt = __builtin_amdgcn_mfma_f32_16x16x32_bf16(kk1, bs1, zt, 0, 0, 0);
      f32x4 yt = __builtin_amdgcn_mfma_f32_16x16x32_bf16(rt0, bs0, f32x4{0.f, 0.f, 0.f, 0.f}, 0, 0, 0);
      yt = __builtin_amdgcn_mfma_f32_16x16x32_bf16(rt1, bs1, yt, 0, 0, 0);
      uint4 zv; zv.x = pk_bf16(zt[0], zt[1]); zv.y = pk_bf16(zt[2], zt[3]); zv.z = vraw.x; zv.w = vraw.y;
      f32x4 pt = __builtin_amdgcn_mfma_f32_16x16x32_bf16(tm, __builtin_bit_cast(bf16x8, zv), f32x4{0.f, 0.f, 0.f, 0.f}, 0, 0, 0);
      uint4 pv; pv.x = pk_bf16(-pt[0], -pt[1]); pv.y = pk_bf16(-pt[2], -pt[3]); pv.z = vraw.x; pv.w = vraw.y;
      const bf16x8 pvf = __builtin_bit_cast(bf16x8, pv);
      yt = __builtin_amdgcn_mfma_f32_16x16x32_bf16(rb, pvf, yt, 0, 0, 0);
#pragma unroll
      for (int m = 0; m < 4; ++m) {
        const int row = (16 * m + i) & 31, ch = (m >> 1) * 4 + g;
        const bf16x8 bk = *(const bf16x8*)(im + IMG_BK + row * 128 + ((ch ^ (row & 7)) << 4));
        const float4 wl = *(const float4*)(im + IMG_WL + (16 * m + 4 * g) * 4);
        f32x4 cin = Sd[m];
        cin[0] *= wl.x; cin[1] *= wl.y; cin[2] *= wl.z; cin[3] *= wl.w;
        Sd[m] = __builtin_amdgcn_mfma_f32_16x16x32_bf16(bk, pvf, cin, 0, 0, 0);
      }
      const bool is_ctx = cidx < NCX / 16;
      {
        const int j = is_ctx ? cidx : cidx - NCX / 16;
        const int tile = d == 0 ? j : (is_ctx ? NCX / 16 : NTL / 16) - 1 - j;
        const int rbase = (is_ctx ? NLAT + b * NCX : b * NTL) + tile * 16;
#pragma unroll
        for (int r_ = 0; r_ < 4; ++r_) {
          const int s_ = 4 * g + r_, tok = d ? 15 - s_ : s_;
          p.YS()[(size_t)(rbase + tok) * 1024 + mixer * 512 + d * 256 + h * 64 + rho0 + i] = f2bf(yt[r_]);
        }
      }
    }
}
__device__ __forceinline__ void chunk_scan(const Params& p, bool last, int task, char* smem, int tid) {
  const int mixer = task / (2 * NB * 4), rem = task % (2 * NB * 4);
  const int d = rem / (NB * 4), b = (rem / 4) % NB, h = rem % 4;
  const char* gimg = img_ptr(p, mixer, d, b, h, 0);
  const int lane = tid & 63, w = tid >> 6;
  const int rho0 = (w & 3) * 16;
  const bool computes = __builtin_amdgcn_readfirstlane(tid >> 6) < 4;
  f32x4 Sd[4];
#pragma unroll
  for (int m = 0; m < 4; ++m) Sd[m] = f32x4{0.f, 0.f, 0.f, 0.f};
  uint4 sa0, sa1, sa2, sa3, sa4, sa5, sa6, sb0, sb1, sb2, sb3, sb4, sb5, sb6;
  const int ngrp = NCHK / SGRP;
#define CS_PC(q) min(tid + (q) * NTHREADS, SGRP_BYTES / 16 - 1)
#define CS_LD1(gi, q, dst) dst = *(const uint4*)(gimg + (size_t)min((gi), ngrp - 1) * SGRP_BYTES + CS_PC(q) * 16);
#define CS_ST1(bi, q, srcv) *(uint4*)(smem + (bi) * SGRP_BYTES + CS_PC(q) * 16) = srcv;
#define CS_LOAD(gi, s_) { CS_LD1(gi, 0, s_##0) CS_LD1(gi, 1, s_##1) CS_LD1(gi, 2, s_##2) CS_LD1(gi, 3, s_##3) CS_LD1(gi, 4, s_##4) CS_LD1(gi, 5, s_##5) CS_LD1(gi, 6, s_##6) }
#define CS_STORE(bi, s_) { CS_ST1(bi, 0, s_##0) CS_ST1(bi, 1, s_##1) CS_ST1(bi, 2, s_##2) CS_ST1(bi, 3, s_##3) CS_ST1(bi, 4, s_##4) CS_ST1(bi, 5, s_##5) CS_ST1(bi, 6, s_##6) }
#define CS_BAR() { asm volatile("s_waitcnt lgkmcnt(0)" ::: "memory"); __builtin_amdgcn_s_barrier(); asm volatile("" ::: "memory"); }
#define CS_LOOP(COMPUTE_) { \
    CS_LOAD(0, sa); CS_LOAD(1, sb); CS_STORE(0, sa); CS_BAR(); \
    for (int gi = 0; gi < ngrp; gi += 2) { \
      CS_LOAD(gi + 2, sa); __builtin_amdgcn_sched_barrier(0); \
      COMPUTE_(gi) \
      __builtin_amdgcn_sched_barrier(0); CS_STORE((gi + 1) % 3, sb); CS_BAR(); \
      CS_LOAD(gi + 3, sb); __builtin_amdgcn_sched_barrier(0); \
      COMPUTE_(gi + 1) \
      __builtin_amdgcn_sched_barrier(0); CS_STORE((gi + 2) % 3, sa); CS_BAR(); \
    } }
#define CS_DO(g_) cs_group(p, last, smem + ((g_) % 3) * SGRP_BYTES, (g_), Sd, mixer, d, b, h, lane, rho0);
#define CS_SKIP(g_)
  static_assert((NCHK / SGRP) % 2 == 0, "group loop is unrolled by two");
  if (computes) CS_LOOP(CS_DO) else CS_LOOP(CS_SKIP)
#undef CS_LOOP
#undef CS_DO
#undef CS_SKIP
#undef CS_PC
#undef CS_LOAD
#undef CS_STORE
#undef CS_LD1
#undef CS_ST1
#undef CS_BAR
}

__device__ __forceinline__ void chunk_post(const Params& p, int l, int nr, int wave_s) {
  for (int row = blockIdx.x * 8 + wave_s; row < nr; row += gridDim.x * 8) {
    const int lane = make_tid(wave_s) & 63;
    const int c0 = lane * 4, h = lane >> 4;
    const bf16_t* ys = p.YS() + (size_t)row * 1024;
    bf16_t* yo = p.Y() + (size_t)row * DM;
    {
      const float4 y0 = ld4(ys + c0), y1 = ld4(ys + 256 + c0);
      const float4 gq = ld4(p.G16() + (size_t)row * 256 + c0), vq = ld4(rv16(p) + (size_t)row * 256 + c0);
      const float4 lg = *(const float4*)(p.rwkv_ln_g + l * 256 + c0), lb = *(const float4*)(p.rwkv_ln_b + l * 256 + c0);
      const float bon = bonbuf(p)[(size_t)row * 4 + h];
      float y[4] = {y0.x + y1.x, y0.y + y1.y, y0.z + y1.z, y0.w + y1.w};
      const float m = reduce16((y[0] + y[1]) + (y[2] + y[3])) * (1.0f / 64);
      float dd[4] = {y[0] - m, y[1] - m, y[2] - m, y[3] - m};
      const float rstd = 1.0f / sqrtf(reduce16((dd[0] * dd[0] + dd[1] * dd[1]) + (dd[2] * dd[2] + dd[3] * dd[3])) * (1.0f / 64) + 64e-5f);
      uint2 o;
      o.x = pk_bf16((dd[0] * rstd * lg.x + lb.x + bon * vq.x) * gq.x, (dd[1] * rstd * lg.y + lb.y + bon * vq.y) * gq.y);
      o.y = pk_bf16((dd[2] * rstd * lg.z + lb.z + bon * vq.z) * gq.z, (dd[3] * rstd * lg.w + lb.w + bon * vq.w) * gq.w);
      *(uint2*)(yo + 256 + c0) = o;
    }
    {
      const float4 o0 = ld4(ys + 512 + c0), o1 = ld4(ys + 768 + c0);
      const float4 gt = ld4(p.P() + (size_t)row * INC + OFF_C + 768 + c0);
      const float4 ng = *(const float4*)(p.gdn_norm_g + l * 64 + (c0 & 63));
      float o[4] = {o0.x + o1.x, o0.y + o1.y, o0.z + o1.z, o0.w + o1.w};
      const float rs = 1.0f / sqrtf(reduce16((o[0] * o[0] + o[1] * o[1]) + (o[2] * o[2] + o[3] * o[3])) * (1.0f / 64) + 1e-6f);
      uint2 r;
      r.x = pk_bf16(o[0] * rs * ng.x * siluf_(gt.x), o[1] * rs * ng.y * siluf_(gt.y));
      r.y = pk_bf16(o[2] * rs * ng.z * siluf_(gt.z), o[3] * rs * ng.w * siluf_(gt.w));
      *(uint2*)(yo + 512 + c0) = r;
    }
  }
}

template <int MMODE = 0>
__device__ __forceinline__ void fast_mixers(const Params& p, int l, char* smem, int wave_s) {
  const int np = 2 * (2 * NB * 4);
  const int nb = gridDim.x;
  if (MMODE != 2) {
    for (int t = blockIdx.x; t < np; t += nb) { int tid = make_tid(wave_s); chunk_scan(p, l == 1, t, smem, tid); }
  }
  if (MMODE != 1) {
    const int nA = NB * 4 * (NTL / 256) + (l == 0 ? NB * 4 * (NCX / 256) : 0);
    const int nD = (NB * 4 * GROWS + (l == 0 ? NB * 4 * (NCX / 64) : 0)) / 2;
    unsigned* ctr = p.bar() + 16 + 16 * l + (MMODE == 2 ? 8 : 0);
    volatile int* slot = (volatile int*)(smem + 160256 + 8);
    for (;;) {
      LDS_BAR();
      if (make_tid(wave_s) == 0) *slot = (int)xb_add(ctr, 1u);
      LDS_BAR();
      const int t = __builtin_amdgcn_readfirstlane(*slot);
      if (t >= nA + nD) break;
      const int tid = make_tid(wave_s);
      if (t < nA) attnA_task(p, l, t, smem, tid);
      else attnD_pair(p, l, t - nA, smem, tid);
    }
  }
}

template <int PH>
__device__ __forceinline__ void run_phase(const Params& p, int l) {
  long n = phase_items(PH, l);
  int tid = threadIdx.x;
  long gtid = (long)(blockIdx.x * NTHREADS + tid);
  long nth = (long)(gridDim.x * NTHREADS);
  for (long i = gtid; i < n; i += nth) phase_item<PH>(p, l, i);
}

#define ITEM_LOOP(n_, ...)                                            \
  {                                                                  \
    int tid_ = threadIdx.x;                                          \
    asm volatile("" : "+v"(tid_));                                   \
    long nth_ = (long)(gridDim.x * NTHREADS);                        \
    for (long i = (long)(blockIdx.x * NTHREADS + tid_); i < (n_); i += nth_) __VA_ARGS__ \
  }
#if MEGA == 1
__global__ void __launch_bounds__(NTHREADS) fwd_megakernel(Params p) {
  __shared__ __attribute__((aligned(16))) char smem[160256 + 16];
#define xb_words (*(uint4*)(smem + 160256))
  cg::grid_group grid = cg::this_grid();
  const int wave_s = __builtin_amdgcn_readfirstlane((int)(threadIdx.x >> 6));
  if (threadIdx.x == 0) xb_words = make_uint4(0u, 0u, 0u, 0u);
  __syncthreads();
  (void)xcd_barrier_post(p.bar(), (volatile LAS unsigned*)&xb_words);
#define GSYNC() { XcdBarrier xb_; xb_.bar = p.bar(); xb_.x = xb_xcc_id(); xb_.st = (volatile LAS unsigned*)&xb_words; xcd_barrier(xb_, wave_s); }
  fast_ada(p, smem, wave_s);
  conv_lora(p, wave_s);
  conv_weights(p, smem, wave_s);
  conv_tables(p, 0, wave_s);
#if PROBE_DUP & 16384
  conv_tables(p, 0, wave_s);
#endif
#if PROBE_DUP & 32768
  conv_weights(p, smem, wave_s);
  fast_ada(p, smem, wave_s);
#endif
  grid.sync();
  fast_ln1(p, 0, wave_s); GSYNC();
  for (int l = 0; l < 2; ++l) {
    const int nr = rows_out(l);
    if (l == 1) conv_tables(p, 1, wave_s);
    gemm_phase<256>(p.Y(), DM, wbt_in(p, l), INC, p.P(), INC, NTOK, smem, wave_s); GSYNC();
#if PROBE_DUP & 1
    gemm_phase<256>(p.Y(), DM, wbt_in(p, l), INC, p.P(), INC, NTOK, smem, wave_s); GSYNC();
#endif
    fast_attprep(p, smem, wave_s);
    chunk_rwprep(p, l, smem, wave_s);
    chunk_gdprep(p, l, smem, wave_s);
#if PROBE_DUP & 32
    chunk_rwprep<1>(p, l, smem, wave_s);
#endif
#if PROBE_DUP & 524288
    chunk_rwprep<2>(p, l, smem, wave_s);
#endif
#if PROBE_DUP & 64
    chunk_gdprep(p, l, smem, wave_s);
#endif
#if PROBE_DUP & 128
    chunk_gdprep<1>(p, l, smem, wave_s);
#endif
#if PROBE_DUP & 256
    chunk_gdprep<2>(p, l, smem, wave_s);
#endif
#if PROBE_DUP & 512
    chunk_gdprep<3>(p, l, smem, wave_s);
#endif
    GSYNC();
    fast_mixers(p, l, smem, wave_s); GSYNC();
#if PROBE_DUP & 2
    fast_mixers(p, l, smem, wave_s); GSYNC();
#endif
#if PROBE_DUP & 1024
    fast_mixers<1>(p, l, smem, wave_s); GSYNC();
#endif
#if PROBE_DUP & 2048
    fast_mixers<2>(p, l, smem, wave_s); GSYNC();
#endif
    chunk_post(p, l, nr, wave_s); GSYNC();
#if PROBE_DUP & 4096
    chunk_post(p, l, nr, wave_s); GSYNC();
#endif
#if PROBE_DUP & 8192
    GSYNC(); GSYNC(); GSYNC(); GSYNC();
#endif
    gemm_phase<128>(p.Y(), DM, wbt_out(p, l), DM, (bf16_t*)p.RW(), DM, nr, smem, wave_s); GSYNC();
    fast_pn1(p, l, nr, wave_s); GSYNC();
    gemm_phase<128>(p.Y(), DM, wbt_q(p, l), 2048, peerQ(p), 2048, nr, smem, wave_s); GSYNC();
#if PROBE_DUP & 8
    gemm_phase<128>(p.Y(), DM, wbt_q(p, l), 2048, peerQ(p), 2048, nr, smem, wave_s); GSYNC();
#endif
    select_phase(p, l, nr, smem, wave_s); GSYNC();
#if PROBE_DUP & 16
    select_phase(p, l, nr, smem, wave_s); GSYNC();
#endif
    expert_u_phase(p, l, nr, wave_s, smem); GSYNC();
#if PROBE_DUP & 65536
    expert_u_phase(p, l, nr, wave_s, smem); GSYNC();
#endif
    expert_phase(p, l, nr, wave_s); GSYNC();
  }
}
#elif MEGA == 0
template <int PH>
__global__ void __launch_bounds__(256) phase_kernel(Params p, int l) {
  run_phase<PH>(p, l);
}
template <int PH>
static void launch_phase(const Params& p, int l, hipStream_t stream) {
  long n = phase_items(PH, l);
  if (n <= 0) return;
  long blocks = (n + 255) / 256;
  if (blocks > 8192) blocks = 8192;
  hipLaunchKernelGGL(phase_kernel<PH>, dim3((unsigned)blocks), dim3(256), 0, stream, p, l);
}
#endif

extern "C" void kernel_launch(void* const* d_in, const int* in_sizes, int n_in, void* d_out, int out_size, void* d_ws,
                              size_t ws_size, hipStream_t stream) {
  Params p{};
  const float** pin = (const float**)&p;
  for (int i = 0; i < 34; ++i) pin[i] = (const float*)d_in[i];
  p.out = (float*)d_out;
  if (ws_size < WS_END) return;
  p.ws = (char*)d_ws;
#if MEGA == 1
  static int grid_blocks = 0;
  if (!grid_blocks) {
    int dev = 0, cus = 0, per_cu = 0;
    hipGetDevice(&dev);
    hipDeviceGetAttribute(&cus, hipDeviceAttributeMultiprocessorCount, dev);
    hipOccupancyMaxActiveBlocksPerMultiprocessor(&per_cu, fwd_megakernel, NTHREADS, 0);
    if (per_cu > 1) per_cu = 1;
    grid_blocks = cus * per_cu;
  }
  (void)hipMemsetAsync(p.bar(), 0, WS_BAR_BYTES, stream);
  void* args[] = {&p};
  (void)hipLaunchCooperativeKernel((void*)fwd_megakernel, dim3(grid_blocks), dim3(NTHREADS), args, 0, stream);
#elif MEGA == 0
  launch_phase<PH_ADA>(p, 0, stream);
  for (int l = 0; l < 2; ++l) {
    launch_phase<PH_LN1>(p, l, stream);
    launch_phase<PH_GEMM_IN>(p, l, stream);
    launch_phase<PH_ROPE>(p, l, stream);
    launch_phase<PH_MIX>(p, l, stream);
    launch_phase<PH_GDPREP>(p, l, stream);
    launch_phase<PH_SCAN>(p, l, stream);
    launch_phase<PH_POST>(p, l, stream);
    launch_phase<PH_GEMM_OUT>(p, l, stream);
    launch_phase<PH_PN1>(p, l, stream);
    launch_phase<PH_GEMM_Q>(p, l, stream);
    launch_phase<PH_TOPK1>(p, l, stream);
    launch_phase<PH_TOPK2>(p, l, stream);
    launch_phase<PH_ACT>(p, l, stream);
    launch_phase<PH_FFN>(p, l, stream);
    launch_phase<PH_PN2>(p, l, stream);
  }
#endif
}
#endif
```

```cpp
#ifndef CPU_EMU
#include <hip/hip_runtime.h>
#include <hip/hip_cooperative_groups.h>
namespace cg = cooperative_groups;
#define DEVFN __device__ __forceinline__
#define HDFN __host__ __device__ __forceinline__
#define MEMFN __host__ __device__ __forceinline__
#define LOAD_FENCE() asm volatile("" ::: "memory")
#define LDS_BAR() { asm volatile("s_waitcnt lgkmcnt(0)" ::: "memory"); __builtin_amdgcn_s_barrier(); asm volatile("" ::: "memory"); }
#else
#include <cmath>
#include <cstdio>
#include <cstdlib>
#include <cstring>
#define DEVFN static inline
#define HDFN static inline
#define MEMFN inline
#define LOAD_FENCE()
struct float4 { float x, y, z, w; };
static inline float4 make_float4(float a, float b, float c, float d) { float4 r{a, b, c, d}; return r; }
#endif

#ifndef MEGA
#define MEGA 1
#endif
#ifndef PROBE_DUP
#define PROBE_DUP 0
#endif
#ifndef K_B
#define K_B 4
#define K_T 4096
#define K_C 256
#endif

typedef unsigned short bf16_t;
constexpr int NB = K_B, NTL = K_T, NCX = K_C;
constexpr int DM = 1024;
constexpr int NLAT = NB * NTL, NCTX = NB * NCX, NTOK = NLAT + NCTX;
constexpr int GROWS = NTL / 64;
constexpr int INC = 3728;
constexpr int OFF_A = 0, OFF_B = 768, OFF_C = 1920, OFF_D = 2960;
constexpr int RWS = 2560;
constexpr int GPS = 784;
constexpr int RWREC = 648;
constexpr int GDREC = 200;
constexpr int NMODV = NB + 1;
constexpr float DN_ALPHA = 1.4142135623730951f;
constexpr float LN_EPS = 1e-5f;

constexpr size_t al256(size_t x) { return (x + 255) & ~(size_t)255; }
constexpr size_t WS_MOD = 0;
constexpr size_t WS_HCTX = al256(WS_MOD + (size_t)2 * NMODV * 6144 * 4);
constexpr size_t WS_Y = al256(WS_HCTX + (size_t)NCTX * DM * 4);
constexpr size_t WS_P = al256(WS_Y + (size_t)NTOK * DM * 2);
constexpr size_t WS_RW = al256(WS_P + (size_t)NTOK * INC * 2);
constexpr size_t WS_GP = al256(WS_RW + (size_t)NTOK * (RWS > 4 * RWREC ? RWS : 4 * RWREC) * 4);
constexpr size_t WS_YS = al256(WS_GP + (size_t)NTOK * (GPS > 4 * GDREC ? GPS : 4 * GDREC) * 4);
constexpr size_t WS_TB = al256(WS_YS + (size_t)NTOK * 1024 * 2);
constexpr size_t WS_G16 = al256(WS_TB + (size_t)2 * 16384 * 1024 * 2);
constexpr size_t WS_VT = al256(WS_G16 + (size_t)NTOK * 256 * 2);
constexpr size_t WS_BAR = al256(WS_VT + (size_t)2 * NB * 4 * 64 * (NTL + NCX) * 2);
constexpr size_t WS_BAR_BYTES = 3456 * 4;
constexpr size_t WS_END = al256(WS_BAR + WS_BAR_BYTES);
struct Params {
  const float *x, *c, *ctx, *c_ctx, *w_ada, *b_ada, *w_in, *w_out, *ln_mix_g, *ln_mix_b, *ln_ffn_g, *ln_ffn_b;
  const float *diff_lam, *diff_norm_g, *rwkv_mu, *rwkv_w0, *rwkv_w2, *rwkv_a0, *rwkv_a2, *rwkv_g2;
  const float *rwkv_kk, *rwkv_ka, *rwkv_rk, *rwkv_ln_g, *rwkv_ln_b, *gdn_conv, *gdn_a_log, *gdn_dt_bias;
  const float *gdn_norm_g, *nat_rpb, *peer_wq, *peer_keys, *peer_u, *peer_v;
  float *out;
  char *ws;
  MEMFN float* mod() const { return (float*)(ws + WS_MOD); }
  MEMFN float* hctx() const { return (float*)(ws + WS_HCTX); }
  MEMFN float* RW() const { return (float*)(ws + WS_RW); }
  MEMFN float* GP() const { return (float*)(ws + WS_GP); }
  MEMFN bf16_t* Y() const { return (bf16_t*)(ws + WS_Y); }
  MEMFN bf16_t* P() const { return (bf16_t*)(ws + WS_P); }
  MEMFN bf16_t* YS() const { return (bf16_t*)(ws + WS_YS); }
  MEMFN bf16_t* TB() const { return (bf16_t*)(ws + WS_TB); }
  MEMFN bf16_t* WBT() const { return (bf16_t*)(ws + WS_TB + (size_t)2 * 16384 * 1024); }
  MEMFN bf16_t* G16() const { return (bf16_t*)(ws + WS_G16); }
  MEMFN bf16_t* VT() const { return (bf16_t*)(ws + WS_VT); }
  MEMFN unsigned* bar() const { return (unsigned*)(ws + WS_BAR); }
};

DEVFN float bf2f(bf16_t v) {
  unsigned u = (unsigned)v << 16; float f;
#ifdef CPU_EMU
  memcpy(&f, &u, 4);
#else
  f = __uint_as_float(u);
#endif
  return f;
}
DEVFN bf16_t f2bf(float f) {
#if !defined(CPU_EMU) && defined(__HIP_DEVICE_COMPILE__)
  typedef __attribute__((ext_vector_type(2))) float f2bf_f2; typedef __attribute__((ext_vector_type(2))) __bf16 f2bf_b2;
  const f2bf_f2 v = {f, 0.f};
  return (bf16_t)(__builtin_bit_cast(unsigned, __builtin_convertvector(v, f2bf_b2)) & 0xffffu);
#else
  unsigned u;
#ifdef CPU_EMU
  memcpy(&u, &f, 4);
#else
  u = __float_as_uint(f);
#endif
  u += 0x7fffu + ((u >> 16) & 1u);
  return (bf16_t)(u >> 16);
#endif
}
DEVFN float4 ld4(const bf16_t* p) {
  const unsigned* q = (const unsigned*)p;
  unsigned a = q[0], b = q[1];
  unsigned x0 = a << 16, x1 = a & 0xffff0000u, x2 = b << 16, x3 = b & 0xffff0000u;
  float4 r;
#ifdef CPU_EMU
  memcpy(&r.x, &x0, 4); memcpy(&r.y, &x1, 4); memcpy(&r.z, &x2, 4); memcpy(&r.w, &x3, 4);
#else
  r.x = __uint_as_float(x0); r.y = __uint_as_float(x1); r.z = __uint_as_float(x2); r.w = __uint_as_float(x3);
#endif
  return r;
}

#ifdef CPU_EMU
#define FEXP expf
#define FLOG logf
#define FSIN sinf
#define FCOS cosf
#define FRCP(x) (1.0f / (x))
#define FRSQ(x) (1.0f / sqrtf(x))
#else
#define FEXP __expf
#define FLOG __logf
#define FSIN __sinf
#define FCOS __cosf
#define FRCP(x) __builtin_amdgcn_rcpf(x)
#define FRSQ(x) __builtin_amdgcn_rsqf(x)
#endif
DEVFN float sigmoidf_(float x) { return FRCP(1.0f + FEXP(-x)); }
DEVFN float siluf_(float x) { return x * FRCP(1.0f + FEXP(-x)); }
DEVFN float softplusf_(float x) { return fmaxf(x, 0.f) + FLOG(1.0f + FEXP(-fabsf(x))); }
DEVFN float tanhf_(float x) { float e = FEXP(2.0f * x); return 1.0f - 2.0f * FRCP(e + 1.0f); }
DEVFN float geluf_(float x) { return 0.5f * x * (1.0f + erff(x * 0.70710678118654752f)); }

DEVFN int modv_of_row(int row) { return row < NLAT ? row / NTL : NB; }
DEVFN const float* hsrc_row(const Params& p, int l, int row) {
  if (row < NLAT) return (l == 0 ? p.x : p.out) + (size_t)row * DM;
  return (l == 0 ? p.ctx : p.hctx()) + (size_t)(row - NLAT) * DM;
}
DEVFN float* hdst_row(const Params& p, int row) {
  if (row < NLAT) return p.out + (size_t)row * DM;
  return p.hctx() + (size_t)(row - NLAT) * DM;
}
DEVFN void seq_pos(int row, int& t, int& len) {
  if (row < NLAT) { t = row % NTL; len = NTL; } else { t = (row - NLAT) % NCX; len = NCX; }
}

DEVFN void ph_ada(const Params& p, long item) {
  int l = (int)(item / 6144), j = (int)(item % 6144);
  float acc[NMODV];
#pragma unroll
  for (int v = 0; v < NMODV; ++v) acc[v] = 0.f;
  for (int i = 0; i < DM; ++i) {
    float w = p.w_ada[((size_t)l * DM + i) * 6144 + j];
#pragma unroll
    for (int v = 0; v < NB; ++v) acc[v] += siluf_(p.c[v * DM + i]) * w;
    acc[NB] += siluf_(p.c_ctx[i]) * w;
  }
  float bb = p.b_ada[l * 6144 + j];
#pragma unroll
  for (int v = 0; v < NMODV; ++v) p.mod()[((size_t)l * NMODV + v) * 6144 + j] = acc[v] + bb;
}

DEVFN void row_stats(const float* r, float& mu, float& rstd) {
  float s = 0.f;
  for (int i = 0; i < DM; ++i) s += r[i];
  mu = s * (1.0f / DM);
  float v = 0.f;
  for (int i = 0; i < DM; ++i) { float d = r[i] - mu; v += d * d; }
  rstd = 1.0f / sqrtf(v * (1.0f / DM) + LN_EPS);
}

DEVFN void ph_ln1(const Params& p, int l, long item) {
  int row = (int)item;
  const float* src = hsrc_row(p, l, row);
  const float* m = p.mod() + ((size_t)l * NMODV + modv_of_row(row)) * 6144;
  float mu, rstd;
  row_stats(src, mu, rstd);
  bf16_t* dst = p.Y() + (size_t)row * DM;
  for (int i = 0; i < DM; ++i) dst[i] = f2bf((src[i] - mu) * rstd * (1.0f + m[1024 + i]) + m[i]);
}

DEVFN void gemm_item(const bf16_t* A, int lda, const float* Bw, int ldb, bf16_t* C, int ldc, int N, int K, long item) {
  int ntn = N / 4;
  int mt = (int)(item / ntn), nt = (int)(item % ntn);
  int r0 = mt * 4, c0 = nt * 4;
  float acc[4][4];
#pragma unroll
  for (int i = 0; i < 4; ++i)
#pragma unroll
    for (int j = 0; j < 4; ++j) acc[i][j] = 0.f;
  for (int k = 0; k < K; k += 4) {
    float4 a[4], b[4];
#pragma unroll
    for (int i = 0; i < 4; ++i) a[i] = ld4(A + (size_t)(r0 + i) * lda + k);
#pragma unroll
    for (int kk = 0; kk < 4; ++kk) b[kk] = *(const float4*)(Bw + (size_t)(k + kk) * ldb + c0);
#pragma unroll
    for (int i = 0; i < 4; ++i) {
      float av[4] = {a[i].x, a[i].y, a[i].z, a[i].w};
#pragma unroll
      for (int kk = 0; kk < 4; ++kk) {
        acc[i][0] += av[kk] * b[kk].x;
        acc[i][1] += av[kk] * b[kk].y;
        acc[i][2] += av[kk] * b[kk].z;
        acc[i][3] += av[kk] * b[kk].w;
      }
    }
  }
#pragma unroll
  for (int i = 0; i < 4; ++i)
#pragma unroll
    for (int j = 0; j < 4; ++j) C[(size_t)(r0 + i) * ldc + c0 + j] = f2bf(acc[i][j]);
}

DEVFN void ph_rope(const Params& p, long item) {
  int token = (int)(item / 256), j = (int)(item % 256);
  int which = j / 128, jj = j % 128, h = jj / 32, pr = jj % 32, blk = pr / 8, i = pr % 8;
  int t = token % NTL;
  int pos = (blk & 1) ? (t % 64) : (t / 64);
  float inv = expf(-(float)i * (9.210340371976184f / 8.0f));
  float ang = (float)pos * inv;
  float cs = FCOS(ang), sn = FSIN(ang);
  bf16_t* base = p.P() + (size_t)token * INC + OFF_A + which * 256 + h * 64 + blk * 16;
  float x1 = bf2f(base[i]), x2 = bf2f(base[i + 8]);
  base[i] = f2bf(x1 * cs - x2 * sn);
  base[i + 8] = f2bf(x1 * sn + x2 * cs);
}

DEVFN float dot32(const bf16_t* q, const bf16_t* k) {
  float s = 0.f;
#pragma unroll
  for (int d = 0; d < 32; d += 4) {
    float4 kv = ld4(k + d);
    float4 qv = ld4(q + d);
    s += qv.x * kv.x + qv.y * kv.y + qv.z * kv.z + qv.w * kv.w;
    if ((d & 15) == 12) LOAD_FENCE();
  }
  return s;
}

DEVFN void mixA_item(const Params& p, int l, int b, int h, int qrow, bool lat) {
  const float* lv = p.diff_lam + l * 128;
  float d01 = 0.f, d23 = 0.f;
#pragma unroll 4
  for (int i = 0; i < 32; ++i) { d01 += lv[i] * lv[32 + i]; d23 += lv[64 + i] * lv[96 + i]; }
  float lam_init = 0.8f - 0.6f * expf(-0.3f * (float)l);
  float lam = expf(d01) - expf(d23) + lam_init;
  const float scale = 0.17677669529663687f;
  const bf16_t* q = p.P() + (size_t)qrow * INC + OFF_A + h * 64;
  int nlat = lat ? NTL : 0;
  int nk = nlat + NCX;
  float m1 = -1e30f, l1 = 0.f, m2 = -1e30f, l2 = 0.f;
  for (int j = 0; j < nk; ++j) {
    int krow = j < nlat ? b * NTL + j : NLAT + b * NCX + (j - nlat);
    const bf16_t* kp = p.P() + (size_t)krow * INC + OFF_A + 256 + h * 64;
    float s1 = dot32(q, kp) * scale, s2 = dot32(q + 32, kp + 32) * scale;
    float n1 = fmaxf(m1, s1); l1 = l1 * expf(m1 - n1) + expf(s1 - n1); m1 = n1;
    float n2 = fmaxf(m2, s2); l2 = l2 * expf(m2 - n2) + expf(s2 - n2); m2 = n2;
  }
  float i1 = 1.0f / l1, i2 = lam / l2;
  bf16_t* yp = p.Y() + (size_t)qrow * DM + 0 + h * 64;
  float ss = 0.f;
  for (int dh = 0; dh < 2; ++dh) {
    float o[32];
#pragma unroll
    for (int d = 0; d < 32; ++d) o[d] = 0.f;
    for (int j = 0; j < nk; ++j) {
      int krow = j < nlat ? b * NTL + j : NLAT + b * NCX + (j - nlat);
      const bf16_t* kp = p.P() + (size_t)krow * INC + OFF_A + 256 + h * 64;
      float s1 = dot32(q, kp) * scale, s2 = dot32(q + 32, kp + 32) * scale;
      float pw = expf(s1 - m1) * i1 - expf(s2 - m2) * i2;
      const bf16_t* vp = kp + 256 + dh * 32;
#pragma unroll
      for (int d = 0; d < 32; d += 4) {
        float4 vv = ld4(vp + d);
        o[d] += pw * vv.x; o[d + 1] += pw * vv.y; o[d + 2] += pw * vv.z; o[d + 3] += pw * vv.w;
      }
    }
#pragma unroll
    for (int d = 0; d < 32; ++d) { ss += o[d] * o[d]; yp[dh * 32 + d] = f2bf(o[d]); }
  }
  float rs = (1.0f / sqrtf(ss * (1.0f / 64) + 1e-6f)) * (1.0f - lam_init);
  const float* g = p.diff_norm_g + l * 64;
#pragma unroll 4
  for (int d = 0; d < 64; ++d) yp[d] = f2bf(bf2f(yp[d]) * rs * g[d]);
}

DEVFN float dot64s(const bf16_t* q, const bf16_t* k) {
  float s = 0.f;
#pragma unroll
  for (int d = 0; d < 64; d += 4) {
    float4 kv = ld4(k + d);
    float4 qv = ld4(q + d);
    s += qv.x * kv.x + qv.y * kv.y + qv.z * kv.z + qv.w * kv.w;
    if ((d & 15) == 12) LOAD_FENCE();
  }
  return s;
}

DEVFN void mixD_item(const Params& p, int l, int b, int h, int qrow, bool lat, int t) {
  const bf16_t* q = p.P() + (size_t)qrow * INC + OFF_D + h * 64;
  int r = t / 64, cq = t % 64;
  int rs = r - 4; rs = rs < 0 ? 0 : (rs > GROWS - 8 ? GROWS - 8 : rs);
  int cs = cq - 8; cs = cs < 0 ? 0 : (cs > 48 ? 48 : cs);
  const float* rpb = p.nat_rpb + ((size_t)l * 4 + h) * 15 * 31;
  int nwin = lat ? 128 : 0;
  int nk = nwin + NCX;
  float m = -1e30f, ls = 0.f;
  bf16_t* yp = p.Y() + (size_t)qrow * DM + 768 + h * 64;
  for (int pass = 0; pass < 3; ++pass) {
    float inv = pass ? 1.0f / ls : 0.f;
    float o[32];
#pragma unroll
    for (int d = 0; d < 32; ++d) o[d] = 0.f;
    for (int j = 0; j < nk; ++j) {
      int krow; float bias = 0.f;
      if (j < nwin) {
        int i = j / 16, jj = j % 16;
        krow = b * NTL + (rs + i) * 64 + cs + jj;
        int dr = rs + i - r + 7;
        int dc = cs + jj - cq; dc = dc < -15 ? -15 : (dc > 15 ? 15 : dc); dc += 15;
        bias = rpb[dr * 31 + dc];
      } else {
        krow = NLAT + b * NCX + (j - nwin);
      }
      const bf16_t* kp = p.P() + (size_t)krow * INC + OFF_D + 256 + h * 64;
      float s = dot64s(q, kp) * 0.125f + bias;
      if (!pass) {
        float n = fmaxf(m, s); ls = ls * expf(m - n) + expf(s - n); m = n;
      } else {
        float pw = expf(s - m) * inv;
        const bf16_t* vp = kp + 256 + (pass - 1) * 32;
#pragma unroll
        for (int d = 0; d < 32; d += 4) {
          float4 vv = ld4(vp + d);
          o[d] += pw * vv.x; o[d + 1] += pw * vv.y; o[d + 2] += pw * vv.z; o[d + 3] += pw * vv.w;
        }
      }
    }
    if (pass) {
#pragma unroll
      for (int d = 0; d < 32; ++d) yp[(pass - 1) * 32 + d] = f2bf(o[d]);
    }
  }
}

DEVFN float rw_conv(const Params& p, int l, int row, int col, bool hp, bool hn) {
  const float* mu = p.rwkv_mu + (size_t)l * 2 * 1152;
  float m0 = mu[col], m1 = mu[1152 + col];
  const bf16_t* c = p.P() + (size_t)row * INC + OFF_B + col;
  float v = bf2f(c[0]) * (1.0f - m0 - m1);
  if (hp) v += bf2f(c[-INC]) * m0;
  if (hn) v += bf2f(c[INC]) * m1;
  return v;
}
DEVFN void rwprep_item(const Params& p, int l, long item) {
  int row = (int)(item / 256), c = (int)(item % 256);
  int h = c / 64;
  int t, len; seq_pos(row, t, len);
  bool hp = t > 0, hn = t < len - 1;
  float r = rw_conv(p, l, row, c, hp, hn);
  float k = rw_conv(p, l, row, 256 + c, hp, hn);
  float v = rw_conv(p, l, row, 512 + c, hp, hn);
  float wr[2], ar[2];
#pragma unroll
  for (int d = 0; d < 2; ++d) {
    float aw = p.rwkv_w0[(l * 2 + d) * 256 + c];
    float aa = p.rwkv_a0[(l * 2 + d) * 256 + c];
#pragma unroll 2
    for (int rr = 0; rr < 64; ++rr) {
      aw += tanhf_(rw_conv(p, l, row, 768 + d * 64 + rr, hp, hn)) * p.rwkv_w2[((size_t)(l * 2 + d) * 64 + rr) * 256 + c];
      aa += rw_conv(p, l, row, 896 + d * 64 + rr, hp, hn) * p.rwkv_a2[((size_t)(l * 2 + d) * 64 + rr) * 256 + c];
    }
    wr[d] = FEXP(-sigmoidf_(aw) * 0.6065306597126334f);
    ar[d] = sigmoidf_(aa);
  }
  float g = 0.f;
#pragma unroll 2
  for (int rr = 0; rr < 128; ++rr)
    g += sigmoidf_(rw_conv(p, l, row, 1024 + rr, hp, hn)) * p.rwkv_g2[((size_t)l * 128 + rr) * 256 + c];
  float n2 = 0.f;
#pragma unroll 2
  for (int cc = h * 64; cc < h * 64 + 64; ++cc) {
    float kc = rw_conv(p, l, row, 256 + cc, hp, hn) * p.rwkv_kk[l * 256 + cc];
    n2 += kc * kc;
  }
  float kk = k * p.rwkv_kk[l * 256 + c] * (1.0f / sqrtf(n2 + 1e-6f));
  float ka = p.rwkv_ka[l * 256 + c];
  float* o = p.RW() + (size_t)row * RWS;
  o[c] = r; o[256 + c] = v; o[512 + c] = g; o[768 + c] = kk;
  o[1024 + c] = wr[0]; o[1280 + c] = wr[1];
  o[1536 + c] = kk * ar[0]; o[1792 + c] = kk * ar[1];
  o[2048 + c] = k * (1.0f + (ar[0] - 1.0f) * ka);
  o[2304 + c] = k * (1.0f + (ar[1] - 1.0f) * ka);
}

DEVFN float gd_conv(const Params& p, int l, int row, int col, bool hp, bool hn) {
  const float* cw = p.gdn_conv + (size_t)l * 3 * 768;
  const bf16_t* c = p.P() + (size_t)row * INC + OFF_C + col;
  float v = bf2f(c[0]) * cw[768 + col];
  if (hp) v += bf2f(c[-INC]) * cw[col];
  if (hn) v += bf2f(c[INC]) * cw[1536 + col];
  return siluf_(v);
}
DEVFN void gdprep_item(const Params& p, int l, long item) {
  int row = (int)(item / 256), c = (int)(item % 256);
  int h = c / 64;
  int t, len; seq_pos(row, t, len);
  bool hp = t > 0, hn = t < len - 1;
  float q = gd_conv(p, l, row, c, hp, hn);
  float k = gd_conv(p, l, row, 256 + c, hp, hn);
  float v = gd_conv(p, l, row, 512 + c, hp, hn);
  float nq = 0.f, nk = 0.f;
#pragma unroll 2
  for (int cc = h * 64; cc < h * 64 + 64; ++cc) {
    float a = gd_conv(p, l, row, cc, hp, hn); nq += a * a;
    float bq = gd_conv(p, l, row, 256 + cc, hp, hn); nk += bq * bq;
  }
  float* o = p.GP() + (size_t)row * GPS;
  o[c] = q * (1.0f / sqrtf(nq + 1e-6f)) * 0.125f;
  o[256 + c] = k * (1.0f / sqrtf(nk + 1e-6f));
  o[512 + c] = v;
  if (c < 8) {
    int d = c / 4, hh = c % 4;
    const bf16_t* ab = p.P() + (size_t)row * INC + OFF_C + 1024;
    float la = -FEXP(p.gdn_a_log[(l * 2 + d) * 4 + hh]) * softplusf_(bf2f(ab[d * 4 + hh]) + p.gdn_dt_bias[(l * 2 + d) * 4 + hh]);
    o[768 + c] = la;
    o[776 + c] = sigmoidf_(bf2f(ab[8 + d * 4 + hh]));
  }
}

DEVFN int scan_row(int b, int d, int step) {
  if (step < NCX) return NLAT + b * NCX + (d ? NCX - 1 - step : step);
  int s2 = step - NCX;
  return b * NTL + (d ? NTL - 1 - s2 : s2);
}
DEVFN void rwscan_item(const Params& p, bool last, long item) {
  int v = (int)(item % 64), h = (int)((item / 64) % 4), b = (int)((item / 256) % NB), d = (int)(item / (256 * NB));
  float s[64];
#pragma unroll
  for (int k = 0; k < 64; ++k) s[k] = 0.f;
  for (int step = 0; step < NCX + NTL; ++step) {
    int row = scan_row(b, d, step);
    const float* base = p.RW() + (size_t)row * RWS + h * 64;
    const float* kkp = base + 768;
    const float* wp = base + 1024 + d * 256;
    const float* kap = base + 1536 + d * 256;
    const float* kdp = base + 2048 + d * 256;
    float vv = base[256 + v];
    float sa = 0.f;
#pragma unroll
    for (int k = 0; k < 64; ++k) sa += s[k] * kkp[k];
    float y = 0.f;
#pragma unroll
    for (int k = 0; k < 64; ++k) {
      s[k] = s[k] * wp[k] - sa * kap[k] + vv * kdp[k];
      y += s[k] * base[k];
    }
    if (!(last && row >= NLAT)) p.YS()[(size_t)row * 1024 + d * 256 + h * 64 + v] = f2bf(y);
  }
}
DEVFN void gdscan_item(const Params& p, bool last, long item) {
  int dv = (int)(item % 64), h = (int)((item / 64) % 4), b = (int)((item / 256) % NB), d = (int)(item / (256 * NB));
  float s[64];
#pragma unroll
  for (int k = 0; k < 64; ++k) s[k] = 0.f;
  for (int step = 0; step < NCX + NTL; ++step) {
    int row = scan_row(b, d, step);
    const float* base = p.GP() + (size_t)row * GPS;
    const float* qp = base + h * 64;
    const float* kp = base + 256 + h * 64;
    float vv = base[512 + h * 64 + dv];
    float eg = FEXP(base[768 + d * 4 + h]);
    float beta = base[776 + d * 4 + h];
    float ks = 0.f;
#pragma unroll
    for (int k = 0; k < 64; ++k) { s[k] *= eg; ks += kp[k] * s[k]; }
    float vn = beta * (vv - ks);
    float o = 0.f;
#pragma unroll
    for (int k = 0; k < 64; ++k) { s[k] += kp[k] * vn; o += qp[k] * s[k]; }
    if (!(last && row >= NLAT)) p.YS()[(size_t)row * 1024 + 512 + d * 256 + h * 64 + dv] = f2bf(o);
  }
}

DEVFN void rwpost_item(const Params& p, int l, int row, int h) {
  const bf16_t* y0 = p.YS() + (size_t)row * 1024 + h * 64;
  const float* rw = p.RW() + (size_t)row * RWS + h * 64;
  float y[64];
  float m = 0.f;
#pragma unroll
  for (int k = 0; k < 64; ++k) { y[k] = bf2f(y0[k]) + bf2f(y0[256 + k]); m += y[k]; if ((k & 7) == 7) LOAD_FENCE(); }
  m *= (1.0f / 64);
  float var = 0.f;
#pragma unroll
  for (int k = 0; k < 64; ++k) { float dd = y[k] - m; var += dd * dd; }
  float rstd = 1.0f / sqrtf(var * (1.0f / 64) + 64e-5f);
  float bonus = 0.f;
  const float* rk = p.rwkv_rk + (l * 4 + h) * 64;
#pragma unroll
  for (int k = 0; k < 64; ++k) { bonus += rw[k] * (rw[2048 + k] + rw[2304 + k]) * rk[k]; if ((k & 7) == 7) LOAD_FENCE(); }
  bf16_t* yp = p.Y() + (size_t)row * DM + 256 + h * 64;
  const float* lg = p.rwkv_ln_g + l * 256 + h * 64;
  const float* lb = p.rwkv_ln_b + l * 256 + h * 64;
#pragma unroll
  for (int k = 0; k < 64; ++k) { yp[k] = f2bf(((y[k] - m) * rstd * lg[k] + lb[k] + bonus * rw[256 + k]) * rw[512 + k]); if ((k & 7) == 7) LOAD_FENCE(); }
}
DEVFN void gdpost_item(const Params& p, int l, int row, int h) {
  const bf16_t* o0 = p.YS() + (size_t)row * 1024 + 512 + h * 64;
  const bf16_t* gate = p.P() + (size_t)row * INC + OFF_C + 768 + h * 64;
  float o[64];
  float ss = 0.f;
#pragma unroll
  for (int k = 0; k < 64; ++k) { o[k] = bf2f(o0[k]) + bf2f(o0[256 + k]); ss += o[k] * o[k]; if ((k & 7) == 7) LOAD_FENCE(); }
  float rs = 1.0f / sqrtf(ss * (1.0f / 64) + 1e-6f);
  const float* g = p.gdn_norm_g + l * 64;
  bf16_t* yp = p.Y() + (size_t)row * DM + 512 + h * 64;
#pragma unroll
  for (int k = 0; k < 64; ++k) { yp[k] = f2bf(o[k] * rs * g[k] * siluf_(bf2f(gate[k]))); if ((k & 7) == 7) LOAD_FENCE(); }
}

DEVFN void ph_pn1(const Params& p, int l, long item) {
  int row = (int)item;
  const float* hs = hsrc_row(p, l, row);
  float* hd = hdst_row(p, row);
  const float* m = p.mod() + ((size_t)l * NMODV + modv_of_row(row)) * 6144;
  const bf16_t* mix = (const bf16_t*)p.RW() + (size_t)row * DM;
  float s = 0.f;
  for (int i = 0; i < DM; ++i) s += DN_ALPHA * hs[i] + m[2048 + i] * bf2f(mix[i]);
  float mu = s * (1.0f / DM);
  float v = 0.f;
  for (int i = 0; i < DM; ++i) { float z = DN_ALPHA * hs[i] + m[2048 + i] * bf2f(mix[i]) - mu; v += z * z; }
  float rstd = 1.0f / sqrtf(v * (1.0f / DM) + LN_EPS);
  const float* g = p.ln_mix_g + l * DM;
  const float* bb = p.ln_mix_b + l * DM;
  float s2 = 0.f;
  for (int i = 0; i < DM; ++i) {
    float z = DN_ALPHA * hs[i] + m[2048 + i] * bf2f(mix[i]);
    float hn = (z - mu) * rstd * g[i] + bb[i];
    hd[i] = hn;
    s2 += hn;
  }
  float mu2 = s2 * (1.0f / DM);
  float v2 = 0.f;
  for (int i = 0; i < DM; ++i) { float dd = hd[i] - mu2; v2 += dd * dd; }
  float rstd2 = 1.0f / sqrtf(v2 * (1.0f / DM) + LN_EPS);
  bf16_t* x2 = p.Y() + (size_t)row * DM;
  for (int i = 0; i < DM; ++i) x2[i] = f2bf((hd[i] - mu2) * rstd2 * (1.0f + m[4096 + i]) + m[3072 + i]);
}
DEVFN void ph_pn2(const Params& p, int l, long item) {
  int row = (int)item;
  float* hd = hdst_row(p, row);
  const float* m = p.mod() + ((size_t)l * NMODV + modv_of_row(row)) * 6144;
  const float* ffn = p.RW() + (size_t)row * DM;
  float s = 0.f;
  for (int i = 0; i < DM; ++i) s += DN_ALPHA * hd[i] + m[5120 + i] * ffn[i];
  float mu = s * (1.0f / DM);
  float v = 0.f;
  for (int i = 0; i < DM; ++i) { float z = DN_ALPHA * hd[i] + m[5120 + i] * ffn[i] - mu; v += z * z; }
  float rstd = 1.0f / sqrtf(v * (1.0f / DM) + LN_EPS);
  const float* g = p.ln_ffn_g + l * DM;
  const float* bb = p.ln_ffn_b + l * DM;
  for (int i = 0; i < DM; ++i) {
    float z = DN_ALPHA * hd[i] + m[5120 + i] * ffn[i];
    hd[i] = (z - mu) * rstd * g[i] + bb[i];
  }
}

DEVFN bf16_t* peerQ(const Params& p) { return p.P(); }
DEVFN float* selbase(const Params& p) { return p.RW() + (size_t)NTOK * 1024; }
DEVFN float* sel1s(const Params& p) { return selbase(p); }
DEVFN int* sel1i(const Params& p) { return (int*)(selbase(p) + (size_t)NTOK * 256); }
DEVFN int* sel2i(const Params& p) { return (int*)(selbase(p) + (size_t)NTOK * 512); }
DEVFN float* sel2g(const Params& p) { return selbase(p) + (size_t)NTOK * 640; }
DEVFN float* coefb(const Params& p) { return selbase(p) + (size_t)NTOK * 768; }

#define TOPK_INSERT(ts, ti, xs, xi)                                      \
  {                                                                      \
    float cs_ = (xs); int ci_ = (xi);                                    \
    _Pragma("unroll") for (int z_ = 0; z_ < 16; ++z_) {                  \
      bool gt_ = cs_ > ts[z_];                                           \
      float os_ = ts[z_]; int oi_ = ti[z_];                              \
      ts[z_] = gt_ ? cs_ : os_; ti[z_] = gt_ ? ci_ : oi_;                \
      cs_ = gt_ ? os_ : cs_; ci_ = gt_ ? oi_ : ci_;                      \
    }                                                                    \
  }

DEVFN void ph_topk1(const Params& p, int l, int nrows, long item) {
  int hp = (int)(item / nrows), row = (int)(item % nrows);
  const bf16_t* q = peerQ(p) + (size_t)row * 2048 + hp * 128;
  const float* keys = p.peer_keys + ((size_t)l * 16 + hp) * 128 * 128;
  float ts[16]; int ti[16];
#pragma unroll
  for (int z = 0; z < 16; ++z) { ts[z] = -3e38f; ti[z] = 0; }
  for (int n = 0; n < 128; ++n) {
    const float* kr = keys + n * 128;
    float s = 0.f;
#pragma unroll 8
    for (int d = 0; d < 128; d += 4) {
      float4 qa = ld4(q + d), kb = *(const float4*)(kr + d);
      s += qa.x * kb.x; s += qa.y * kb.y; s += qa.z * kb.z; s += qa.w * kb.w;
    }
    TOPK_INSERT(ts, ti, s, n);
  }
  float* os = sel1s(p) + ((size_t)row * 16 + hp) * 16;
  int* oi = sel1i(p) + ((size_t)row * 16 + hp) * 16;
#pragma unroll
  for (int z = 0; z < 16; ++z) { os[z] = ts[z]; oi[z] = ti[z]; }
}
DEVFN void ph_topk2(const Params& p, int nrows, long item) {
  int h = (int)(item / nrows), row = (int)(item % nrows);
  const float* s0 = sel1s(p) + ((size_t)row * 16 + h * 2) * 16;
  const int* i0 = sel1i(p) + ((size_t)row * 16 + h * 2) * 16;
  float s1[16]; int i1[16];
#pragma unroll
  for (int z = 0; z < 16; ++z) { s1[z] = s0[16 + z]; i1[z] = i0[16 + z]; }
  float ts[16]; int ti[16];
#pragma unroll
  for (int z = 0; z < 16; ++z) { ts[z] = -3e38f; ti[z] = 0; }
  for (int i = 0; i < 16; ++i) {
    float a = s0[i]; int ai = i0[i] * 128;
#pragma unroll
    for (int j = 0; j < 16; ++j) TOPK_INSERT(ts, ti, a + s1[j], ai + i1[j]);
  }
  float sum = 0.f;
  float mx = ts[0];
#pragma unroll
  for (int z = 0; z < 16; ++z) { ts[z] = expf(ts[z] - mx); }
#pragma unroll
  for (int z = 0; z < 16; ++z) sum += ts[z];
  float inv = 1.0f / sum;
  int* oi = sel2i(p) + ((size_t)row * 8 + h) * 16;
  float* og = sel2g(p) + ((size_t)row * 8 + h) * 16;
#pragma unroll
  for (int z = 0; z < 16; ++z) { oi[z] = ti[z]; og[z] = ts[z] * inv; }
}
DEVFN void ph_act(const Params& p, int l, long item) {
  int row = (int)(item / 128);
  int idx = sel2i(p)[item];
  const bf16_t* x2 = p.Y() + (size_t)row * DM;
  const float* u = p.peer_u + ((size_t)l * 16384 + idx) * DM;
  float s = 0.f;
  for (int i = 0; i < DM; i += 4) {
    float4 a = ld4(x2 + i), b = *(const float4*)(u + i);
    s += a.x * b.x + a.y * b.y + a.z * b.z + a.w * b.w;
  }
  coefb(p)[item] = sel2g(p)[item] * geluf_(s);
}
DEVFN void ph_ffn(const Params& p, int l, long item) {
  int row = (int)(item / 256), c4 = (int)(item % 256);
  const int* idx = sel2i(p) + (size_t)row * 128;
  const float* cf = coefb(p) + (size_t)row * 128;
  float4 acc = make_float4(0.f, 0.f, 0.f, 0.f);
  for (int j = 0; j < 128; ++j) {
    float4 vv = *(const float4*)(p.peer_v + ((size_t)l * 16384 + idx[j]) * DM + c4 * 4);
    float c = cf[j];
    acc.x += c * vv.x; acc.y += c * vv.y; acc.z += c * vv.z; acc.w += c * vv.w;
  }
  *(float4*)(p.RW() + (size_t)row * DM + c4 * 4) = acc;
}

enum { PH_ADA = 0, PH_LN1, PH_GEMM_IN, PH_ROPE, PH_MIX, PH_GDPREP, PH_SCAN, PH_POST, PH_GEMM_OUT, PH_PN1, PH_GEMM_Q,
       PH_TOPK1, PH_TOPK2, PH_ACT, PH_FFN, PH_PN2, PH_COUNT };

HDFN int rows_out(int l) { return l == 1 ? NLAT : NTOK; }

HDFN long phase_items(int ph, int l) {
  bool last = l == 1;
  long nr = rows_out(l);
  switch (ph) {
    case PH_ADA: return l == 0 ? 2 * 6144 : 0;
    case PH_LN1: return NTOK;
    case PH_GEMM_IN: return (long)(NTOK / 4) * (INC / 4);
    case PH_ROPE: return (long)NLAT * 256;
    case PH_MIX: return 2L * NB * 4 * NTL + (last ? 0 : 2L * NB * 4 * NCX) + (long)NTOK * 256;
    case PH_GDPREP: return (long)NTOK * 256;
    case PH_SCAN: return 2L * 2 * NB * 4 * 64;
    case PH_POST: return nr * 4 * 2;
    case PH_GEMM_OUT: return (nr / 4) * (DM / 4);
    case PH_PN1: return nr;
    case PH_GEMM_Q: return (nr / 4) * (2048 / 4);
    case PH_TOPK1: return nr * 16;
    case PH_TOPK2: return nr * 8;
    case PH_ACT: return nr * 128;
    case PH_FFN: return nr * 256;
    case PH_PN2: return nr;
  }
  return 0;
}

template <int PH>
DEVFN void phase_item(const Params& p, int l, long item) {
  bool last = l == 1;
  int nr = rows_out(l);
  if (PH == PH_ADA) ph_ada(p, item);
  else if (PH == PH_LN1) ph_ln1(p, l, item);
  else if (PH == PH_GEMM_IN) gemm_item(p.Y(), DM, p.w_in + (size_t)l * DM * INC, INC, p.P(), INC, INC, DM, item);
  else if (PH == PH_ROPE) ph_rope(p, item);
  else if (PH == PH_MIX) {
    long nAl = (long)NB * 4 * NTL, nAc = last ? 0 : (long)NB * 4 * NCX;
    if (item < nAl) {
      int bh = (int)(item / NTL), t = (int)(item % NTL);
      mixA_item(p, l, bh / 4, bh % 4, (bh / 4) * NTL + t, true);
    } else if (item < nAl + nAc) {
      long it = item - nAl; int bh = (int)(it / NCX), t = (int)(it % NCX);
      mixA_item(p, l, bh / 4, bh % 4, NLAT + (bh / 4) * NCX + t, false);
    } else if (item < 2 * nAl + nAc) {
      long it = item - nAl - nAc; int bh = (int)(it / NTL), t = (int)(it % NTL);
      mixD_item(p, l, bh / 4, bh % 4, (bh / 4) * NTL + t, true, t);
    } else if (item < 2 * nAl + 2 * nAc) {
      long it = item - 2 * nAl - nAc; int bh = (int)(it / NCX), t = (int)(it % NCX);
      mixD_item(p, l, bh / 4, bh % 4, NLAT + (bh / 4) * NCX + t, false, 0);
    } else {
      rwprep_item(p, l, item - 2 * nAl - 2 * nAc);
    }
  } else if (PH == PH_GDPREP) gdprep_item(p, l, item);
  else if (PH == PH_SCAN) {
    long n1 = 2L * NB * 4 * 64;
    if (item < n1) rwscan_item(p, last, item); else gdscan_item(p, last, item - n1);
  } else if (PH == PH_POST) {
    long n1 = (long)nr * 4;
    if (item < n1) rwpost_item(p, l, (int)(item / 4), (int)(item % 4));
    else { long it = item - n1; gdpost_item(p, l, (int)(it / 4), (int)(it % 4)); }
  } else if (PH == PH_GEMM_OUT) gemm_item(p.Y(), DM, p.w_out + (size_t)l * DM * DM, DM, (bf16_t*)p.RW(), DM, DM, DM, item);
  else if (PH == PH_PN1) ph_pn1(p, l, item);
  else if (PH == PH_GEMM_Q) gemm_item(p.Y(), DM, p.peer_wq + (size_t)l * DM * 2048, 2048, peerQ(p), 2048, 2048, DM, item);
  else if (PH == PH_TOPK1) ph_topk1(p, l, nr, item);
  else if (PH == PH_TOPK2) ph_topk2(p, nr, item);
  else if (PH == PH_ACT) ph_act(p, l, item);
  else if (PH == PH_FFN) ph_ffn(p, l, item);
  else if (PH == PH_PN2) ph_pn2(p, l, item);
}


#ifndef CPU_EMU
__device__ __forceinline__ int make_tid(int wave_s) {
  int lane;
  asm volatile("v_mbcnt_lo_u32_b32 %0, -1, 0\n\tv_mbcnt_hi_u32_b32 %0, -1, %0" : "=v"(lane));
  return wave_s * 64 + lane;
}
#define XB_TMO      128
#define XB_XCNT(j)  (256  + 64 * (j))
#define XB_XSUB(j)  (1280 + 64 * (j))
#define XB_XGEN(j)  (2304 + 64 * (j))
#define XB_TOP      3328
#define XB_TOPGEN   3392
#define XCD_BAR_WORDS 3456
#define XB_SPIN_CAP (1u << 18)
#define LAS __attribute__((address_space(3)))

__device__ __forceinline__ unsigned xb_ld(unsigned* p)              { return __hip_atomic_load(p, __ATOMIC_RELAXED, __HIP_MEMORY_SCOPE_AGENT); }
__device__ __forceinline__ unsigned xb_add(unsigned* p, unsigned v) { return __hip_atomic_fetch_add(p, v, __ATOMIC_RELAXED, __HIP_MEMORY_SCOPE_AGENT); }
__device__ __forceinline__ unsigned xb_xcc_id() { return (unsigned)__builtin_amdgcn_s_getreg((3 << 11) | 20) & 0xFu; }
#define XB_SPIN(cond, bar) do { unsigned _sp = 0; while (cond) { __builtin_amdgcn_s_sleep(1); \
    if ((++_sp & 255u) == 0u) { if (xb_ld(&(bar)[XB_TMO])) break; if (_sp > XB_SPIN_CAP) { atomicAdd(&(bar)[XB_TMO], 1u); break; } } } } while (0)

struct XcdBarrier {
    unsigned* bar; unsigned x;
    volatile LAS unsigned* st;
};

__device__ __forceinline__ XcdBarrier xcd_barrier_post(unsigned* bar, volatile LAS unsigned* st) {
    XcdBarrier b; b.bar = bar; b.x = xb_xcc_id(); b.st = st;
    if (threadIdx.x == 0) (void)xb_add(&bar[XB_XCNT(b.x)], 1u);
    return b;
}
__device__ __forceinline__ void xcd_barrier_complete(unsigned* bar, unsigned x, unsigned& nloc, unsigned& nx) {
    const unsigned G = gridDim.x * gridDim.y * gridDim.z;
    unsigned sum, cnt, mine, sp = 0u;
    for (;;) {
        sum = 0u; cnt = 0u; mine = 0u;
#pragma unroll
        for (unsigned j = 0; j < 16; ++j) { const unsigned c = xb_ld(&bar[XB_XCNT(j)]); sum += c; cnt += (c > 0u) ? 1u : 0u; mine = (j == x) ? c : mine; }
        if (sum == G) break;
        __builtin_amdgcn_s_sleep(1);
        if ((++sp & 255u) == 0u) { if (xb_ld(&bar[XB_TMO])) break; if (sp > XB_SPIN_CAP) { atomicAdd(&bar[XB_TMO], 1u); break; } }
    }
    nloc = mine > 0u ? mine : 1u; nx = cnt > 0u ? cnt : 1u;
}

__device__ __forceinline__ void xcd_barrier(const XcdBarrier& b, int wave_s) {
    asm volatile("s_waitcnt vmcnt(0)" ::: "memory");
    __syncthreads();
    if (make_tid(wave_s) == 0) {
        unsigned* bar = b.bar;
        __builtin_amdgcn_s_waitcnt(0);
        unsigned nloc = b.st[0], nx = b.st[1];
        if (nloc == 0u) { xcd_barrier_complete(bar, b.x, nloc, nx); b.st[0] = nloc; b.st[1] = nx; }
        const unsigned old = xb_add(&bar[XB_XSUB(b.x)], 1u);
        const unsigned gen = old / nloc;
        if (old + 1u == (gen + 1u) * nloc) {
            __builtin_amdgcn_fence(__ATOMIC_RELEASE, "agent");
            asm volatile("s_waitcnt vmcnt(0)" ::: "memory");
            const unsigned og = xb_add(&bar[XB_TOP], 1u);
            const unsigned tg = og / nx;
            if (og + 1u == (tg + 1u) * nx) xb_add(&bar[XB_TOPGEN], 1u);
            else XB_SPIN(xb_ld(&bar[XB_TOPGEN]) == tg, bar);
            __builtin_amdgcn_fence(__ATOMIC_ACQUIRE, "agent");
            xb_add(&bar[XB_XGEN(b.x)], 1u);
            asm volatile("s_waitcnt vmcnt(0)" ::: "memory");
        } else {
            XB_SPIN(xb_ld(&bar[XB_XGEN(b.x)]) == gen, bar);
            __builtin_amdgcn_fence(__ATOMIC_ACQUIRE, "agent");
            asm volatile("s_waitcnt vmcnt(0)" ::: "memory");
        }
    }
    __syncthreads();
}


constexpr int NTHREADS = 512;
typedef __attribute__((ext_vector_type(8))) __bf16 bf16x8;
typedef __attribute__((ext_vector_type(2))) __bf16 bf16x2;
typedef __attribute__((ext_vector_type(2))) float f32x2;
typedef __attribute__((ext_vector_type(4))) float f32x4;

__device__ __forceinline__ unsigned pk_bf16(float a, float b) {
  f32x2 v = {a, b};
  return __builtin_bit_cast(unsigned, __builtin_convertvector(v, bf16x2));
}

constexpr int NPAD_IN = 3840;
constexpr size_t WBT_LAYER = (size_t)(NPAD_IN + 1024 + 2048) * 1024;
__device__ __forceinline__ bf16_t* wbt_in(const Params& p, int l) { return p.WBT() + (size_t)l * WBT_LAYER; }
__device__ __forceinline__ bf16_t* wbt_out(const Params& p, int l) { return p.WBT() + (size_t)l * WBT_LAYER + (size_t)NPAD_IN * 1024; }
__device__ __forceinline__ bf16_t* wbt_q(const Params& p, int l) { return p.WBT() + (size_t)l * WBT_LAYER + (size_t)(NPAD_IN + 1024) * 1024; }

__device__ __forceinline__ void conv_weight_tiles(const float* W, int N, int npad, bf16_t* Bt, char* smem, int tid) {
  bf16_t* T = (bf16_t*)smem;
  const int ntn = npad / 64, ntiles = 16 * ntn;
  for (int t0 = blockIdx.x * 4; t0 < ntiles; t0 += gridDim.x * 4) {
    float4 v[4][2];
#pragma unroll
    for (int q = 0; q < 4; ++q) {
      const int tt = t0 + q, kt = tt / ntn, nt = tt % ntn;
#pragma unroll
      for (int j = 0; j < 2; ++j) {
        const int k = (tid >> 4) + 32 * j, n = nt * 64 + (tid & 15) * 4;
        const bool ok = tt < ntiles && n < N;
        v[q][j] = *(const float4*)(W + (size_t)((ok ? kt : 0) * 64 + k) * N + (ok ? n : 0));
      }
    }
#pragma unroll
    for (int q = 0; q < 4; ++q) {
      const int tt = t0 + q, nt = tt % ntn;
      const bool ok = tt < ntiles && nt * 64 + (tid & 15) * 4 < N;
#pragma unroll
      for (int j = 0; j < 2; ++j) if (!ok) v[q][j] = make_float4(0.f, 0.f, 0.f, 0.f);
    }
#pragma unroll
    for (int q = 0; q < 4; ++q)
#pragma unroll
      for (int j = 0; j < 2; ++j) {
        const int k = (tid >> 4) + 32 * j, n4 = (tid & 15) * 4;
        bf16_t* Tq = T + q * 64 * 72;
        Tq[(n4 + 0) * 72 + k] = f2bf(v[q][j].x); Tq[(n4 + 1) * 72 + k] = f2bf(v[q][j].y);
        Tq[(n4 + 2) * 72 + k] = f2bf(v[q][j].z); Tq[(n4 + 3) * 72 + k] = f2bf(v[q][j].w);
      }
    LDS_BAR();
#pragma unroll
    for (int q = 0; q < 4; ++q) {
      const int tt = t0 + q, kt = tt / ntn, nt = tt % ntn;
      const int n = tid >> 3, kc = tid & 7;
      if (tt < ntiles) *(uint4*)(Bt + (size_t)(nt * 64 + n) * 1024 + kt * 64 + kc * 8) = *(const uint4*)(T + q * 64 * 72 + n * 72 + kc * 8);
    }
    LDS_BAR();
  }
}
__device__ __forceinline__ void conv_weights(const Params& p, char* smem, int wave_s) {
  int tid = make_tid(wave_s);
  for (int l = 0; l < 2; ++l) {
    conv_weight_tiles(p.w_in + (size_t)l * DM * INC, INC, NPAD_IN, wbt_in(p, l), smem, tid);
    conv_weight_tiles(p.w_out + (size_t)l * DM * DM, DM, DM, wbt_out(p, l), smem, tid);
    conv_weight_tiles(p.peer_wq + (size_t)l * DM * 2048, 2048, 2048, wbt_q(p, l), smem, tid);
  }
}

template <int BM>
__device__ __forceinline__ void gemm_tile(const bf16_t* __restrict__ A, int lda, const bf16_t* __restrict__ Bt, int N,
                                          bf16_t* __restrict__ C, int ldc, int m0, int n0, char* smem, int tid,
                                          bool staged, bool has_next, int m0n, int n0n) {
  constexpr int WM = BM / 4, MJ = WM / 16, ACH = BM * 8 / NTHREADS;
  constexpr int ABYTES = BM * 128, BBYTES = 128 * 128;
  const int lane = tid & 63, w = tid >> 6, wm = w >> 1, wn = w & 1;
  char* As = smem;
  char* Bs = smem + 3 * ABYTES;
  f32x4 acc[4][MJ];
#pragma unroll
  for (int i = 0; i < 4; ++i)
#pragma unroll
    for (int j = 0; j < MJ; ++j) acc[i][j] = f32x4{0.f, 0.f, 0.f, 0.f};
  typedef __attribute__((address_space(3))) void* lds_ptr;
  const int srow = lane >> 3, schunk = (lane & 7) ^ (lane >> 3);
  const bf16_t* aptr[ACH];
  const bf16_t* bptr[2];
#pragma unroll
  for (int i = 0; i < ACH; ++i) aptr[i] = A + (size_t)(m0 + (w + 8 * i) * 8 + srow) * lda + schunk * 8;
#pragma unroll
  for (int i = 0; i < 2; ++i) bptr[i] = Bt + (size_t)(n0 + (w + 8 * i) * 8 + srow) * 1024 + schunk * 8;
#define GEMM_STAGE(kt, buf)                                                                                   \
  {                                                                                                           \
    _Pragma("unroll") for (int i = 0; i < ACH; ++i)                                                           \
      __builtin_amdgcn_global_load_lds((const void*)(aptr[i] + (kt) * 64), (lds_ptr)(As + (buf) * ABYTES + (w + 8 * i) * 1024 + lane * 16), 16, 0, 0); \
    _Pragma("unroll") for (int i = 0; i < 2; ++i)                                                             \
      __builtin_amdgcn_global_load_lds((const void*)(bptr[i] + (kt) * 64), (lds_ptr)(Bs + (buf) * BBYTES + (w + 8 * i) * 1024 + lane * 16), 16, 0, 0); \
  }
  const int l15 = lane & 15, lq = lane >> 4, sw = lane & 7;
  const int bbase = (wn * 64 + l15) * 128, abase = (wm * WM + l15) * 128;
  if (!staged) { GEMM_STAGE(0, 0); GEMM_STAGE(1, 1); }
  int buf = 0;
  for (int kt = 0; kt < 16; ++kt) {
    if (kt < 15) { if (ACH == 4) asm volatile("s_waitcnt vmcnt(6)" ::: "memory"); else asm volatile("s_waitcnt vmcnt(4)" ::: "memory"); }
    else asm volatile("s_waitcnt vmcnt(0)" ::: "memory");
    __builtin_amdgcn_s_barrier();
    if (kt < 14) { const int nb_ = buf == 0 ? 2 : buf - 1; GEMM_STAGE(kt + 2, nb_); }
#pragma unroll
    for (int ks = 0; ks < 2; ++ks) {
      const int koff = ((ks * 4 + lq) ^ sw) << 4;
      bf16x8 af[4], bf[MJ];
#pragma unroll
      for (int i = 0; i < 4; ++i) af[i] = *(const bf16x8*)(Bs + buf * BBYTES + bbase + i * 2048 + koff);
#pragma unroll
      for (int j = 0; j < MJ; ++j) bf[j] = *(const bf16x8*)(As + buf * ABYTES + abase + j * 2048 + koff);
#pragma unroll
      for (int i = 0; i < 4; ++i)
#pragma unroll
        for (int j = 0; j < MJ; ++j) acc[i][j] = __builtin_amdgcn_mfma_f32_16x16x32_bf16(af[i], bf[j], acc[i][j], 0, 0, 0);
    }
    buf = buf == 2 ? 0 : buf + 1;
  }
  asm volatile("s_waitcnt lgkmcnt(0)" ::: "memory");
  __builtin_amdgcn_s_barrier();
  if (has_next) {
#pragma unroll
    for (int i = 0; i < ACH; ++i) aptr[i] = A + (size_t)(m0n + (w + 8 * i) * 8 + srow) * lda + schunk * 8;
#pragma unroll
    for (int i = 0; i < 2; ++i) bptr[i] = Bt + (size_t)(n0n + (w + 8 * i) * 8 + srow) * 1024 + schunk * 8;
    GEMM_STAGE(0, 0); GEMM_STAGE(1, 1);
  }
#undef GEMM_STAGE
#pragma unroll
  for (int i = 0; i < 4; ++i) {
    int n = n0 + wn * 64 + i * 16 + lq * 4;
    if (n < N) {
#pragma unroll
      for (int j = 0; j < MJ; ++j) {
        int m = m0 + wm * WM + j * 16 + l15;
        uint2 v;
        v.x = pk_bf16(acc[i][j][0], acc[i][j][1]);
        v.y = pk_bf16(acc[i][j][2], acc[i][j][3]);
        *(uint2*)(C + (size_t)m * ldc + n) = v;
      }
    }
  }
}

template <int BM>
__device__ __forceinline__ void gemm_phase(const bf16_t* A, int lda, const bf16_t* Bt, int N, bf16_t* C, int ldc, int M, char* smem, int wave_s) {
  const int ntn = (N + 127) / 128, ntm = M / BM;
  const int ntiles = ntm * ntn;
  int tid = make_tid(wave_s);
  const int nb = gridDim.x;
  const int vid = (nb % 8 == 0) ? (int)((blockIdx.x % 8) * (nb / 8) + blockIdx.x / 8) : (int)blockIdx.x;
#define GEMM_TILE_MN(t_, mt_, nt_) { const int grp = (t_) / (8 * ntn), fm = grp * 8; const int gsz = (ntm - fm) < 8 ? (ntm - fm) : 8; \
    const int r = (t_) - grp * 8 * ntn; mt_ = fm + (r % gsz); nt_ = r / gsz; }
  bool staged = false;
  for (int t = vid; t < ntiles; t += nb) {
    int mt, nt, mtn = 0, ntn_ = 0;
    GEMM_TILE_MN(t, mt, nt)
    const bool has_next = t + nb < ntiles;
    if (has_next) GEMM_TILE_MN(t + nb, mtn, ntn_)
    const int tid2 = make_tid(wave_s);
    gemm_tile<BM>(A, lda, Bt, N, C, ldc, mt * BM, nt * 128, smem, tid2, staged, has_next, mtn * BM, ntn_ * 128);
    staged = has_next;
  }
#undef GEMM_TILE_MN
  asm volatile("s_waitcnt vmcnt(0)" ::: "memory");
}

__device__ __forceinline__ float wave_sum(float v) {
#pragma unroll
  for (int o = 32; o >= 1; o >>= 1) v += __shfl_xor(v, o);
  return v;
}
__device__ __forceinline__ void unpack8(uint4 v, float* x) {
  x[0] = __uint_as_float(v.x << 16); x[1] = __uint_as_float(v.x & 0xffff0000u);
  x[2] = __uint_as_float(v.y << 16); x[3] = __uint_as_float(v.y & 0xffff0000u);
  x[4] = __uint_as_float(v.z << 16); x[5] = __uint_as_float(v.z & 0xffff0000u);
  x[6] = __uint_as_float(v.w << 16); x[7] = __uint_as_float(v.w & 0xffff0000u);
}
__device__ __forceinline__ void ldrow_f32(const float* r, int lane, float (&x)[16]) {
  float4 a = *(const float4*)(r + lane * 8), b = *(const float4*)(r + lane * 8 + 4);
  float4 c = *(const float4*)(r + 512 + lane * 8), d = *(const float4*)(r + 512 + lane * 8 + 4);
  x[0] = a.x; x[1] = a.y; x[2] = a.z; x[3] = a.w; x[4] = b.x; x[5] = b.y; x[6] = b.z; x[7] = b.w;
  x[8] = c.x; x[9] = c.y; x[10] = c.z; x[11] = c.w; x[12] = d.x; x[13] = d.y; x[14] = d.z; x[15] = d.w;
}
__device__ __forceinline__ void ldrow_bf16(const bf16_t* r, int lane, float (&x)[16]) {
  uint4 a = *(const uint4*)(r + lane * 8), b = *(const uint4*)(r + 512 + lane * 8);
  unpack8(a, x); unpack8(b, x + 8);
}
__device__ __forceinline__ void strow_f32(float* r, int lane, const float (&x)[16]) {
  *(float4*)(r + lane * 8) = make_float4(x[0], x[1], x[2], x[3]);
  *(float4*)(r + lane * 8 + 4) = make_float4(x[4], x[5], x[6], x[7]);
  *(float4*)(r + 512 + lane * 8) = make_float4(x[8], x[9], x[10], x[11]);
  *(float4*)(r + 512 + lane * 8 + 4) = make_float4(x[12], x[13], x[14], x[15]);
}
__device__ __forceinline__ void strow_bf16(bf16_t* r, int lane, const float (&x)[16]) {
  uint4 a, b;
  a.x = pk_bf16(x[0], x[1]); a.y = pk_bf16(x[2], x[3]); a.z = pk_bf16(x[4], x[5]); a.w = pk_bf16(x[6], x[7]);
  b.x = pk_bf16(x[8], x[9]); b.y = pk_bf16(x[10], x[11]); b.z = pk_bf16(x[12], x[13]); b.w = pk_bf16(x[14], x[15]);
  *(uint4*)(r + lane * 8) = a;
  *(uint4*)(r + 512 + lane * 8) = b;
}
__device__ __forceinline__ void ldrow16_f32(const float* r, int lane, float (&x)[16]) {
  const float4 a = *(const float4*)(r + lane * 16), b = *(const float4*)(r + lane * 16 + 4);
  const float4 c = *(const float4*)(r + lane * 16 + 8), d = *(const float4*)(r + lane * 16 + 12);
  x[0] = a.x; x[1] = a.y; x[2] = a.z; x[3] = a.w; x[4] = b.x; x[5] = b.y; x[6] = b.z; x[7] = b.w;
  x[8] = c.x; x[9] = c.y; x[10] = c.z; x[11] = c.w; x[12] = d.x; x[13] = d.y; x[14] = d.z; x[15] = d.w;
}
__device__ __forceinline__ void ldrow16_bf16(const bf16_t* r, int lane, float (&x)[16]) {
  const uint4 a = *(const uint4*)(r + lane * 16), b = *(const uint4*)(r + lane * 16 + 8);
  unpack8(a, x); unpack8(b, x + 8);
}
__device__ __forceinline__ void strow16_f32(float* r, int lane, const float (&x)[16]) {
  *(float4*)(r + lane * 16) = make_float4(x[0], x[1], x[2], x[3]);
  *(float4*)(r + lane * 16 + 4) = make_float4(x[4], x[5], x[6], x[7]);
  *(float4*)(r + lane * 16 + 8) = make_float4(x[8], x[9], x[10], x[11]);
  *(float4*)(r + lane * 16 + 12) = make_float4(x[12], x[13], x[14], x[15]);
}
__device__ __forceinline__ void strow16_bf16(bf16_t* r, int lane, const float (&x)[16]) {
  uint4 a, b;
  a.x = pk_bf16(x[0], x[1]); a.y = pk_bf16(x[2], x[3]); a.z = pk_bf16(x[4], x[5]); a.w = pk_bf16(x[6], x[7]);
  b.x = pk_bf16(x[8], x[9]); b.y = pk_bf16(x[10], x[11]); b.z = pk_bf16(x[12], x[13]); b.w = pk_bf16(x[14], x[15]);
  *(uint4*)(r + lane * 16) = a;
  *(uint4*)(r + lane * 16 + 8) = b;
}
__device__ __forceinline__ void row_ln_stats(const float (&x)[16], float& mean, float& rstd) {
  float s = 0.f;
#pragma unroll
  for (int i = 0; i < 16; ++i) s += x[i];
  mean = wave_sum(s) * (1.0f / DM);
  float v = 0.f;
#pragma unroll
  for (int i = 0; i < 16; ++i) { float d = x[i] - mean; v += d * d; }
  rstd = 1.0f / sqrtf(wave_sum(v) * (1.0f / DM) + LN_EPS);
}
__device__ __forceinline__ void row_modulate(float (&x)[16], const float* sh, const float* sc, int lane) {
  float mean, rstd; row_ln_stats(x, mean, rstd);
  float a[16], b[16];
  ldrow_f32(sc, lane, a); ldrow_f32(sh, lane, b);
#pragma unroll
  for (int i = 0; i < 16; ++i) x[i] = (x[i] - mean) * rstd * (1.0f + a[i]) + b[i];
}
__device__ __forceinline__ void row_affine_ln(float (&x)[16], const float* g, const float* bb, int lane) {
  float mean, rstd; row_ln_stats(x, mean, rstd);
  float a[16], b[16];
  ldrow_f32(g, lane, a); ldrow_f32(bb, lane, b);
#pragma unroll
  for (int i = 0; i < 16; ++i) x[i] = (x[i] - mean) * rstd * a[i] + b[i];
}

__device__ __forceinline__ void fast_ln1(const Params& p, int l, int wave_s) {
  for (int row = blockIdx.x * 8 + wave_s; row < NTOK; row += gridDim.x * 8) {
    const int lane = make_tid(wave_s) & 63;
    const float* m = p.mod() + ((size_t)l * NMODV + modv_of_row(row)) * 6144;
    float x[16];
    ldrow_f32(hsrc_row(p, l, row), lane, x);
    row_modulate(x, m, m + 1024, lane);
    strow_bf16(p.Y() + (size_t)row * DM, lane, x);
  }
}
template <int CTRL> __device__ __forceinline__ float dppx(float x) {
  return __builtin_bit_cast(float, __builtin_amdgcn_update_dpp(0, __builtin_bit_cast(int, x), CTRL, 0xf, 0xf, true));
}
typedef __attribute__((ext_vector_type(2))) float f32x2v;
constexpr float XQ_SCALE = 8.0f;
DEVFN unsigned char* xqbuf(const Params& p) { return (unsigned char*)p.P() + (size_t)NTOK * 4096; }
__device__ __forceinline__ void fast_pn1(const Params& p, int l, int nr, int wave_s) {
  for (int row = blockIdx.x * 8 + wave_s; row < nr; row += gridDim.x * 8) {
    const int lane = make_tid(wave_s) & 63;
    const float* m = p.mod() + ((size_t)l * NMODV + modv_of_row(row)) * 6144;
    float x[16], y[16], g[16];
    ldrow_f32(hsrc_row(p, l, row), lane, x);
    ldrow_bf16((const bf16_t*)p.RW() + (size_t)row * DM, lane, y);
    ldrow_f32(m + 2048, lane, g);
#pragma unroll
    for (int i = 0; i < 16; ++i) x[i] = DN_ALPHA * x[i] + g[i] * y[i];
    row_affine_ln(x, p.ln_mix_g + l * DM, p.ln_mix_b + l * DM, lane);
    strow_f32(hdst_row(p, row), lane, x);
    row_modulate(x, m + 3072, m + 4096, lane);
    strow_bf16(p.Y() + (size_t)row * DM, lane, x);
    unsigned char* xq = xqbuf(p) + (size_t)row * 1024;
#pragma unroll
    for (int hf = 0; hf < 2; ++hf) {
      uint2 hi = make_uint2(0u, 0u);
#define XQ_PAIR(k_, hw_, sel_) { \
        const float a = fminf(fmaxf(x[hf * 8 + 2 * (k_)] * XQ_SCALE, -448.f), 448.f); \
        const float b = fminf(fmaxf(x[hf * 8 + 2 * (k_) + 1] * XQ_SCALE, -448.f), 448.f); \
        hw_ = __builtin_amdgcn_cvt_pk_fp8_f32(a, b, hw_, sel_); }
      XQ_PAIR(0, hi.x, false) XQ_PAIR(1, hi.x, true) XQ_PAIR(2, hi.y, false) XQ_PAIR(3, hi.y, true)
      *(uint2*)(xq + (hf * 64 + lane) * 8) = hi;
    }
  }
}

constexpr float U8_SCALE = 64.0f, V8_SCALE = 4.0f;
__device__ __forceinline__ void conv_tables(const Params& p, int l, int wave_s) {
  int tid = make_tid(wave_s);
  const size_t nch = (size_t)16384 * 1024 / 16;
  const size_t nth = (size_t)gridDim.x * NTHREADS;
  const float* su = p.peer_u + (size_t)l * 16384 * 1024;
  const float* sv = p.peer_v + (size_t)l * 16384 * 1024;
  unsigned char* dst = (unsigned char*)p.TB();
  size_t c = (size_t)blockIdx.x * NTHREADS + tid;
  for (; c + 3 * nth < 2 * nch; c += 4 * nth) {
    float4 f[4][4];
#pragma unroll
    for (int q = 0; q < 4; ++q) {
      const size_t cq = c + q * nth;
      const float* src = cq < nch ? su + cq * 16 : sv + (cq - nch) * 16;
#pragma unroll
      for (int j = 0; j < 4; ++j) f[q][j] = *(const float4*)(src + 4 * j);
    }
#pragma unroll
    for (int q = 0; q < 4; ++q) {
      const size_t cq = c + q * nth;
      const float sc = cq < nch ? U8_SCALE : V8_SCALE;
      unsigned w[4];
#pragma unroll
      for (int j = 0; j < 4; ++j) {
        w[j] = __builtin_amdgcn_cvt_pk_fp8_f32(f[q][j].x * sc, f[q][j].y * sc, 0, false);
        w[j] = __builtin_amdgcn_cvt_pk_fp8_f32(f[q][j].z * sc, f[q][j].w * sc, w[j], true);
      }
      *(uint4*)(dst + cq * 16) = make_uint4(w[0], w[1], w[2], w[3]);
    }
  }
  for (; c < 2 * nch; c += nth) {
    const bool isu = c < nch;
    const float* src = isu ? su + c * 16 : sv + (c - nch) * 16;
    const float sc = isu ? U8_SCALE : V8_SCALE;
    const float4 f0 = *(const float4*)src, f1 = *(const float4*)(src + 4), f2 = *(const float4*)(src + 8), f3 = *(const float4*)(src + 12);
    uint4 v;
    v.x = __builtin_amdgcn_cvt_pk_fp8_f32(f0.x * sc, f0.y * sc, 0, false); v.x = __builtin_amdgcn_cvt_pk_fp8_f32(f0.z * sc, f0.w * sc, v.x, true);
    v.y = __builtin_amdgcn_cvt_pk_fp8_f32(f1.x * sc, f1.y * sc, 0, false); v.y = __builtin_amdgcn_cvt_pk_fp8_f32(f1.z * sc, f1.w * sc, v.y, true);
    v.z = __builtin_amdgcn_cvt_pk_fp8_f32(f2.x * sc, f2.y * sc, 0, false); v.z = __builtin_amdgcn_cvt_pk_fp8_f32(f2.z * sc, f2.w * sc, v.z, true);
    v.w = __builtin_amdgcn_cvt_pk_fp8_f32(f3.x * sc, f3.y * sc, 0, false); v.w = __builtin_amdgcn_cvt_pk_fp8_f32(f3.z * sc, f3.w * sc, v.w, true);
    *(uint4*)(dst + c * 16) = v;
  }
}

typedef unsigned long long u64;
__device__ __forceinline__ unsigned f2ord(float f) { unsigned u = __float_as_uint(f); return u ^ ((u >> 31) ? 0xffffffffu : 0x80000000u); }
__device__ __forceinline__ float ord2f(unsigned u) { return __uint_as_float(u ^ ((u >> 31) ? 0x80000000u : 0xffffffffu)); }
__device__ const unsigned char PEER_CAND[56] = {
  0x00,0x01,0x02,0x03,0x04,0x05,0x06,0x07,0x08,0x09,0x0a,0x0b,0x0c,0x0d,0x0e,0x0f,
  0x10,0x11,0x12,0x13,0x14,0x15,0x16,0x17,
  0x20,0x21,0x22,0x23,0x24,
  0x30,0x31,0x32,0x33,
  0x40,0x41,0x42,
  0x50,0x51, 0x60,0x61, 0x70,0x71,
  0x80,0x90,0xa0,0xb0,0xc0,0xd0,0xe0,0xf0,
  0xff,0xff,0xff,0xff,0xff,0xff};

template <int N>
__device__ __forceinline__ void sort_desc(unsigned (&a)[N]) {
#pragma unroll
  for (int k = 2; k <= N; k <<= 1) {
#pragma unroll
    for (int j = k >> 1; j > 0; j >>= 1) {
#pragma unroll
      for (int i = 0; i < N; ++i) {
        const int m = i ^ j;
        if (m > i) {
          const unsigned x = a[i], y = a[m];
          const unsigned hi = x > y ? x : y, lo = x > y ? y : x;
          if ((i & k) == 0) { a[i] = hi; a[m] = lo; } else { a[i] = lo; a[m] = hi; }
        }
      }
    }
  }
}
template <int CTRL> __device__ __forceinline__ unsigned dpp_mov_u(unsigned x) {
  return (unsigned)__builtin_amdgcn_update_dpp(0, (int)x, CTRL, 0xf, 0xf, true);
}
__device__ __forceinline__ unsigned group8_max(unsigned v) {
  unsigned o = dpp_mov_u<0xB1>(v); v = o > v ? o : v;
  o = dpp_mov_u<0x4E>(v); v = o > v ? o : v;
  o = dpp_mov_u<0x141>(v); v = o > v ? o : v;
  return v;
}

__device__ __forceinline__ void select_load_keys(const Params& p, int l, int h, char* Ks, int tid) {
#pragma unroll
  for (int ph = 0; ph < 2; ++ph) {
    const float* kbase = p.peer_keys + ((size_t)(l * 8 + h) * 2 + ph) * 128 * 128;
#pragma unroll
    for (int i = 0; i < 4; ++i) {
      const int c = tid + i * NTHREADS, row = c >> 4, kc = c & 15;
      const float4 a = *(const float4*)(kbase + row * 128 + kc * 8), b = *(const float4*)(kbase + row * 128 + kc * 8 + 4);
      uint4 v;
      v.x = pk_bf16(a.x, a.y); v.y = pk_bf16(a.z, a.w); v.z = pk_bf16(b.x, b.y); v.w = pk_bf16(b.z, b.w);
      *(uint4*)(Ks + ph * 32768 + row * 256 + ((kc ^ (row & 15)) << 4)) = v;
    }
  }
}
#define SEL_BAR() { asm volatile("s_waitcnt lgkmcnt(0)" ::: "memory"); __builtin_amdgcn_s_barrier(); asm volatile("" ::: "memory"); }
__device__ __forceinline__ void select_qload(const Params& p, int tb, int h, int ph, int tid, uint4& q0, uint4& q1) {
  const bf16_t* Qg = peerQ(p);
  { const int c = tid, row = c >> 4, kc = c & 15; q0 = *(const uint4*)(Qg + (size_t)(tb * 64 + row) * 2048 + h * 256 + ph * 128 + kc * 8); }
  { const int c = tid + NTHREADS, row = c >> 4, kc = c & 15; q1 = *(const uint4*)(Qg + (size_t)(tb * 64 + row) * 2048 + h * 256 + ph * 128 + kc * 8); }
}
__device__ __forceinline__ void select_tile(const Params& p, int tb, int tbn, int h, char* smem, int tid, uint4& q0, uint4& q1) {
  const int tok0 = tb * 64;
  char* Ks = smem;
  char* Qs = smem + 65536;
  float* Sc = (float*)(smem + 81920);
  unsigned* tops = (unsigned*)(smem + 115712);
  const int lane = tid & 63, w = tid >> 6, l15 = lane & 15, lq = lane >> 4;
  const int tok = tid >> 3, g = tid & 7;
#pragma unroll
  for (int ph = 0; ph < 2; ++ph) {
    { const int c = tid, row = c >> 4, kc = c & 15; *(uint4*)(Qs + row * 256 + ((kc ^ (row & 15)) << 4)) = q0; }
    { const int c = tid + NTHREADS, row = c >> 4, kc = c & 15; *(uint4*)(Qs + row * 256 + ((kc ^ (row & 15)) << 4)) = q1; }
    if (ph == 0) select_qload(p, tb, h, 1, tid, q0, q1); else select_qload(p, tbn, h, 0, tid, q0, q1);
    SEL_BAR();
    {
      f32x4 acc[4];
#pragma unroll
      for (int j = 0; j < 4; ++j) acc[j] = f32x4{0.f, 0.f, 0.f, 0.f};
#pragma unroll
      for (int ks = 0; ks < 4; ++ks) {
        const int koff = ((ks * 4 + lq) ^ l15) << 4;
        bf16x8 af = *(const bf16x8*)(Ks + ph * 32768 + (16 * w + l15) * 256 + koff);
#pragma unroll
        for (int j = 0; j < 4; ++j) {
          bf16x8 bfr = *(const bf16x8*)(Qs + (16 * j + l15) * 256 + koff);
          acc[j] = __builtin_amdgcn_mfma_f32_16x16x32_bf16(af, bfr, acc[j], 0, 0, 0);
        }
      }
#pragma unroll
      for (int j = 0; j < 4; ++j)
        *(float4*)(Sc + (16 * j + l15) * 132 + 16 * w + lq * 4) = make_float4(acc[j][0], acc[j][1], acc[j][2], acc[j][3]);
    }
    SEL_BAR();
    {
      unsigned lst[16];
      const float* sr = Sc + tok * 132 + g * 16;
#pragma unroll
      for (int q4 = 0; q4 < 4; ++q4) {
        float4 v = *(const float4*)(sr + q4 * 4);
        const unsigned base = 127u - (unsigned)(g * 16 + q4 * 4);
        lst[q4 * 4 + 0] = (f2ord(v.x) & ~127u) | (base);
        lst[q4 * 4 + 1] = (f2ord(v.y) & ~127u) | (base - 1);
        lst[q4 * 4 + 2] = (f2ord(v.z) & ~127u) | (base - 2);
        lst[q4 * 4 + 3] = (f2ord(v.w) & ~127u) | (base - 3);
      }
      sort_desc<16>(lst);
      unsigned* tp = tops + (tok * 2 + ph) * 16;
#pragma unroll
      for (int it = 0; it < 16; ++it) {
        const unsigned mx = group8_max(lst[0]);
        const bool own = lst[0] == mx;
#pragma unroll
        for (int k = 0; k < 15; ++k) lst[k] = own ? lst[k + 1] : lst[k];
        lst[15] = own ? 0u : lst[15];
        if (g == 0) tp[it] = mx;
      }
    }
  }
  SEL_BAR();
  {
    const unsigned* t0 = tops + (tok * 2) * 16;
    const unsigned* t1 = t0 + 16;
    unsigned lst[8];
#pragma unroll
    for (int s_ = 0; s_ < 7; ++s_) {
      const unsigned c = PEER_CAND[g + 8 * s_];
      unsigned key = 0u;
      if (c != 0xff) {
        const float sc = ord2f(t0[c >> 4] & ~127u) + ord2f(t1[c & 15] & ~127u);
        key = (f2ord(sc) & ~63u) | (63u - (unsigned)(g + 8 * s_));
      }
      lst[s_] = key;
    }
    lst[7] = 0u;
    sort_desc<8>(lst);
    float bs[16]; unsigned bc[16];
#pragma unroll
    for (int it = 0; it < 16; ++it) {
      const unsigned mx = group8_max(lst[0]);
      const bool own = lst[0] == mx;
#pragma unroll
      for (int k = 0; k < 7; ++k) lst[k] = own ? lst[k + 1] : lst[k];
      lst[7] = own ? 0u : lst[7];
      bs[it] = ord2f(mx & ~63u);
      bc[it] = 63u - (mx & 63u);
    }
    const float mx0 = bs[0];
    float sum = 0.f;
#pragma unroll
    for (int it = 0; it < 16; ++it) { bs[it] = FEXP(bs[it] - mx0); sum += bs[it]; }
    const float inv = 1.0f / sum;
    int* oi = sel2i(p) + ((size_t)(tok0 + tok) * 8 + h) * 16;
    float* og = sel2g(p) + ((size_t)(tok0 + tok) * 8 + h) * 16;
#pragma unroll
    for (int it = 0; it < 16; ++it) {
      if ((it & 7) == g) {
        const unsigned c = PEER_CAND[bc[it]];
        const unsigned i0 = 127u - (t0[c >> 4] & 127u), i1 = 127u - (t1[c & 15] & 127u);
        oi[it] = (int)(i0 * 128 + i1);
        og[it] = bs[it] * inv;
      }
    }
  }
  SEL_BAR();
}

__device__ __forceinline__ void select_phase(const Params& p, int l, int nr, char* smem, int wave_s) {
  const int ntb = nr / 64, nb = gridDim.x;
  int cur_h = -1;
  if (nb % 8 == 0) {
    const int bph = nb / 8, h = blockIdx.x / bph;
    uint4 q0, q1;
    {
      const int tid = make_tid(wave_s);
      select_qload(p, min((int)(blockIdx.x % bph), ntb - 1), h, 0, tid, q0, q1);
    }
    for (int tb = blockIdx.x % bph; tb < ntb; tb += bph) {
      const int tid = make_tid(wave_s);
      if (cur_h != h) { select_load_keys(p, l, h, smem, tid); cur_h = h; }
      select_tile(p, tb, min(tb + bph, ntb - 1), h, smem, tid, q0, q1);
    }
  } else {
    for (int t = blockIdx.x; t < ntb * 8; t += nb) {
      const int tid = make_tid(wave_s);
      const int h = t & 7;
      __syncthreads();
      select_load_keys(p, l, h, smem, tid);
      uint4 q0, q1;
      select_qload(p, t >> 3, h, 0, tid, q0, q1);
      select_tile(p, t >> 3, t >> 3, h, smem, tid, q0, q1);
    }
  }
}

__device__ __forceinline__ float dot16_fp8(const float (&x)[16], uint4 u, float acc) {
  f32x2v t;
  t = __builtin_amdgcn_cvt_pk_f32_fp8(u.x, false); acc += x[0] * t[0]; acc += x[1] * t[1];
  t = __builtin_amdgcn_cvt_pk_f32_fp8(u.x, true);  acc += x[2] * t[0]; acc += x[3] * t[1];
  t = __builtin_amdgcn_cvt_pk_f32_fp8(u.y, false); acc += x[4] * t[0]; acc += x[5] * t[1];
  t = __builtin_amdgcn_cvt_pk_f32_fp8(u.y, true);  acc += x[6] * t[0]; acc += x[7] * t[1];
  t = __builtin_amdgcn_cvt_pk_f32_fp8(u.z, false); acc += x[8] * t[0]; acc += x[9] * t[1];
  t = __builtin_amdgcn_cvt_pk_f32_fp8(u.z, true);  acc += x[10] * t[0]; acc += x[11] * t[1];
  t = __builtin_amdgcn_cvt_pk_f32_fp8(u.w, false); acc += x[12] * t[0]; acc += x[13] * t[1];
  t = __builtin_amdgcn_cvt_pk_f32_fp8(u.w, true);  acc += x[14] * t[0]; acc += x[15] * t[1];
  return acc;
}
__device__ __forceinline__ void axpy16_fp8(float c, uint4 v, float (&acc)[16]) {
  f32x2v t;
  t = __builtin_amdgcn_cvt_pk_f32_fp8(v.x, false); acc[0] += c * t[0]; acc[1] += c * t[1];
  t = __builtin_amdgcn_cvt_pk_f32_fp8(v.x, true);  acc[2] += c * t[0]; acc[3] += c * t[1];
  t = __builtin_amdgcn_cvt_pk_f32_fp8(v.y, false); acc[4] += c * t[0]; acc[5] += c * t[1];
  t = __builtin_amdgcn_cvt_pk_f32_fp8(v.y, true);  acc[6] += c * t[0]; acc[7] += c * t[1];
  t = __builtin_amdgcn_cvt_pk_f32_fp8(v.z, false); acc[8] += c * t[0]; acc[9] += c * t[1];
  t = __builtin_amdgcn_cvt_pk_f32_fp8(v.z, true);  acc[10] += c * t[0]; acc[11] += c * t[1];
  t = __builtin_amdgcn_cvt_pk_f32_fp8(v.w, false); acc[12] += c * t[0]; acc[13] += c * t[1];
  t = __builtin_amdgcn_cvt_pk_f32_fp8(v.w, true);  acc[14] += c * t[0]; acc[15] += c * t[1];
}
__device__ __forceinline__ f32x2v fma2(f32x2v a, f32x2v b, f32x2v c) { return __builtin_elementwise_fma(a, b, c); }
__device__ __forceinline__ float dot16p_fp8(const f32x2v (&x)[8], uint4 u) {
  f32x2v a = x[0] * __builtin_amdgcn_cvt_pk_f32_fp8(u.x, false);
  a = fma2(x[1], __builtin_amdgcn_cvt_pk_f32_fp8(u.x, true), a);
  a = fma2(x[2], __builtin_amdgcn_cvt_pk_f32_fp8(u.y, false), a);
  a = fma2(x[3], __builtin_amdgcn_cvt_pk_f32_fp8(u.y, true), a);
  a = fma2(x[4], __builtin_amdgcn_cvt_pk_f32_fp8(u.z, false), a);
  a = fma2(x[5], __builtin_amdgcn_cvt_pk_f32_fp8(u.z, true), a);
  a = fma2(x[6], __builtin_amdgcn_cvt_pk_f32_fp8(u.w, false), a);
  a = fma2(x[7], __builtin_amdgcn_cvt_pk_f32_fp8(u.w, true), a);
  return a[0] + a[1];
}
__device__ __forceinline__ void axpy16p_fp8(float c, uint4 v, f32x2v (&acc)[8]) {
  const f32x2v c2 = {c, c};
  acc[0] = fma2(c2, __builtin_amdgcn_cvt_pk_f32_fp8(v.x, false), acc[0]);
  acc[1] = fma2(c2, __builtin_amdgcn_cvt_pk_f32_fp8(v.x, true), acc[1]);
  acc[2] = fma2(c2, __builtin_amdgcn_cvt_pk_f32_fp8(v.y, false), acc[2]);
  acc[3] = fma2(c2, __builtin_amdgcn_cvt_pk_f32_fp8(v.y, true), acc[3]);
  acc[4] = fma2(c2, __builtin_amdgcn_cvt_pk_f32_fp8(v.z, false), acc[4]);
  acc[5] = fma2(c2, __builtin_amdgcn_cvt_pk_f32_fp8(v.z, true), acc[5]);
  acc[6] = fma2(c2, __builtin_amdgcn_cvt_pk_f32_fp8(v.w, false), acc[6]);
  acc[7] = fma2(c2, __builtin_amdgcn_cvt_pk_f32_fp8(v.w, true), acc[7]);
}
__device__ __forceinline__ f32x2v bf2_to_f2(unsigned w) {
  f32x2v r; r[0] = __builtin_bit_cast(float, w << 16); r[1] = __builtin_bit_cast(float, w & 0xffff0000u); return r;
}
typedef __attribute__((ext_vector_type(4))) float f32x4u;
typedef __attribute__((ext_vector_type(2))) long i64x2u;
struct UPre { int idxA, idxB; float gA, gB; i64x2u xh; };
__device__ __forceinline__ void u_load_pre(const Params& p, int row, int lane, UPre& P) {
  P.idxA = sel2i(p)[(size_t)row * 128 + lane]; P.idxB = sel2i(p)[(size_t)row * 128 + 64 + lane];
  P.gA = sel2g(p)[(size_t)row * 128 + lane]; P.gB = sel2g(p)[(size_t)row * 128 + 64 + lane];
  P.xh = *(const i64x2u*)(xqbuf(p) + (size_t)row * 1024 + lane * 16);
}
__device__ __forceinline__ float trace_dot(i64x2u u, i64x2u xh, bool b0, bool b1, bool ondiag) {
  const f32x4u z = {0.f, 0.f, 0.f, 0.f};
  f32x4u a0 = __builtin_amdgcn_mfma_f32_16x16x32_fp8_fp8(u[0], xh[0], z, 0, 0, 0);
  a0 = __builtin_amdgcn_mfma_f32_16x16x32_fp8_fp8(u[1], xh[1], a0, 0, 0, 0);
  const float t01 = b0 ? a0[1] : a0[0], t23 = b0 ? a0[3] : a0[2];
  const float t = b1 ? t23 : t01;
  return ondiag ? t : 0.f;
}
__device__ __forceinline__ float gelu_as(float x) {
  const float z = fabsf(x) * 0.70710678118654752f;
  const float t = __builtin_amdgcn_rcpf(fmaf(0.3275911f, z, 1.0f));
  float q = fmaf(1.061405429f, t, -1.453152027f);
  q = fmaf(q, t, 1.421413741f); q = fmaf(q, t, -0.284496736f); q = fmaf(q, t, 0.254829592f);
  const float e = 1.0f - q * t * __builtin_amdgcn_exp2f(-1.4426950408889634f * z * z);
  return 0.5f * x * (1.0f + copysignf(e, x));
}
__device__ __forceinline__ void u_gather(const unsigned char* TBu, const int2* L, int lane, int b0, int cnt, i64x2u (&ub)[16]) {
  const int2 ent = L[min(b0 + (lane & 15), max(cnt - 1, 0))];
#pragma unroll
  for (int qd = 0; qd < 4; ++qd) {
    if (qd == 0 || b0 + 4 * qd < cnt) {
#pragma unroll
      for (int e = 4 * qd; e < 4 * qd + 4; ++e) {
        const int ie = __builtin_amdgcn_readlane(ent.x, e) & 0x3fff;
        ub[e] = *(const i64x2u*)(TBu + (size_t)ie * 1024 + lane * 16);
      }
    }
  }
}
__device__ __forceinline__ void u_dots(const int2* L, int lane, int b0, int cnt, const i64x2u (&ub)[16], i64x2u xh, float* cfr) {
  const bool db0 = lane & 1, db1 = lane & 2, ondiag = ((lane >> 2) & 3) == (lane >> 4);
  float d[16];
#pragma unroll
  for (int qd = 0; qd < 4; ++qd) {
    if (qd == 0 || b0 + 4 * qd < cnt) {
#pragma unroll
      for (int e = 4 * qd; e < 4 * qd + 4; ++e) d[e] = trace_dot(ub[e], xh, db0, db1, ondiag);
    } else {
#pragma unroll
      for (int e = 4 * qd; e < 4 * qd + 4; ++e) d[e] = 0.f;
    }
  }
  float r8[8], r4[4], r2[2], r1;
  {
    const bool up = lane & 32;
#pragma unroll
    for (int i = 0; i < 8; ++i) { float snd = up ? d[i] : d[i + 8]; float kp = up ? d[i + 8] : d[i]; r8[i] = kp + __shfl_xor(snd, 32); }
  }
  {
    const bool up = lane & 16;
#pragma unroll
    for (int i = 0; i < 4; ++i) { float snd = up ? r8[i] : r8[i + 4]; float kp = up ? r8[i + 4] : r8[i]; r4[i] = kp + __shfl_xor(snd, 16); }
  }
  {
    const bool up = lane & 8;
#pragma unroll
    for (int i = 0; i < 2; ++i) { float snd = up ? r4[i] : r4[i + 2]; float kp = up ? r4[i + 2] : r4[i]; r2[i] = kp + __shfl_xor(snd, 8); }
  }
  {
    const bool up = lane & 4;
    float snd = up ? r2[0] : r2[1]; float kp = up ? r2[1] : r2[0];
    r1 = kp + __shfl_xor(snd, 4);
  }
  r1 += dppx<0xB1>(r1);
  r1 += dppx<0x4E>(r1);
  r1 *= (1.0f / (U8_SCALE * XQ_SCALE));
  const int my_e = ((lane & 32) ? 8 : 0) + ((lane & 16) ? 4 : 0) + ((lane & 8) ? 2 : 0) + ((lane & 4) ? 1 : 0);
  const int pos = b0 + my_e;
  const int2 e2 = L[min(pos, max(cnt - 1, 0))];
  const float coef = __builtin_bit_cast(float, e2.y) * gelu_as(r1) * (1.0f / V8_SCALE);
  if (pos < cnt && (lane & 3) == 0) cfr[e2.x >> 16] = coef;
}
__device__ __forceinline__ int u_compact(const UPre& P, int2* L, int lane, int part) {
  const int idxA = P.idxA, idxB = P.idxB; const float gA = P.gA, gB = P.gB;
  const bool mA = (idxA >> 11) == part, mB = (idxB >> 11) == part;
  const unsigned long long maskA = __ballot(mA), maskB = __ballot(mB);
  const int cntA = __popcll(maskA), cnt = cntA + __popcll(maskB);
  const int rnkA = (int)__builtin_amdgcn_mbcnt_hi((unsigned)(maskA >> 32), __builtin_amdgcn_mbcnt_lo((unsigned)maskA, 0u));
  const int rnkB = cntA + (int)__builtin_amdgcn_mbcnt_hi((unsigned)(maskB >> 32), __builtin_amdgcn_mbcnt_lo((unsigned)maskB, 0u));
  if (mA) L[rnkA] = make_int2(idxA | (lane << 16), __builtin_bit_cast(int, gA));
  if (mB) L[rnkB] = make_int2(idxB | ((lane + 64) << 16), __builtin_bit_cast(int, gB));
  return cnt;
}
__device__ __forceinline__ void u_pair(const Params& p, const unsigned char* TBu, char* W, int lane, int unA, int unB, int total,
                                       int sh, bool even, int prowA_next, int prowB_next, UPre& PA, UPre& PB) {
  int2* LA = (int2*)W; int2* LB = (int2*)(W + 1024);
  const int cntA = u_compact(PA, LA, lane, even ? (int)(blockIdx.x & 7) : (unA & 7));
  const int cntB = (unB < total) ? u_compact(PB, LB, lane, even ? (int)(blockIdx.x & 7) : (unB & 7)) : 0;
  const i64x2u xhA = PA.xh, xhB = PB.xh;
  float* cfA = coefb(p) + (size_t)(unA >> sh) * 128;
  float* cfB = coefb(p) + (size_t)(min(unB, total - 1) >> sh) * 128;
  i64x2u ubA[16], ubB[16];
  for (int b0 = ((cntA - 1) >> 4) << 4; b0 >= 32; b0 -= 16) { u_gather(TBu, LA, lane, b0, cntA, ubA); u_dots(LA, lane, b0, cntA, ubA, xhA, cfA); }
  for (int b0 = ((cntB - 1) >> 4) << 4; b0 >= 32; b0 -= 16) { u_gather(TBu, LB, lane, b0, cntB, ubB); u_dots(LB, lane, b0, cntB, ubB, xhB, cfB); }
  if (cntA > 16 || cntB > 16) {
    if (cntA > 16) u_gather(TBu, LA, lane, 16, cntA, ubA);
    if (cntB > 16) u_gather(TBu, LB, lane, 16, cntB, ubB);
    __builtin_amdgcn_sched_barrier(0);
    if (cntA > 16) u_dots(LA, lane, 16, cntA, ubA, xhA, cfA);
    if (cntB > 16) u_dots(LB, lane, 16, cntB, ubB, xhB, cfB);
  }
  u_gather(TBu, LA, lane, 0, cntA, ubA);
  u_gather(TBu, LB, lane, 0, cntB, ubB);
  __builtin_amdgcn_sched_barrier(0);
  u_load_pre(p, prowA_next, lane, PA);
  u_load_pre(p, prowB_next, lane, PB);
  __builtin_amdgcn_sched_barrier(0);
  u_dots(LA, lane, 0, cntA, ubA, xhA, cfA);
  u_dots(LB, lane, 0, cntB, ubB, xhB, cfB);
}
__device__ __forceinline__ void expert_u_phase(const Params& p, int l, int nr, int wave_s, char* smem) {
  const unsigned char* TBu = (const unsigned char*)p.TB();
  char* W = smem + wave_s * 2048;
  const int nb = gridDim.x;
  const bool even = (nb & 7) == 0;
  const int sh = even ? 0 : 3;
  const int total = nr << sh;
  const int stride = (even ? (nb >> 3) : nb) * 8;
  int un = (even ? (int)(blockIdx.x >> 3) : (int)blockIdx.x) * 8 + wave_s;
  UPre P0, P1, P2, P3;
  {
    const int lane = make_tid(wave_s) & 63;
    u_load_pre(p, min(un, total - 1) >> sh, lane, P0);
    u_load_pre(p, min(un + stride, total - 1) >> sh, lane, P1);
    u_load_pre(p, min(un + 2 * stride, total - 1) >> sh, lane, P2);
    u_load_pre(p, min(un + 3 * stride, total - 1) >> sh, lane, P3);
  }
  while (un < total) {
    {
      const int lane = make_tid(wave_s) & 63;
      u_pair(p, TBu, W, lane, un, un + stride, total, sh, even,
             min(un + 4 * stride, total - 1) >> sh, min(un + 5 * stride, total - 1) >> sh, P0, P1);
    }
    un += 2 * stride;
    if (un >= total) break;
    {
      const int lane = make_tid(wave_s) & 63;
      u_pair(p, TBu, W, lane, un, un + stride, total, sh, even,
             min(un + 4 * stride, total - 1) >> sh, min(un + 5 * stride, total - 1) >> sh, P2, P3);
    }
    un += 2 * stride;
  }
}

#define VLOAD(buf_, idxv_, base_) _Pragma("unroll") for (int e = 0; e < 16; ++e) { \
    const int ie = __builtin_amdgcn_readlane(idxv_, (base_) + e); buf_[e] = *(const uint4*)(TBv + (size_t)ie * 1024 + lane * 16); }
#define VAXPY(buf_, cfv_, base_) _Pragma("unroll") for (int e = 0; e < 16; ++e) { \
    const float c = __builtin_bit_cast(float, __builtin_amdgcn_readlane(__builtin_bit_cast(int, cfv_), (base_) + e)); axpy16p_fp8(c, buf_[e], acc2); }
__device__ __forceinline__ void expert_phase(const Params& p, int l, int nr, int wave_s) {
  const unsigned char* TBv = (const unsigned char*)p.TB() + (size_t)16384 * 1024;
  for (int row = blockIdx.x * 8 + wave_s; row < nr; row += gridDim.x * 8) {
    const int lane = make_tid(wave_s) & 63;
    const int* idxr = sel2i(p) + (size_t)row * 128;
    const float* cfr = coefb(p) + (size_t)row * 128;
    const int iA = idxr[lane], iB = idxr[64 + lane];
    const float cA = cfr[lane], cB = cfr[64 + lane];
    f32x2v acc2[8];
#pragma unroll
    for (int i = 0; i < 8; ++i) { acc2[i][0] = 0.f; acc2[i][1] = 0.f; }
    uint4 va[16], vb[16];
    VLOAD(va, iA, 0)
    VLOAD(vb, iA, 16) LOAD_FENCE(); VAXPY(va, cA, 0)
    VLOAD(va, iA, 32) LOAD_FENCE(); VAXPY(vb, cA, 16)
    VLOAD(vb, iA, 48) LOAD_FENCE(); VAXPY(va, cA, 32)
    VLOAD(va, iB, 0)  LOAD_FENCE(); VAXPY(vb, cA, 48)
    VLOAD(vb, iB, 16) LOAD_FENCE(); VAXPY(va, cB, 0)
    VLOAD(va, iB, 32) LOAD_FENCE(); VAXPY(vb, cB, 16)
    VLOAD(vb, iB, 48) LOAD_FENCE(); VAXPY(va, cB, 32)
    LOAD_FENCE(); VAXPY(vb, cB, 48)
    float acc[16];
#pragma unroll
    for (int i = 0; i < 8; ++i) { acc[2 * i] = acc2[i][0]; acc[2 * i + 1] = acc2[i][1]; }
    const float* m = p.mod() + ((size_t)l * NMODV + modv_of_row(row)) * 6144;
    float hx[16], g[16], bb[16];
    float* hd = hdst_row(p, row);
    ldrow16_f32(hd, lane, hx);
    ldrow16_f32(m + 5120, lane, g);
#pragma unroll
    for (int i = 0; i < 16; ++i) { asm volatile("" : "+v"(acc[i])); hx[i] = fmaf(g[i], acc[i], DN_ALPHA * hx[i]); }
    float mean, rstd;
    row_ln_stats(hx, mean, rstd);
    ldrow16_f32(p.ln_ffn_g + l * DM, lane, g); ldrow16_f32(p.ln_ffn_b + l * DM, lane, bb);
#pragma unroll
    for (int i = 0; i < 16; ++i) hx[i] = (hx[i] - mean) * rstd * g[i] + bb[i];
    strow16_f32(hd, lane, hx);
    if (l == 0) {
      const float* m1 = p.mod() + ((size_t)1 * NMODV + modv_of_row(row)) * 6144;
      row_ln_stats(hx, mean, rstd);
      ldrow16_f32(m1 + 1024, lane, g); ldrow16_f32(m1, lane, bb);
#pragma unroll
      for (int i = 0; i < 16; ++i) hx[i] = (hx[i] - mean) * rstd * (1.0f + g[i]) + bb[i];
      strow16_bf16(p.Y() + (size_t)row * DM, lane, hx);
    }
  }
}

__device__ __forceinline__ float reduce32(float x) {
  x += dppx<0xB1>(x);
  x += dppx<0x4E>(x);
  x += dppx<0x141>(x);
  x += dppx<0x140>(x);
  float a = x, b = x;
  asm volatile("s_nop 1\n\tv_permlane16_swap_b32 %0, %1" : "+v"(a), "+v"(b));
  return a + b;
}

__device__ __forceinline__ float reduce16(float x) {
  x += dppx<0xB1>(x);
  x += dppx<0x4E>(x);
  x += dppx<0x141>(x);
  x += dppx<0x140>(x);
  return x;
}

__device__ __forceinline__ float wsum(float x) {
  x = reduce16(x);
  float a = x, b = x;
  asm volatile("s_nop 1\n\tv_permlane16_swap_b32 %0, %1" : "+v"(a), "+v"(b));
  x = a + b; a = x; b = x;
  asm volatile("s_nop 1\n\tv_permlane32_swap_b32 %0, %1" : "+v"(a), "+v"(b));
  return a + b;
}

__device__ __forceinline__ void fast_rwprep(const Params& p, int l, char* smem, int wave_s) {
  int tid = make_tid(wave_s);
  float* Cv = (float*)smem;
  const float* mu = p.rwkv_mu + (size_t)l * 2 * 1152;
  const int c = tid & 255, tg = tid >> 8, lane = tid & 63, h = c >> 6;
  for (int tile = blockIdx.x; tile < NTOK / 16; tile += gridDim.x) {
    const int r0 = tile * 16;
#pragma unroll
    for (int q = 0; q < 5; ++q) {
      const int idx = tid + q * NTHREADS;
      if (idx < 16 * 144) {
        const int tk = idx / 144, ch = idx - tk * 144, col = ch * 8;
        const int row = r0 + tk;
        int t, len; seq_pos(row, t, len);
        const bf16_t* src = p.P() + (size_t)row * INC + OFF_B + col;
        const uint4 zero4 = make_uint4(0u, 0u, 0u, 0u);
        const uint4 cu = *(const uint4*)src;
        const uint4 pu = t > 0 ? *(const uint4*)(src - INC) : zero4;
        const uint4 nu = t < len - 1 ? *(const uint4*)(src + INC) : zero4;
        float xc[8], xp[8], xn[8], m0[8], m1[8];
        unpack8(cu, xc); unpack8(pu, xp); unpack8(nu, xn);
        *(float4*)m0 = *(const float4*)(mu + col); *(float4*)(m0 + 4) = *(const float4*)(mu + col + 4);
        *(float4*)m1 = *(const float4*)(mu + 1152 + col); *(float4*)(m1 + 4) = *(const float4*)(mu + 1152 + col + 4);
        float o[8];
#pragma unroll
        for (int e = 0; e < 8; ++e) {
          float v = xc[e] * (1.0f - m0[e] - m1[e]) + xp[e] * m0[e] + xn[e] * m1[e];
          if (col >= 768 && col < 896) v = tanhf_(v);
          else if (col >= 1024) v = sigmoidf_(v);
          o[e] = v;
        }
        *(float4*)(Cv + tk * 1152 + col) = make_float4(o[0], o[1], o[2], o[3]);
        *(float4*)(Cv + tk * 1152 + col + 4) = make_float4(o[4], o[5], o[6], o[7]);
      }
    }
    __syncthreads();
    float aw0[8], aw1[8], aa0[8], aa1[8], ag[8];
#pragma unroll
    for (int t = 0; t < 8; ++t) { aw0[t] = 0.f; aw1[t] = 0.f; aa0[t] = 0.f; aa1[t] = 0.f; ag[t] = 0.f; }
    const float* cvb = Cv + (tg * 8) * 1152;
    const float* w2a = p.rwkv_w2 + (size_t)(l * 2 + 0) * 64 * 256 + c;
    const float* w2b = p.rwkv_w2 + (size_t)(l * 2 + 1) * 64 * 256 + c;
    const float* a2a = p.rwkv_a2 + (size_t)(l * 2 + 0) * 64 * 256 + c;
    const float* a2b = p.rwkv_a2 + (size_t)(l * 2 + 1) * 64 * 256 + c;
    const float* g2p = p.rwkv_g2 + (size_t)l * 128 * 256 + c;
    for (int rr = 0; rr < 64; rr += 4) {
      float wa[4], wb[4], xa[4], xb[4];
#pragma unroll
      for (int q = 0; q < 4; ++q) { wa[q] = w2a[(rr + q) * 256]; wb[q] = w2b[(rr + q) * 256]; xa[q] = a2a[(rr + q) * 256]; xb[q] = a2b[(rr + q) * 256]; }
#pragma unroll
      for (int t = 0; t < 8; ++t) {
        float4 d0 = *(const float4*)(cvb + t * 1152 + 768 + rr), d1 = *(const float4*)(cvb + t * 1152 + 832 + rr);
        float4 e0 = *(const float4*)(cvb + t * 1152 + 896 + rr), e1 = *(const float4*)(cvb + t * 1152 + 960 + rr);
        aw0[t] += d0.x * wa[0] + d0.y * wa[1] + d0.z * wa[2] + d0.w * wa[3];
        aw1[t] += d1.x * wb[0] + d1.y * wb[1] + d1.z * wb[2] + d1.w * wb[3];
        aa0[t] += e0.x * xa[0] + e0.y * xa[1] + e0.z * xa[2] + e0.w * xa[3];
        aa1[t] += e1.x * xb[0] + e1.y * xb[1] + e1.z * xb[2] + e1.w * xb[3];
      }
    }
    for (int rr = 0; rr < 128; rr += 4) {
      float gg[4];
#pragma unroll
      for (int q = 0; q < 4; ++q) gg[q] = g2p[(rr + q) * 256];
#pragma unroll
      for (int t = 0; t < 8; ++t) {
        float4 d0 = *(const float4*)(cvb + t * 1152 + 1024 + rr);
        ag[t] += d0.x * gg[0] + d0.y * gg[1] + d0.z * gg[2] + d0.w * gg[3];
      }
    }
    const float w00 = p.rwkv_w0[(l * 2 + 0) * 256 + c], w01 = p.rwkv_w0[(l * 2 + 1) * 256 + c];
    const float a00 = p.rwkv_a0[(l * 2 + 0) * 256 + c], a01 = p.rwkv_a0[(l * 2 + 1) * 256 + c];
    const float kkc = p.rwkv_kk[l * 256 + c], kac = p.rwkv_ka[l * 256 + c], rkc = p.rwkv_rk[l * 256 + c];
#pragma unroll
    for (int t = 0; t < 8; ++t) {
      const int row = r0 + tg * 8 + t;
      const float r = cvb[t * 1152 + c], k = cvb[t * 1152 + 256 + c], v = cvb[t * 1152 + 512 + c];
      const float wd0 = FEXP(-sigmoidf_(w00 + aw0[t]) * 0.6065306597126334f);
      const float wd1 = FEXP(-sigmoidf_(w01 + aw1[t]) * 0.6065306597126334f);
      const float ad0 = sigmoidf_(a00 + aa0[t]), ad1 = sigmoidf_(a01 + aa1[t]);
      const float kr = k * kkc;
      const float kk = kr * (1.0f / sqrtf(wsum(kr * kr) + 1e-6f));
      const float kd0 = k * (1.0f + (ad0 - 1.0f) * kac), kd1 = k * (1.0f + (ad1 - 1.0f) * kac);
      const float ka0 = kk * ad0, ka1 = kk * ad1;
      const float c10 = wsum(kd0 * r), c20 = wsum(ka0 * r), c11 = wsum(kd1 * r), c21 = wsum(ka1 * r);
      const float bonus = wsum(r * (kd0 + kd1) * rkc);
      float* rec = p.RW() + ((size_t)row * 4 + h) * RWREC;
      rec[lane] = kk; rec[64 + lane] = v;
      rec[128 + lane] = wd0 * r; rec[192 + lane] = wd0; rec[256 + lane] = kd0; rec[320 + lane] = ka0;
      rec[384 + lane] = wd1 * r; rec[448 + lane] = wd1; rec[512 + lane] = kd1; rec[576 + lane] = ka1;
      if (lane == 0) { *(float4*)(rec + 640) = make_float4(c10, c20, bonus, 0.f); *(float4*)(rec + 644) = make_float4(c11, c21, 0.f, 0.f); }
      p.G16()[(size_t)row * 256 + c] = f2bf(ag[t]);
    }
    __syncthreads();
  }
}

__device__ __forceinline__ void fast_gdprep(const Params& p, int l, int wave_s) {
  int tid = make_tid(wave_s);
  const int c = tid & 255, lane = tid & 63, h = c >> 6, tg = tid >> 8;
  const float* cw = p.gdn_conv + (size_t)l * 3 * 768;
  float w0[3], w1[3], w2[3];
#pragma unroll
  for (int j = 0; j < 3; ++j) { w0[j] = cw[j * 256 + c]; w1[j] = cw[768 + j * 256 + c]; w2[j] = cw[1536 + j * 256 + c]; }
  for (int r0 = blockIdx.x * 8; r0 < NTOK; r0 += gridDim.x * 8) {
    float raw[4][3][3];
#pragma unroll
    for (int i = 0; i < 4; ++i) {
      const int row = r0 + tg * 4 + i;
      int t, len; seq_pos(row, t, len);
#pragma unroll
      for (int j = 0; j < 3; ++j) {
        const bf16_t* src = p.P() + (size_t)row * INC + OFF_C + j * 256 + c;
        raw[i][j][1] = bf2f(src[0]);
        raw[i][j][0] = t > 0 ? bf2f(src[-INC]) : 0.f;
        raw[i][j][2] = t < len - 1 ? bf2f(src[INC]) : 0.f;
      }
    }
#pragma unroll
    for (int i = 0; i < 4; ++i) {
      const int row = r0 + tg * 4 + i;
      float qkv[3];
#pragma unroll
      for (int j = 0; j < 3; ++j) qkv[j] = siluf_(raw[i][j][0] * w0[j] + raw[i][j][1] * w1[j] + raw[i][j][2] * w2[j]);
      const float qn = qkv[0] * FRSQ(wsum(qkv[0] * qkv[0]) + 1e-6f) * 0.125f;
      const float kn = qkv[1] * FRSQ(wsum(qkv[1] * qkv[1]) + 1e-6f);
      const float qk = wsum(qn * kn);
      float* rec = p.GP() + ((size_t)row * 4 + h) * GDREC;
      rec[lane] = qn; rec[64 + lane] = kn; rec[128 + lane] = qkv[2];
      if (lane < 2) {
        const int d = lane;
        const bf16_t* ab = p.P() + (size_t)row * INC + OFF_C + 1024;
        const float la = -FEXP(p.gdn_a_log[(l * 2 + d) * 4 + h]) * softplusf_(bf2f(ab[d * 4 + h]) + p.gdn_dt_bias[(l * 2 + d) * 4 + h]);
        *(float4*)(rec + 192 + d * 4) = make_float4(FEXP(la), sigmoidf_(bf2f(ab[8 + d * 4 + h])), qk, 0.f);
      }
    }
  }
}

constexpr int SCH = 16;
template <bool RWKV>
__device__ __forceinline__ void scan_pair(const Params& p, bool last, int task0, char* smem, int tid) {
  constexpr int STEPF = RWKV ? 340 : 148;
  constexpr int NF4 = STEPF / 4;
  constexpr int NLD = (SCH * NF4 + 255) / 256;
  const int hb = tid >> 8, ht = tid & 255;
  const int task = task0 + hb, chain = task >> 2, qr = task & 3;
  const int d = chain / (NB * 4), b = (chain / 4) % NB, h = chain % 4;
  const int v0 = qr * 16;
  float* buf = (float*)(smem + hb * 45056);
  float* ybuf = buf + 2 * SCH * STEPF;
  const int rl = ht >> 4, seg = ht & 15;
  const float* recbase = RWKV ? p.RW() : p.GP();
  constexpr int REC = RWKV ? RWREC : GDREC;
  float S0 = 0.f, S1 = 0.f, S2 = 0.f, S3 = 0.f;
  float4 st0, st1, st2, st3, st4, st5;
  const int nch = (NCX + NTL) / SCH;
#define SCAN_LOAD1(ch, q, dst)                                                                         \
  if ((q) < NLD) {                                                                                     \
    int idx = ht + (q) * 256;                                                                          \
    if (idx < SCH * NF4) {                                                                             \
      int i = idx / NF4, e4 = idx - i * NF4;                                                           \
      int row = scan_row(b, d, (ch) * SCH + i);                                                        \
      const float* rec = recbase + ((size_t)row * 4 + h) * REC;                                        \
      int off;                                                                                         \
      if (RWKV) off = e4 < 16 ? e4 * 4 : (e4 < 80 ? 128 + d * 256 + (e4 - 16) * 4 : (e4 < 84 ? 64 + v0 + (e4 - 80) * 4 : 640 + d * 4)); \
      else off = e4 < 16 ? 64 + e4 * 4 : (e4 < 32 ? (e4 - 16) * 4 : (e4 < 36 ? 128 + v0 + (e4 - 32) * 4 : 192 + d * 4)); \
      dst = *(const float4*)(rec + off);                                                               \
    }                                                                                                  \
  }
#define SCAN_LOAD(ch) { SCAN_LOAD1(ch, 0, st0) SCAN_LOAD1(ch, 1, st1) SCAN_LOAD1(ch, 2, st2) SCAN_LOAD1(ch, 3, st3) SCAN_LOAD1(ch, 4, st4) SCAN_LOAD1(ch, 5, st5) }
#define SCAN_STORE1(bi, q, srcv)                                                                       \
  if ((q) < NLD) {                                                                                     \
    int idx = ht + (q) * 256;                                                                          \
    if (idx < SCH * NF4) *(float4*)(buf + (bi) * SCH * STEPF + idx * 4) = srcv;                        \
  }
#define SCAN_STORE(bi) { SCAN_STORE1(bi, 0, st0) SCAN_STORE1(bi, 1, st1) SCAN_STORE1(bi, 2, st2) SCAN_STORE1(bi, 3, st3) SCAN_STORE1(bi, 4, st4) SCAN_STORE1(bi, 5, st5) }
  SCAN_LOAD(0); SCAN_STORE(0);
  __syncthreads();
  for (int ch = 0; ch < nch; ++ch) {
    const int cur = ch & 1;
    if (ch + 1 < nch) SCAN_LOAD(ch + 1);
    const float* sb = buf + cur * SCH * STEPF;
    float yk = 0.f;
    if (RWKV) {
      float4 kkA, wrA, wA, kdA, kaA, kkB, wrB, wB, kdB, kaB; float2 ccA, ccB; float vA, vB;
#define RW_LD(sp, X) { kk##X = *(const float4*)((sp) + seg * 4); wr##X = *(const float4*)((sp) + 64 + seg * 4); w##X = *(const float4*)((sp) + 128 + seg * 4); \
        kd##X = *(const float4*)((sp) + 192 + seg * 4); ka##X = *(const float4*)((sp) + 256 + seg * 4); v##X = (sp)[320 + rl]; cc##X = *(const float2*)((sp) + 336); }
#define RW_STEP(X, i) { float sa = (S0 * kk##X.x + S1 * kk##X.y) + (S2 * kk##X.z + S3 * kk##X.w); float z = (S0 * wr##X.x + S1 * wr##X.y) + (S2 * wr##X.z + S3 * wr##X.w); \
        sa = reduce16(sa); z = reduce16(z); \
        S0 = S0 * w##X.x + (v##X * kd##X.x - sa * ka##X.x); S1 = S1 * w##X.y + (v##X * kd##X.y - sa * ka##X.y); \
        S2 = S2 * w##X.z + (v##X * kd##X.z - sa * ka##X.z); S3 = S3 * w##X.w + (v##X * kd##X.w - sa * ka##X.w); \
        const float y_ = z + v##X * cc##X.x - sa * cc##X.y; yk = (seg == (i)) ? y_ : yk; }
      RW_LD(sb, A);
#pragma unroll 1
      for (int i = 0; i < SCH; i += 2) {
        RW_LD(sb + (i + 1) * STEPF, B);
        RW_STEP(A, i);
        if (i + 2 < SCH) RW_LD(sb + (i + 2) * STEPF, A);
        RW_STEP(B, i + 1);
      }
#undef RW_LD
#undef RW_STEP
    } else {
      float4 kA, qA, kB, qB, sA, sB; float vA, vB;
#define GD_LD(sp, X) { k##X = *(const float4*)((sp) + seg * 4); q##X = *(const float4*)((sp) + 64 + seg * 4); v##X = (sp)[128 + rl]; s##X = *(const float4*)((sp) + 144); }
#define GD_STEP(X, i) { float ks = (S0 * k##X.x + S1 * k##X.y) + (S2 * k##X.z + S3 * k##X.w); float qs = (S0 * q##X.x + S1 * q##X.y) + (S2 * q##X.z + S3 * q##X.w); \
        ks = reduce16(ks); qs = reduce16(qs); \
        const float vn = s##X.y * (v##X - s##X.x * ks); \
        S0 = S0 * s##X.x + k##X.x * vn; S1 = S1 * s##X.x + k##X.y * vn; S2 = S2 * s##X.x + k##X.z * vn; S3 = S3 * s##X.x + k##X.w * vn; \
        const float y_ = s##X.x * qs + s##X.z * vn; yk = (seg == (i)) ? y_ : yk; }
      GD_LD(sb, A);
#pragma unroll 1
      for (int i = 0; i < SCH; i += 2) {
        GD_LD(sb + (i + 1) * STEPF, B);
        GD_STEP(A, i);
        if (i + 2 < SCH) GD_LD(sb + (i + 2) * STEPF, A);
        GD_STEP(B, i + 1);
      }
#undef GD_LD
#undef GD_STEP
    }
    ybuf[seg * 16 + rl] = yk;
    __syncthreads();
    {
      const int i = ht >> 4, j = ht & 15;
      const int row = scan_row(b, d, ch * SCH + i);
      if (!(last && row >= NLAT)) p.YS()[(size_t)row * 1024 + (RWKV ? 0 : 512) + d * 256 + h * 64 + v0 + j] = f2bf(ybuf[i * 16 + j]);
    }
    if (ch + 1 < nch) SCAN_STORE(cur ^ 1);
    __syncthreads();
  }
#undef SCAN_LOAD
#undef SCAN_STORE
#undef SCAN_LOAD1
#undef SCAN_STORE1
}
__device__ __forceinline__ int scan_npairs() { return 2 * (2 * NB * 4) * 4 / 2; }
__device__ __forceinline__ void scan_run_pair(const Params& p, bool last, int pair, char* smem, int tid) {
  const int nrw = (2 * NB * 4) * 4;
  const int task0 = pair * 2;
  if (task0 < nrw) scan_pair<true>(p, last, task0, smem, tid);
  else scan_pair<false>(p, last, task0 - nrw, smem, tid);
}

__device__ __forceinline__ void fast_post(const Params& p, int l, int nr, int wave_s) {
  int tid = make_tid(wave_s);
  const int lane = tid & 63;
  for (int row = blockIdx.x * 8 + (tid >> 6); row < nr; row += gridDim.x * 8) {
    const bf16_t* ys = p.YS() + (size_t)row * 1024;
    bf16_t* yo = p.Y() + (size_t)row * DM;
#pragma unroll
    for (int h = 0; h < 4; ++h) {
      const int c = h * 64 + lane;
      {
        const float* rec = p.RW() + ((size_t)row * 4 + h) * RWREC;
        const float y = bf2f(ys[c]) + bf2f(ys[256 + c]);
        const float m = wave_sum(y) * (1.0f / 64);
        const float dd = y - m;
        const float rstd = 1.0f / sqrtf(wave_sum(dd * dd) * (1.0f / 64) + 64e-5f);
        const float yn = dd * rstd * p.rwkv_ln_g[l * 256 + c] + p.rwkv_ln_b[l * 256 + c];
        yo[256 + c] = f2bf((yn + rec[642] * rec[64 + lane]) * bf2f(p.G16()[(size_t)row * 256 + c]));
      }
      {
        const float o = bf2f(ys[512 + c]) + bf2f(ys[768 + c]);
        const float rs = 1.0f / sqrtf(wave_sum(o * o) * (1.0f / 64) + 1e-6f);
        const float gate = bf2f(p.P()[(size_t)row * INC + OFF_C + 768 + c]);
        yo[512 + c] = f2bf(o * rs * p.gdn_norm_g[l * 64 + lane] * siluf_(gate));
      }
    }
  }
}

constexpr int NKEY = NTL + NCX;
__device__ __forceinline__ int key_row(int b, int j) { return j < NTL ? b * NTL + j : NLAT + b * NCX + (j - NTL); }

__device__ __forceinline__ void fast_attprep(const Params& p, char* smem, int wave_s) {
  int tid = make_tid(wave_s);
  for (int it = blockIdx.x * NTHREADS + tid; it < NLAT * 32; it += gridDim.x * NTHREADS) {
    const int token = it >> 5, j = it & 31;
    const int blk = j & 3;
    const int t = token % NTL;
    const int pos = (blk & 1) ? (t & 63) : (t >> 6);
    bf16_t* base = p.P() + (size_t)token * INC + OFF_A + (j >> 4) * 256 + ((j >> 2) & 3) * 64 + blk * 16;
    uint4 a = *(const uint4*)base, b = *(const uint4*)(base + 8);
    float x1[8], x2[8];
    unpack8(a, x1); unpack8(b, x2);
#pragma unroll
    for (int i = 0; i < 8; ++i) {
      const float ang = (float)pos * FEXP(-(float)i * (9.210340371976184f / 8.0f));
      const float cs = FCOS(ang), sn = FSIN(ang);
      const float y1 = x1[i] * cs - x2[i] * sn, y2 = x1[i] * sn + x2[i] * cs;
      x1[i] = y1; x2[i] = y2;
    }
    a.x = pk_bf16(x1[0], x1[1]); a.y = pk_bf16(x1[2], x1[3]); a.z = pk_bf16(x1[4], x1[5]); a.w = pk_bf16(x1[6], x1[7]);
    b.x = pk_bf16(x2[0], x2[1]); b.y = pk_bf16(x2[2], x2[3]); b.z = pk_bf16(x2[4], x2[5]); b.w = pk_bf16(x2[6], x2[7]);
    *(uint4*)base = a; *(uint4*)(base + 8) = b;
  }
  bf16_t* Ts = (bf16_t*)smem;
  const int ntile = NKEY / 64;
  const int nt_all = 2 * NB * 4 * ntile;
#define VT_SRC(tix_) (p.P() + (size_t)key_row((((tix_) % (NB * 4 * ntile)) / ntile) >> 2, (((tix_) % (NB * 4 * ntile)) % ntile) * 64 + (tid >> 3)) * INC \
      + (((tix_) / (NB * 4 * ntile)) ? OFF_D : OFF_A) + 512 + ((((tix_) % (NB * 4 * ntile)) / ntile) & 3) * 64 + (tid & 7) * 8)
  uint4 vnext = make_uint4(0u, 0u, 0u, 0u);
  if ((int)blockIdx.x < nt_all) vnext = *(const uint4*)VT_SRC(min((int)blockIdx.x, nt_all - 1));
  for (int tix = blockIdx.x; tix < nt_all; tix += gridDim.x) {
    const int mixer = tix / (NB * 4 * ntile), rem = tix % (NB * 4 * ntile);
    const int bh = rem / ntile, kt = rem % ntile;
    const uint4 v = vnext;
    {
      const int tn = min(tix + (int)gridDim.x, nt_all - 1);
      vnext = *(const uint4*)VT_SRC(tn);
    }
    {
      const int key = tid >> 3, dc = tid & 7;
      const int pos = (key & 32) | ((key & 12) << 1) | ((key & 16) >> 2) | (key & 3);
      bf16_t e[8];
      *(uint4*)e = v;
#pragma unroll
      for (int i = 0; i < 8; ++i) Ts[(dc * 8 + i) * 72 + pos] = e[i];
    }
    LDS_BAR();
    {
      const int d = tid >> 3, pc = tid & 7;
      const uint4 vv = *(const uint4*)(Ts + d * 72 + pc * 8);
      *(uint4*)(p.VT() + (((size_t)mixer * NB * 4 + bh) * 64 + d) * NKEY + kt * 64 + pc * 8) = vv;
    }
    LDS_BAR();
  }
#undef VT_SRC
}

__device__ __forceinline__ float xmax_16_32(float x) {
  float a = x, b = x;
  asm volatile("s_nop 1\n\tv_permlane16_swap_b32 %0, %1" : "+v"(a), "+v"(b));
  x = fmaxf(a, b); a = x; b = x;
  asm volatile("s_nop 1\n\tv_permlane32_swap_b32 %0, %1" : "+v"(a), "+v"(b));
  return fmaxf(a, b);
}
__device__ __forceinline__ float xsum_16_32(float x) {
  float a = x, b = x;
  asm volatile("s_nop 1\n\tv_permlane16_swap_b32 %0, %1" : "+v"(a), "+v"(b));
  x = a + b; a = x; b = x;
  asm volatile("s_nop 1\n\tv_permlane32_swap_b32 %0, %1" : "+v"(a), "+v"(b));
  return a + b;
}
__device__ __forceinline__ bf16x8 pack_p8(const f32x4& lo, const f32x4& hi) {
  uint4 u;
  u.x = pk_bf16(lo[0], lo[1]); u.y = pk_bf16(lo[2], lo[3]); u.z = pk_bf16(hi[0], hi[1]); u.w = pk_bf16(hi[2], hi[3]);
  return __builtin_bit_cast(bf16x8, u);
}

__device__ __forceinline__ void attnA_task(const Params& p, int l, int task, char* smem, int tid) {
  const int nlat_tasks = NB * 4 * (NTL / 256);
  const bool lat = task < nlat_tasks;
  int b, h, qrow0, kt0;
  if (lat) { const int bh = task / (NTL / 256), qb = task % (NTL / 256); b = bh >> 2; h = bh & 3; qrow0 = b * NTL + qb * 256; kt0 = 0; }
  else { const int t2 = task - nlat_tasks; const int bh = t2 / (NCX / 256), qb = t2 % (NCX / 256); b = bh >> 2; h = bh & 3; qrow0 = NLAT + b * NCX + qb * 256; kt0 = NTL / 64; }
  const int nkt = NKEY / 64;
  const int lane = tid & 63, w = tid >> 6, l15 = lane & 15, lq = lane >> 4, sw = l15 & 7;
  char* Ks = smem;
  char* Vs = smem + 16384;
  const float c = 0.17677669529663687f * 1.4426950408889634f;
  bf16x8 qf[2][2];
#pragma unroll
  for (int qt = 0; qt < 2; ++qt)
#pragma unroll
    for (int br = 0; br < 2; ++br)
      qf[br][qt] = *(const bf16x8*)(p.P() + (size_t)(qrow0 + w * 32 + qt * 16 + l15) * INC + OFF_A + h * 64 + br * 32 + lq * 8);
  f32x4 O[2][2][4], L[2][2];
  float m_[2][2];
  const uint4 ones_u = make_uint4(0x3f803f80u, 0x3f803f80u, 0x3f803f80u, 0x3f803f80u);
  const bf16x8 ones8 = __builtin_bit_cast(bf16x8, ones_u);
#pragma unroll
  for (int br = 0; br < 2; ++br)
#pragma unroll
    for (int qt = 0; qt < 2; ++qt) {
      m_[br][qt] = -1e30f; L[br][qt] = f32x4{0.f, 0.f, 0.f, 0.f};
#pragma unroll
      for (int dt = 0; dt < 4; ++dt) O[br][qt][dt] = f32x4{0.f, 0.f, 0.f, 0.f};
    }
  const int srow = tid >> 3, sch = tid & 7;
  const int soff = srow * 128 + ((sch ^ (srow & 7)) << 4);
  const bf16_t* vtbase = p.VT() + (((size_t)0 * NB * 4 + b * 4 + h) * 64 + srow) * NKEY + sch * 8;
  uint4 rk, rv;
#define ATT_LOAD(kt) { rk = *(const uint4*)(p.P() + (size_t)key_row(b, (kt) * 64 + srow) * INC + OFF_A + 256 + h * 64 + sch * 8); rv = *(const uint4*)(vtbase + (kt) * 64); }
#define ATT_STORE(bi) { *(uint4*)(Ks + (bi) * 8192 + soff) = rk; *(uint4*)(Vs + (bi) * 8192 + soff) = rv; }
  ATT_LOAD(kt0);
  ATT_STORE(0);
  LDS_BAR();
  for (int kt = kt0; kt < nkt; ++kt) {
    const int cur = (kt - kt0) & 1;
    if (kt + 1 < nkt) ATT_LOAD(kt + 1);
    const char* kb = Ks + cur * 8192;
    const char* vb = Vs + cur * 8192;
    bf16x8 vf[4][2];
#pragma unroll
    for (int dt = 0; dt < 4; ++dt)
#pragma unroll
      for (int ks = 0; ks < 2; ++ks) vf[dt][ks] = *(const bf16x8*)(vb + (16 * dt + l15) * 128 + (((ks * 4 + lq) ^ sw) << 4));
#pragma unroll
    for (int br = 0; br < 2; ++br) {
      f32x4 S[2][4];
      {
        bf16x8 kf[4];
#pragma unroll
        for (int a = 0; a < 4; ++a) kf[a] = *(const bf16x8*)(kb + (16 * a + l15) * 128 + (((br * 4 + lq) ^ sw) << 4));
#pragma unroll
        for (int qt = 0; qt < 2; ++qt)
#pragma unroll
          for (int a = 0; a < 4; ++a) S[qt][a] = __builtin_amdgcn_mfma_f32_16x16x32_bf16(kf[a], qf[br][qt], f32x4{0.f, 0.f, 0.f, 0.f}, 0, 0, 0);
      }
      float mx[2];
#pragma unroll
      for (int qt = 0; qt < 2; ++qt) {
        float m0 = fmaxf(fmaxf(S[qt][0][0], S[qt][0][1]), fmaxf(S[qt][0][2], S[qt][0][3]));
#pragma unroll
        for (int a = 1; a < 4; ++a) m0 = fmaxf(m0, fmaxf(fmaxf(S[qt][a][0], S[qt][a][1]), fmaxf(S[qt][a][2], S[qt][a][3])));
        mx[qt] = m0 * c;
      }
      if (__any((mx[0] > m_[br][0] + 8.0f) || (mx[1] > m_[br][1] + 8.0f))) {
#pragma unroll
        for (int qt = 0; qt < 2; ++qt) {
          const float mxx = xmax_16_32(mx[qt]);
          const float mn = fmaxf(m_[br][qt], mxx);
          const float alpha = __builtin_amdgcn_exp2f(m_[br][qt] - mn);
          m_[br][qt] = mn;
          L[br][qt] *= alpha;
#pragma unroll
          for (int dt = 0; dt < 4; ++dt) O[br][qt][dt] *= alpha;
        }
      }
#pragma unroll
      for (int qt = 0; qt < 2; ++qt) {
        const float mcur = m_[br][qt];
#pragma unroll
        for (int a = 0; a < 4; ++a)
#pragma unroll
          for (int r = 0; r < 4; ++r) S[qt][a][r] = __builtin_amdgcn_exp2f(S[qt][a][r] * c - mcur);
        const bf16x8 p0 = pack_p8(S[qt][0], S[qt][1]), p1 = pack_p8(S[qt][2], S[qt][3]);
#pragma unroll
        for (int dt = 0; dt < 4; ++dt) {
          O[br][qt][dt] = __builtin_amdgcn_mfma_f32_16x16x32_bf16(vf[dt][0], p0, O[br][qt][dt], 0, 0, 0);
          O[br][qt][dt] = __builtin_amdgcn_mfma_f32_16x16x32_bf16(vf[dt][1], p1, O[br][qt][dt], 0, 0, 0);
        }
        L[br][qt] = __builtin_amdgcn_mfma_f32_16x16x32_bf16(ones8, p0, L[br][qt], 0, 0, 0);
        L[br][qt] = __builtin_amdgcn_mfma_f32_16x16x32_bf16(ones8, p1, L[br][qt], 0, 0, 0);
      }
    }
    if (kt + 1 < nkt) ATT_STORE(cur ^ 1);
    LDS_BAR();
  }
#undef ATT_LOAD
#undef ATT_STORE
  const float* lv = p.diff_lam + l * 128;
  float d01 = 0.f, d23 = 0.f;
#pragma unroll 4
  for (int i = 0; i < 32; ++i) { d01 += lv[i] * lv[32 + i]; d23 += lv[64 + i] * lv[96 + i]; }
  const float lam_init = 0.8f - 0.6f * FEXP(-0.3f * (float)l);
  const float lam = FEXP(d01) - FEXP(d23) + lam_init;
#pragma unroll
  for (int qt = 0; qt < 2; ++qt) {
    const float i1 = 1.0f / L[0][qt][0], i2 = lam / L[1][qt][0];
    float ss = 0.f;
    f32x4 o[4];
#pragma unroll
    for (int dt = 0; dt < 4; ++dt)
#pragma unroll
      for (int r = 0; r < 4; ++r) { o[dt][r] = O[0][qt][dt][r] * i1 - O[1][qt][dt][r] * i2; ss += o[dt][r] * o[dt][r]; }
    ss = xsum_16_32(ss);
    const float rs = (1.0f / sqrtf(ss * (1.0f / 64) + 1e-6f)) * (1.0f - lam_init);
    bf16_t* yp = p.Y() + (size_t)(qrow0 + w * 32 + qt * 16 + l15) * DM + h * 64;
#pragma unroll
    for (int dt = 0; dt < 4; ++dt) {
      const float4 g = *(const float4*)(p.diff_norm_g + l * 64 + dt * 16 + lq * 4);
      uint2 v;
      v.x = pk_bf16(o[dt][0] * rs * g.x, o[dt][1] * rs * g.y);
      v.y = pk_bf16(o[dt][2] * rs * g.z, o[dt][3] * rs * g.w);
      *(uint2*)(yp + dt * 16 + lq * 4) = v;
    }
  }
  LDS_BAR();
}
__device__ __forceinline__ void fast_attnA(const Params& p, int l, char* smem, int wave_s, int vb, int nvb) {
  int tid = make_tid(wave_s);
  const int ntask = NB * 4 * (NTL / 256) + (l == 0 ? NB * 4 * (NCX / 256) : 0);
  for (int t = vb; t < ntask; t += nvb) { const int tid2 = make_tid(wave_s); attnA_task(p, l, t, smem, tid2); }
}

__device__ __forceinline__ void attnD_pair(const Params& p, int l, int pair, char* smem, int tid) {
  const int nlat = NB * 4 * GROWS;
  const int hb = tid >> 8;
  const int task = pair * 2 + hb;
  const bool lat = task < nlat;
  int b, h, qrow0, rq = 0, rs = 0, ntile;
  if (lat) {
    const int bh = task / GROWS; rq = task % GROWS; b = bh >> 2; h = bh & 3;
    qrow0 = b * NTL + rq * 64;
    rs = rq - 4; rs = rs < 0 ? 0 : (rs > GROWS - 8 ? GROWS - 8 : rs);
    ntile = 8 + NCX / 64;
  } else {
    const int t2 = task - nlat; const int bh = t2 / (NCX / 64), sub = t2 % (NCX / 64); b = bh >> 2; h = bh & 3;
    qrow0 = NLAT + b * NCX + sub * 64;
    ntile = NCX / 64;
  }
  const int ht = tid & 255, lane = tid & 63, wq = (tid >> 6) & 3, l15 = lane & 15, lq = lane >> 4, sw = l15 & 7;
  char* Ks = smem + hb * 34816;
  char* Vs = Ks + 16384;
  float* tbl = (float*)(Ks + 32768);
  for (int i = ht; i < 15 * 31; i += 256) tbl[i] = p.nat_rpb[((size_t)l * 4 + h) * 465 + i];
  const float LOG2E = 1.4426950408889634f;
  bf16x8 qf[2];
#pragma unroll
  for (int ks = 0; ks < 2; ++ks)
    qf[ks] = *(const bf16x8*)(p.P() + (size_t)(qrow0 + wq * 16 + l15) * INC + OFF_D + h * 64 + ks * 32 + lq * 8);
  f32x4 O[4];
#pragma unroll
  for (int dt = 0; dt < 4; ++dt) O[dt] = f32x4{0.f, 0.f, 0.f, 0.f};
  float m_ = -1e30f;
  f32x4 Ls = f32x4{0.f, 0.f, 0.f, 0.f};
  const uint4 ones_u = make_uint4(0x3f803f80u, 0x3f803f80u, 0x3f803f80u, 0x3f803f80u);
  const bf16x8 ones8 = __builtin_bit_cast(bf16x8, ones_u);
  const int cq = wq * 16 + l15;
  int cs = cq - 8; cs = cs < 0 ? 0 : (cs > 48 ? 48 : cs);
  const int srow = ht >> 2, sch = (ht & 3) * 2;
  const int soff0 = srow * 128 + ((sch ^ (srow & 7)) << 4), soff1 = srow * 128 + (((sch + 1) ^ (srow & 7)) << 4);
  const bf16_t* vtb = p.VT() + (((size_t)1 * NB * 4 + b * 4 + h) * 64 + srow) * NKEY + sch * 8;
  uint4 rk0, rk1, rv0, rv1;
#define ATD_KEY0(j) (lat ? ((j) < 8 ? (rs + (j)) * 64 : NTL + ((j) - 8) * 64) : NTL + (j) * 64)
#define ATD_LOAD(j) { const int k0_ = ATD_KEY0(j); const bf16_t* kp_ = p.P() + (size_t)key_row(b, k0_ + srow) * INC + OFF_D + 256 + h * 64 + sch * 8; \
    rk0 = *(const uint4*)kp_; rk1 = *(const uint4*)(kp_ + 8); rv0 = *(const uint4*)(vtb + k0_); rv1 = *(const uint4*)(vtb + k0_ + 8); }
#define ATD_STORE(bi) { *(uint4*)(Ks + (bi) * 8192 + soff0) = rk0; *(uint4*)(Ks + (bi) * 8192 + soff1) = rk1; \
    *(uint4*)(Vs + (bi) * 8192 + soff0) = rv0; *(uint4*)(Vs + (bi) * 8192 + soff1) = rv1; }
  ATD_LOAD(0);
  ATD_STORE(0);
  LDS_BAR();
  for (int j = 0; j < ntile; ++j) {
    const int cur = j & 1;
    if (j + 1 < ntile) ATD_LOAD(j + 1);
    const char* kb = Ks + cur * 8192;
    const char* vb = Vs + cur * 8192;
    f32x4 S[4];
#pragma unroll
    for (int a = 0; a < 4; ++a) {
      S[a] = f32x4{0.f, 0.f, 0.f, 0.f};
#pragma unroll
      for (int ks = 0; ks < 2; ++ks) {
        const bf16x8 kf = *(const bf16x8*)(kb + (16 * a + l15) * 128 + (((ks * 4 + lq) ^ sw) << 4));
        S[a] = __builtin_amdgcn_mfma_f32_16x16x32_bf16(kf, qf[ks], S[a], 0, 0, 0);
      }
    }
    const bool win = lat && j < 8;
    const float* trow = tbl + (rs + j - rq + 7) * 31 - cq + 15;
    float mx = -1e30f;
#pragma unroll
    for (int a = 0; a < 4; ++a)
#pragma unroll
      for (int r = 0; r < 4; ++r) {
        float v = S[a][r] * (0.125f * LOG2E);
        if (win) {
          const int ck = 16 * a + 4 * lq + r;
          const bool ok = (unsigned)(ck - cs) < 16u;
          v = ok ? v + trow[ok ? ck : cq] * LOG2E : -1e30f;
        }
        S[a][r] = v;
        mx = fmaxf(mx, v);
      }
    if (__any(mx > m_ + 8.0f)) {
      mx = xmax_16_32(mx);
      const float mn = fmaxf(m_, mx);
      const float alpha = __builtin_amdgcn_exp2f(m_ - mn);
      m_ = mn;
      Ls *= alpha;
#pragma unroll
      for (int dt = 0; dt < 4; ++dt) O[dt] *= alpha;
    }
#pragma unroll
    for (int a = 0; a < 4; ++a)
#pragma unroll
      for (int r = 0; r < 4; ++r) S[a][r] = __builtin_amdgcn_exp2f(S[a][r] - m_);
    const bf16x8 p0 = pack_p8(S[0], S[1]), p1 = pack_p8(S[2], S[3]);
#pragma unroll
    for (int dt = 0; dt < 4; ++dt) {
      const bf16x8 v0 = *(const bf16x8*)(vb + (16 * dt + l15) * 128 + (((0 * 4 + lq) ^ sw) << 4));
      const bf16x8 v1 = *(const bf16x8*)(vb + (16 * dt + l15) * 128 + (((1 * 4 + lq) ^ sw) << 4));
      O[dt] = __builtin_amdgcn_mfma_f32_16x16x32_bf16(v0, p0, O[dt], 0, 0, 0);
      O[dt] = __builtin_amdgcn_mfma_f32_16x16x32_bf16(v1, p1, O[dt], 0, 0, 0);
    }
    Ls = __builtin_amdgcn_mfma_f32_16x16x32_bf16(ones8, p0, Ls, 0, 0, 0);
    Ls = __builtin_amdgcn_mfma_f32_16x16x32_bf16(ones8, p1, Ls, 0, 0, 0);
    if (j + 1 < ntile) ATD_STORE(cur ^ 1);
    LDS_BAR();
  }
#undef ATD_KEY0
#undef ATD_LOAD
#undef ATD_STORE
  const float inv = 1.0f / Ls[0];
  bf16_t* yp = p.Y() + (size_t)(qrow0 + wq * 16 + l15) * DM + 768 + h * 64;
#pragma unroll
  for (int dt = 0; dt < 4; ++dt) {
    uint2 v;
    v.x = pk_bf16(O[dt][0] * inv, O[dt][1] * inv);
    v.y = pk_bf16(O[dt][2] * inv, O[dt][3] * inv);
    *(uint2*)(yp + dt * 16 + lq * 4) = v;
  }
  LDS_BAR();
}
__device__ __forceinline__ void fast_attnD(const Params& p, int l, char* smem, int wave_s, int vb, int nvb) {
  int tid = make_tid(wave_s);
  const int npair = (NB * 4 * GROWS + (l == 0 ? NB * 4 * (NCX / 64) : 0)) / 2;
  for (int t = vb; t < npair; t += nvb) { const int tid2 = make_tid(wave_s); attnD_pair(p, l, t, smem, tid2); }
}

__device__ __forceinline__ void fast_ada(const Params& p, char* smem, int wave_s) {
  int tid = make_tid(wave_s);
  float* red = (float*)smem;
  const int jc = tid & 31, ks = tid >> 5;
  for (int t = blockIdx.x; t < 2 * (6144 / 32); t += gridDim.x) {
    const int l = t / (6144 / 32), j = (t % (6144 / 32)) * 32 + jc;
    float acc[NMODV];
#pragma unroll
    for (int v = 0; v < NMODV; ++v) acc[v] = 0.f;
    for (int i = ks * 64; i < ks * 64 + 64; ++i) {
      const float w = p.w_ada[((size_t)l * DM + i) * 6144 + j];
#pragma unroll
      for (int v = 0; v < NB; ++v) acc[v] += siluf_(p.c[v * DM + i]) * w;
      acc[NB] += siluf_(p.c_ctx[i]) * w;
    }
#pragma unroll
    for (int v = 0; v < NMODV; ++v) red[(ks * NMODV + v) * 32 + jc] = acc[v];
    __syncthreads();
    if (tid < NMODV * 32) {
      const int v = tid >> 5;
      float sacc = p.b_ada[l * 6144 + j];
#pragma unroll
      for (int k2 = 0; k2 < 16; ++k2) sacc += red[(k2 * NMODV + v) * 32 + jc];
      p.mod()[((size_t)l * NMODV + v) * 6144 + j] = sacc;
    }
    __syncthreads();
  }
}

constexpr int CL = 16;
constexpr int NCHK = (NTL + NCX) / CL;
constexpr int IMG_KK = 0, IMG_RT = 2048, IMG_TR = 4096, IMG_BK = 6144, IMG_WL = 10240, IMG_VV = 10496, IMG_BYTES = 12544;
__device__ __forceinline__ char* img_ptr(const Params& p, int mixer, int d, int b, int h, int cidx) {
  return (char*)p.RW() + ((size_t)((((mixer * 2 + d) * NB + b) * 4 + h)) * NCHK + cidx) * IMG_BYTES;
}
__device__ __forceinline__ bf16_t* rv16(const Params& p) { return (bf16_t*)((char*)p.RW() + (size_t)2 * 2 * NB * 4 * NCHK * IMG_BYTES); }
__device__ __forceinline__ float* bonbuf(const Params& p) { return (float*)(rv16(p) + (size_t)NTOK * 256); }
constexpr int LORAT_LAYER = 2 * 256 * 64 * 2 + 256 * 128;
__device__ __forceinline__ bf16_t* lorat(const Params& p, int l) { return (bf16_t*)(bonbuf(p) + (size_t)NTOK * 4) + (size_t)l * LORAT_LAYER; }
__device__ __forceinline__ void conv_lora(const Params& p, int wave_s) {
  const int tid = make_tid(wave_s);
  for (int idx = blockIdx.x * NTHREADS + tid; idx < 2 * LORAT_LAYER; idx += gridDim.x * NTHREADS) {
    const int l = idx / LORAT_LAYER, e = idx % LORAT_LAYER;
    float v;
    if (e < 2 * 256 * 64) { const int d = e / (256 * 64), c = (e / 64) % 256, k = e % 64; v = p.rwkv_w2[((size_t)(l * 2 + d) * 64 + k) * 256 + c]; }
    else if (e < 4 * 256 * 64) { const int e2 = e - 2 * 256 * 64; const int d = e2 / (256 * 64), c = (e2 / 64) % 256, k = e2 % 64; v = p.rwkv_a2[((size_t)(l * 2 + d) * 64 + k) * 256 + c]; }
    else { const int e2 = e - 4 * 256 * 64; const int c = e2 / 128, k = e2 % 128; v = p.rwkv_g2[((size_t)l * 128 + k) * 256 + c]; }
    lorat(p, l)[e] = f2bf(v);
  }
}
__device__ __forceinline__ int colp(int pp) { return 16 * (2 * (pp >> 5) + ((pp & 7) >> 2)) + 4 * ((pp >> 3) & 3) + (pp & 3); }
__device__ __forceinline__ int tile_cidx(bool is_ctx, int t0, int d) {
  const int j = t0 >> 4;
  if (is_ctx) return d == 0 ? j : NCX / 16 - 1 - j;
  return NCX / 16 + (d == 0 ? j : NTL / 16 - 1 - j);
}
constexpr int VEC_OFF = 77824;
constexpr int VS = 258;
constexpr int WCS = 65, MS = 17;
constexpr int VEC_W0 = 0, VEC_W1 = 16384, VEC_KK = 32768, VEC_R = VEC_KK + 16 * VS * 2, VEC_B0 = VEC_R + 16 * VS * 2, VEC_B1 = VEC_B0 + 16 * VS * 2,
              VEC_KD0 = VEC_B1 + 16 * VS * 2, VEC_KD1 = VEC_KD0 + 16 * VS * 2;
constexpr int SCR_WC = 0, SCR_T6 = 8192, SCR_MAT = 57344;

template <bool NOWRITE>
__device__ __forceinline__ void chunk_prep_head(const Params& p, int mixer, int b, bool is_ctx, int t0, int h, char* smem, int tid) {
  const char* vec = smem + VEC_OFF;
  float* Wc = (float*)(smem + SCR_WC);
  float* T6 = (float*)(smem + SCR_T6);
  float* MAT = (float*)(smem + SCR_MAT);
  if (tid < 128) {
    const int d = tid >> 6, k = tid & 63;
    const float* wv = (const float*)(vec + (d ? VEC_W1 : VEC_W0));
    float acc = 1.f;
#pragma unroll
    for (int s_ = 0; s_ < 16; ++s_) {
      const int tok = d ? 15 - s_ : s_;
      acc *= wv[tok * 256 + h * 64 + k];
      Wc[(d * 16 + s_) * 64 + k] = acc;
    }
  }
  __syncthreads();
#pragma unroll
  for (int q = 0; q < 4; ++q) {
    const int idx = tid + q * NTHREADS;
    const int d = idx >> 10, s_ = (idx >> 6) & 15, k = idx & 63;
    const int tok = d ? 15 - s_ : s_;
    const int vi = tok * 256 + h * 64 + k;
    const float W = Wc[(d * 16 + s_) * 64 + k];
    const float Wp = s_ ? Wc[(d * 16 + s_ - 1) * 64 + k] : 1.f;
    const float WL = Wc[(d * 16 + 15) * 64 + k];
    const float iW = 1.0f / W;
    const float kk = bf2f(((const bf16_t*)(vec + VEC_KK))[vi]), r = bf2f(((const bf16_t*)(vec + VEC_R))[vi]);
    const float bb = bf2f(((const bf16_t*)(vec + (d ? VEC_B1 : VEC_B0)))[vi]), kd = bf2f(((const bf16_t*)(vec + (d ? VEC_KD1 : VEC_KD0)))[vi]);
    float* t6 = T6 + (size_t)d * 6 * 1024 + s_ * 64 + k;
    t6[0] = kk * Wp; t6[1024] = r * W; t6[2048] = bb * iW; t6[3072] = kd * iW; t6[4096] = bb * (WL * iW); t6[5120] = kd * (WL * iW);
  }
  __syncthreads();
  {
    const int lane = tid & 63, w = tid >> 6, d = w >> 2, mat = w & 3, i = lane & 15, g = lane >> 4;
    const float* X = T6 + (size_t)d * 6 * 1024 + (mat < 2 ? 0 : 1024) + i * 64 + g;
    const float* Yv = T6 + (size_t)d * 6 * 1024 + ((mat & 1) ? 3072 : 2048) + i * 64 + g;
    float xa[16], ya[16];
#pragma unroll
    for (int k4 = 0; k4 < 16; ++k4) { xa[k4] = X[4 * k4]; ya[k4] = Yv[4 * k4]; }
    f32x4 ac4[4];
#pragma unroll
    for (int q = 0; q < 4; ++q) ac4[q] = f32x4{0.f, 0.f, 0.f, 0.f};
#pragma unroll
    for (int k4 = 0; k4 < 16; ++k4) ac4[k4 & 3] = __builtin_amdgcn_mfma_f32_16x16x4f32(xa[k4], ya[k4], ac4[k4 & 3], 0, 0, 0);
    const f32x4 acc = (ac4[0] + ac4[1]) + (ac4[2] + ac4[3]);
#pragma unroll
    for (int r_ = 0; r_ < 4; ++r_) {
      const int s_ = 4 * g + r_;
      const bool keep = mat < 2 ? (i < s_) : (i <= s_);
      MAT[((d * 6 + mat) * 16 + s_) * 16 + i] = keep ? acc[r_] : 0.f;
    }
  }
  __syncthreads();
  {
    const int d = tid >> 8, col = (tid >> 4) & 15, j = tid & 15;
    const float* A = MAT + (d * 6 + 0) * 256 + j;
    float a[16];
#pragma unroll
    for (int i = 0; i < 16; ++i) a[i] = A[i * 16];
    float xj = 0.f;
#pragma unroll
    for (int i = 0; i < 16; ++i) {
      const float part = (j < i) ? a[i] * xj : 0.f;
      const float sum = reduce16(part);
      const float xi = ((i == col) ? 1.f : 0.f) - sum;
      xj = (j == i) ? xi : xj;
    }
    MAT[(d * 6 + 4) * 256 + j * 16 + col] = xj;
  }
  __syncthreads();
  {
    const int d = tid >> 8, s_ = (tid >> 4) & 15, j = tid & 15;
    const float* Ti = MAT + (d * 6 + 4) * 256 + s_ * 16;
    const float* Ak = MAT + (d * 6 + 1) * 256 + j;
    float acc = 0.f;
#pragma unroll
    for (int u = 0; u < 16; ++u) acc += Ti[u] * Ak[u * 16];
    MAT[(d * 6 + 5) * 256 + s_ * 16 + j] = acc;
  }
  __syncthreads();
#pragma unroll
  for (int q = 0; q < 3; ++q) {
    const int idx = tid + q * NTHREADS;
    if (!NOWRITE && idx < 2 * 656) {
      const int d = idx / 656, c = idx - d * 656;
      char* img = img_ptr(p, mixer, d, b, h, tile_cidx(is_ctx, t0, d));
      const float* t6 = T6 + (size_t)d * 6 * 1024;
      const float* mt = MAT + d * 6 * 256;
      if (c < 640) {
        float e[8];
        int off;
        if (c < 256) {
          const int which = c >> 7, cc = c & 127, s_ = cc >> 3, ch = cc & 7;
          const float* src = t6 + which * 1024 + s_ * 64;
#pragma unroll
          for (int e_ = 0; e_ < 8; ++e_) e[e_] = src[colp(ch * 8 + e_)];
          off = (which ? IMG_RT : IMG_KK) + s_ * 128 + ((ch ^ (s_ & 7)) << 4);
        } else if (c < 384) {
          const int cc = c - 256, s_ = cc >> 3, ch = cc & 7, g = ch & 3;
          const float* m0 = mt + (ch < 4 ? 4 : 2) * 256 + s_ * 16 + 4 * g;
          const float* m1 = mt + (ch < 4 ? 5 : 3) * 256 + s_ * 16 + 4 * g;
#pragma unroll
          for (int e_ = 0; e_ < 4; ++e_) { e[e_] = m0[e_]; e[4 + e_] = m1[e_]; }
          off = IMG_TR + s_ * 128 + ((ch ^ (s_ & 7)) << 4);
        } else {
          const int cc = c - 384, kc = cc >> 2, g = cc & 3;
#pragma unroll
          for (int e_ = 0; e_ < 4; ++e_) { e[e_] = t6[4096 + (4 * g + e_) * 64 + kc]; e[4 + e_] = t6[5120 + (4 * g + e_) * 64 + kc]; }
          const int row = kc & 31, ch = (kc >> 5) * 4 + g;
          off = IMG_BK + row * 128 + ((ch ^ (row & 7)) << 4);
        }
        uint4 v;
        v.x = pk_bf16(e[0], e[1]); v.y = pk_bf16(e[2], e[3]); v.z = pk_bf16(e[4], e[5]); v.w = pk_bf16(e[6], e[7]);
        *(uint4*)(img + off) = v;
      } else {
        const int k0 = (c - 640) * 4;
        *(float4*)(img + IMG_WL + k0 * 4) = *(const float4*)(Wc + (d * 16 + 15) * 64 + k0);
      }
    }
  }
  __syncthreads();
}

__device__ __forceinline__ float4 ld4f(const float* q) { return make_float4(q[0], q[1], q[2], q[3]); }
__device__ __forceinline__ f32x4 mm16(const float* X, const float* Y, int i, int g, bool neg_x_plus_eye) {
  f32x4 acc = f32x4{0.f, 0.f, 0.f, 0.f};
#pragma unroll
  for (int k4 = 0; k4 < 4; ++k4) {
    float a = X[i * MS + 4 * k4 + g];
    if (neg_x_plus_eye) a = ((i == 4 * k4 + g) ? 1.f : 0.f) - a;
    const float b = Y[(4 * k4 + g) * MS + i];
    acc = __builtin_amdgcn_mfma_f32_16x16x4f32(a, b, acc, 0, 0, 0);
  }
  return acc;
}
__device__ __forceinline__ void st16(float* M, const f32x4& v, int i, int g) {
#pragma unroll
  for (int r_ = 0; r_ < 4; ++r_) M[(4 * g + r_) * MS + i] = v[r_];
}
__device__ __forceinline__ void chunk_prep_wave(const Params& p, int mixer, int b, bool is_ctx, int t0, char* smem, int tid) {
  const int lane = tid & 63, w = tid >> 6, h = w & 3, d = w >> 2, i = lane & 15, g = lane >> 4;
  const char* vec = smem + VEC_OFF;
  float* Wc = (float*)(smem + w * 9728);
  float* M0 = Wc + 16 * WCS;
  float* M1 = M0 + 16 * MS;
  float* M2 = M1 + 16 * MS;
  float* M3 = M2 + 16 * MS;
  float* M4 = M3 + 16 * MS;
  char* img = img_ptr(p, mixer, d, b, h, tile_cidx(is_ctx, t0, d));
  const float* wv = (const float*)(vec + (d ? VEC_W1 : VEC_W0)) + h * 64;
  const bf16_t* vkk = (const bf16_t*)(vec + VEC_KK) + h * 64;
  const bf16_t* vr = (const bf16_t*)(vec + VEC_R) + h * 64;
  const bf16_t* vb = (const bf16_t*)(vec + (d ? VEC_B1 : VEC_B0)) + h * 64;
  const bf16_t* vkd = (const bf16_t*)(vec + (d ? VEC_KD1 : VEC_KD0)) + h * 64;
  {
    float acc = 1.f;
#pragma unroll
    for (int s_ = 0; s_ < 16; ++s_) {
      const int tok = d ? 15 - s_ : s_;
      acc *= wv[tok * 256 + lane];
      Wc[s_ * WCS + lane] = acc;
    }
  }
  {
    const int tok = d ? 15 - i : i;
    float KKT[16], RT[16], BT[16], KDT[16];
#pragma unroll
    for (int k4 = 0; k4 < 16; ++k4) {
      const int k = 4 * k4 + g;
      const float W = Wc[i * WCS + k];
      const float Wp = i ? Wc[(i - 1) * WCS + k] : 1.f;
      const float iW = __builtin_amdgcn_rcpf(W);
      KKT[k4] = bf2f(vkk[tok * VS + k]) * Wp;
      RT[k4] = bf2f(vr[tok * VS + k]) * W;
      BT[k4] = bf2f(vb[tok * VS + k]) * iW;
      KDT[k4] = bf2f(vkd[tok * VS + k]) * iW;
    }
    f32x4 aab = f32x4{0.f, 0.f, 0.f, 0.f}, aak = aab, rbb = aab, rkk = aab;
#pragma unroll
    for (int k4 = 0; k4 < 16; ++k4) {
      aab = __builtin_amdgcn_mfma_f32_16x16x4f32(KKT[k4], BT[k4], aab, 0, 0, 0);
      aak = __builtin_amdgcn_mfma_f32_16x16x4f32(KKT[k4], KDT[k4], aak, 0, 0, 0);
      rbb = __builtin_amdgcn_mfma_f32_16x16x4f32(RT[k4], BT[k4], rbb, 0, 0, 0);
      rkk = __builtin_amdgcn_mfma_f32_16x16x4f32(RT[k4], KDT[k4], rkk, 0, 0, 0);
    }
#pragma unroll
    for (int r_ = 0; r_ < 4; ++r_) {
      const int s_ = 4 * g + r_;
      const bool st = i < s_, inc = i <= s_;
      M0[s_ * MS + i] = st ? aab[r_] : 0.f;
      M1[s_ * MS + i] = st ? aak[r_] : 0.f;
      M2[s_ * MS + i] = inc ? rbb[r_] : 0.f;
      M3[s_ * MS + i] = inc ? rkk[r_] : 0.f;
    }
  }
  {
    const int s_ = lane >> 2, gg = lane & 3;
    const float4 x0 = ld4f(M2 + s_ * MS + 4 * gg), x1 = ld4f(M3 + s_ * MS + 4 * gg);
    uint4 v;
    v.x = pk_bf16(x0.x, x0.y); v.y = pk_bf16(x0.z, x0.w); v.z = pk_bf16(x1.x, x1.y); v.w = pk_bf16(x1.z, x1.w);
    *(uint4*)(img + IMG_TR + s_ * 128 + (((4 + gg) ^ (s_ & 7)) << 4)) = v;
  }
  {
    f32x4 P;
#pragma unroll
    for (int r_ = 0; r_ < 4; ++r_) { const int s_ = 4 * g + r_; P[r_] = ((s_ == i) ? 1.f : 0.f) - M0[s_ * MS + i]; }
    f32x4 X2 = mm16(M0, M0, i, g, false);
    st16(M2, X2, i, g);
    st16(M3, P, i, g);
    P += mm16(M3, M2, i, g, false);
    f32x4 X4 = mm16(M2, M2, i, g, false);
    st16(M4, X4, i, g);
    st16(M3, P, i, g);
    P += mm16(M3, M4, i, g, false);
    f32x4 X8 = mm16(M4, M4, i, g, false);
    st16(M2, X8, i, g);
    st16(M3, P, i, g);
    P += mm16(M3, M2, i, g, false);
    st16(M3, P, i, g);
    f32x4 Mm = mm16(M3, M1, i, g, false);
    st16(M2, Mm, i, g);
  }
  {
    const int s_ = lane >> 2, gg = lane & 3;
    const float4 x0 = ld4f(M3 + s_ * MS + 4 * gg), x1 = ld4f(M2 + s_ * MS + 4 * gg);
    uint4 v;
    v.x = pk_bf16(x0.x, x0.y); v.y = pk_bf16(x0.z, x0.w); v.z = pk_bf16(x1.x, x1.y); v.w = pk_bf16(x1.z, x1.w);
    *(uint4*)(img + IMG_TR + s_ * 128 + ((gg ^ (s_ & 7)) << 4)) = v;
  }
#pragma unroll
  for (int q = 0; q < 2; ++q) {
    const int cc = lane + 64 * q, s_ = cc >> 3, ch = cc & 7;
    const int tok = d ? 15 - s_ : s_;
    float ek[8], er[8];
#pragma unroll
    for (int e_ = 0; e_ < 8; ++e_) {
      const int k = colp(ch * 8 + e_);
      const float W = Wc[s_ * WCS + k];
      const float Wp = s_ ? Wc[(s_ - 1) * WCS + k] : 1.f;
      ek[e_] = bf2f(vkk[tok * VS + k]) * Wp;
      er[e_] = bf2f(vr[tok * VS + k]) * W;
    }
    uint4 v;
    v.x = pk_bf16(ek[0], ek[1]); v.y = pk_bf16(ek[2], ek[3]); v.z = pk_bf16(ek[4], ek[5]); v.w = pk_bf16(ek[6], ek[7]);
    *(uint4*)(img + IMG_KK + s_ * 128 + ((ch ^ (s_ & 7)) << 4)) = v;
    v.x = pk_bf16(er[0], er[1]); v.y = pk_bf16(er[2], er[3]); v.z = pk_bf16(er[4], er[5]); v.w = pk_bf16(er[6], er[7]);
    *(uint4*)(img + IMG_RT + s_ * 128 + ((ch ^ (s_ & 7)) << 4)) = v;
  }
#pragma unroll
  for (int q = 0; q < 4; ++q) {
    const int cc = lane + 64 * q, kc = cc >> 2, gg = cc & 3;
    const float WL = Wc[15 * WCS + kc];
    float e[8];
#pragma unroll
    for (int e_ = 0; e_ < 4; ++e_) {
      const int s_ = 4 * gg + e_, tok = d ? 15 - s_ : s_;
      const float f = WL * __builtin_amdgcn_rcpf(Wc[s_ * WCS + kc]);
      e[e_] = bf2f(vb[tok * VS + kc]) * f;
      e[4 + e_] = bf2f(vkd[tok * VS + kc]) * f;
    }
    const int row = kc & 31, ch = (kc >> 5) * 4 + gg;
    uint4 v;
    v.x = pk_bf16(e[0], e[1]); v.y = pk_bf16(e[2], e[3]); v.z = pk_bf16(e[4], e[5]); v.w = pk_bf16(e[6], e[7]);
    *(uint4*)(img + IMG_BK + row * 128 + ((ch ^ (row & 7)) << 4)) = v;
  }
  if (lane < 16) *(float4*)(img + IMG_WL + lane * 16) = ld4f(Wc + 15 * WCS + lane * 4);
}

constexpr int CVS = 1156;
__device__ __forceinline__ bf16x8 cv_frag(const float* q) {
  const float4 a = *(const float4*)q, b = *(const float4*)(q + 4);
  uint4 u; u.x = pk_bf16(a.x, a.y); u.y = pk_bf16(a.z, a.w); u.z = pk_bf16(b.x, b.y); u.w = pk_bf16(b.z, b.w);
  return __builtin_bit_cast(bf16x8, u);
}
struct RwFill { uint4 cu, pu, nu; float4 m0a, m0b, m1a, m1b; };
__device__ __forceinline__ void rw_fill_load(const Params& p, const float* mu, int r0, int tk, int ch, RwFill& f) {
  const int col = ch * 8;
  const int row = r0 + tk;
  int t, len; seq_pos(row, t, len);
  const bf16_t* src = p.P() + (size_t)row * INC + OFF_B + col;
  const uint4 zero4 = make_uint4(0u, 0u, 0u, 0u);
  f.cu = *(const uint4*)src;
  const bool hp = t > 0, hn = t < len - 1;
  const uint4 pu = *(const uint4*)(src - (hp ? INC : 0)), nu = *(const uint4*)(src + (hn ? INC : 0));
  f.pu = hp ? pu : zero4;
  f.nu = hn ? nu : zero4;
  f.m0a = *(const float4*)(mu + col); f.m0b = *(const float4*)(mu + col + 4);
  f.m1a = *(const float4*)(mu + 1152 + col); f.m1b = *(const float4*)(mu + 1152 + col + 4);
}
template <int ACT>
__device__ __forceinline__ void rw_fill_store(float* Cv, int tk, int ch, const RwFill& f) {
  const int col = ch * 8;
  float xc[8], xp[8], xn[8];
  unpack8(f.cu, xc); unpack8(f.pu, xp); unpack8(f.nu, xn);
  const float m0[8] = {f.m0a.x, f.m0a.y, f.m0a.z, f.m0a.w, f.m0b.x, f.m0b.y, f.m0b.z, f.m0b.w};
  const float m1[8] = {f.m1a.x, f.m1a.y, f.m1a.z, f.m1a.w, f.m1b.x, f.m1b.y, f.m1b.z, f.m1b.w};
  float o[8];
#pragma unroll
  for (int e = 0; e < 8; ++e) {
    float v = xc[e] * (1.0f - m0[e] - m1[e]) + xp[e] * m0[e] + xn[e] * m1[e];
    if (ACT == 1) v = tanhf_(v);
    if (ACT == 2) v = sigmoidf_(v);
    o[e] = v;
  }
  *(float4*)(Cv + tk * CVS + col) = make_float4(o[0], o[1], o[2], o[3]);
  *(float4*)(Cv + tk * CVS + col + 4) = make_float4(o[4], o[5], o[6], o[7]);
}
template <int RPM = 0>
__device__ __forceinline__ void chunk_rwprep(const Params& p, int l, char* smem, int wave_s) {
  const int tid0 = make_tid(wave_s);
  float* Cv = (float*)smem;
  char* vec = smem + VEC_OFF;
  const float* mu = p.rwkv_mu + (size_t)l * 2 * 1152;
  const bf16_t* LT = lorat(p, l);
  for (int tile = blockIdx.x; tile < NTOK / 16; tile += gridDim.x) {
    int tid = tid0; asm volatile("" : "+v"(tid));
    const int lane = tid & 63, w = tid >> 6, h = w & 3, i = lane & 15, g = lane >> 4;
    const int r0 = tile * 16;
    const bool is_ctx = r0 >= NLAT;
    const int b = is_ctx ? (r0 - NLAT) / NCX : r0 / NTL;
    const int t0 = is_ctx ? (r0 - NLAT) % NCX : r0 % NTL;
    {
      const int wu = __builtin_amdgcn_readfirstlane(tid >> 6);
      const int cidx = tid & 255;
      const int tkA = cidx >> 4, chA = (wu < 4 ? 96 : 128) + (cidx & 15);
      int tkP[4], chP[4];
#pragma unroll
      for (int q = 0; q < 4; ++q) { const int idx = min(tid + q * NTHREADS, 1791); tkP[q] = idx / 112; const int c = idx - tkP[q] * 112; chP[q] = c < 96 ? c : c + 16; }
      RwFill fa, f0, f1, f2, f3;
      rw_fill_load(p, mu, r0, tkA, chA, fa);
      rw_fill_load(p, mu, r0, tkP[0], chP[0], f0); rw_fill_load(p, mu, r0, tkP[1], chP[1], f1);
      rw_fill_load(p, mu, r0, tkP[2], chP[2], f2); rw_fill_load(p, mu, r0, tkP[3], chP[3], f3);
      __builtin_amdgcn_sched_barrier(0);
      if (wu < 4) rw_fill_store<1>(Cv, tkA, chA, fa); else rw_fill_store<2>(Cv, tkA, chA, fa);
      rw_fill_store<0>(Cv, tkP[0], chP[0], f0); rw_fill_store<0>(Cv, tkP[1], chP[1], f1);
      rw_fill_store<0>(Cv, tkP[2], chP[2], f2);
      if (wu < 4) rw_fill_store<0>(Cv, tkP[3], chP[3], f3);
    }
    const bool gate_wave = __builtin_amdgcn_readfirstlane(tid >> 6) >= 4;
    LDS_BAR();
    __builtin_amdgcn_sched_barrier(0);
    if (gate_wave) {
      f32x4 ag[4];
#pragma unroll
      for (int nt = 0; nt < 4; ++nt) ag[nt] = f32x4{0.f, 0.f, 0.f, 0.f};
      bf16x8 lf[16];
#pragma unroll
      for (int ks = 0; ks < 4; ++ks)
#pragma unroll
        for (int nt = 0; nt < 4; ++nt)
          lf[ks * 4 + nt] = *(const bf16x8*)(LT + 4 * 256 * 64 + (size_t)(h * 64 + nt * 16 + i) * 128 + ks * 32 + g * 8);
      __builtin_amdgcn_sched_barrier(0);
#pragma unroll
      for (int ks = 0; ks < 4; ++ks) {
        const bf16x8 af = cv_frag(Cv + i * CVS + 1024 + ks * 32 + g * 8);
#pragma unroll
        for (int nt = 0; nt < 4; ++nt) {
          ag[nt] = __builtin_amdgcn_mfma_f32_16x16x32_bf16(af, lf[ks * 4 + nt], ag[nt], 0, 0, 0);
        }
      }
#pragma unroll
      for (int nt = 0; nt < 4; ++nt)
#pragma unroll
        for (int r_ = 0; r_ < 4; ++r_) p.G16()[(size_t)(r0 + 4 * g + r_) * 256 + h * 64 + nt * 16 + i] = f2bf(ag[nt][r_]);
    } else {
      f32x4 aw0[4], aw1[4], aa0[4], aa1[4];
#pragma unroll
      for (int nt = 0; nt < 4; ++nt) { aw0[nt] = f32x4{0.f, 0.f, 0.f, 0.f}; aw1[nt] = aw0[nt]; aa0[nt] = aw0[nt]; aa1[nt] = aw0[nt]; }
#pragma unroll
      for (int ks = 0; ks < 2; ++ks) {
        bf16x8 lf[16];
#pragma unroll
        for (int nt = 0; nt < 4; ++nt) {
          const size_t co = (size_t)(h * 64 + nt * 16 + i) * 64 + ks * 32 + g * 8;
          lf[nt * 4 + 0] = *(const bf16x8*)(LT + co);
          lf[nt * 4 + 1] = *(const bf16x8*)(LT + 256 * 64 + co);
          lf[nt * 4 + 2] = *(const bf16x8*)(LT + 2 * 256 * 64 + co);
          lf[nt * 4 + 3] = *(const bf16x8*)(LT + 3 * 256 * 64 + co);
        }
        __builtin_amdgcn_sched_barrier(0);
        const bf16x8 fw0 = cv_frag(Cv + i * CVS + 768 + ks * 32 + g * 8), fw1 = cv_frag(Cv + i * CVS + 832 + ks * 32 + g * 8);
        const bf16x8 fa0 = cv_frag(Cv + i * CVS + 896 + ks * 32 + g * 8), fa1 = cv_frag(Cv + i * CVS + 960 + ks * 32 + g * 8);
#pragma unroll
        for (int nt = 0; nt < 4; ++nt) {
          aw0[nt] = __builtin_amdgcn_mfma_f32_16x16x32_bf16(fw0, lf[nt * 4 + 0], aw0[nt], 0, 0, 0);
          aw1[nt] = __builtin_amdgcn_mfma_f32_16x16x32_bf16(fw1, lf[nt * 4 + 1], aw1[nt], 0, 0, 0);
          aa0[nt] = __builtin_amdgcn_mfma_f32_16x16x32_bf16(fa0, lf[nt * 4 + 2], aa0[nt], 0, 0, 0);
          aa1[nt] = __builtin_amdgcn_mfma_f32_16x16x32_bf16(fa1, lf[nt * 4 + 3], aa1[nt], 0, 0, 0);
        }
        __builtin_amdgcn_sched_barrier(0);
      }
      if (RPM == 2) {
        float z = 0.f;
#pragma unroll
        for (int nt = 0; nt < 4; ++nt) z += aw0[nt][0] + aw1[nt][1] + aa0[nt][2] + aa1[nt][3];
        if (z == 123.456f) bonbuf(p)[0] = z;
      } else {
      float n2[4], bon[4];
#pragma unroll
      for (int r_ = 0; r_ < 4; ++r_) { n2[r_] = 0.f; bon[r_] = 0.f; }
#pragma unroll
      for (int nt = 0; nt < 4; ++nt) {
        const int c = h * 64 + nt * 16 + i;
        const float kkc = p.rwkv_kk[l * 256 + c];
#pragma unroll
        for (int r_ = 0; r_ < 4; ++r_) { const float kr = Cv[(4 * g + r_) * CVS + 256 + c] * kkc; n2[r_] += kr * kr; }
      }
#pragma unroll
      for (int r_ = 0; r_ < 4; ++r_) n2[r_] = FRSQ(reduce16(n2[r_]) + 1e-6f);
      char* vv0 = img_ptr(p, 0, 0, b, h, tile_cidx(is_ctx, t0, 0)) + IMG_VV;
      char* vv1 = img_ptr(p, 0, 1, b, h, tile_cidx(is_ctx, t0, 1)) + IMG_VV;
#pragma unroll
      for (int nt = 0; nt < 4; ++nt) {
        const int c = h * 64 + nt * 16 + i;
        const float w00 = p.rwkv_w0[(l * 2 + 0) * 256 + c], w01 = p.rwkv_w0[(l * 2 + 1) * 256 + c];
        const float a00 = p.rwkv_a0[(l * 2 + 0) * 256 + c], a01 = p.rwkv_a0[(l * 2 + 1) * 256 + c];
        const float kkc = p.rwkv_kk[l * 256 + c], kac = p.rwkv_ka[l * 256 + c], rkc = p.rwkv_rk[l * 256 + c];
#pragma unroll
        for (int r_ = 0; r_ < 4; ++r_) {
          const int tok = 4 * g + r_;
          const float r = Cv[tok * CVS + c], k = Cv[tok * CVS + 256 + c], v = Cv[tok * CVS + 512 + c];
          const float wd0 = FEXP(-sigmoidf_(w00 + aw0[nt][r_]) * 0.6065306597126334f);
          const float wd1 = FEXP(-sigmoidf_(w01 + aw1[nt][r_]) * 0.6065306597126334f);
          const float ad0 = sigmoidf_(a00 + aa0[nt][r_]), ad1 = sigmoidf_(a01 + aa1[nt][r_]);
          const float kk = k * kkc * n2[r_];
          const float kd0 = k * (1.0f + (ad0 - 1.0f) * kac), kd1 = k * (1.0f + (ad1 - 1.0f) * kac);
          bon[r_] += r * (kd0 + kd1) * rkc;
          ((float*)(vec + VEC_W0))[tok * 256 + c] = wd0; ((float*)(vec + VEC_W1))[tok * 256 + c] = wd1;
          ((bf16_t*)(vec + VEC_KK))[tok * VS + c] = f2bf(kk); ((bf16_t*)(vec + VEC_R))[tok * VS + c] = f2bf(r);
          ((bf16_t*)(vec + VEC_B0))[tok * VS + c] = f2bf(kk * ad0); ((bf16_t*)(vec + VEC_B1))[tok * VS + c] = f2bf(kk * ad1);
          ((bf16_t*)(vec + VEC_KD0))[tok * VS + c] = f2bf(kd0); ((bf16_t*)(vec + VEC_KD1))[tok * VS + c] = f2bf(kd1);
          const bf16_t vb = f2bf(v);
          *(bf16_t*)(vv0 + ((nt * 16 + i) * 16 + tok) * 2) = vb;
          *(bf16_t*)(vv1 + ((nt * 16 + i) * 16 + 15 - tok) * 2) = vb;
          rv16(p)[(size_t)(r0 + tok) * 256 + c] = vb;
        }
      }
#pragma unroll
      for (int r_ = 0; r_ < 4; ++r_) {
        const float bs = reduce16(bon[r_]);
        if (i == 0) bonbuf(p)[(size_t)(r0 + 4 * g + r_) * 4 + h] = bs;
      }
      }
    }
    LDS_BAR();
    if (RPM == 0) chunk_prep_wave(p, 0, b, is_ctx, t0, smem, tid);
    LDS_BAR();
  }
}

template <int PMODE = 0>
__device__ __forceinline__ void chunk_gdprep(const Params& p, int l, char* smem, int wave_s) {
  const int tid0 = make_tid(wave_s);
  char* vec = smem + VEC_OFF;
  const float* cw = p.gdn_conv + (size_t)l * 3 * 768;
  for (int tile = (int)((blockIdx.x + gridDim.x - (NTOK / 16) % gridDim.x) % gridDim.x); tile < NTOK / 16; tile += gridDim.x) {
    int tid = tid0; asm volatile("" : "+v"(tid));
    const int c = tid & 255, lane = tid & 63, h = c >> 6, tg = tid >> 8;
    float w0[3], w1[3], w2[3];
#pragma unroll
    for (int j = 0; j < 3; ++j) { w0[j] = cw[j * 256 + c]; w1[j] = cw[768 + j * 256 + c]; w2[j] = cw[1536 + j * 256 + c]; }
    const float nal0 = -FEXP(p.gdn_a_log[(l * 2 + 0) * 4 + h]), nal1 = -FEXP(p.gdn_a_log[(l * 2 + 1) * 4 + h]);
    const float dtb0 = p.gdn_dt_bias[(l * 2 + 0) * 4 + h], dtb1 = p.gdn_dt_bias[(l * 2 + 1) * 4 + h];
    const int r0 = tile * 16;
    const bool is_ctx = r0 >= NLAT;
    const int b = is_ctx ? (r0 - NLAT) / NCX : r0 / NTL;
    const int t0 = is_ctx ? (r0 - NLAT) % NCX : r0 % NTL;
    char* vv0 = img_ptr(p, 1, 0, b, h, tile_cidx(is_ctx, t0, 0)) + IMG_VV + lane * 32;
    char* vv1 = img_ptr(p, 1, 1, b, h, tile_cidx(is_ctx, t0, 1)) + IMG_VV + lane * 32;
    char* vbf = vec + (tg * 8 * 256 + c) * 4;
    char* vbh = vec + VEC_KK + (tg * 8 * VS + c) * 2;
    asm volatile("" : "+v"(vbf), "+v"(vbh));
    bf16_t* rawP = (bf16_t*)smem;
    constexpr int RPS = 792;
    {
      const int slen = is_ctx ? NCX : NTL;
      uint4 sv[4];
#pragma unroll
      for (int q = 0; q < 4; ++q) {
        const int idx = min(tid + q * NTHREADS, 18 * 98 - 1);
        const int rr = idx / 98, ch = idx - rr * 98;
        const int t = t0 + rr - 1;
        const bool ok = t >= 0 && t < slen;
        sv[q] = *(const uint4*)(p.P() + (size_t)(r0 + (ok ? rr - 1 : 0)) * INC + OFF_C + (ch < 96 ? ch * 8 : 1024 + (ch - 96) * 8));
      }
      __builtin_amdgcn_sched_barrier(0);
#pragma unroll
      for (int q = 0; q < 4; ++q) {
        const int idx = min(tid + q * NTHREADS, 18 * 98 - 1);
        const int rr = idx / 98, ch = idx - rr * 98;
        const int t = t0 + rr - 1;
        const bool ok = t >= 0 && t < slen;
        *(uint4*)(rawP + rr * RPS + ch * 8) = ok ? sv[q] : make_uint4(0u, 0u, 0u, 0u);
      }
    }
    LDS_BAR();
#pragma unroll
    for (int tt = 0; tt < (PMODE >= 2 ? 0 : 8); ++tt) {
      const int tok = tg * 8 + tt;
      const bf16_t* rp = rawP + (tok + 1) * RPS;
      float qkv[3];
#pragma unroll
      for (int j = 0; j < 3; ++j)
        qkv[j] = siluf_(bf2f(rp[-RPS + j * 256 + c]) * w0[j] + bf2f(rp[j * 256 + c]) * w1[j] + bf2f(rp[RPS + j * 256 + c]) * w2[j]);
      const float ab0 = bf2f(rp[768 + 0 * 4 + h]), ab1 = bf2f(rp[768 + 1 * 4 + h]), ab2 = bf2f(rp[768 + 8 + 0 * 4 + h]), ab3 = bf2f(rp[768 + 8 + 1 * 4 + h]);
      const float qn = qkv[0] * FRSQ(wsum(qkv[0] * qkv[0]) + 1e-6f) * 0.125f;
      const float kn = qkv[1] * FRSQ(wsum(qkv[1] * qkv[1]) + 1e-6f);
      const float eg0 = FEXP(nal0 * softplusf_(ab0 + dtb0)), eg1 = FEXP(nal1 * softplusf_(ab1 + dtb1));
      const float be0 = sigmoidf_(ab2), be1 = sigmoidf_(ab3);
      *(float*)(vbf + VEC_W0 + tt * 1024) = eg0; *(float*)(vbf + VEC_W1 + tt * 1024) = eg1;
      *(bf16_t*)(vbh + tt * (VS * 2)) = f2bf(kn); *(bf16_t*)(vbh + (VEC_R - VEC_KK) + tt * (VS * 2)) = f2bf(qn);
      *(bf16_t*)(vbh + (VEC_B0 - VEC_KK) + tt * (VS * 2)) = f2bf(be0 * eg0 * kn); *(bf16_t*)(vbh + (VEC_B1 - VEC_KK) + tt * (VS * 2)) = f2bf(be1 * eg1 * kn);
      *(bf16_t*)(vbh + (VEC_KD0 - VEC_KK) + tt * (VS * 2)) = f2bf(be0 * kn); *(bf16_t*)(vbh + (VEC_KD1 - VEC_KK) + tt * (VS * 2)) = f2bf(be1 * kn);
      const bf16_t vb = f2bf(qkv[2]);
      *(bf16_t*)(vv0 + tok * 2) = vb;
      *(bf16_t*)(vv1 + (15 - tok) * 2) = vb;
    }
    LDS_BAR();
    if (PMODE != 1) chunk_prep_wave(p, 1, b, is_ctx, t0, smem, tid);
    LDS_BAR();
  }
}

constexpr int SGRP = 4;
constexpr int SGRP_BYTES = SGRP * IMG_BYTES;
__device__ __forceinline__ void cs_group(const Params& p, bool last, const char* buf, int gi, f32x4 (&Sd)[4],
                                         int mixer, int d, int b, int h, int lane, int rho0) {
  const int i = lane & 15, g = lane >> 4, sw = i & 7;
#pragma unroll
    for (int cc = 0; cc < SGRP; ++cc) {
      const char* im = buf + cc * IMG_BYTES;
      const int cidx = gi * SGRP + cc;
      const bf16x8 bs0 = pack_p8(Sd[0], Sd[1]), bs1 = pack_p8(Sd[2], Sd[3]);
      const bf16x8 kk0 = *(const bf16x8*)(im + IMG_KK + i * 128 + (((0 + g) ^ sw) << 4));
      const bf16x8 kk1 = *(const bf16x8*)(im + IMG_KK + i * 128 + (((4 + g) ^ sw) << 4));
      const bf16x8 rt0 = *(const bf16x8*)(im + IMG_RT + i * 128 + (((0 + g) ^ sw) << 4));
      const bf16x8 rt1 = *(const bf16x8*)(im + IMG_RT + i * 128 + (((4 + g) ^ sw) << 4));
      const bf16x8 tm = *(const bf16x8*)(im + IMG_TR + i * 128 + (((0 + g) ^ sw) << 4));
      const bf16x8 rb = *(const bf16x8*)(im + IMG_TR + i * 128 + (((4 + g) ^ sw) << 4));
      const uint2 vraw = *(const uint2*)(im + IMG_VV + ((rho0 + i) * 16 + 4 * g) * 2);
      f32x4 zt = __builtin_amdgcn_mfma_f32_16x16x32_bf16(kk0, bs0, f32x4{0.f, 0.f, 0.f, 0.f}, 0, 0, 0);
      zt = __builtin_amdgcn_mfma_f32_16x16x32_bf16(kk1, bs1, zt, 0, 0, 0);
      f32x4 yt = __builtin_amdgcn_mfma_f32_16x16x32_bf16(rt0, bs0, f32x4{0.f, 0.f, 0.f, 0.f}, 0, 0, 0);
      yt = __builtin_amdgcn_mfma_f32_16x16x32_bf16(rt1, bs1, yt, 0, 0, 0);
      uint4 zv; zv.x = pk_bf16(zt[0], zt[1]); zv.y = pk_bf16(zt[2], zt[3]); zv.z = vraw.x; zv.w = vraw.y;
      f32x4 pt = __builtin_amdgcn_mfma_f32_16x16x32_bf16(tm, __builtin_bit_cast(bf16x8, zv), f32x4{0.f, 0.f, 0.f, 0.f}, 0, 0, 0);
      uint4 pv; pv.x = pk_bf16(-pt[0], -pt[1]); pv.y = pk_bf16(-pt[2], -pt[3]); pv.z = vraw.x; pv.w = vraw.y;
      const bf16x8 pvf = __builtin_bit_cast(bf16x8, pv);
      yt = __builtin_amdgcn_mfma_f32_16x16x32_bf16(rb, pvf, yt, 0, 0, 0);
#pragma unroll
      for (int m = 0; m < 4; ++m) {
        const int row = (16 * m + i) & 31, ch = (m >> 1) * 4 + g;
        const bf16x8 bk = *(const bf16x8*)(im + IMG_BK + row * 128 + ((ch ^ (row & 7)) << 4));
        const float4 wl = *(const float4*)(im + IMG_WL + (16 * m + 4 * g) * 4);
        f32x4 cin = Sd[m];
        cin[0] *= wl.x; cin[1] *= wl.y; cin[2] *= wl.z; cin[3] *= wl.w;
        Sd[m] = __builtin_amdgcn_mfma_f32_16x16x32_bf16(bk, pvf, cin, 0, 0, 0);
      }
      const bool is_ctx = cidx < NCX / 16;
      {
        const int j = is_ctx ? cidx : cidx - NCX / 16;
        const int tile = d == 0 ? j : (is_ctx ? NCX / 16 : NTL / 16) - 1 - j;
        const int rbase = (is_ctx ? NLAT + b * NCX : b * NTL) + tile * 16;
#pragma unroll
        for (int r_ = 0; r_ < 4; ++r_) {
          const int s_ = 4 * g + r_, tok = d ? 15 - s_ : s_;
          p.YS()[(size_t)(rbase + tok) * 1024 + mixer * 512 + d * 256 + h * 64 + rho0 + i] = f2bf(yt[r_]);
        }
      }
    }
}
__device__ __forceinline__ void chunk_scan(const Params& p, bool last, int task, char* smem, int tid) {
  const int mixer = task / (2 * NB * 4), rem = task % (2 * NB * 4);
  const int d = rem / (NB * 4), b = (rem / 4) % NB, h = rem % 4;
  const char* gimg = img_ptr(p, mixer, d, b, h, 0);
  const int lane = tid & 63, w = tid >> 6;
  const int rho0 = (w & 3) * 16;
  const bool computes = __builtin_amdgcn_readfirstlane(tid >> 6) < 4;
  f32x4 Sd[4];
#pragma unroll
  for (int m = 0; m < 4; ++m) Sd[m] = f32x4{0.f, 0.f, 0.f, 0.f};
  uint4 sa0, sa1, sa2, sa3, sa4, sa5, sa6, sb0, sb1, sb2, sb3, sb4, sb5, sb6;
  const int ngrp = NCHK / SGRP;
#define CS_PC(q) min(tid + (q) * NTHREADS, SGRP_BYTES / 16 - 1)
#define CS_LD1(gi, q, dst) dst = *(const uint4*)(gimg + (size_t)min((gi), ngrp - 1) * SGRP_BYTES + CS_PC(q) * 16);
#define CS_ST1(bi, q, srcv) *(uint4*)(smem + (bi) * SGRP_BYTES + CS_PC(q) * 16) = srcv;
#define CS_LOAD(gi, s_) { CS_LD1(gi, 0, s_##0) CS_LD1(gi, 1, s_##1) CS_LD1(gi, 2, s_##2) CS_LD1(gi, 3, s_##3) CS_LD1(gi, 4, s_##4) CS_LD1(gi, 5, s_##5) CS_LD1(gi, 6, s_##6) }
#define CS_STORE(bi, s_) { CS_ST1(bi, 0, s_##0) CS_ST1(bi, 1, s_##1) CS_ST1(bi, 2, s_##2) CS_ST1(bi, 3, s_##3) CS_ST1(bi, 4, s_##4) CS_ST1(bi, 5, s_##5) CS_ST1(bi, 6, s_##6) }
#define CS_BAR() { asm volatile("s_waitcnt lgkmcnt(0)" ::: "memory"); __builtin_amdgcn_s_barrier(); asm volatile("" ::: "memory"); }
#define CS_LOOP(COMPUTE_) { \
    CS_LOAD(0, sa); CS_LOAD(1, sb); CS_STORE(0, sa); CS_BAR(); \
    for (int gi = 0; gi < ngrp; gi += 2) { \
      CS_LOAD(gi + 2, sa); __builtin_amdgcn_sched_barrier(0); \
      COMPUTE_(gi) \
      __builtin_amdgcn_sched_barrier(0); CS_STORE((gi + 1) % 3, sb); CS_BAR(); \
      CS_LOAD(gi + 3, sb); __builtin_amdgcn_sched_barrier(0); \
      COMPUTE_(gi + 1) \
      __builtin_amdgcn_sched_barrier(0); CS_STORE((gi + 2) % 3, sa); CS_BAR(); \
    } }
#define CS_DO(g_) cs_group(p, last, smem + ((g_) % 3) * SGRP_BYTES, (g_), Sd, mixer, d, b, h, lane, rho0);
#define CS_SKIP(g_)
  static_assert((NCHK / SGRP) % 2 == 0, "group loop is unrolled by two");
  if (computes) CS_LOOP(CS_DO) else CS_LOOP(CS_SKIP)
#undef CS_LOOP
#undef CS_DO
#undef CS_SKIP
#undef CS_PC
#undef CS_LOAD
#undef CS_STORE
#undef CS_LD1
#undef CS_ST1
#undef CS_BAR
}

__device__ __forceinline__ void chunk_post(const Params& p, int l, int nr, int wave_s) {
  for (int row = blockIdx.x * 8 + wave_s; row < nr; row += gridDim.x * 8) {
    const int lane = make_tid(wave_s) & 63;
    const int c0 = lane * 4, h = lane >> 4;
    const bf16_t* ys = p.YS() + (size_t)row * 1024;
    bf16_t* yo = p.Y() + (size_t)row * DM;
    {
      const float4 y0 = ld4(ys + c0), y1 = ld4(ys + 256 + c0);
      const float4 gq = ld4(p.G16() + (size_t)row * 256 + c0), vq = ld4(rv16(p) + (size_t)row * 256 + c0);
      const float4 lg = *(const float4*)(p.rwkv_ln_g + l * 256 + c0), lb = *(const float4*)(p.rwkv_ln_b + l * 256 + c0);
      const float bon = bonbuf(p)[(size_t)row * 4 + h];
      float y[4] = {y0.x + y1.x, y0.y + y1.y, y0.z + y1.z, y0.w + y1.w};
      const float m = reduce16((y[0] + y[1]) + (y[2] + y[3])) * (1.0f / 64);
      float dd[4] = {y[0] - m, y[1] - m, y[2] - m, y[3] - m};
      const float rstd = 1.0f / sqrtf(reduce16((dd[0] * dd[0] + dd[1] * dd[1]) + (dd[2] * dd[2] + dd[3] * dd[3])) * (1.0f / 64) + 64e-5f);
      uint2 o;
      o.x = pk_bf16((dd[0] * rstd * lg.x + lb.x + bon * vq.x) * gq.x, (dd[1] * rstd * lg.y + lb.y + bon * vq.y) * gq.y);
      o.y = pk_bf16((dd[2] * rstd * lg.z + lb.z + bon * vq.z) * gq.z, (dd[3] * rstd * lg.w + lb.w + bon * vq.w) * gq.w);
      *(uint2*)(yo + 256 + c0) = o;
    }
    {
      const float4 o0 = ld4(ys + 512 + c0), o1 = ld4(ys + 768 + c0);
      const float4 gt = ld4(p.P() + (size_t)row * INC + OFF_C + 768 + c0);
      const float4 ng = *(const float4*)(p.gdn_norm_g + l * 64 + (c0 & 63));
      float o[4] = {o0.x + o1.x, o0.y + o1.y, o0.z + o1.z, o0.w + o1.w};
      const float rs = 1.0f / sqrtf(reduce16((o[0] * o[0] + o[1] * o[1]) + (o[2] * o[2] + o[3] * o[3])) * (1.0f / 64) + 1e-6f);
      uint2 r;
      r.x = pk_bf16(o[0] * rs * ng.x * siluf_(gt.x), o[1] * rs * ng.y * siluf_(gt.y));
      r.y = pk_bf16(o[2] * rs * ng.z * siluf_(gt.z), o[3] * rs * ng.w * siluf_(gt.w));
      *(uint2*)(yo + 512 + c0) = r;
    }
  }
}

template <int MMODE = 0>
__device__ __forceinline__ void fast_mixers(const Params& p, int l, char* smem, int wave_s) {
  const int np = 2 * (2 * NB * 4);
  const int nb = gridDim.x;
  if (MMODE != 2) {
    for (int t = blockIdx.x; t < np; t += nb) { int tid = make_tid(wave_s); chunk_scan(p, l == 1, t, smem, tid); }
  }
  if (MMODE != 1) {
    const int nA = NB * 4 * (NTL / 256) + (l == 0 ? NB * 4 * (NCX / 256) : 0);
    const int nD = (NB * 4 * GROWS + (l == 0 ? NB * 4 * (NCX / 64) : 0)) / 2;
    unsigned* ctr = p.bar() + 16 + 16 * l + (MMODE == 2 ? 8 : 0);
    volatile int* slot = (volatile int*)(smem + 160256 + 8);
    for (;;) {
      LDS_BAR();
      if (make_tid(wave_s) == 0) *slot = (int)xb_add(ctr, 1u);
      LDS_BAR();
      const int t = __builtin_amdgcn_readfirstlane(*slot);
      if (t >= nA + nD) break;
      const int tid = make_tid(wave_s);
      if (t < nA) attnA_task(p, l, t, smem, tid);
      else attnD_pair(p, l, t - nA, smem, tid);
    }
  }
}

template <int PH>
__device__ __forceinline__ void run_phase(const Params& p, int l) {
  long n = phase_items(PH, l);
  int tid = threadIdx.x;
  long gtid = (long)(blockIdx.x * NTHREADS + tid);
  long nth = (long)(gridDim.x * NTHREADS);
  for (long i = gtid; i < n; i += nth) phase_item<PH>(p, l, i);
}

#define ITEM_LOOP(n_, ...)                                            \
  {                                                                  \
    int tid_ = threadIdx.x;                                          \
    asm volatile("" : "+v"(tid_));                                   \
    long nth_ = (long)(gridDim.x * NTHREADS);                        \
    for (long i = (long)(blockIdx.x * NTHREADS + tid_); i < (n_); i += nth_) __VA_ARGS__ \
  }
#if MEGA == 1
__global__ void __launch_bounds__(NTHREADS) fwd_megakernel(Params p) {
  __shared__ __attribute__((aligned(16))) char smem[160256 + 16];
#define xb_words (*(uint4*)(smem + 160256))
  cg::grid_group grid = cg::this_grid();
  const int wave_s = __builtin_amdgcn_readfirstlane((int)(threadIdx.x >> 6));
  if (threadIdx.x == 0) xb_words = make_uint4(0u, 0u, 0u, 0u);
  __syncthreads();
  (void)xcd_barrier_post(p.bar(), (volatile LAS unsigned*)&xb_words);
#define GSYNC() { XcdBarrier xb_; xb_.bar = p.bar(); xb_.x = xb_xcc_id(); xb_.st = (volatile LAS unsigned*)&xb_words; xcd_barrier(xb_, wave_s); }
  fast_ada(p, smem, wave_s);
  conv_lora(p, wave_s);
  conv_weights(p, smem, wave_s);
  conv_tables(p, 0, wave_s);
#if PROBE_DUP & 16384
  conv_tables(p, 0, wave_s);
#endif
#if PROBE_DUP & 32768
  conv_weights(p, smem, wave_s);
  fast_ada(p, smem, wave_s);
#endif
  grid.sync();
  fast_ln1(p, 0, wave_s); GSYNC();
  for (int l = 0; l < 2; ++l) {
    const int nr = rows_out(l);
    if (l == 1) conv_tables(p, 1, wave_s);
    gemm_phase<256>(p.Y(), DM, wbt_in(p, l), INC, p.P(), INC, NTOK, smem, wave_s); GSYNC();
#if PROBE_DUP & 1
    gemm_phase<256>(p.Y(), DM, wbt_in(p, l), INC, p.P(), INC, NTOK, smem, wave_s); GSYNC();
#endif
    fast_attprep(p, smem, wave_s);
    chunk_rwprep(p, l, smem, wave_s);
    chunk_gdprep(p, l, smem, wave_s);
#if PROBE_DUP & 32
    chunk_rwprep<1>(p, l, smem, wave_s);
#endif
#if PROBE_DUP & 524288
    chunk_rwprep<2>(p, l, smem, wave_s);
#endif
#if PROBE_DUP & 64
    chunk_gdprep(p, l, smem, wave_s);
#endif
#if PROBE_DUP & 128
    chunk_gdprep<1>(p, l, smem, wave_s);
#endif
#if PROBE_DUP & 256
    chunk_gdprep<2>(p, l, smem, wave_s);
#endif
#if PROBE_DUP & 512
    chunk_gdprep<3>(p, l, smem, wave_s);
#endif
    GSYNC();
    fast_mixers(p, l, smem, wave_s); GSYNC();
#if PROBE_DUP & 2
    fast_mixers(p, l, smem, wave_s); GSYNC();
#endif
#if PROBE_DUP & 1024
    fast_mixers<1>(p, l, smem, wave_s); GSYNC();
#endif
#if PROBE_DUP & 2048
    fast_mixers<2>(p, l, smem, wave_s); GSYNC();
#endif
    chunk_post(p, l, nr, wave_s); GSYNC();
#if PROBE_DUP & 4096
    chunk_post(p, l, nr, wave_s); GSYNC();
#endif
#if PROBE_DUP & 8192
    GSYNC(); GSYNC(); GSYNC(); GSYNC();
#endif
    gemm_phase<128>(p.Y(), DM, wbt_out(p, l), DM, (bf16_t*)p.RW(), DM, nr, smem, wave_s); GSYNC();
    fast_pn1(p, l, nr, wave_s); GSYNC();
    gemm_phase<128>(p.Y(), DM, wbt_q(p, l), 2048, peerQ(p), 2048, nr, smem, wave_s); GSYNC();
#if PROBE_DUP & 8
    gemm_phase<128>(p.Y(), DM, wbt_q(p, l), 2048, peerQ(p), 2048, nr, smem, wave_s); GSYNC();
#endif
    select_phase(p, l, nr, smem, wave_s); GSYNC();
#if PROBE_DUP & 16
    select_phase(p, l, nr, smem, wave_s); GSYNC();
#endif
    expert_u_phase(p, l, nr, wave_s, smem); GSYNC();
#if PROBE_DUP & 65536
    expert_u_phase(p, l, nr, wave_s, smem); GSYNC();
#endif
    expert_phase(p, l, nr, wave_s); GSYNC();
  }
}
#elif MEGA == 0
template <int PH>
__global__ void __launch_bounds__(256) phase_kernel(Params p, int l) {
  run_phase<PH>(p, l);
}
template <int PH>
static void launch_phase(const Params& p, int l, hipStream_t stream) {
  long n = phase_items(PH, l);
  if (n <= 0) return;
  long blocks = (n + 255) / 256;
  if (blocks > 8192) blocks = 8192;
  hipLaunchKernelGGL(phase_kernel<PH>, dim3((unsigned)blocks), dim3(256), 0, stream, p, l);
}
#endif

extern "C" void kernel_launch(void* const* d_in, const int* in_sizes, int n_in, void* d_out, int out_size, void* d_ws,
                              size_t ws_size, hipStream_t stream) {
  Params p{};
  const float** pin = (const float**)&p;
  for (int i = 0; i < 34; ++i) pin[i] = (const float*)d_in[i];
  p.out = (float*)d_out;
  if (ws_size < WS_END) return;
  p.ws = (char*)d_ws;
#if MEGA == 1
  static int grid_blocks = 0;
  if (!grid_blocks) {
    int dev = 0, cus = 0, per_cu = 0;
    hipGetDevice(&dev);
    hipDeviceGetAttribute(&cus, hipDeviceAttributeMultiprocessorCount, dev);
    hipOccupancyMaxActiveBlocksPerMultiprocessor(&per_cu, fwd_megakernel, NTHREADS, 0);
    if (per_cu > 1) per_cu = 1;
    grid_blocks = cus * per_cu;
  }
  (void)hipMemsetAsync(p.bar(), 0, WS_BAR_BYTES, stream);
  void* args[] = {&p};
  (void)hipLaunchCooperativeKernel((void*)fwd_megakernel, dim3(grid_blocks), dim3(NTHREADS), args, 0, stream);
#elif MEGA == 0
  launch_phase<PH_ADA>(p, 0, stream);
  for (int l = 0; l < 2; ++l) {
    launch_phase<PH_LN1>(p, l, stream);
    launch_phase<PH_GEMM_IN>(p, l, stream);
    launch_phase<PH_ROPE>(p, l, stream);
    launch_phase<PH_MIX>(p, l, stream);
    launch_phase<PH_GDPREP>(p, l, stream);
    launch_phase<PH_SCAN>(p, l, stream);
    launch_phase<PH_POST>(p, l, stream);
    launch_phase<PH_GEMM_OUT>(p, l, stream);
    launch_phase<PH_PN1>(p, l, stream);
    launch_phase<PH_GEMM_Q>(p, l, stream);
    launch_phase<PH_TOPK1>(p, l, stream);
    launch_phase<PH_TOPK2>(p, l, stream);
    launch_phase<PH_ACT>(p, l, stream);
    launch_phase<PH_FFN>(p, l, stream);
    launch_phase<PH_PN2>(p, l, stream);
  }
#endif
}
#endif
```

```cpp
#ifndef CPU_EMU
#include <hip/hip_runtime.h>
#include <hip/hip_cooperative_groups.h>
namespace cg = cooperative_groups;
#define DEVFN __device__ __forceinline__
#define HDFN __host__ __device__ __forceinline__
#define MEMFN __host__ __device__ __forceinline__
#define LOAD_FENCE() asm volatile("" ::: "memory")
#define LDS_BAR() { asm volatile("s_waitcnt lgkmcnt(0)" ::: "memory"); __builtin_amdgcn_s_barrier(); asm volatile("" ::: "memory"); }
#else
#include <cmath>
#include <cstdio>
#include <cstdlib>
#include <cstring>
#define DEVFN static inline
#define HDFN static inline
#define MEMFN inline
#define LOAD_FENCE()
struct float4 { float x, y, z, w; };
static inline float4 make_float4(float a, float b, float c, float d) { float4 r{a, b, c, d}; return r; }
#endif

#ifndef MEGA
#define MEGA 1
#endif
#ifndef PROBE_DUP
#define PROBE_DUP 0
#endif
#ifndef K_B
#define K_B 4
#define K_T 4096
#define K_C 256
#endif

typedef unsigned short bf16_t;
constexpr int NB = K_B, NTL = K_T, NCX = K_C;
constexpr int DM = 1024;
constexpr int NLAT = NB * NTL, NCTX = NB * NCX, NTOK = NLAT + NCTX;
constexpr int GROWS = NTL / 64;
constexpr int INC = 3728;
constexpr int OFF_A = 0, OFF_B = 768, OFF_C = 1920, OFF_D = 2960;
constexpr int RWS = 2560;
constexpr int GPS = 784;
constexpr int RWREC = 648;
constexpr int GDREC = 200;
constexpr int NMODV = NB + 1;
constexpr float DN_ALPHA = 1.4142135623730951f;
constexpr float LN_EPS = 1e-5f;

constexpr size_t al256(size_t x) { return (x + 255) & ~(size_t)255; }
constexpr size_t WS_MOD = 0;
constexpr size_t WS_HCTX = al256(WS_MOD + (size_t)2 * NMODV * 6144 * 4);
constexpr size_t WS_Y = al256(WS_HCTX + (size_t)NCTX * DM * 4);
constexpr size_t WS_P = al256(WS_Y + (size_t)NTOK * DM * 2);
constexpr size_t WS_RW = al256(WS_P + (size_t)NTOK * INC * 2);
constexpr size_t WS_GP = al256(WS_RW + (size_t)NTOK * (RWS > 4 * RWREC ? RWS : 4 * RWREC) * 4);
constexpr size_t WS_YS = al256(WS_GP + (size_t)NTOK * (GPS > 4 * GDREC ? GPS : 4 * GDREC) * 4);
constexpr size_t WS_TB = al256(WS_YS + (size_t)NTOK * 1024 * 2);
constexpr size_t WS_G16 = al256(WS_TB + (size_t)2 * 16384 * 1024 * 2);
constexpr size_t WS_VT = al256(WS_G16 + (size_t)NTOK * 256 * 2);
constexpr size_t WS_BAR = al256(WS_VT + (size_t)2 * NB * 4 * 64 * (NTL + NCX) * 2);
constexpr size_t WS_BAR_BYTES = 3456 * 4;
constexpr size_t WS_END = al256(WS_BAR + WS_BAR_BYTES);
struct Params {
  const float *x, *c, *ctx, *c_ctx, *w_ada, *b_ada, *w_in, *w_out, *ln_mix_g, *ln_mix_b, *ln_ffn_g, *ln_ffn_b;
  const float *diff_lam, *diff_norm_g, *rwkv_mu, *rwkv_w0, *rwkv_w2, *rwkv_a0, *rwkv_a2, *rwkv_g2;
  const float *rwkv_kk, *rwkv_ka, *rwkv_rk, *rwkv_ln_g, *rwkv_ln_b, *gdn_conv, *gdn_a_log, *gdn_dt_bias;
  const float *gdn_norm_g, *nat_rpb, *peer_wq, *peer_keys, *peer_u, *peer_v;
  float *out;
  char *ws;
  MEMFN float* mod() const { return (float*)(ws + WS_MOD); }
  MEMFN float* hctx() const { return (float*)(ws + WS_HCTX); }
  MEMFN float* RW() const { return (float*)(ws + WS_RW); }
  MEMFN float* GP() const { return (float*)(ws + WS_GP); }
  MEMFN bf16_t* Y() const { return (bf16_t*)(ws + WS_Y); }
  MEMFN bf16_t* P() const { return (bf16_t*)(ws + WS_P); }
  MEMFN bf16_t* YS() const { return (bf16_t*)(ws + WS_YS); }
  MEMFN bf16_t* TB() const { return (bf16_t*)(ws + WS_TB); }
  MEMFN bf16_t* WBT() const { return (bf16_t*)(ws + WS_TB + (size_t)2 * 16384 * 1024); }
  MEMFN bf16_t* G16() const { return (bf16_t*)(ws + WS_G16); }
  MEMFN bf16_t* VT() const { return (bf16_t*)(ws + WS_VT); }
  MEMFN unsigned* bar() const { return (unsigned*)(ws + WS_BAR); }
};

DEVFN float bf2f(bf16_t v) {
  unsigned u = (unsigned)v << 16; float f;
#ifdef CPU_EMU
  memcpy(&f, &u, 4);
#else
  f = __uint_as_float(u);
#endif
  return f;
}
DEVFN bf16_t f2bf(float f) {
#if !defined(CPU_EMU) && defined(__HIP_DEVICE_COMPILE__)
  typedef __attribute__((ext_vector_type(2))) float f2bf_f2; typedef __attribute__((ext_vector_type(2))) __bf16 f2bf_b2;
  const f2bf_f2 v = {f, 0.f};
  return (bf16_t)(__builtin_bit_cast(unsigned, __builtin_convertvector(v, f2bf_b2)) & 0xffffu);
#else
  unsigned u;
#ifdef CPU_EMU
  memcpy(&u, &f, 4);
#else
  u = __float_as_uint(f);
#endif
  u += 0x7fffu + ((u >> 16) & 1u);
  return (bf16_t)(u >> 16);
#endif
}
DEVFN float4 ld4(const bf16_t* p) {
  const unsigned* q = (const unsigned*)p;
  unsigned a = q[0], b = q[1];
  unsigned x0 = a << 16, x1 = a & 0xffff0000u, x2 = b << 16, x3 = b & 0xffff0000u;
  float4 r;
#ifdef CPU_EMU
  memcpy(&r.x, &x0, 4); memcpy(&r.y, &x1, 4); memcpy(&r.z, &x2, 4); memcpy(&r.w, &x3, 4);
#else
  r.x = __uint_as_float(x0); r.y = __uint_as_float(x1); r.z = __uint_as_float(x2); r.w = __uint_as_float(x3);
#endif
  return r;
}

#ifdef CPU_EMU
#define FEXP expf
#define FLOG logf
#define FSIN sinf
#define FCOS cosf
#define FRCP(x) (1.0f / (x))
#define FRSQ(x) (1.0f / sqrtf(x))
#else
#define FEXP __expf
#define FLOG __logf
#define FSIN __sinf
#define FCOS __cosf
#define FRCP(x) __builtin_amdgcn_rcpf(x)
#define FRSQ(x) __builtin_amdgcn_rsqf(x)
#endif
DEVFN float sigmoidf_(float x) { return FRCP(1.0f + FEXP(-x)); }
DEVFN float siluf_(float x) { return x * FRCP(1.0f + FEXP(-x)); }
DEVFN float softplusf_(float x) { return fmaxf(x, 0.f) + FLOG(1.0f + FEXP(-fabsf(x))); }
DEVFN float tanhf_(float x) { float e = FEXP(2.0f * x); return 1.0f - 2.0f * FRCP(e + 1.0f); }
DEVFN float geluf_(float x) { return 0.5f * x * (1.0f + erff(x * 0.70710678118654752f)); }

DEVFN int modv_of_row(int row) { return row < NLAT ? row / NTL : NB; }
DEVFN const float* hsrc_row(const Params& p, int l, int row) {
  if (row < NLAT) return (l == 0 ? p.x : p.out) + (size_t)row * DM;
  return (l == 0 ? p.ctx : p.hctx()) + (size_t)(row - NLAT) * DM;
}
DEVFN float* hdst_row(const Params& p, int row) {
  if (row < NLAT) return p.out + (size_t)row * DM;
  return p.hctx() + (size_t)(row - NLAT) * DM;
}
DEVFN void seq_pos(int row, int& t, int& len) {
  if (row < NLAT) { t = row % NTL; len = NTL; } else { t = (row - NLAT) % NCX; len = NCX; }
}

DEVFN void ph_ada(const Params& p, long item) {
  int l = (int)(item / 6144), j = (int)(item % 6144);
  float acc[NMODV];
#pragma unroll
  for (int v = 0; v < NMODV; ++v) acc[v] = 0.f;
  for (int i = 0; i < DM; ++i) {
    float w = p.w_ada[((size_t)l * DM + i) * 6144 + j];
#pragma unroll
    for (int v = 0; v < NB; ++v) acc[v] += siluf_(p.c[v * DM + i]) * w;
    acc[NB] += siluf_(p.c_ctx[i]) * w;
  }
  float bb = p.b_ada[l * 6144 + j];
#pragma unroll
  for (int v = 0; v < NMODV; ++v) p.mod()[((size_t)l * NMODV + v) * 6144 + j] = acc[v] + bb;
}

DEVFN void row_stats(const float* r, float& mu, float& rstd) {
  float s = 0.f;
  for (int i = 0; i < DM; ++i) s += r[i];
  mu = s * (1.0f / DM);
  float v = 0.f;
  for (int i = 0; i < DM; ++i) { float d = r[i] - mu; v += d * d; }
  rstd = 1.0f / sqrtf(v * (1.0f / DM) + LN_EPS);
}

DEVFN void ph_ln1(const Params& p, int l, long item) {
  int row = (int)item;
  const float* src = hsrc_row(p, l, row);
  const float* m = p.mod() + ((size_t)l * NMODV + modv_of_row(row)) * 6144;
  float mu, rstd;
  row_stats(src, mu, rstd);
  bf16_t* dst = p.Y() + (size_t)row * DM;
  for (int i = 0; i < DM; ++i) dst[i] = f2bf((src[i] - mu) * rstd * (1.0f + m[1024 + i]) + m[i]);
}

DEVFN void gemm_item(const bf16_t* A, int lda, const float* Bw, int ldb, bf16_t* C, int ldc, int N, int K, long item) {
  int ntn = N / 4;
  int mt = (int)(item / ntn), nt = (int)(item % ntn);
  int r0 = mt * 4, c0 = nt * 4;
  float acc[4][4];
#pragma unroll
  for (int i = 0; i < 4; ++i)
#pragma unroll
    for (int j = 0; j < 4; ++j) acc[i][j] = 0.f;
  for (int k = 0; k < K; k += 4) {
    float4 a[4], b[4];
#pragma unroll
    for (int i = 0; i < 4; ++i) a[i] = ld4(A + (size_t)(r0 + i) * lda + k);
#pragma unroll
    for (int kk = 0; kk < 4; ++kk) b[kk] = *(const float4*)(Bw + (size_t)(k + kk) * ldb + c0);
#pragma unroll
    for (int i = 0; i < 4; ++i) {
      float av[4] = {a[i].x, a[i].y, a[i].z, a[i].w};
#pragma unroll
      for (int kk = 0; kk < 4; ++kk) {
        acc[i][0] += av[kk] * b[kk].x;
        acc[i][1] += av[kk] * b[kk].y;
        acc[i][2] += av[kk] * b[kk].z;
        acc[i][3] += av[kk] * b[kk].w;
      }
    }
  }
#pragma unroll
  for (int i = 0; i < 4; ++i)
#pragma unroll
    for (int j = 0; j < 4; ++j) C[(size_t)(r0 + i) * ldc + c0 + j] = f2bf(acc[i][j]);
}

DEVFN void ph_rope(const Params& p, long item) {
  int token = (int)(item / 256), j = (int)(item % 256);
  int which = j / 128, jj = j % 128, h = jj / 32, pr = jj % 32, blk = pr / 8, i = pr % 8;
  int t = token % NTL;
  int pos = (blk & 1) ? (t % 64) : (t / 64);
  float inv = expf(-(float)i * (9.210340371976184f / 8.0f));
  float ang = (float)pos * inv;
  float cs = FCOS(ang), sn = FSIN(ang);
  bf16_t* base = p.P() + (size_t)token * INC + OFF_A + which * 256 + h * 64 + blk * 16;
  float x1 = bf2f(base[i]), x2 = bf2f(base[i + 8]);
  base[i] = f2bf(x1 * cs - x2 * sn);
  base[i + 8] = f2bf(x1 * sn + x2 * cs);
}

DEVFN float dot32(const bf16_t* q, const bf16_t* k) {
  float s = 0.f;
#pragma unroll
  for (int d = 0; d < 32; d += 4) {
    float4 kv = ld4(k + d);
    float4 qv = ld4(q + d);
    s += qv.x * kv.x + qv.y * kv.y + qv.z * kv.z + qv.w * kv.w;
    if ((d & 15) == 12) LOAD_FENCE();
  }
  return s;
}

DEVFN void mixA_item(const Params& p, int l, int b, int h, int qrow, bool lat) {
  const float* lv = p.diff_lam + l * 128;
  float d01 = 0.f, d23 = 0.f;
#pragma unroll 4
  for (int i = 0; i < 32; ++i) { d01 += lv[i] * lv[32 + i]; d23 += lv[64 + i] * lv[96 + i]; }
  float lam_init = 0.8f - 0.6f * expf(-0.3f * (float)l);
  float lam = expf(d01) - expf(d23) + lam_init;
  const float scale = 0.17677669529663687f;
  const bf16_t* q = p.P() + (size_t)qrow * INC + OFF_A + h * 64;
  int nlat = lat ? NTL : 0;
  int nk = nlat + NCX;
  float m1 = -1e30f, l1 = 0.f, m2 = -1e30f, l2 = 0.f;
  for (int j = 0; j < nk; ++j) {
    int krow = j < nlat ? b * NTL + j : NLAT + b * NCX + (j - nlat);
    const bf16_t* kp = p.P() + (size_t)krow * INC + OFF_A + 256 + h * 64;
    float s1 = dot32(q, kp) * scale, s2 = dot32(q + 32, kp + 32) * scale;
    float n1 = fmaxf(m1, s1); l1 = l1 * expf(m1 - n1) + expf(s1 - n1); m1 = n1;
    float n2 = fmaxf(m2, s2); l2 = l2 * expf(m2 - n2) + expf(s2 - n2); m2 = n2;
  }
  float i1 = 1.0f / l1, i2 = lam / l2;
  bf16_t* yp = p.Y() + (size_t)qrow * DM + 0 + h * 64;
  float ss = 0.f;
  for (int dh = 0; dh < 2; ++dh) {
    float o[32];
#pragma unroll
    for (int d = 0; d < 32; ++d) o[d] = 0.f;
    for (int j = 0; j < nk; ++j) {
      int krow = j < nlat ? b * NTL + j : NLAT + b * NCX + (j - nlat);
      const bf16_t* kp = p.P() + (size_t)krow * INC + OFF_A + 256 + h * 64;
      float s1 = dot32(q, kp) * scale, s2 = dot32(q + 32, kp + 32) * scale;
      float pw = expf(s1 - m1) * i1 - expf(s2 - m2) * i2;
      const bf16_t* vp = kp + 256 + dh * 32;
#pragma unroll
      for (int d = 0; d < 32; d += 4) {
        float4 vv = ld4(vp + d);
        o[d] += pw * vv.x; o[d + 1] += pw * vv.y; o[d + 2] += pw * vv.z; o[d + 3] += pw * vv.w;
      }
    }
#pragma unroll
    for (int d = 0; d < 32; ++d) { ss += o[d] * o[d]; yp[dh * 32 + d] = f2bf(o[d]); }
  }
  float rs = (1.0f / sqrtf(ss * (1.0f / 64) + 1e-6f)) * (1.0f - lam_init);
  const float* g = p.diff_norm_g + l * 64;
#pragma unroll 4
  for (int d = 0; d < 64; ++d) yp[d] = f2bf(bf2f(yp[d]) * rs * g[d]);
}

DEVFN float dot64s(const bf16_t* q, const bf16_t* k) {
  float s = 0.f;
#pragma unroll
  for (int d = 0; d < 64; d += 4) {
    float4 kv = ld4(k + d);
    float4 qv = ld4(q + d);
    s += qv.x * kv.x + qv.y * kv.y + qv.z * kv.z + qv.w * kv.w;
    if ((d & 15) == 12) LOAD_FENCE();
  }
  return s;
}

DEVFN void mixD_item(const Params& p, int l, int b, int h, int qrow, bool lat, int t) {
  const bf16_t* q = p.P() + (size_t)qrow * INC + OFF_D + h * 64;
  int r = t / 64, cq = t % 64;
  int rs = r - 4; rs = rs < 0 ? 0 : (rs > GROWS - 8 ? GROWS - 8 : rs);
  int cs = cq - 8; cs = cs < 0 ? 0 : (cs > 48 ? 48 : cs);
  const float* rpb = p.nat_rpb + ((size_t)l * 4 + h) * 15 * 31;
  int nwin = lat ? 128 : 0;
  int nk = nwin + NCX;
  float m = -1e30f, ls = 0.f;
  bf16_t* yp = p.Y() + (size_t)qrow * DM + 768 + h * 64;
  for (int pass = 0; pass < 3; ++pass) {
    float inv = pass ? 1.0f / ls : 0.f;
    float o[32];
#pragma unroll
    for (int d = 0; d < 32; ++d) o[d] = 0.f;
    for (int j = 0; j < nk; ++j) {
      int krow; float bias = 0.f;
      if (j < nwin) {
        int i = j / 16, jj = j % 16;
        krow = b * NTL + (rs + i) * 64 + cs + jj;
        int dr = rs + i - r + 7;
        int dc = cs + jj - cq; dc = dc < -15 ? -15 : (dc > 15 ? 15 : dc); dc += 15;
        bias = rpb[dr * 31 + dc];
      } else {
        krow = NLAT + b * NCX + (j - nwin);
      }
      const bf16_t* kp = p.P() + (size_t)krow * INC + OFF_D + 256 + h * 64;
      float s = dot64s(q, kp) * 0.125f + bias;
      if (!pass) {
        float n = fmaxf(m, s); ls = ls * expf(m - n) + expf(s - n); m = n;
      } else {
        float pw = expf(s - m) * inv;
        const bf16_t* vp = kp + 256 + (pass - 1) * 32;
#pragma unroll
        for (int d = 0; d < 32; d += 4) {
          float4 vv = ld4(vp + d);
          o[d] += pw * vv.x; o[d + 1] += pw * vv.y; o[d + 2] += pw * vv.z; o[d + 3] += pw * vv.w;
        }
      }
    }
    if (pass) {
#pragma unroll
      for (int d = 0; d < 32; ++d) yp[(pass - 1) * 32 + d] = f2bf(o[d]);
    }
  }
}

DEVFN float rw_conv(const Params& p, int l, int row, int col, bool hp, bool hn) {
  const float* mu = p.rwkv_mu + (size_t)l * 2 * 1152;
  float m0 = mu[col], m1 = mu[1152 + col];
  const bf16_t* c = p.P() + (size_t)row * INC + OFF_B + col;
  float v = bf2f(c[0]) * (1.0f - m0 - m1);
  if (hp) v += bf2f(c[-INC]) * m0;
  if (hn) v += bf2f(c[INC]) * m1;
  return v;
}
DEVFN void rwprep_item(const Params& p, int l, long item) {
  int row = (int)(item / 256), c = (int)(item % 256);
  int h = c / 64;
  int t, len; seq_pos(row, t, len);
  bool hp = t > 0, hn = t < len - 1;
  float r = rw_conv(p, l, row, c, hp, hn);
  float k = rw_conv(p, l, row, 256 + c, hp, hn);
  float v = rw_conv(p, l, row, 512 + c, hp, hn);
  float wr[2], ar[2];
#pragma unroll
  for (int d = 0; d < 2; ++d) {
    float aw = p.rwkv_w0[(l * 2 + d) * 256 + c];
    float aa = p.rwkv_a0[(l * 2 + d) * 256 + c];
#pragma unroll 2
    for (int rr = 0; rr < 64; ++rr) {
      aw += tanhf_(rw_conv(p, l, row, 768 + d * 64 + rr, hp, hn)) * p.rwkv_w2[((size_t)(l * 2 + d) * 64 + rr) * 256 + c];
      aa += rw_conv(p, l, row, 896 + d * 64 + rr, hp, hn) * p.rwkv_a2[((size_t)(l * 2 + d) * 64 + rr) * 256 + c];
    }
    wr[d] = FEXP(-sigmoidf_(aw) * 0.6065306597126334f);
    ar[d] = sigmoidf_(aa);
  }
  float g = 0.f;
#pragma unroll 2
  for (int rr = 0; rr < 128; ++rr)
    g += sigmoidf_(rw_conv(p, l, row, 1024 + rr, hp, hn)) * p.rwkv_g2[((size_t)l * 128 + rr) * 256 + c];
  float n2 = 0.f;
#pragma unroll 2
  for (int cc = h * 64; cc < h * 64 + 64; ++cc) {
    float kc = rw_conv(p, l, row, 256 + cc, hp, hn) * p.rwkv_kk[l * 256 + cc];
    n2 += kc * kc;
  }
  float kk = k * p.rwkv_kk[l * 256 + c] * (1.0f / sqrtf(n2 + 1e-6f));
  float ka = p.rwkv_ka[l * 256 + c];
  float* o = p.RW() + (size_t)row * RWS;
  o[c] = r; o[256 + c] = v; o[512 + c] = g; o[768 + c] = kk;
  o[1024 + c] = wr[0]; o[1280 + c] = wr[1];
  o[1536 + c] = kk * ar[0]; o[1792 + c] = kk * ar[1];
  o[2048 + c] = k * (1.0f + (ar[0] - 1.0f) * ka);
  o[2304 + c] = k * (1.0f + (ar[1] - 1.0f) * ka);
}

DEVFN float gd_conv(const Params& p, int l, int row, int col, bool hp, bool hn) {
  const float* cw = p.gdn_conv + (size_t)l * 3 * 768;
  const bf16_t* c = p.P() + (size_t)row * INC + OFF_C + col;
  float v = bf2f(c[0]) * cw[768 + col];
  if (hp) v += bf2f(c[-INC]) * cw[col];
  if (hn) v += bf2f(c[INC]) * cw[1536 + col];
  return siluf_(v);
}
DEVFN void gdprep_item(const Params& p, int l, long item) {
  int row = (int)(item / 256), c = (int)(item % 256);
  int h = c / 64;
  int t, len; seq_pos(row, t, len);
  bool hp = t > 0, hn = t < len - 1;
  float q = gd_conv(p, l, row, c, hp, hn);
  float k = gd_conv(p, l, row, 256 + c, hp, hn);
  float v = gd_conv(p, l, row, 512 + c, hp, hn);
  float nq = 0.f, nk = 0.f;
#pragma unroll 2
  for (int cc = h * 64; cc < h * 64 + 64; ++cc) {
    float a = gd_conv(p, l, row, cc, hp, hn); nq += a * a;
    float bq = gd_conv(p, l, row, 256 + cc, hp, hn); nk += bq * bq;
  }
  float* o = p.GP() + (size_t)row * GPS;
  o[c] = q * (1.0f / sqrtf(nq + 1e-6f)) * 0.125f;
  o[256 + c] = k * (1.0f / sqrtf(nk + 1e-6f));
  o[512 + c] = v;
  if (c < 8) {
    int d = c / 4, hh = c % 4;
    const bf16_t* ab = p.P() + (size_t)row * INC + OFF_C + 1024;
    float la = -FEXP(p.gdn_a_log[(l * 2 + d) * 4 + hh]) * softplusf_(bf2f(ab[d * 4 + hh]) + p.gdn_dt_bias[(l * 2 + d) * 4 + hh]);
    o[768 + c] = la;
    o[776 + c] = sigmoidf_(bf2f(ab[8 + d * 4 + hh]));
  }
}

DEVFN int scan_row(int b, int d, int step) {
  if (step < NCX) return NLAT + b * NCX + (d ? NCX - 1 - step : step);
  int s2 = step - NCX;
  return b * NTL + (d ? NTL - 1 - s2 : s2);
}
DEVFN void rwscan_item(const Params& p, bool last, long item) {
  int v = (int)(item % 64), h = (int)((item / 64) % 4), b = (int)((item / 256) % NB), d = (int)(item / (256 * NB));
  float s[64];
#pragma unroll
  for (int k = 0; k < 64; ++k) s[k] = 0.f;
  for (int step = 0; step < NCX + NTL; ++step) {
    int row = scan_row(b, d, step);
    const float* base = p.RW() + (size_t)row * RWS + h * 64;
    const float* kkp = base + 768;
    const float* wp = base + 1024 + d * 256;
    const float* kap = base + 1536 + d * 256;
    const float* kdp = base + 2048 + d * 256;
    float vv = base[256 + v];
    float sa = 0.f;
#pragma unroll
    for (int k = 0; k < 64; ++k) sa += s[k] * kkp[k];
    float y = 0.f;
#pragma unroll
    for (int k = 0; k < 64; ++k) {
      s[k] = s[k] * wp[k] - sa * kap[k] + vv * kdp[k];
      y += s[k] * base[k];
    }
    if (!(last && row >= NLAT)) p.YS()[(size_t)row * 1024 + d * 256 + h * 64 + v] = f2bf(y);
  }
}
DEVFN void gdscan_item(const Params& p, bool last, long item) {
  int dv = (int)(item % 64), h = (int)((item / 64) % 4), b = (int)((item / 256) % NB), d = (int)(item / (256 * NB));
  float s[64];
#pragma unroll
  for (int k = 0; k < 64; ++k) s[k] = 0.f;
  for (int step = 0; step < NCX + NTL; ++step) {
    int row = scan_row(b, d, step);
    const float* base = p.GP() + (size_t)row * GPS;
    const float* qp = base + h * 64;
    const float* kp = base + 256 + h * 64;
    float vv = base[512 + h * 64 + dv];
    float eg = FEXP(base[768 + d * 4 + h]);
    float beta = base[776 + d * 4 + h];
    float ks = 0.f;
#pragma unroll
    for (int k = 0; k < 64; ++k) { s[k] *= eg; ks += kp[k] * s[k]; }
    float vn = beta * (vv - ks);
    float o = 0.f;
#pragma unroll
    for (int k = 0; k < 64; ++k) { s[k] += kp[k] * vn; o += qp[k] * s[k]; }
    if (!(last && row >= NLAT)) p.YS()[(size_t)row * 1024 + 512 + d * 256 + h * 64 + dv] = f2bf(o);
  }
}

DEVFN void rwpost_item(const Params& p, int l, int row, int h) {
  const bf16_t* y0 = p.YS() + (size_t)row * 1024 + h * 64;
  const float* rw = p.RW() + (size_t)row * RWS + h * 64;
  float y[64];
  float m = 0.f;
#pragma unroll
  for (int k = 0; k < 64; ++k) { y[k] = bf2f(y0[k]) + bf2f(y0[256 + k]); m += y[k]; if ((k & 7) == 7) LOAD_FENCE(); }
  m *= (1.0f / 64);
  float var = 0.f;
#pragma unroll
  for (int k = 0; k < 64; ++k) { float dd = y[k] - m; var += dd * dd; }
  float rstd = 1.0f / sqrtf(var * (1.0f / 64) + 64e-5f);
  float bonus = 0.f;
  const float* rk = p.rwkv_rk + (l * 4 + h) * 64;
#pragma unroll
  for (int k = 0; k < 64; ++k) { bonus += rw[k] * (rw[2048 + k] + rw[2304 + k]) * rk[k]; if ((k & 7) == 7) LOAD_FENCE(); }
  bf16_t* yp = p.Y() + (size_t)row * DM + 256 + h * 64;
  const float* lg = p.rwkv_ln_g + l * 256 + h * 64;
  const float* lb = p.rwkv_ln_b + l * 256 + h * 64;
#pragma unroll
  for (int k = 0; k < 64; ++k) { yp[k] = f2bf(((y[k] - m) * rstd * lg[k] + lb[k] + bonus * rw[256 + k]) * rw[512 + k]); if ((k & 7) == 7) LOAD_FENCE(); }
}
DEVFN void gdpost_item(const Params& p, int l, int row, int h) {
  const bf16_t* o0 = p.YS() + (size_t)row * 1024 + 512 + h * 64;
  const bf16_t* gate = p.P() + (size_t)row * INC + OFF_C + 768 + h * 64;
  float o[64];
  float ss = 0.f;
#pragma unroll
  for (int k = 0; k < 64; ++k) { o[k] = bf2f(o0[k]) + bf2f(o0[256 + k]); ss += o[k] * o[k]; if ((k & 7) == 7) LOAD_FENCE(); }
  float rs = 1.0f / sqrtf(ss * (1.0f / 64) + 1e-6f);
  const float* g = p.gdn_norm_g + l * 64;
  bf16_t* yp = p.Y() + (size_t)row * DM + 512 + h * 64;
#pragma unroll
  for (int k = 0; k < 64; ++k) { yp[k] = f2bf(o[k] * rs * g[k] * siluf_(bf2f(gate[k]))); if ((k & 7) == 7) LOAD_FENCE(); }
}

DEVFN void ph_pn1(const Params& p, int l, long item) {
  int row = (int)item;
  const float* hs = hsrc_row(p, l, row);
  float* hd = hdst_row(p, row);
  const float* m = p.mod() + ((size_t)l * NMODV + modv_of_row(row)) * 6144;
  const bf16_t* mix = (const bf16_t*)p.RW() + (size_t)row * DM;
  float s = 0.f;
  for (int i = 0; i < DM; ++i) s += DN_ALPHA * hs[i] + m[2048 + i] * bf2f(mix[i]);
  float mu = s * (1.0f / DM);
  float v = 0.f;
  for (int i = 0; i < DM; ++i) { float z = DN_ALPHA * hs[i] + m[2048 + i] * bf2f(mix[i]) - mu; v += z * z; }
  float rstd = 1.0f / sqrtf(v * (1.0f / DM) + LN_EPS);
  const float* g = p.ln_mix_g + l * DM;
  const float* bb = p.ln_mix_b + l * DM;
  float s2 = 0.f;
  for (int i = 0; i < DM; ++i) {
    float z = DN_ALPHA * hs[i] + m[2048 + i] * bf2f(mix[i]);
    float hn = (z - mu) * rstd * g[i] + bb[i];
    hd[i] = hn;
    s2 += hn;
  }
  float mu2 = s2 * (1.0f / DM);
  float v2 = 0.f;
  for (int i = 0; i < DM; ++i) { float dd = hd[i] - mu2; v2 += dd * dd; }
  float rstd2 = 1.0f / sqrtf(v2 * (1.0f / DM) + LN_EPS);
  bf16_t* x2 = p.Y() + (size_t)row * DM;
  for (int i = 0; i < DM; ++i) x2[i] = f2bf((hd[i] - mu2) * rstd2 * (1.0f + m[4096 + i]) + m[3072 + i]);
}
DEVFN void ph_pn2(const Params& p, int l, long item) {
  int row = (int)item;
  float* hd = hdst_row(p, row);
  const float* m = p.mod() + ((size_t)l * NMODV + modv_of_row(row)) * 6144;
  const float* ffn = p.RW() + (size_t)row * DM;
  float s = 0.f;
  for (int i = 0; i < DM; ++i) s += DN_ALPHA * hd[i] + m[5120 + i] * ffn[i];
  float mu = s * (1.0f / DM);
  float v = 0.f;
  for (int i = 0; i < DM; ++i) { float z = DN_ALPHA * hd[i] + m[5120 + i] * ffn[i] - mu; v += z * z; }
  float rstd = 1.0f / sqrtf(v * (1.0f / DM) + LN_EPS);
  const float* g = p.ln_ffn_g + l * DM;
  const float* bb = p.ln_ffn_b + l * DM;
  for (int i = 0; i < DM; ++i) {
    float z = DN_ALPHA * hd[i] + m[5120 + i] * ffn[i];
    hd[i] = (z - mu) * rstd * g[i] + bb[i];
  }
}

DEVFN bf16_t* peerQ(const Params& p) { return p.P(); }
DEVFN float* selbase(const Params& p) { return p.RW() + (size_t)NTOK * 1024; }
DEVFN float* sel1s(const Params& p) { return selbase(p); }
DEVFN int* sel1i(const Params& p) { return (int*)(selbase(p) + (size_t)NTOK * 256); }
DEVFN int* sel2i(const Params& p) { return (int*)(selbase(p) + (size_t)NTOK * 512); }
DEVFN float* sel2g(const Params& p) { return selbase(p) + (size_t)NTOK * 640; }
DEVFN float* coefb(const Params& p) { return selbase(p) + (size_t)NTOK * 768; }

#define TOPK_INSERT(ts, ti, xs, xi)                                      \
  {                                                                      \
    float cs_ = (xs); int ci_ = (xi);                                    \
    _Pragma("unroll") for (int z_ = 0; z_ < 16; ++z_) {                  \
      bool gt_ = cs_ > ts[z_];                                           \
      float os_ = ts[z_]; int oi_ = ti[z_];                              \
      ts[z_] = gt_ ? cs_ : os_; ti[z_] = gt_ ? ci_ : oi_;                \
      cs_ = gt_ ? os_ : cs_; ci_ = gt_ ? oi_ : ci_;                      \
    }                                                                    \
  }

DEVFN void ph_topk1(const Params& p, int l, int nrows, long item) {
  int hp = (int)(item / nrows), row = (int)(item % nrows);
  const bf16_t* q = peerQ(p) + (size_t)row * 2048 + hp * 128;
  const float* keys = p.peer_keys + ((size_t)l * 16 + hp) * 128 * 128;
  float ts[16]; int ti[16];
#pragma unroll
  for (int z = 0; z < 16; ++z) { ts[z] = -3e38f; ti[z] = 0; }
  for (int n = 0; n < 128; ++n) {
    const float* kr = keys + n * 128;
    float s = 0.f;
#pragma unroll 8
    for (int d = 0; d < 128; d += 4) {
      float4 qa = ld4(q + d), kb = *(const float4*)(kr + d);
      s += qa.x * kb.x; s += qa.y * kb.y; s += qa.z * kb.z; s += qa.w * kb.w;
    }
    TOPK_INSERT(ts, ti, s, n);
  }
  float* os = sel1s(p) + ((size_t)row * 16 + hp) * 16;
  int* oi = sel1i(p) + ((size_t)row * 16 + hp) * 16;
#pragma unroll
  for (int z = 0; z < 16; ++z) { os[z] = ts[z]; oi[z] = ti[z]; }
}
DEVFN void ph_topk2(const Params& p, int nrows, long item) {
  int h = (int)(item / nrows), row = (int)(item % nrows);
  const float* s0 = sel1s(p) + ((size_t)row * 16 + h * 2) * 16;
  const int* i0 = sel1i(p) + ((size_t)row * 16 + h * 2) * 16;
  float s1[16]; int i1[16];
#pragma unroll
  for (int z = 0; z < 16; ++z) { s1[z] = s0[16 + z]; i1[z] = i0[16 + z]; }
  float ts[16]; int ti[16];
#pragma unroll
  for (int z = 0; z < 16; ++z) { ts[z] = -3e38f; ti[z] = 0; }
  for (int i = 0; i < 16; ++i) {
    float a = s0[i]; int ai = i0[i] * 128;
#pragma unroll
    for (int j = 0; j < 16; ++j) TOPK_INSERT(ts, ti, a + s1[j], ai + i1[j]);
  }
  float sum = 0.f;
  float mx = ts[0];
#pragma unroll
  for (int z = 0; z < 16; ++z) { ts[z] = expf(ts[z] - mx); }
#pragma unroll
  for (int z = 0; z < 16; ++z) sum += ts[z];
  float inv = 1.0f / sum;
  int* oi = sel2i(p) + ((size_t)row * 8 + h) * 16;
  float* og = sel2g(p) + ((size_t)row * 8 + h) * 16;
#pragma unroll
  for (int z = 0; z < 16; ++z) { oi[z] = ti[z]; og[z] = ts[z] * inv; }
}
DEVFN void ph_act(const Params& p, int l, long item) {
  int row = (int)(item / 128);
  int idx = sel2i(p)[item];
  const bf16_t* x2 = p.Y() + (size_t)row * DM;
  const float* u = p.peer_u + ((size_t)l * 16384 + idx) * DM;
  float s = 0.f;
  for (int i = 0; i < DM; i += 4) {
    float4 a = ld4(x2 + i), b = *(const float4*)(u + i);
    s += a.x * b.x + a.y * b.y + a.z * b.z + a.w * b.w;
  }
  coefb(p)[item] = sel2g(p)[item] * geluf_(s);
}
DEVFN void ph_ffn(const Params& p, int l, long item) {
  int row = (int)(item / 256), c4 = (int)(item % 256);
  const int* idx = sel2i(p) + (size_t)row * 128;
  const float* cf = coefb(p) + (size_t)row * 128;
  float4 acc = make_float4(0.f, 0.f, 0.f, 0.f);
  for (int j = 0; j < 128; ++j) {
    float4 vv = *(const float4*)(p.peer_v + ((size_t)l * 16384 + idx[j]) * DM + c4 * 4);
    float c = cf[j];
    acc.x += c * vv.x; acc.y += c * vv.y; acc.z += c * vv.z; acc.w += c * vv.w;
  }
  *(float4*)(p.RW() + (size_t)row * DM + c4 * 4) = acc;
}

enum { PH_ADA = 0, PH_LN1, PH_GEMM_IN, PH_ROPE, PH_MIX, PH_GDPREP, PH_SCAN, PH_POST, PH_GEMM_OUT, PH_PN1, PH_GEMM_Q,
       PH_TOPK1, PH_TOPK2, PH_ACT, PH_FFN, PH_PN2, PH_COUNT };

HDFN int rows_out(int l) { return l == 1 ? NLAT : NTOK; }

HDFN long phase_items(int ph, int l) {
  bool last = l == 1;
  long nr = rows_out(l);
  switch (ph) {
    case PH_ADA: return l == 0 ? 2 * 6144 : 0;
    case PH_LN1: return NTOK;
    case PH_GEMM_IN: return (long)(NTOK / 4) * (INC / 4);
    case PH_ROPE: return (long)NLAT * 256;
    case PH_MIX: return 2L * NB * 4 * NTL + (last ? 0 : 2L * NB * 4 * NCX) + (long)NTOK * 256;
    case PH_GDPREP: return (long)NTOK * 256;
    case PH_SCAN: return 2L * 2 * NB * 4 * 64;
    case PH_POST: return nr * 4 * 2;
    case PH_GEMM_OUT: return (nr / 4) * (DM / 4);
    case PH_PN1: return nr;
    case PH_GEMM_Q: return (nr / 4) * (2048 / 4);
    case PH_TOPK1: return nr * 16;
    case PH_TOPK2: return nr * 8;
    case PH_ACT: return nr * 128;
    case PH_FFN: return nr * 256;
    case PH_PN2: return nr;
  }
  return 0;
}

template <int PH>
DEVFN void phase_item(const Params& p, int l, long item) {
  bool last = l == 1;
  int nr = rows_out(l);
  if (PH == PH_ADA) ph_ada(p, item);
  else if (PH == PH_LN1) ph_ln1(p, l, item);
  else if (PH == PH_GEMM_IN) gemm_item(p.Y(), DM, p.w_in + (size_t)l * DM * INC, INC, p.P(), INC, INC, DM, item);
  else if (PH == PH_ROPE) ph_rope(p, item);
  else if (PH == PH_MIX) {
    long nAl = (long)NB * 4 * NTL, nAc = last ? 0 : (long)NB * 4 * NCX;
    if (item < nAl) {
      int bh = (int)(item / NTL), t = (int)(item % NTL);
      mixA_item(p, l, bh / 4, bh % 4, (bh / 4) * NTL + t, true);
    } else if (item < nAl + nAc) {
      long it = item - nAl; int bh = (int)(it / NCX), t = (int)(it % NCX);
      mixA_item(p, l, bh / 4, bh % 4, NLAT + (bh / 4) * NCX + t, false);
    } else if (item < 2 * nAl + nAc) {
      long it = item - nAl - nAc; int bh = (int)(it / NTL), t = (int)(it % NTL);
      mixD_item(p, l, bh / 4, bh % 4, (bh / 4) * NTL + t, true, t);
    } else if (item < 2 * nAl + 2 * nAc) {
      long it = item - 2 * nAl - nAc; int bh = (int)(it / NCX), t = (int)(it % NCX);
      mixD_item(p, l, bh / 4, bh % 4, NLAT + (bh / 4) * NCX + t, false, 0);
    } else {
      rwprep_item(p, l, item - 2 * nAl - 2 * nAc);
    }
  } else if (PH == PH_GDPREP) gdprep_item(p, l, item);
  else if (PH == PH_SCAN) {
    long n1 = 2L * NB * 4 * 64;
    if (item < n1) rwscan_item(p, last, item); else gdscan_item(p, last, item - n1);
  } else if (PH == PH_POST) {
    long n1 = (long)nr * 4;
    if (item < n1) rwpost_item(p, l, (int)(item / 4), (int)(item % 4));
    else { long it = item - n1; gdpost_item(p, l, (int)(it / 4), (int)(it % 4)); }
  } else if (PH == PH_GEMM_OUT) gemm_item(p.Y(), DM, p.w_out + (size_t)l * DM * DM, DM, (bf16_t*)p.RW(), DM, DM, DM, item);
  else if (PH == PH_PN1) ph_pn1(p, l, item);
  else if (PH == PH_GEMM_Q) gemm_item(p.Y(), DM, p.peer_wq + (size_t)l * DM * 2048, 2048, peerQ(p), 2048, 2048, DM, item);
  else if (PH == PH_TOPK1) ph_topk1(p, l, nr, item);
  else if (PH == PH_TOPK2) ph_topk2(p, nr, item);
  else if (PH == PH_ACT) ph_act(p, l, item);
  else if (PH == PH_FFN) ph_ffn(p, l, item);
  else if (PH == PH_PN2) ph_pn2(p, l, item);
}


#ifndef CPU_EMU
__device__ __forceinline__ int make_tid(int wave_s) {
  int lane;
  asm volatile("v_mbcnt_lo_u32_b32 %0, -1, 0\n\tv_mbcnt_hi_u32_b32 %0, -1, %0" : "=v"(lane));
  return wave_s * 64 + lane;
}
#define XB_TMO      128
#define XB_XCNT(j)  (256  + 64 * (j))
#define XB_XSUB(j)  (1280 + 64 * (j))
#define XB_XGEN(j)  (2304 + 64 * (j))
#define XB_TOP      3328
#define XB_TOPGEN   3392
#define XCD_BAR_WORDS 3456
#define XB_SPIN_CAP (1u << 18)
#define LAS __attribute__((address_space(3)))

__device__ __forceinline__ unsigned xb_ld(unsigned* p)              { return __hip_atomic_load(p, __ATOMIC_RELAXED, __HIP_MEMORY_SCOPE_AGENT); }
__device__ __forceinline__ unsigned xb_add(unsigned* p, unsigned v) { return __hip_atomic_fetch_add(p, v, __ATOMIC_RELAXED, __HIP_MEMORY_SCOPE_AGENT); }
__device__ __forceinline__ unsigned xb_xcc_id() { return (unsigned)__builtin_amdgcn_s_getreg((3 << 11) | 20) & 0xFu; }
#define XB_SPIN(cond, bar) do { unsigned _sp = 0; while (cond) { __builtin_amdgcn_s_sleep(1); \
    if ((++_sp & 255u) == 0u) { if (xb_ld(&(bar)[XB_TMO])) break; if (_sp > XB_SPIN_CAP) { atomicAdd(&(bar)[XB_TMO], 1u); break; } } } } while (0)

struct XcdBarrier {
    unsigned* bar; unsigned x;
    volatile LAS unsigned* st;
};

__device__ __forceinline__ XcdBarrier xcd_barrier_post(unsigned* bar, volatile LAS unsigned* st) {
    XcdBarrier b; b.bar = bar; b.x = xb_xcc_id(); b.st = st;
    if (threadIdx.x == 0) (void)xb_add(&bar[XB_XCNT(b.x)], 1u);
    return b;
}
__device__ __forceinline__ void xcd_barrier_complete(unsigned* bar, unsigned x, unsigned& nloc, unsigned& nx) {
    const unsigned G = gridDim.x * gridDim.y * gridDim.z;
    unsigned sum, cnt, mine, sp = 0u;
    for (;;) {
        sum = 0u; cnt = 0u; mine = 0u;
#pragma unroll
        for (unsigned j = 0; j < 16; ++j) { const unsigned c = xb_ld(&bar[XB_XCNT(j)]); sum += c; cnt += (c > 0u) ? 1u : 0u; mine = (j == x) ? c : mine; }
        if (sum == G) break;
        __builtin_amdgcn_s_sleep(1);
        if ((++sp & 255u) == 0u) { if (xb_ld(&bar[XB_TMO])) break; if (sp > XB_SPIN_CAP) { atomicAdd(&bar[XB_TMO], 1u); break; } }
    }
    nloc = mine > 0u ? mine : 1u; nx = cnt > 0u ? cnt : 1u;
}

__device__ __forceinline__ void xcd_barrier(const XcdBarrier& b, int wave_s) {
    asm volatile("s_waitcnt vmcnt(0)" ::: "memory");
    __syncthreads();
    if (make_tid(wave_s) == 0) {
        unsigned* bar = b.bar;
        __builtin_amdgcn_s_waitcnt(0);
        unsigned nloc = b.st[0], nx = b.st[1];
        if (nloc == 0u) { xcd_barrier_complete(bar, b.x, nloc, nx); b.st[0] = nloc; b.st[1] = nx; }
        const unsigned old = xb_add(&bar[XB_XSUB(b.x)], 1u);
        const unsigned gen = old / nloc;
        if (old + 1u == (gen + 1u) * nloc) {
            __builtin_amdgcn_fence(__ATOMIC_RELEASE, "agent");
            asm volatile("s_waitcnt vmcnt(0)" ::: "memory");
            const unsigned og = xb_add(&bar[XB_TOP], 1u);
            const unsigned tg = og / nx;
            if (og + 1u == (tg + 1u) * nx) xb_add(&bar[XB_TOPGEN], 1u);
            else XB_SPIN(xb_ld(&bar[XB_TOPGEN]) == tg, bar);
            __builtin_amdgcn_fence(__ATOMIC_ACQUIRE, "agent");
            xb_add(&bar[XB_XGEN(b.x)], 1u);
            asm volatile("s_waitcnt vmcnt(0)" ::: "memory");
        } else {
            XB_SPIN(xb_ld(&bar[XB_XGEN(b.x)]) == gen, bar);
            __builtin_amdgcn_fence(__ATOMIC_ACQUIRE, "agent");
            asm volatile("s_waitcnt vmcnt(0)" ::: "memory");
        }
    }
    __syncthreads();
}


constexpr int NTHREADS = 512;
typedef __attribute__((ext_vector_type(8))) __bf16 bf16x8;
typedef __attribute__((ext_vector_type(2))) __bf16 bf16x2;
typedef __attribute__((ext_vector_type(2))) float f32x2;
typedef __attribute__((ext_vector_type(4))) float f32x4;

__device__ __forceinline__ unsigned pk_bf16(float a, float b) {
  f32x2 v = {a, b};
  return __builtin_bit_cast(unsigned, __builtin_convertvector(v, bf16x2));
}

constexpr int NPAD_IN = 3840;
constexpr size_t WBT_LAYER = (size_t)(NPAD_IN + 1024 + 2048) * 1024;
__device__ __forceinline__ bf16_t* wbt_in(const Params& p, int l) { return p.WBT() + (size_t)l * WBT_LAYER; }
__device__ __forceinline__ bf16_t* wbt_out(const Params& p, int l) { return p.WBT() + (size_t)l * WBT_LAYER + (size_t)NPAD_IN * 1024; }
__device__ __forceinline__ bf16_t* wbt_q(const Params& p, int l) { return p.WBT() + (size_t)l * WBT_LAYER + (size_t)(NPAD_IN + 1024) * 1024; }

__device__ __forceinline__ void conv_weight_tiles(const float* W, int N, int npad, bf16_t* Bt, char* smem, int tid, int& rot) {
  bf16_t* T = (bf16_t*)smem;
  const int ntn = npad / 64, ntiles = 16 * ntn;
  const int vblk = (int)((blockIdx.x + gridDim.x - (unsigned)rot % gridDim.x) % gridDim.x);
  rot += (ntiles + 3) / 4;
  for (int t0 = vblk * 4; t0 < ntiles; t0 += gridDim.x * 4) {
    float4 v[4][2];
#pragma unroll
    for (int q = 0; q < 4; ++q) {
      const int tt = t0 + q, kt = tt / ntn, nt = tt % ntn;
#pragma unroll
      for (int j = 0; j < 2; ++j) {
        const int k = (tid >> 4) + 32 * j, n = nt * 64 + (tid & 15) * 4;
        const bool ok = tt < ntiles && n < N;
        v[q][j] = *(const float4*)(W + (size_t)((ok ? kt : 0) * 64 + k) * N + (ok ? n : 0));
      }
    }
#pragma unroll
    for (int q = 0; q < 4; ++q) {
      const int tt = t0 + q, nt = tt % ntn;
      const bool ok = tt < ntiles && nt * 64 + (tid & 15) * 4 < N;
#pragma unroll
      for (int j = 0; j < 2; ++j) if (!ok) v[q][j] = make_float4(0.f, 0.f, 0.f, 0.f);
    }
#pragma unroll
    for (int q = 0; q < 4; ++q)
#pragma unroll
      for (int j = 0; j < 2; ++j) {
        const int k = (tid >> 4) + 32 * j, n4 = (tid & 15) * 4;
        bf16_t* Tq = T + q * 64 * 72;
        Tq[(n4 + 0) * 72 + k] = f2bf(v[q][j].x); Tq[(n4 + 1) * 72 + k] = f2bf(v[q][j].y);
        Tq[(n4 + 2) * 72 + k] = f2bf(v[q][j].z); Tq[(n4 + 3) * 72 + k] = f2bf(v[q][j].w);
      }
    LDS_BAR();
#pragma unroll
    for (int q = 0; q < 4; ++q) {
      const int tt = t0 + q, kt = tt / ntn, nt = tt % ntn;
      const int n = tid >> 3, kc = tid & 7;
      if (tt < ntiles) *(uint4*)(Bt + (size_t)(nt * 64 + n) * 1024 + kt * 64 + kc * 8) = *(const uint4*)(T + q * 64 * 72 + n * 72 + kc * 8);
    }
    LDS_BAR();
  }
}
__device__ __forceinline__ void conv_weights(const Params& p, char* smem, int wave_s) {
  int tid = make_tid(wave_s);
  int rot = 2 * (6144 / 32);
  for (int l = 0; l < 2; ++l) {
    conv_weight_tiles(p.w_in + (size_t)l * DM * INC, INC, NPAD_IN, wbt_in(p, l), smem, tid, rot);
    conv_weight_tiles(p.w_out + (size_t)l * DM * DM, DM, DM, wbt_out(p, l), smem, tid, rot);
    conv_weight_tiles(p.peer_wq + (size_t)l * DM * 2048, 2048, 2048, wbt_q(p, l), smem, tid, rot);
  }
}

template <int BM>
__device__ __forceinline__ void gemm_tile(const bf16_t* __restrict__ A, int lda, const bf16_t* __restrict__ Bt, int N,
                                          bf16_t* __restrict__ C, int ldc, int m0, int n0, char* smem, int tid,
                                          bool staged, bool has_next, int m0n, int n0n) {
  constexpr int WM = BM / 4, MJ = WM / 16, ACH = BM * 8 / NTHREADS;
  constexpr int ABYTES = BM * 128, BBYTES = 128 * 128;
  const int lane = tid & 63, w = tid >> 6, wm = w >> 1, wn = w & 1;
  char* As = smem;
  char* Bs = smem + 3 * ABYTES;
  f32x4 acc[4][MJ];
#pragma unroll
  for (int i = 0; i < 4; ++i)
#pragma unroll
    for (int j = 0; j < MJ; ++j) acc[i][j] = f32x4{0.f, 0.f, 0.f, 0.f};
  typedef __attribute__((address_space(3))) void* lds_ptr;
  const int srow = lane >> 3, schunk = (lane & 7) ^ (lane >> 3);
  const bf16_t* aptr[ACH];
  const bf16_t* bptr[2];
#pragma unroll
  for (int i = 0; i < ACH; ++i) aptr[i] = A + (size_t)(m0 + (w + 8 * i) * 8 + srow) * lda + schunk * 8;
#pragma unroll
  for (int i = 0; i < 2; ++i) bptr[i] = Bt + (size_t)(n0 + (w + 8 * i) * 8 + srow) * 1024 + schunk * 8;
#define GEMM_STAGE(kt, buf)                                                                                   \
  {                                                                                                           \
    _Pragma("unroll") for (int i = 0; i < ACH; ++i)                                                           \
      __builtin_amdgcn_global_load_lds((const void*)(aptr[i] + (kt) * 64), (lds_ptr)(As + (buf) * ABYTES + (w + 8 * i) * 1024 + lane * 16), 16, 0, 0); \
    _Pragma("unroll") for (int i = 0; i < 2; ++i)                                                             \
      __builtin_amdgcn_global_load_lds((const void*)(bptr[i] + (kt) * 64), (lds_ptr)(Bs + (buf) * BBYTES + (w + 8 * i) * 1024 + lane * 16), 16, 0, 0); \
  }
  const int l15 = lane & 15, lq = lane >> 4, sw = lane & 7;
  const int bbase = (wn * 64 + l15) * 128, abase = (wm * WM + l15) * 128;
  if (!staged) { GEMM_STAGE(0, 0); GEMM_STAGE(1, 1); }
  int buf = 0;
  for (int kt = 0; kt < 16; ++kt) {
    if (kt < 15) { if (ACH == 4) asm volatile("s_waitcnt vmcnt(6)" ::: "memory"); else asm volatile("s_waitcnt vmcnt(4)" ::: "memory"); }
    else asm volatile("s_waitcnt vmcnt(0)" ::: "memory");
    __builtin_amdgcn_s_barrier();
    if (kt < 14) { const int nb_ = buf == 0 ? 2 : buf - 1; GEMM_STAGE(kt + 2, nb_); }
#pragma unroll
    for (int ks = 0; ks < 2; ++ks) {
      const int koff = ((ks * 4 + lq) ^ sw) << 4;
      bf16x8 af[4], bf[MJ];
#pragma unroll
      for (int i = 0; i < 4; ++i) af[i] = *(const bf16x8*)(Bs + buf * BBYTES + bbase + i * 2048 + koff);
#pragma unroll
      for (int j = 0; j < MJ; ++j) bf[j] = *(const bf16x8*)(As + buf * ABYTES + abase + j * 2048 + koff);
      __builtin_amdgcn_s_setprio(1);
#pragma unroll
      for (int i = 0; i < 4; ++i)
#pragma unroll
        for (int j = 0; j < MJ; ++j) acc[i][j] = __builtin_amdgcn_mfma_f32_16x16x32_bf16(af[i], bf[j], acc[i][j], 0, 0, 0);
      __builtin_amdgcn_s_setprio(0);
    }
    buf = buf == 2 ? 0 : buf + 1;
  }
  asm volatile("s_waitcnt lgkmcnt(0)" ::: "memory");
  __builtin_amdgcn_s_barrier();
  if (has_next) {
#pragma unroll
    for (int i = 0; i < ACH; ++i) aptr[i] = A + (size_t)(m0n + (w + 8 * i) * 8 + srow) * lda + schunk * 8;
#pragma unroll
    for (int i = 0; i < 2; ++i) bptr[i] = Bt + (size_t)(n0n + (w + 8 * i) * 8 + srow) * 1024 + schunk * 8;
    GEMM_STAGE(0, 0); GEMM_STAGE(1, 1);
  }
#undef GEMM_STAGE
#pragma unroll
  for (int i = 0; i < 4; ++i) {
    int n = n0 + wn * 64 + i * 16 + lq * 4;
    if (n < N) {
#pragma unroll
      for (int j = 0; j < MJ; ++j) {
        int m = m0 + wm * WM + j * 16 + l15;
        uint2 v;
        v.x = pk_bf16(acc[i][j][0], acc[i][j][1]);
        v.y = pk_bf16(acc[i][j][2], acc[i][j][3]);
        *(uint2*)(C + (size_t)m * ldc + n) = v;
      }
    }
  }
}

__device__ __forceinline__ void gemm_tile256(const bf16_t* __restrict__ A, int lda, const bf16_t* __restrict__ Bt, int N,
                                             bf16_t* __restrict__ C, int ldc, int m0, int n0, char* smem, int tid,
                                             bool staged, bool has_next, int m0n, int n0n) {
  constexpr int ABYTES = 256 * 128, BBYTES = 256 * 128;
  const int lane = tid & 63, w = tid >> 6, wm = w >> 2, wn = w & 3;
  char* As = smem;
  char* Bs = smem + 2 * ABYTES;
  f32x4 acc[4][8];
#pragma unroll
  for (int i = 0; i < 4; ++i)
#pragma unroll
    for (int j = 0; j < 8; ++j) acc[i][j] = f32x4{0.f, 0.f, 0.f, 0.f};
  typedef __attribute__((address_space(3))) void* lds_ptr;
  const int srow = lane >> 3, schunk = (lane & 7) ^ (lane >> 3);
  const char* Ab = (const char*)(A + (size_t)m0 * lda);
  const char* Bb = (const char*)(Bt + (size_t)n0 * 1024);
  const unsigned voff = (unsigned)(((w * 8 + srow) * 1024 + schunk * 8) * 2);
  const unsigned loff = (unsigned)(w * 1024 + lane * 16);
#define GEMM_STAGE(ap, bp, buf)                                                                               \
  {                                                                                                           \
    _Pragma("unroll") for (int i = 0; i < 4; ++i)                                                             \
      __builtin_amdgcn_global_load_lds((const void*)((ap) + (size_t)(i * 131072) + voff), (lds_ptr)(As + (buf) * ABYTES + i * 8192 + loff), 16, 0, 0); \
    _Pragma("unroll") for (int i = 0; i < 4; ++i)                                                             \
      __builtin_amdgcn_global_load_lds((const void*)((bp) + (size_t)(i * 131072) + voff), (lds_ptr)(Bs + (buf) * BBYTES + i * 8192 + loff), 16, 0, 0); \
  }
  const int l15 = lane & 15, lq = lane >> 4, sw = lane & 7;
  const int bbase = (wn * 64 + l15) * 128, abase = (wm * 128 + l15) * 128;
  if (!staged) {
    GEMM_STAGE(Ab, Bb, 0);
    asm volatile("s_waitcnt vmcnt(0)" ::: "memory");
    __builtin_amdgcn_s_barrier();
  }
  const char* Abn = has_next ? (const char*)(A + (size_t)m0n * lda) : Ab;
  const char* Bbn = has_next ? (const char*)(Bt + (size_t)n0n * 1024) : Bb;
  int buf = 0;
#pragma unroll 1
  for (int kt = 0; kt < 16; ++kt) {
    int ktl = kt;
    asm volatile("" : "+s"(ktl));
    const char* ap = ktl < 15 ? Ab + (ktl + 1) * 128 : Abn;
    const char* bp = ktl < 15 ? Bb + (ktl + 1) * 128 : Bbn;
    GEMM_STAGE(ap, bp, buf ^ 1);
#pragma unroll
    for (int ks = 0; ks < 2; ++ks) {
      const int koff = ((ks * 4 + lq) ^ sw) << 4;
      bf16x8 af[4];
#pragma unroll
      for (int i = 0; i < 4; ++i) af[i] = *(const bf16x8*)(Bs + buf * BBYTES + bbase + i * 2048 + koff);
#pragma unroll
      for (int jh = 0; jh < 2; ++jh) {
        bf16x8 bf[4];
#pragma unroll
        for (int j = 0; j < 4; ++j) bf[j] = *(const bf16x8*)(As + buf * ABYTES + abase + (jh * 4 + j) * 2048 + koff);
        __builtin_amdgcn_s_setprio(1);
#pragma unroll
        for (int i = 0; i < 4; ++i)
#pragma unroll
          for (int j = 0; j < 4; ++j) acc[i][jh * 4 + j] = __builtin_amdgcn_mfma_f32_16x16x32_bf16(af[i], bf[j], acc[i][jh * 4 + j], 0, 0, 0);
        __builtin_amdgcn_s_setprio(0);
      }
    }
    asm volatile("s_waitcnt vmcnt(0) lgkmcnt(0)" ::: "memory");
    __builtin_amdgcn_s_barrier();
    buf ^= 1;
  }
#undef GEMM_STAGE
#pragma unroll
  for (int i = 0; i < 4; ++i) {
    int n = n0 + wn * 64 + i * 16 + lq * 4;
#pragma unroll
    for (int j = 0; j < 8; ++j) {
      int m = m0 + wm * 128 + j * 16 + l15;
      uint2 v;
      v.x = pk_bf16(acc[i][j][0], acc[i][j][1]);
      v.y = pk_bf16(acc[i][j][2], acc[i][j][3]);
      if (n < N) *(uint2*)(C + (size_t)m * ldc + n) = v;
    }
  }
}
__device__ __forceinline__ int g8_lds_byte(int r, int c) {
  int st = (r >> 4) * 2 + (c >> 5), rr = r & 15, cc = c & 31, ob = rr * 64 + cc * 2;
  return st * 1024 + (ob ^ (((ob >> 9) & 1) << 5));
}
__device__ __forceinline__ void g8_stage_rc(int b, int& R, int& C) {
  int st = b / 1024, sb = b % 1024, swz = sb ^ (((sb >> 9) & 1) << 5);
  R = (st >> 1) * 16 + swz / 64; C = (st & 1) * 32 + (swz % 64) / 2;
}
__device__ __forceinline__ void gemm_tile_8ph(const bf16_t* __restrict__ A, const bf16_t* __restrict__ Bt, int N,
                                              bf16_t* __restrict__ C, int ldc, int brow, int bcol, char* smem, int tid, int wave_s,
                                              bool first, int browN, int bcolN) {
  constexpr int K = 1024, BK = 64, HALF = 128, HT = HALF * BK;
  typedef __attribute__((address_space(3))) void* lds_ptr;
  bf16_t* shm = (bf16_t*)smem;
#define SA(b, h) (shm + ((b) * 2 + (h)) * HT)
#define SB(b, h) (shm + (4 + (b) * 2 + (h)) * HT)
  const int lane = tid & 63, wid = tid >> 6, wr = wid >> 2, wc = wid & 3, fr = lane & 15, fq = lane >> 4;
  int r0_, c0_, r1_, c1_;
  g8_stage_rc(tid * 16, r0_, c0_);
  g8_stage_rc(tid * 16 + 8192, r1_, c1_);
  const unsigned so0 = (unsigned)((r0_ * K + c0_) * 2), so1 = (unsigned)((r1_ * K + c1_) * 2);
  const unsigned lds0 = (unsigned)(size_t)(lds_ptr)smem;
#define STAGEP(P, gp)                                                                                          \
  {                                                                                                            \
    const char* g_ = (const char*)(gp);                                                                        \
    const unsigned l_ = lds0 + (unsigned)((const char*)(P) - smem) + wave_s * 1024;                            \
    asm volatile("s_mov_b32 m0, %2\n\ts_nop 0\n\tglobal_load_lds_dwordx4 %0, %1" :: "v"(so0), "s"(g_), "s"(l_) : "memory", "m0"); \
    asm volatile("s_mov_b32 m0, %2\n\ts_nop 0\n\tglobal_load_lds_dwordx4 %0, %1" :: "v"(so1), "s"(g_), "s"(l_ + 8192u) : "memory", "m0"); \
  }
  const int swz_ = (fr * 64 + fq * 16) ^ ((fr >> 3) << 5);
  const char* abase = smem + wr * 8192 + swz_;
  const char* bbase = smem + 65536 + wc * 4096 + swz_;
#define LDA(dst, b, h)                                                                                         \
  _Pragma("unroll") for (int m = 0; m < 4; ++m) _Pragma("unroll") for (int k = 0; k < 2; ++k)                  \
    dst[m][k] = *reinterpret_cast<const bf16x8*>(abase + (((b) * 2 + (h)) * 16384 + m * 2048 + k * 1024));
#define LDB(dst, b, h)                                                                                         \
  _Pragma("unroll") for (int n = 0; n < 2; ++n) _Pragma("unroll") for (int k = 0; k < 2; ++k)                  \
    dst[n][k] = *reinterpret_cast<const bf16x8*>(bbase + (((b) * 2 + (h)) * 16384 + n * 2048 + k * 1024));
#define MMA(ai, bj, At_, Bf_)                                                                                  \
  {                                                                                                            \
    __builtin_amdgcn_s_setprio(1);                                                                             \
    _Pragma("unroll") for (int m = 0; m < 4; ++m) _Pragma("unroll") for (int n = 0; n < 2; ++n)                \
      _Pragma("unroll") for (int k = 0; k < 2; ++k)                                                            \
        acc[ai][bj][m][n] = __builtin_amdgcn_mfma_f32_16x16x32_bf16(Bf_[n][k], At_[m][k], acc[ai][bj][m][n], 0, 0, 0); \
    __builtin_amdgcn_s_setprio(0);                                                                             \
  }
#define WAIT_V(n) asm volatile("s_waitcnt vmcnt(" #n ")" ::: "memory")
#define WAIT_L(n) asm volatile("s_waitcnt lgkmcnt(" #n ")" ::: "memory")
#define BAR __builtin_amdgcn_s_barrier()
#define SCHED __builtin_amdgcn_sched_barrier(0)
  f32x4 acc[2][2][4][2];
#pragma unroll
  for (int a_ = 0; a_ < 2; ++a_)
#pragma unroll
    for (int b_ = 0; b_ < 2; ++b_)
#pragma unroll
      for (int m = 0; m < 4; ++m)
#pragma unroll
        for (int n = 0; n < 2; ++n) acc[a_][b_][m][n] = f32x4{0.f, 0.f, 0.f, 0.f};
  bf16x8 At[4][2], B0[2][2], B1[2][2];
  constexpr int nt = K / BK;
  const bf16_t* Ac = A + (size_t)brow * K;
  const bf16_t* Bc = Bt + (size_t)bcol * K;
  const bf16_t* An = A + (size_t)browN * K;
  const bf16_t* Bn = Bt + (size_t)bcolN * K;
  if (first) {
    STAGEP(SB(0, 0), Bc); STAGEP(SA(0, 0), Ac);
    STAGEP(SB(0, 1), Bc + HALF * K); STAGEP(SA(0, 1), Ac + HALF * K);
    STAGEP(SB(1, 0), Bc + BK); STAGEP(SA(1, 0), Ac + BK); STAGEP(SB(1, 1), Bc + HALF * K + BK);
    if (wr == 1) BAR;
    WAIT_V(10); BAR;
    WAIT_V(6); BAR;
  }
#pragma unroll 1
  for (int t = 0; t < nt; t += 2) {
    int tl = t;
    asm volatile("" : "+s"(tl));
    const bf16_t* A1 = Ac + HALF * K + (tl + 1) * BK;
    const bf16_t* A2 = tl + 2 < nt ? Ac + (tl + 2) * BK : An;
    const bf16_t* B2 = tl + 2 < nt ? Bc + (tl + 2) * BK : Bn;
    LDB(B0, 0, 0); SCHED; LDA(At, 0, 0); STAGEP(SA(1, 1), A1);
    WAIT_L(8); BAR; WAIT_L(0); MMA(0, 0, At, B0); BAR; SCHED;
    LDB(B1, 0, 1); STAGEP(SB(0, 0), B2);
    BAR; WAIT_L(0); MMA(0, 1, At, B1); BAR;
    LDA(At, 0, 1); STAGEP(SA(0, 0), A2);
    BAR; WAIT_L(0); MMA(1, 0, At, B0); BAR; SCHED;
    STAGEP(SB(0, 1), B2 + HALF * K);
    WAIT_V(6); BAR; MMA(1, 1, At, B1); BAR;
    LDB(B0, 1, 0); SCHED; LDA(At, 1, 0); STAGEP(SA(0, 1), A2 + HALF * K);
    WAIT_L(8); BAR; WAIT_L(0); MMA(0, 0, At, B0); BAR; SCHED;
    LDB(B1, 1, 1); STAGEP(SB(1, 0), B2 + BK);
    BAR; WAIT_L(0); MMA(0, 1, At, B1); BAR;
    LDA(At, 1, 1); STAGEP(SA(1, 0), A2 + BK);
    BAR; WAIT_L(0); MMA(1, 0, At, B0); BAR; SCHED;
    STAGEP(SB(1, 1), B2 + HALF * K + BK);
    WAIT_V(6); BAR; MMA(1, 1, At, B1); BAR;
  }
  const unsigned coff = (unsigned)(((wr * 64 + fr) * ldc + wc * 32 + fq * 4) * 2);
#pragma unroll
  for (int ai = 0; ai < 2; ++ai)
#pragma unroll
    for (int bj = 0; bj < 2; ++bj)
#pragma unroll
      for (int n = 0; n < 2; ++n) {
        const int nn = bcol + bj * HALF + wc * 32 + n * 16 + fq * 4;
#pragma unroll
        for (int m = 0; m < 4; ++m) {
          char* cb = (char*)(C + (size_t)(brow + ai * HALF + m * 16) * ldc + bcol + bj * HALF + n * 16);
          uint2 v;
          v.x = pk_bf16(acc[ai][bj][m][n][0], acc[ai][bj][m][n][1]);
          v.y = pk_bf16(acc[ai][bj][m][n][2], acc[ai][bj][m][n][3]);
          if (nn < N) *(uint2*)(cb + coff) = v;
        }
      }
#undef SA
#undef SB
#undef STAGEP
#undef LDA
#undef LDB
#undef MMA
#undef WAIT_V
#undef WAIT_L
#undef BAR
#undef SCHED
}
__device__ __forceinline__ void gemm_phase_8ph(const bf16_t* A, const bf16_t* Bt, int N, bf16_t* C, int ldc, int M, char* smem, int wave_s) {
  const int ntn = (N + 255) / 256, ntm = M / 256;
  const int ntiles = ntm * ntn;
  const int nb = gridDim.x;
  const int vid = (nb % 8 == 0) ? (int)((blockIdx.x % 8) * (nb / 8) + blockIdx.x / 8) : (int)blockIdx.x;
#define GEMM_TILE_MN(t_, mt_, nt_) { const int grp = (t_) / (8 * ntn), fm = grp * 8; const int gsz = (ntm - fm) < 8 ? (ntm - fm) : 8; \
    const int r = (t_) - grp * 8 * ntn; mt_ = fm + (r % gsz); nt_ = r / gsz; }
  if (vid < ntiles) {
    bool first = true;
    for (int t = vid; t < ntiles; t += nb) {
      int mt, nt, mtn, ntn_;
      GEMM_TILE_MN(t, mt, nt)
      mtn = mt; ntn_ = nt;
      if (t + nb < ntiles) GEMM_TILE_MN(t + nb, mtn, ntn_)
      const int tid2 = make_tid(wave_s);
      gemm_tile_8ph(A, Bt, N, C, ldc, mt * 256, nt * 256, smem, tid2, wave_s, first, mtn * 256, ntn_ * 256);
      first = false;
    }
    if ((wave_s >> 2) == 0) __builtin_amdgcn_s_barrier();
  }
#undef GEMM_TILE_MN
  asm volatile("s_waitcnt vmcnt(0)" ::: "memory");
  __builtin_amdgcn_s_barrier();
}

__device__ __forceinline__ void gemm_phase256(const bf16_t* A, int lda, const bf16_t* Bt, int N, bf16_t* C, int ldc, int M, char* smem, int wave_s) {
  const int ntn = (N + 255) / 256, ntm = M / 256;
  const int ntiles = ntm * ntn;
  const int nb = gridDim.x;
  const int vid = (nb % 8 == 0) ? (int)((blockIdx.x % 8) * (nb / 8) + blockIdx.x / 8) : (int)blockIdx.x;
#define GEMM_TILE_MN(t_, mt_, nt_) { const int grp = (t_) / (8 * ntn), fm = grp * 8; const int gsz = (ntm - fm) < 8 ? (ntm - fm) : 8; \
    const int r = (t_) - grp * 8 * ntn; mt_ = fm + (r % gsz); nt_ = r / gsz; }
  bool staged = false;
  for (int t = vid; t < ntiles; t += nb) {
    int mt, nt, mtn = 0, ntn_ = 0;
    GEMM_TILE_MN(t, mt, nt)
    const bool has_next = t + nb < ntiles;
    if (has_next) GEMM_TILE_MN(t + nb, mtn, ntn_)
    const int tid2 = make_tid(wave_s);
    gemm_tile256(A, lda, Bt, N, C, ldc, mt * 256, nt * 256, smem, tid2, staged, has_next, mtn * 256, ntn_ * 256);
    staged = has_next;
  }
#undef GEMM_TILE_MN
  asm volatile("s_waitcnt vmcnt(0)" ::: "memory");
}

template <int BM>
__device__ __forceinline__ void gemm_phase(const bf16_t* A, int lda, const bf16_t* Bt, int N, bf16_t* C, int ldc, int M, char* smem, int wave_s) {
  const int ntn = (N + 127) / 128, ntm = M / BM;
  const int ntiles = ntm * ntn;
  int tid = make_tid(wave_s);
  const int nb = gridDim.x;
  const int vid = (nb % 8 == 0) ? (int)((blockIdx.x % 8) * (nb / 8) + blockIdx.x / 8) : (int)blockIdx.x;
#define GEMM_TILE_MN(t_, mt_, nt_) { const int grp = (t_) / (8 * ntn), fm = grp * 8; const int gsz = (ntm - fm) < 8 ? (ntm - fm) : 8; \
    const int r = (t_) - grp * 8 * ntn; mt_ = fm + (r % gsz); nt_ = r / gsz; }
  bool staged = false;
  for (int t = vid; t < ntiles; t += nb) {
    int mt, nt, mtn = 0, ntn_ = 0;
    GEMM_TILE_MN(t, mt, nt)
    const bool has_next = t + nb < ntiles;
    if (has_next) GEMM_TILE_MN(t + nb, mtn, ntn_)
    const int tid2 = make_tid(wave_s);
    gemm_tile<BM>(A, lda, Bt, N, C, ldc, mt * BM, nt * 128, smem, tid2, staged, has_next, mtn * BM, ntn_ * 128);
    staged = has_next;
  }
#undef GEMM_TILE_MN
  asm volatile("s_waitcnt vmcnt(0)" ::: "memory");
}

__device__ __forceinline__ float wave_sum(float v) {
#pragma unroll
  for (int o = 32; o >= 1; o >>= 1) v += __shfl_xor(v, o);
  return v;
}
__device__ __forceinline__ void unpack8(uint4 v, float* x) {
  x[0] = __uint_as_float(v.x << 16); x[1] = __uint_as_float(v.x & 0xffff0000u);
  x[2] = __uint_as_float(v.y << 16); x[3] = __uint_as_float(v.y & 0xffff0000u);
  x[4] = __uint_as_float(v.z << 16); x[5] = __uint_as_float(v.z & 0xffff0000u);
  x[6] = __uint_as_float(v.w << 16); x[7] = __uint_as_float(v.w & 0xffff0000u);
}
__device__ __forceinline__ void ldrow_f32(const float* r, int lane, float (&x)[16]) {
  float4 a = *(const float4*)(r + lane * 8), b = *(const float4*)(r + lane * 8 + 4);
  float4 c = *(const float4*)(r + 512 + lane * 8), d = *(const float4*)(r + 512 + lane * 8 + 4);
  x[0] = a.x; x[1] = a.y; x[2] = a.z; x[3] = a.w; x[4] = b.x; x[5] = b.y; x[6] = b.z; x[7] = b.w;
  x[8] = c.x; x[9] = c.y; x[10] = c.z; x[11] = c.w; x[12] = d.x; x[13] = d.y; x[14] = d.z; x[15] = d.w;
}
__device__ __forceinline__ void ldrow_bf16(const bf16_t* r, int lane, float (&x)[16]) {
  uint4 a = *(const uint4*)(r + lane * 8), b = *(const uint4*)(r + 512 + lane * 8);
  unpack8(a, x); unpack8(b, x + 8);
}
__device__ __forceinline__ void strow_f32(float* r, int lane, const float (&x)[16]) {
  *(float4*)(r + lane * 8) = make_float4(x[0], x[1], x[2], x[3]);
  *(float4*)(r + lane * 8 + 4) = make_float4(x[4], x[5], x[6], x[7]);
  *(float4*)(r + 512 + lane * 8) = make_float4(x[8], x[9], x[10], x[11]);
  *(float4*)(r + 512 + lane * 8 + 4) = make_float4(x[12], x[13], x[14], x[15]);
}
__device__ __forceinline__ void strow_bf16(bf16_t* r, int lane, const float (&x)[16]) {
  uint4 a, b;
  a.x = pk_bf16(x[0], x[1]); a.y = pk_bf16(x[2], x[3]); a.z = pk_bf16(x[4], x[5]); a.w = pk_bf16(x[6], x[7]);
  b.x = pk_bf16(x[8], x[9]); b.y = pk_bf16(x[10], x[11]); b.z = pk_bf16(x[12], x[13]); b.w = pk_bf16(x[14], x[15]);
  *(uint4*)(r + lane * 8) = a;
  *(uint4*)(r + 512 + lane * 8) = b;
}
__device__ __forceinline__ void ldrow16_f32(const float* r, int lane, float (&x)[16]) {
  const float4 a = *(const float4*)(r + lane * 16), b = *(const float4*)(r + lane * 16 + 4);
  const float4 c = *(const float4*)(r + lane * 16 + 8), d = *(const float4*)(r + lane * 16 + 12);
  x[0] = a.x; x[1] = a.y; x[2] = a.z; x[3] = a.w; x[4] = b.x; x[5] = b.y; x[6] = b.z; x[7] = b.w;
  x[8] = c.x; x[9] = c.y; x[10] = c.z; x[11] = c.w; x[12] = d.x; x[13] = d.y; x[14] = d.z; x[15] = d.w;
}
__device__ __forceinline__ void ldrow16_bf16(const bf16_t* r, int lane, float (&x)[16]) {
  const uint4 a = *(const uint4*)(r + lane * 16), b = *(const uint4*)(r + lane * 16 + 8);
  unpack8(a, x); unpack8(b, x + 8);
}
__device__ __forceinline__ void strow16_f32(float* r, int lane, const float (&x)[16]) {
  *(float4*)(r + lane * 16) = make_float4(x[0], x[1], x[2], x[3]);
  *(float4*)(r + lane * 16 + 4) = make_float4(x[4], x[5], x[6], x[7]);
  *(float4*)(r + lane * 16 + 8) = make_float4(x[8], x[9], x[10], x[11]);
  *(float4*)(r + lane * 16 + 12) = make_float4(x[12], x[13], x[14], x[15]);
}
__device__ __forceinline__ void strow16_bf16(bf16_t* r, int lane, const float (&x)[16]) {
  uint4 a, b;
  a.x = pk_bf16(x[0], x[1]); a.y = pk_bf16(x[2], x[3]); a.z = pk_bf16(x[4], x[5]); a.w = pk_bf16(x[6], x[7]);
  b.x = pk_bf16(x[8], x[9]); b.y = pk_bf16(x[10], x[11]); b.z = pk_bf16(x[12], x[13]); b.w = pk_bf16(x[14], x[15]);
  *(uint4*)(r + lane * 16) = a;
  *(uint4*)(r + lane * 16 + 8) = b;
}
__device__ __forceinline__ void row_ln_stats(const float (&x)[16], float& mean, float& rstd) {
  float s = 0.f;
#pragma unroll
  for (int i = 0; i < 16; ++i) s += x[i];
  mean = wave_sum(s) * (1.0f / DM);
  float v = 0.f;
#pragma unroll
  for (int i = 0; i < 16; ++i) { float d = x[i] - mean; v += d * d; }
  rstd = 1.0f / sqrtf(wave_sum(v) * (1.0f / DM) + LN_EPS);
}
__device__ __forceinline__ void row_modulate(float (&x)[16], const float* sh, const float* sc, int lane) {
  float mean, rstd; row_ln_stats(x, mean, rstd);
  float a[16], b[16];
  ldrow_f32(sc, lane, a); ldrow_f32(sh, lane, b);
#pragma unroll
  for (int i = 0; i < 16; ++i) x[i] = (x[i] - mean) * rstd * (1.0f + a[i]) + b[i];
}
__device__ __forceinline__ void row_affine_ln(float (&x)[16], const float* g, const float* bb, int lane) {
  float mean, rstd; row_ln_stats(x, mean, rstd);
  float a[16], b[16];
  ldrow_f32(g, lane, a); ldrow_f32(bb, lane, b);
#pragma unroll
  for (int i = 0; i < 16; ++i) x[i] = (x[i] - mean) * rstd * a[i] + b[i];
}

__device__ __forceinline__ void fast_ln1(const Params& p, int l, int wave_s) {
  for (int row = blockIdx.x * 8 + wave_s; row < NTOK; row += gridDim.x * 8) {
    const int lane = make_tid(wave_s) & 63;
    const float* m = p.mod() + ((size_t)l * NMODV + modv_of_row(row)) * 6144;
    float x[16];
    ldrow_f32(hsrc_row(p, l, row), lane, x);
    row_modulate(x, m, m + 1024, lane);
    strow_bf16(p.Y() + (size_t)row * DM, lane, x);
  }
}
template <int CTRL> __device__ __forceinline__ float dppx(float x) {
  return __builtin_bit_cast(float, __builtin_amdgcn_update_dpp(0, __builtin_bit_cast(int, x), CTRL, 0xf, 0xf, true));
}
typedef __attribute__((ext_vector_type(2))) float f32x2v;
constexpr float XQ_SCALE = 8.0f;
DEVFN unsigned char* xqbuf(const Params& p) { return (unsigned char*)p.P() + (size_t)NTOK * 4096; }
__device__ __forceinline__ void fast_pn1(const Params& p, int l, int nr, int wave_s) {
  for (int row = blockIdx.x * 8 + wave_s; row < nr; row += gridDim.x * 8) {
    const int lane = make_tid(wave_s) & 63;
    const float* m = p.mod() + ((size_t)l * NMODV + modv_of_row(row)) * 6144;
    float x[16], y[16], g[16];
    ldrow_f32(hsrc_row(p, l, row), lane, x);
    ldrow_bf16((const bf16_t*)p.RW() + (size_t)row * DM, lane, y);
    ldrow_f32(m + 2048, lane, g);
#pragma unroll
    for (int i = 0; i < 16; ++i) x[i] = DN_ALPHA * x[i] + g[i] * y[i];
    row_affine_ln(x, p.ln_mix_g + l * DM, p.ln_mix_b + l * DM, lane);
    strow_f32(hdst_row(p, row), lane, x);
    row_modulate(x, m + 3072, m + 4096, lane);
    strow_bf16(p.Y() + (size_t)row * DM, lane, x);
    unsigned char* xq = xqbuf(p) + (size_t)row * 1024;
#pragma unroll
    for (int hf = 0; hf < 2; ++hf) {
      uint2 hi = make_uint2(0u, 0u);
#define XQ_PAIR(k_, hw_, sel_) { \
        const float a = fminf(fmaxf(x[hf * 8 + 2 * (k_)] * XQ_SCALE, -448.f), 448.f); \
        const float b = fminf(fmaxf(x[hf * 8 + 2 * (k_) + 1] * XQ_SCALE, -448.f), 448.f); \
        hw_ = __builtin_amdgcn_cvt_pk_fp8_f32(a, b, hw_, sel_); }
      XQ_PAIR(0, hi.x, false) XQ_PAIR(1, hi.x, true) XQ_PAIR(2, hi.y, false) XQ_PAIR(3, hi.y, true)
      *(uint2*)(xq + (hf * 64 + lane) * 8) = hi;
    }
  }
}

constexpr float U8_SCALE = 64.0f, V8_SCALE = 4.0f;
__device__ __forceinline__ size_t tb_off(size_t c, size_t nch) {
  if (c < nch) return c * 16;
  const size_t cv = c - nch, row = cv >> 6, cc = cv & 63;
  return nch * 16 + (cc >> 3) * ((size_t)16384 * 128) + row * 128 + (cc & 7) * 16;
}
__device__ __forceinline__ void conv_tables(const Params& p, int l, int wave_s) {
  int tid = make_tid(wave_s);
  const size_t nch = (size_t)16384 * 1024 / 16;
  const size_t nth = (size_t)gridDim.x * NTHREADS;
  const float* su = p.peer_u + (size_t)l * 16384 * 1024;
  const float* sv = p.peer_v + (size_t)l * 16384 * 1024;
  unsigned char* dst = (unsigned char*)p.TB();
  size_t c = (size_t)blockIdx.x * NTHREADS + tid;
  for (; c + 3 * nth < 2 * nch; c += 4 * nth) {
    float4 f[4][4];
#pragma unroll
    for (int q = 0; q < 4; ++q) {
      const size_t cq = c + q * nth;
      const float* src = cq < nch ? su + cq * 16 : sv + (cq - nch) * 16;
#pragma unroll
      for (int j = 0; j < 4; ++j) f[q][j] = *(const float4*)(src + 4 * j);
    }
#pragma unroll
    for (int q = 0; q < 4; ++q) {
      const size_t cq = c + q * nth;
      const float sc = cq < nch ? U8_SCALE : V8_SCALE;
      unsigned w[4];
#pragma unroll
      for (int j = 0; j < 4; ++j) {
        w[j] = __builtin_amdgcn_cvt_pk_fp8_f32(f[q][j].x * sc, f[q][j].y * sc, 0, false);
        w[j] = __builtin_amdgcn_cvt_pk_fp8_f32(f[q][j].z * sc, f[q][j].w * sc, w[j], true);
      }
      *(uint4*)(dst + tb_off(cq, nch)) = make_uint4(w[0], w[1], w[2], w[3]);
    }
  }
  for (; c < 2 * nch; c += nth) {
    const bool isu = c < nch;
    const float* src = isu ? su + c * 16 : sv + (c - nch) * 16;
    const float sc = isu ? U8_SCALE : V8_SCALE;
    const float4 f0 = *(const float4*)src, f1 = *(const float4*)(src + 4), f2 = *(const float4*)(src + 8), f3 = *(const float4*)(src + 12);
    uint4 v;
    v.x = __builtin_amdgcn_cvt_pk_fp8_f32(f0.x * sc, f0.y * sc, 0, false); v.x = __builtin_amdgcn_cvt_pk_fp8_f32(f0.z * sc, f0.w * sc, v.x, true);
    v.y = __builtin_amdgcn_cvt_pk_fp8_f32(f1.x * sc, f1.y * sc, 0, false); v.y = __builtin_amdgcn_cvt_pk_fp8_f32(f1.z * sc, f1.w * sc, v.y, true);
    v.z = __builtin_amdgcn_cvt_pk_fp8_f32(f2.x * sc, f2.y * sc, 0, false); v.z = __builtin_amdgcn_cvt_pk_fp8_f32(f2.z * sc, f2.w * sc, v.z, true);
    v.w = __builtin_amdgcn_cvt_pk_fp8_f32(f3.x * sc, f3.y * sc, 0, false); v.w = __builtin_amdgcn_cvt_pk_fp8_f32(f3.z * sc, f3.w * sc, v.w, true);
    *(uint4*)(dst + tb_off(c, nch)) = v;
  }
}

typedef unsigned long long u64;
__device__ __forceinline__ unsigned f2ord(float f) { unsigned u = __float_as_uint(f); return u ^ ((u >> 31) ? 0xffffffffu : 0x80000000u); }
__device__ __forceinline__ float ord2f(unsigned u) { return __uint_as_float(u ^ ((u >> 31) ? 0x80000000u : 0xffffffffu)); }
__device__ const unsigned char PEER_CAND[56] = {
  0x00,0x01,0x02,0x03,0x04,0x05,0x06,0x07,0x08,0x09,0x0a,0x0b,0x0c,0x0d,0x0e,0x0f,
  0x10,0x11,0x12,0x13,0x14,0x15,0x16,0x17,
  0x20,0x21,0x22,0x23,0x24,
  0x30,0x31,0x32,0x33,
  0x40,0x41,0x42,
  0x50,0x51, 0x60,0x61, 0x70,0x71,
  0x80,0x90,0xa0,0xb0,0xc0,0xd0,0xe0,0xf0,
  0xff,0xff,0xff,0xff,0xff,0xff};

constexpr int SEL_CAND_OFF = 124032;
template <int N>
__device__ __forceinline__ void sort_desc(unsigned (&a)[N]) {
#pragma unroll
  for (int k = 2; k <= N; k <<= 1) {
#pragma unroll
    for (int j = k >> 1; j > 0; j >>= 1) {
#pragma unroll
      for (int i = 0; i < N; ++i) {
        const int m = i ^ j;
        if (m > i) {
          const unsigned x = a[i], y = a[m];
          const unsigned hi = x > y ? x : y, lo = x > y ? y : x;
          if ((i & k) == 0) { a[i] = hi; a[m] = lo; } else { a[i] = lo; a[m] = hi; }
        }
      }
    }
  }
}
template <int CTRL> __device__ __forceinline__ unsigned dpp_mov_u(unsigned x) {
  return (unsigned)__builtin_amdgcn_update_dpp(0, (int)x, CTRL, 0xf, 0xf, true);
}
__device__ __forceinline__ unsigned group8_max(unsigned v) {
  unsigned o = dpp_mov_u<0xB1>(v); v = o > v ? o : v;
  o = dpp_mov_u<0x4E>(v); v = o > v ? o : v;
  o = dpp_mov_u<0x141>(v); v = o > v ? o : v;
  return v;
}

__device__ __forceinline__ void select_load_keys(const Params& p, int l, int h, char* Ks, int tid) {
#pragma unroll
  for (int ph = 0; ph < 2; ++ph) {
    const float* kbase = p.peer_keys + ((size_t)(l * 8 + h) * 2 + ph) * 128 * 128;
#pragma unroll
    for (int i = 0; i < 4; ++i) {
      const int c = tid + i * NTHREADS, row = c >> 4, kc = c & 15;
      const float4 a = *(const float4*)(kbase + row * 128 + kc * 8), b = *(const float4*)(kbase + row * 128 + kc * 8 + 4);
      uint4 v;
      v.x = pk_bf16(a.x, a.y); v.y = pk_bf16(a.z, a.w); v.z = pk_bf16(b.x, b.y); v.w = pk_bf16(b.z, b.w);
      *(uint4*)(Ks + ph * 32768 + row * 256 + ((kc ^ (row & 15)) << 4)) = v;
    }
  }
}
#define SEL_BAR() { asm volatile("s_waitcnt lgkmcnt(0)" ::: "memory"); __builtin_amdgcn_s_barrier(); asm volatile("" ::: "memory"); }
__device__ __forceinline__ void select_qload(const Params& p, int tb, int h, int ph, int tid, uint4& q0, uint4& q1) {
  const bf16_t* Qg = peerQ(p);
  { const int c = tid, row = c >> 4, kc = c & 15; q0 = *(const uint4*)(Qg + (size_t)(tb * 64 + row) * 2048 + h * 256 + ph * 128 + kc * 8); }
  { const int c = tid + NTHREADS, row = c >> 4, kc = c & 15; q1 = *(const uint4*)(Qg + (size_t)(tb * 64 + row) * 2048 + h * 256 + ph * 128 + kc * 8); }
}
__device__ __forceinline__ void select_tile(const Params& p, int tb, int tbn, int h, char* smem, int tid, uint4& q0, uint4& q1) {
  const int tok0 = tb * 64;
  char* Ks = smem;
  char* Qs = smem + 65536;
  float* Sc = (float*)(smem + 81920);
  unsigned* tops = (unsigned*)(smem + 115712);
  const unsigned char* cand = (const unsigned char*)(smem + SEL_CAND_OFF);
  const int lane = tid & 63, w = tid >> 6, l15 = lane & 15, lq = lane >> 4;
  const int tok = tid >> 3, g = tid & 7;
#pragma unroll
  for (int ph = 0; ph < 2; ++ph) {
    { const int c = tid, row = c >> 4, kc = c & 15; *(uint4*)(Qs + row * 256 + ((kc ^ (row & 15)) << 4)) = q0; }
    { const int c = tid + NTHREADS, row = c >> 4, kc = c & 15; *(uint4*)(Qs + row * 256 + ((kc ^ (row & 15)) << 4)) = q1; }
    if (ph == 0) select_qload(p, tb, h, 1, tid, q0, q1); else select_qload(p, tbn, h, 0, tid, q0, q1);
    SEL_BAR();
    {
      f32x4 acc[4];
#pragma unroll
      for (int j = 0; j < 4; ++j) acc[j] = f32x4{0.f, 0.f, 0.f, 0.f};
#pragma unroll
      for (int ks = 0; ks < 4; ++ks) {
        const int koff = ((ks * 4 + lq) ^ l15) << 4;
        bf16x8 af = *(const bf16x8*)(Ks + ph * 32768 + (16 * w + l15) * 256 + koff);
#pragma unroll
        for (int j = 0; j < 4; ++j) {
          bf16x8 bfr = *(const bf16x8*)(Qs + (16 * j + l15) * 256 + koff);
          acc[j] = __builtin_amdgcn_mfma_f32_16x16x32_bf16(af, bfr, acc[j], 0, 0, 0);
        }
      }
#pragma unroll
      for (int j = 0; j < 4; ++j)
        *(float4*)(Sc + (16 * j + l15) * 132 + 16 * w + lq * 4) = make_float4(acc[j][0], acc[j][1], acc[j][2], acc[j][3]);
    }
    SEL_BAR();
    {
      unsigned lst[16];
      const float* sr = Sc + tok * 132 + g * 16;
#pragma unroll
      for (int q4 = 0; q4 < 4; ++q4) {
        float4 v = *(const float4*)(sr + q4 * 4);
        const unsigned base = 127u - (unsigned)(g * 16 + q4 * 4);
        lst[q4 * 4 + 0] = (f2ord(v.x) & ~127u) | (base);
        lst[q4 * 4 + 1] = (f2ord(v.y) & ~127u) | (base - 1);
        lst[q4 * 4 + 2] = (f2ord(v.z) & ~127u) | (base - 2);
        lst[q4 * 4 + 3] = (f2ord(v.w) & ~127u) | (base - 3);
      }
      sort_desc<16>(lst);
      unsigned* tp = tops + (tok * 2 + ph) * 16;
#pragma unroll
      for (int it = 0; it < 16; ++it) {
        const unsigned mx = group8_max(lst[0]);
        const bool own = lst[0] == mx;
#pragma unroll
        for (int k = 0; k < 15; ++k) lst[k] = own ? lst[k + 1] : lst[k];
        lst[15] = own ? 0u : lst[15];
        if (g == 0) tp[it] = mx;
      }
    }
  }
  SEL_BAR();
  {
    const unsigned* t0 = tops + (tok * 2) * 16;
    const unsigned* t1 = t0 + 16;
    unsigned lst[8];
#pragma unroll
    for (int s_ = 0; s_ < 7; ++s_) {
      const unsigned c = cand[g + 8 * s_];
      unsigned key = 0u;
      if (c != 0xff) {
        const float sc = ord2f(t0[c >> 4] & ~127u) + ord2f(t1[c & 15] & ~127u);
        key = (f2ord(sc) & ~63u) | (63u - (unsigned)(g + 8 * s_));
      }
      lst[s_] = key;
    }
    lst[7] = 0u;
    sort_desc<8>(lst);
    float bs[16]; unsigned bc[16];
#pragma unroll
    for (int it = 0; it < 16; ++it) {
      const unsigned mx = group8_max(lst[0]);
      const bool own = lst[0] == mx;
#pragma unroll
      for (int k = 0; k < 7; ++k) lst[k] = own ? lst[k + 1] : lst[k];
      lst[7] = own ? 0u : lst[7];
      bs[it] = ord2f(mx & ~63u);
      bc[it] = 63u - (mx & 63u);
    }
    const float mx0 = bs[0];
    float sum = 0.f;
#pragma unroll
    for (int it = 0; it < 16; ++it) { bs[it] = FEXP(bs[it] - mx0); sum += bs[it]; }
    const float inv = 1.0f / sum;
    int* oi = sel2i(p) + ((size_t)(tok0 + tok) * 8 + h) * 16;
    float* og = sel2g(p) + ((size_t)(tok0 + tok) * 8 + h) * 16;
#pragma unroll
    for (int it = 0; it < 16; ++it) {
      if ((it & 7) == g) {
        const unsigned c = cand[bc[it]];
        const unsigned i0 = 127u - (t0[c >> 4] & 127u), i1 = 127u - (t1[c & 15] & 127u);
        oi[it] = (int)(i0 * 128 + i1);
        og[it] = bs[it] * inv;
      }
    }
  }
  SEL_BAR();
}

__device__ __forceinline__ void select_phase(const Params& p, int l, int nr, char* smem, int wave_s) {
  const int ntb = nr / 64, nb = gridDim.x;
  int cur_h = -1;
  { const int tid = make_tid(wave_s); if (tid < 56) smem[SEL_CAND_OFF + tid] = (char)PEER_CAND[tid]; }
  if (nb % 8 == 0) {
    const int bph = nb / 8, h = blockIdx.x / bph;
    uint4 q0, q1;
    {
      const int tid = make_tid(wave_s);
      select_qload(p, min((int)(blockIdx.x % bph), ntb - 1), h, 0, tid, q0, q1);
    }
    for (int tb = blockIdx.x % bph; tb < ntb; tb += bph) {
      const int tid = make_tid(wave_s);
      if (cur_h != h) { select_load_keys(p, l, h, smem, tid); cur_h = h; }
      select_tile(p, tb, min(tb + bph, ntb - 1), h, smem, tid, q0, q1);
    }
  } else {
    for (int t = blockIdx.x; t < ntb * 8; t += nb) {
      const int tid = make_tid(wave_s);
      const int h = t & 7;
      __syncthreads();
      select_load_keys(p, l, h, smem, tid);
      uint4 q0, q1;
      select_qload(p, t >> 3, h, 0, tid, q0, q1);
      select_tile(p, t >> 3, t >> 3, h, smem, tid, q0, q1);
    }
  }
}

__device__ __forceinline__ float dot16_fp8(const float (&x)[16], uint4 u, float acc) {
  f32x2v t;
  t = __builtin_amdgcn_cvt_pk_f32_fp8(u.x, false); acc += x[0] * t[0]; acc += x[1] * t[1];
  t = __builtin_amdgcn_cvt_pk_f32_fp8(u.x, true);  acc += x[2] * t[0]; acc += x[3] * t[1];
  t = __builtin_amdgcn_cvt_pk_f32_fp8(u.y, false); acc += x[4] * t[0]; acc += x[5] * t[1];
  t = __builtin_amdgcn_cvt_pk_f32_fp8(u.y, true);  acc += x[6] * t[0]; acc += x[7] * t[1];
  t = __builtin_amdgcn_cvt_pk_f32_fp8(u.z, false); acc += x[8] * t[0]; acc += x[9] * t[1];
  t = __builtin_amdgcn_cvt_pk_f32_fp8(u.z, true);  acc += x[10] * t[0]; acc += x[11] * t[1];
  t = __builtin_amdgcn_cvt_pk_f32_fp8(u.w, false); acc += x[12] * t[0]; acc += x[13] * t[1];
  t = __builtin_amdgcn_cvt_pk_f32_fp8(u.w, true);  acc += x[14] * t[0]; acc += x[15] * t[1];
  return acc;
}
__device__ __forceinline__ void axpy16_fp8(float c, uint4 v, float (&acc)[16]) {
  f32x2v t;
  t = __builtin_amdgcn_cvt_pk_f32_fp8(v.x, false); acc[0] += c * t[0]; acc[1] += c * t[1];
  t = __builtin_amdgcn_cvt_pk_f32_fp8(v.x, true);  acc[2] += c * t[0]; acc[3] += c * t[1];
  t = __builtin_amdgcn_cvt_pk_f32_fp8(v.y, false); acc[4] += c * t[0]; acc[5] += c * t[1];
  t = __builtin_amdgcn_cvt_pk_f32_fp8(v.y, true);  acc[6] += c * t[0]; acc[7] += c * t[1];
  t = __builtin_amdgcn_cvt_pk_f32_fp8(v.z, false); acc[8] += c * t[0]; acc[9] += c * t[1];
  t = __builtin_amdgcn_cvt_pk_f32_fp8(v.z, true);  acc[10] += c * t[0]; acc[11] += c * t[1];
  t = __builtin_amdgcn_cvt_pk_f32_fp8(v.w, false); acc[12] += c * t[0]; acc[13] += c * t[1];
  t = __builtin_amdgcn_cvt_pk_f32_fp8(v.w, true);  acc[14] += c * t[0]; acc[15] += c * t[1];
}
__device__ __forceinline__ f32x2v fma2(f32x2v a, f32x2v b, f32x2v c) { return __builtin_elementwise_fma(a, b, c); }
__device__ __forceinline__ float dot16p_fp8(const f32x2v (&x)[8], uint4 u) {
  f32x2v a = x[0] * __builtin_amdgcn_cvt_pk_f32_fp8(u.x, false);
  a = fma2(x[1], __builtin_amdgcn_cvt_pk_f32_fp8(u.x, true), a);
  a = fma2(x[2], __builtin_amdgcn_cvt_pk_f32_fp8(u.y, false), a);
  a = fma2(x[3], __builtin_amdgcn_cvt_pk_f32_fp8(u.y, true), a);
  a = fma2(x[4], __builtin_amdgcn_cvt_pk_f32_fp8(u.z, false), a);
  a = fma2(x[5], __builtin_amdgcn_cvt_pk_f32_fp8(u.z, true), a);
  a = fma2(x[6], __builtin_amdgcn_cvt_pk_f32_fp8(u.w, false), a);
  a = fma2(x[7], __builtin_amdgcn_cvt_pk_f32_fp8(u.w, true), a);
  return a[0] + a[1];
}
__device__ __forceinline__ void axpy16p_fp8(float c, uint4 v, f32x2v (&acc)[8]) {
  const f32x2v c2 = {c, c};
  acc[0] = fma2(c2, __builtin_amdgcn_cvt_pk_f32_fp8(v.x, false), acc[0]);
  acc[1] = fma2(c2, __builtin_amdgcn_cvt_pk_f32_fp8(v.x, true), acc[1]);
  acc[2] = fma2(c2, __builtin_amdgcn_cvt_pk_f32_fp8(v.y, false), acc[2]);
  acc[3] = fma2(c2, __builtin_amdgcn_cvt_pk_f32_fp8(v.y, true), acc[3]);
  acc[4] = fma2(c2, __builtin_amdgcn_cvt_pk_f32_fp8(v.z, false), acc[4]);
  acc[5] = fma2(c2, __builtin_amdgcn_cvt_pk_f32_fp8(v.z, true), acc[5]);
  acc[6] = fma2(c2, __builtin_amdgcn_cvt_pk_f32_fp8(v.w, false), acc[6]);
  acc[7] = fma2(c2, __builtin_amdgcn_cvt_pk_f32_fp8(v.w, true), acc[7]);
}
__device__ __forceinline__ f32x2v bf2_to_f2(unsigned w) {
  f32x2v r; r[0] = __builtin_bit_cast(float, w << 16); r[1] = __builtin_bit_cast(float, w & 0xffff0000u); return r;
}
typedef __attribute__((ext_vector_type(4))) float f32x4u;
typedef __attribute__((ext_vector_type(2))) long i64x2u;
struct UPre { int idxA, idxB; float gA, gB; i64x2u xh; };
__device__ __forceinline__ void u_load_pre(const Params& p, int row, int lane, UPre& P) {
  P.idxA = sel2i(p)[(size_t)row * 128 + lane]; P.idxB = sel2i(p)[(size_t)row * 128 + 64 + lane];
  P.gA = sel2g(p)[(size_t)row * 128 + lane]; P.gB = sel2g(p)[(size_t)row * 128 + 64 + lane];
  P.xh = *(const i64x2u*)(xqbuf(p) + (size_t)row * 1024 + lane * 16);
}
__device__ __forceinline__ float trace_dot(i64x2u u, i64x2u xh, bool b0, bool b1, bool ondiag) {
  const f32x4u z = {0.f, 0.f, 0.f, 0.f};
  f32x4u a0 = __builtin_amdgcn_mfma_f32_16x16x32_fp8_fp8(u[0], xh[0], z, 0, 0, 0);
  a0 = __builtin_amdgcn_mfma_f32_16x16x32_fp8_fp8(u[1], xh[1], a0, 0, 0, 0);
  const float t01 = b0 ? a0[1] : a0[0], t23 = b0 ? a0[3] : a0[2];
  const float t = b1 ? t23 : t01;
  return ondiag ? t : 0.f;
}
__device__ __forceinline__ float gelu_as(float x) {
  const float z = fabsf(x) * 0.70710678118654752f;
  const float t = __builtin_amdgcn_rcpf(fmaf(0.3275911f, z, 1.0f));
  float q = fmaf(1.061405429f, t, -1.453152027f);
  q = fmaf(q, t, 1.421413741f); q = fmaf(q, t, -0.284496736f); q = fmaf(q, t, 0.254829592f);
  const float e = 1.0f - q * t * __builtin_amdgcn_exp2f(-1.4426950408889634f * z * z);
  return 0.5f * x * (1.0f + copysignf(e, x));
}
__device__ __forceinline__ void u_gather(const unsigned char* TBu, const int2* L, int lane, int b0, int cnt, i64x2u (&ub)[16]) {
  const int2 ent = L[min(b0 + (lane & 15), max(cnt - 1, 0))];
#pragma unroll
  for (int qd = 0; qd < 4; ++qd) {
    if (qd == 0 || b0 + 4 * qd < cnt) {
#pragma unroll
      for (int e = 4 * qd; e < 4 * qd + 4; ++e) {
        const int ie = __builtin_amdgcn_readlane(ent.x, e) & 0x3fff;
        ub[e] = *(const i64x2u*)(TBu + (size_t)ie * 1024 + lane * 16);
      }
    }
  }
}
__device__ __forceinline__ void u_dots(const int2* L, int lane, int b0, int cnt, const i64x2u (&ub)[16], i64x2u xh, float* cfr) {
  const bool db0 = lane & 1, db1 = lane & 2, ondiag = ((lane >> 2) & 3) == (lane >> 4);
  float d[16];
#pragma unroll
  for (int qd = 0; qd < 4; ++qd) {
    if (qd == 0 || b0 + 4 * qd < cnt) {
#pragma unroll
      for (int e = 4 * qd; e < 4 * qd + 4; ++e) d[e] = trace_dot(ub[e], xh, db0, db1, ondiag);
    } else {
#pragma unroll
      for (int e = 4 * qd; e < 4 * qd + 4; ++e) d[e] = 0.f;
    }
  }
  float r8[8], r4[4], r2[2], r1;
  {
    const bool up = lane & 32;
#pragma unroll
    for (int i = 0; i < 8; ++i) { float snd = up ? d[i] : d[i + 8]; float kp = up ? d[i + 8] : d[i]; r8[i] = kp + __shfl_xor(snd, 32); }
  }
  {
    const bool up = lane & 16;
#pragma unroll
    for (int i = 0; i < 4; ++i) { float snd = up ? r8[i] : r8[i + 4]; float kp = up ? r8[i + 4] : r8[i]; r4[i] = kp + __shfl_xor(snd, 16); }
  }
  {
    const bool up = lane & 8;
#pragma unroll
    for (int i = 0; i < 2; ++i) { float snd = up ? r4[i] : r4[i + 2]; float kp = up ? r4[i + 2] : r4[i]; r2[i] = kp + __shfl_xor(snd, 8); }
  }
  {
    const bool up = lane & 4;
    float snd = up ? r2[0] : r2[1]; float kp = up ? r2[1] : r2[0];
    r1 = kp + __shfl_xor(snd, 4);
  }
  r1 += dppx<0xB1>(r1);
  r1 += dppx<0x4E>(r1);
  r1 *= (1.0f / (U8_SCALE * XQ_SCALE));
  const int my_e = ((lane & 32) ? 8 : 0) + ((lane & 16) ? 4 : 0) + ((lane & 8) ? 2 : 0) + ((lane & 4) ? 1 : 0);
  const int pos = b0 + my_e;
  const int2 e2 = L[min(pos, max(cnt - 1, 0))];
  const float coef = __builtin_bit_cast(float, e2.y) * gelu_as(r1) * (1.0f / V8_SCALE);
  if (pos < cnt && (lane & 3) == 0) cfr[e2.x >> 16] = coef;
}
__device__ __forceinline__ int u_compact(const UPre& P, int2* L, int lane, int part) {
  const int idxA = P.idxA, idxB = P.idxB; const float gA = P.gA, gB = P.gB;
  const bool mA = (idxA >> 11) == part, mB = (idxB >> 11) == part;
  const unsigned long long maskA = __ballot(mA), maskB = __ballot(mB);
  const int cntA = __popcll(maskA), cnt = cntA + __popcll(maskB);
  const int rnkA = (int)__builtin_amdgcn_mbcnt_hi((unsigned)(maskA >> 32), __builtin_amdgcn_mbcnt_lo((unsigned)maskA, 0u));
  const int rnkB = cntA + (int)__builtin_amdgcn_mbcnt_hi((unsigned)(maskB >> 32), __builtin_amdgcn_mbcnt_lo((unsigned)maskB, 0u));
  if (mA) L[rnkA] = make_int2(idxA | (lane << 16), __builtin_bit_cast(int, gA));
  if (mB) L[rnkB] = make_int2(idxB | ((lane + 64) << 16), __builtin_bit_cast(int, gB));
  return cnt;
}
__device__ __forceinline__ void u_pair(const Params& p, const unsigned char* TBu, char* W, int lane, int unA, int unB, int total,
                                       int sh, bool even, int prowA_next, int prowB_next, UPre& PA, UPre& PB) {
  int2* LA = (int2*)W; int2* LB = (int2*)(W + 1024);
  const int cntA = u_compact(PA, LA, lane, even ? (int)(blockIdx.x & 7) : (unA & 7));
  const int cntB = (unB < total) ? u_compact(PB, LB, lane, even ? (int)(blockIdx.x & 7) : (unB & 7)) : 0;
  const i64x2u xhA = PA.xh, xhB = PB.xh;
  float* cfA = coefb(p) + (size_t)(unA >> sh) * 128;
  float* cfB = coefb(p) + (size_t)(min(unB, total - 1) >> sh) * 128;
  i64x2u ubA[16], ubB[16];
  for (int b0 = ((cntA - 1) >> 4) << 4; b0 >= 32; b0 -= 16) { u_gather(TBu, LA, lane, b0, cntA, ubA); u_dots(LA, lane, b0, cntA, ubA, xhA, cfA); }
  for (int b0 = ((cntB - 1) >> 4) << 4; b0 >= 32; b0 -= 16) { u_gather(TBu, LB, lane, b0, cntB, ubB); u_dots(LB, lane, b0, cntB, ubB, xhB, cfB); }
  if (cntA > 16 || cntB > 16) {
    if (cntA > 16) u_gather(TBu, LA, lane, 16, cntA, ubA);
    if (cntB > 16) u_gather(TBu, LB, lane, 16, cntB, ubB);
    __builtin_amdgcn_sched_barrier(0);
    if (cntA > 16) u_dots(LA, lane, 16, cntA, ubA, xhA, cfA);
    if (cntB > 16) u_dots(LB, lane, 16, cntB, ubB, xhB, cfB);
  }
  u_gather(TBu, LA, lane, 0, cntA, ubA);
  u_gather(TBu, LB, lane, 0, cntB, ubB);
  __builtin_amdgcn_sched_barrier(0);
  u_load_pre(p, prowA_next, lane, PA);
  u_load_pre(p, prowB_next, lane, PB);
  __builtin_amdgcn_sched_barrier(0);
  u_dots(LA, lane, 0, cntA, ubA, xhA, cfA);
  u_dots(LB, lane, 0, cntB, ubB, xhB, cfB);
}
__device__ __forceinline__ void expert_u_phase(const Params& p, int l, int nr, int wave_s, char* smem) {
  const unsigned char* TBu = (const unsigned char*)p.TB();
  char* W = smem + wave_s * 2048;
  const int nb = gridDim.x;
  const bool even = (nb & 7) == 0;
  const int sh = even ? 0 : 3;
  const int total = nr << sh;
  const int stride = (even ? (nb >> 3) : nb) * 8;
  int un = (even ? (int)(blockIdx.x >> 3) : (int)blockIdx.x) * 8 + wave_s;
  UPre P0, P1, P2, P3;
  {
    const int lane = make_tid(wave_s) & 63;
    u_load_pre(p, min(un, total - 1) >> sh, lane, P0);
    u_load_pre(p, min(un + stride, total - 1) >> sh, lane, P1);
    u_load_pre(p, min(un + 2 * stride, total - 1) >> sh, lane, P2);
    u_load_pre(p, min(un + 3 * stride, total - 1) >> sh, lane, P3);
  }
  while (un < total) {
    {
      const int lane = make_tid(wave_s) & 63;
      u_pair(p, TBu, W, lane, un, un + stride, total, sh, even,
             min(un + 4 * stride, total - 1) >> sh, min(un + 5 * stride, total - 1) >> sh, P0, P1);
    }
    un += 2 * stride;
    if (un >= total) break;
    {
      const int lane = make_tid(wave_s) & 63;
      u_pair(p, TBu, W, lane, un, un + stride, total, sh, even,
             min(un + 4 * stride, total - 1) >> sh, min(un + 5 * stride, total - 1) >> sh, P2, P3);
    }
    un += 2 * stride;
  }
}

#define VLOAD(buf_, idxv_, base_) _Pragma("unroll") for (int e = 0; e < 16; ++e) { \
    const int ie = __builtin_amdgcn_readlane(idxv_, (base_) + e); buf_[e] = *(const uint4*)(TBv + (size_t)ie * 1024 + lane * 16); }
#define VAXPY(buf_, cfv_, base_) _Pragma("unroll") for (int e = 0; e < 16; ++e) { \
    const float c = __builtin_bit_cast(float, __builtin_amdgcn_readlane(__builtin_bit_cast(int, cfv_), (base_) + e)); axpy16p_fp8(c, buf_[e], acc2); }
__device__ __forceinline__ void expert_phase(const Params& p, int l, int nr, int wave_s) {
  const unsigned char* TBv = (const unsigned char*)p.TB() + (size_t)16384 * 1024;
  for (int row = blockIdx.x * 8 + wave_s; row < nr; row += gridDim.x * 8) {
    const int lane = make_tid(wave_s) & 63;
    const int* idxr = sel2i(p) + (size_t)row * 128;
    const float* cfr = coefb(p) + (size_t)row * 128;
    const int iA = idxr[lane], iB = idxr[64 + lane];
    const float cA = cfr[lane], cB = cfr[64 + lane];
    f32x2v acc2[8];
#pragma unroll
    for (int i = 0; i < 8; ++i) { acc2[i][0] = 0.f; acc2[i][1] = 0.f; }
    uint4 va[16], vb[16];
    VLOAD(va, iA, 0)
    VLOAD(vb, iA, 16) LOAD_FENCE(); VAXPY(va, cA, 0)
    VLOAD(va, iA, 32) LOAD_FENCE(); VAXPY(vb, cA, 16)
    VLOAD(vb, iA, 48) LOAD_FENCE(); VAXPY(va, cA, 32)
    VLOAD(va, iB, 0)  LOAD_FENCE(); VAXPY(vb, cA, 48)
    VLOAD(vb, iB, 16) LOAD_FENCE(); VAXPY(va, cB, 0)
    VLOAD(va, iB, 32) LOAD_FENCE(); VAXPY(vb, cB, 16)
    VLOAD(vb, iB, 48) LOAD_FENCE(); VAXPY(va, cB, 32)
    LOAD_FENCE(); VAXPY(vb, cB, 48)
    float acc[16];
#pragma unroll
    for (int i = 0; i < 8; ++i) { acc[2 * i] = acc2[i][0]; acc[2 * i + 1] = acc2[i][1]; }
    const float* m = p.mod() + ((size_t)l * NMODV + modv_of_row(row)) * 6144;
    float hx[16], g[16], bb[16];
    float* hd = hdst_row(p, row);
    ldrow16_f32(hd, lane, hx);
    ldrow16_f32(m + 5120, lane, g);
#pragma unroll
    for (int i = 0; i < 16; ++i) { asm volatile("" : "+v"(acc[i])); hx[i] = fmaf(g[i], acc[i], DN_ALPHA * hx[i]); }
    float mean, rstd;
    row_ln_stats(hx, mean, rstd);
    ldrow16_f32(p.ln_ffn_g + l * DM, lane, g); ldrow16_f32(p.ln_ffn_b + l * DM, lane, bb);
#pragma unroll
    for (int i = 0; i < 16; ++i) hx[i] = (hx[i] - mean) * rstd * g[i] + bb[i];
    strow16_f32(hd, lane, hx);
    if (l == 0) {
      const float* m1 = p.mod() + ((size_t)1 * NMODV + modv_of_row(row)) * 6144;
      row_ln_stats(hx, mean, rstd);
      ldrow16_f32(m1 + 1024, lane, g); ldrow16_f32(m1, lane, bb);
#pragma unroll
      for (int i = 0; i < 16; ++i) hx[i] = (hx[i] - mean) * rstd * (1.0f + g[i]) + bb[i];
      strow16_bf16(p.Y() + (size_t)row * DM, lane, hx);
    }
  }
}

#define VS_UNIT(un_, row_, tb_) { const int uc_ = min((un_), total - 1); row_ = uc_ >> sh; \
    tb_ = TBv + (size_t)__builtin_amdgcn_readfirstlane(even ? (int)(blockIdx.x & 7) : (uc_ & 7)) * ((size_t)16384 * 128); }
  \
#define VS_IDX(ie_, row_) { const int4* ir_ = (const int4*)(sel2i(p) + (size_t)(row_) * 128 + g * 16); \
    _Pragma("unroll") for (int q = 0; q < 4; ++q) { const int4 t_ = ir_[q]; ie_[4 * q] = t_.x; ie_[4 * q + 1] = t_.y; ie_[4 * q + 2] = t_.z; ie_[4 * q + 3] = t_.w; } }
#define VS_ROWS(v_, ce_, ie_, row_, tb_) { const float4* cr_ = (const float4*)(coefb(p) + (size_t)(row_) * 128 + g * 16); \
    _Pragma("unroll") for (int e = 0; e < 16; ++e) v_[e] = *(const uint4*)((tb_) + (size_t)(unsigned)(ie_[e] * 128 + ch * 16)); \
    _Pragma("unroll") for (int q = 0; q < 4; ++q) { const float4 t_ = cr_[q]; ce_[4 * q] = t_.x; ce_[4 * q + 1] = t_.y; ce_[4 * q + 2] = t_.z; ce_[4 * q + 3] = t_.w; } }
#define VS_SUM(v_, ce_, un_, row_, tb_) if ((un_) < total) { \
    float* hp_ = hdst_row(p, row_) + (((tb_) - TBv) >> 14) + ch * 16 + 2 * g;     \
    const float* mp_ = p.mod() + ((size_t)l * NMODV + modv_of_row(row_)) * 6144 + 5120 + (((tb_) - TBv) >> 14) + ch * 16 + 2 * g; \
    const float2 h2_ = *(const float2*)hp_; const float2 g2_ = *(const float2*)mp_; \
    f32x2v acc2[8]; \
    _Pragma("unroll") for (int i = 0; i < 8; ++i) { acc2[i][0] = 0.f; acc2[i][1] = 0.f; } \
    _Pragma("unroll") for (int e = 0; e < 16; ++e) axpy16p_fp8(ce_[e], v_[e], acc2); \
    float s8_[8], t4_[4]; \
    _Pragma("unroll") for (int i = 0; i < 8; ++i) { float x_ = (i < 4) ? acc2[i >> 1][i & 1] : acc2[i >> 1][i & 1]; float y_ = acc2[(i + 8) >> 1][i & 1]; \
      asm volatile("s_nop 1\n\tv_permlane32_swap_b32 %0, %1" : "+v"(x_), "+v"(y_)); s8_[i] = x_ + y_; } \
    _Pragma("unroll") for (int i = 0; i < 4; ++i) { float x_ = s8_[i], y_ = s8_[i + 4]; \
      asm volatile("s_nop 1\n\tv_permlane16_swap_b32 %0, %1" : "+v"(x_), "+v"(y_)); t4_[i] = x_ + y_; } \
    const bool b3_ = (lane & 8) != 0; \
    const float k0_ = b3_ ? t4_[2] : t4_[0], k1_ = b3_ ? t4_[3] : t4_[1]; \
    const float d0_ = b3_ ? t4_[0] : t4_[2], d1_ = b3_ ? t4_[1] : t4_[3]; \
    const float r0_ = k0_ + dppx<0x128>(d0_), r1_ = k1_ + dppx<0x128>(d1_);     \
    float2 o_; o_.x = fmaf(g2_.x, r0_, DN_ALPHA * h2_.x); o_.y = fmaf(g2_.y, r1_, DN_ALPHA * h2_.y); \
    *(float2*)hp_ = o_; }
__device__ __forceinline__ void expert_v_sliced(const Params& p, int l, int nr, int wave_s) {
  const unsigned char* TBv = (const unsigned char*)p.TB() + (size_t)16384 * 1024;
  const int nb = gridDim.x;
  const bool even = (nb & 7) == 0;
  const int sh = even ? 0 : 3;
  const int total = nr << sh;
  const int stride = (even ? (nb >> 3) : nb) * 8;
  int un = (even ? (int)(blockIdx.x >> 3) : (int)blockIdx.x) * 8 + wave_s;
  if (un >= total) return;
  const int lane = make_tid(wave_s) & 63, g = lane >> 3, ch = lane & 7;
  int ia[16], ib[16];
  float ca[16], cb[16];
  uint4 va[16], vb[16];
  int rowa, rowb;
  const unsigned char* tba;
  const unsigned char* tbb;
  VS_UNIT(un, rowa, tba)
  VS_IDX(ia, rowa)
  VS_UNIT(un + stride, rowb, tbb)
  VS_IDX(ib, rowb)
  VS_ROWS(va, ca, ia, rowa, tba)
  for (;;) {
    VS_ROWS(vb, cb, ib, rowb, tbb)
    { int r2; const unsigned char* t2; VS_UNIT(un + 2 * stride, r2, t2) VS_IDX(ia, r2)
      __builtin_amdgcn_sched_barrier(0);
      VS_SUM(va, ca, un, rowa, tba)
      rowa = r2; tba = t2; }
    un += stride;
    if (un >= total) break;
    VS_ROWS(va, ca, ia, rowa, tba)
    { int r2; const unsigned char* t2; VS_UNIT(un + 2 * stride, r2, t2) VS_IDX(ib, r2)
      __builtin_amdgcn_sched_barrier(0);
      VS_SUM(vb, cb, un, rowb, tbb)
      rowb = r2; tbb = t2; }
    un += stride;
    if (un >= total) break;
  }
}
#undef VS_UNIT
#undef VS_IDX
#undef VS_ROWS
#undef VS_SUM
__device__ __forceinline__ void ffn_tail_phase(const Params& p, int l, int nr, int wave_s) {
  for (int row = blockIdx.x * 8 + wave_s; row < nr; row += gridDim.x * 8) {
    const int lane = make_tid(wave_s) & 63;
    float hx[16], g[16], bb[16];
    float* hd = hdst_row(p, row);
    ldrow16_f32(hd, lane, hx);
    float mean, rstd;
    row_ln_stats(hx, mean, rstd);
    ldrow16_f32(p.ln_ffn_g + l * DM, lane, g); ldrow16_f32(p.ln_ffn_b + l * DM, lane, bb);
#pragma unroll
    for (int i = 0; i < 16; ++i) hx[i] = (hx[i] - mean) * rstd * g[i] + bb[i];
    strow16_f32(hd, lane, hx);
    if (l == 0) {
      const float* m1 = p.mod() + ((size_t)1 * NMODV + modv_of_row(row)) * 6144;
      row_ln_stats(hx, mean, rstd);
      ldrow16_f32(m1 + 1024, lane, g); ldrow16_f32(m1, lane, bb);
#pragma unroll
      for (int i = 0; i < 16; ++i) hx[i] = (hx[i] - mean) * rstd * (1.0f + g[i]) + bb[i];
      strow16_bf16(p.Y() + (size_t)row * DM, lane, hx);
    }
  }
}

__device__ __forceinline__ float reduce32(float x) {
  x += dppx<0xB1>(x);
  x += dppx<0x4E>(x);
  x += dppx<0x141>(x);
  x += dppx<0x140>(x);
  float a = x, b = x;
  asm volatile("s_nop 1\n\tv_permlane16_swap_b32 %0, %1" : "+v"(a), "+v"(b));
  return a + b;
}

__device__ __forceinline__ float reduce16(float x) {
  x += dppx<0xB1>(x);
  x += dppx<0x4E>(x);
  x += dppx<0x141>(x);
  x += dppx<0x140>(x);
  return x;
}

__device__ __forceinline__ float wsum(float x) {
  x = reduce16(x);
  float a = x, b = x;
  asm volatile("s_nop 1\n\tv_permlane16_swap_b32 %0, %1" : "+v"(a), "+v"(b));
  x = a + b; a = x; b = x;
  asm volatile("s_nop 1\n\tv_permlane32_swap_b32 %0, %1" : "+v"(a), "+v"(b));
  return a + b;
}

__device__ __forceinline__ void fast_rwprep(const Params& p, int l, char* smem, int wave_s) {
  int tid = make_tid(wave_s);
  float* Cv = (float*)smem;
  const float* mu = p.rwkv_mu + (size_t)l * 2 * 1152;
  const int c = tid & 255, tg = tid >> 8, lane = tid & 63, h = c >> 6;
  for (int tile = blockIdx.x; tile < NTOK / 16; tile += gridDim.x) {
    const int r0 = tile * 16;
#pragma unroll
    for (int q = 0; q < 5; ++q) {
      const int idx = tid + q * NTHREADS;
      if (idx < 16 * 144) {
        const int tk = idx / 144, ch = idx - tk * 144, col = ch * 8;
        const int row = r0 + tk;
        int t, len; seq_pos(row, t, len);
        const bf16_t* src = p.P() + (size_t)row * INC + OFF_B + col;
        const uint4 zero4 = make_uint4(0u, 0u, 0u, 0u);
        const uint4 cu = *(const uint4*)src;
        const uint4 pu = t > 0 ? *(const uint4*)(src - INC) : zero4;
        const uint4 nu = t < len - 1 ? *(const uint4*)(src + INC) : zero4;
        float xc[8], xp[8], xn[8], m0[8], m1[8];
        unpack8(cu, xc); unpack8(pu, xp); unpack8(nu, xn);
        *(float4*)m0 = *(const float4*)(mu + col); *(float4*)(m0 + 4) = *(const float4*)(mu + col + 4);
        *(float4*)m1 = *(const float4*)(mu + 1152 + col); *(float4*)(m1 + 4) = *(const float4*)(mu + 1152 + col + 4);
        float o[8];
#pragma unroll
        for (int e = 0; e < 8; ++e) {
          float v = xc[e] * (1.0f - m0[e] - m1[e]) + xp[e] * m0[e] + xn[e] * m1[e];
          if (col >= 768 && col < 896) v = tanhf_(v);
          else if (col >= 1024) v = sigmoidf_(v);
          o[e] = v;
        }
        *(float4*)(Cv + tk * 1152 + col) = make_float4(o[0], o[1], o[2], o[3]);
        *(float4*)(Cv + tk * 1152 + col + 4) = make_float4(o[4], o[5], o[6], o[7]);
      }
    }
    __syncthreads();
    float aw0[8], aw1[8], aa0[8], aa1[8], ag[8];
#pragma unroll
    for (int t = 0; t < 8; ++t) { aw0[t] = 0.f; aw1[t] = 0.f; aa0[t] = 0.f; aa1[t] = 0.f; ag[t] = 0.f; }
    const float* cvb = Cv + (tg * 8) * 1152;
    const float* w2a = p.rwkv_w2 + (size_t)(l * 2 + 0) * 64 * 256 + c;
    const float* w2b = p.rwkv_w2 + (size_t)(l * 2 + 1) * 64 * 256 + c;
    const float* a2a = p.rwkv_a2 + (size_t)(l * 2 + 0) * 64 * 256 + c;
    const float* a2b = p.rwkv_a2 + (size_t)(l * 2 + 1) * 64 * 256 + c;
    const float* g2p = p.rwkv_g2 + (size_t)l * 128 * 256 + c;
    for (int rr = 0; rr < 64; rr += 4) {
      float wa[4], wb[4], xa[4], xb[4];
#pragma unroll
      for (int q = 0; q < 4; ++q) { wa[q] = w2a[(rr + q) * 256]; wb[q] = w2b[(rr + q) * 256]; xa[q] = a2a[(rr + q) * 256]; xb[q] = a2b[(rr + q) * 256]; }
#pragma unroll
      for (int t = 0; t < 8; ++t) {
        float4 d0 = *(const float4*)(cvb + t * 1152 + 768 + rr), d1 = *(const float4*)(cvb + t * 1152 + 832 + rr);
        float4 e0 = *(const float4*)(cvb + t * 1152 + 896 + rr), e1 = *(const float4*)(cvb + t * 1152 + 960 + rr);
        aw0[t] += d0.x * wa[0] + d0.y * wa[1] + d0.z * wa[2] + d0.w * wa[3];
        aw1[t] += d1.x * wb[0] + d1.y * wb[1] + d1.z * wb[2] + d1.w * wb[3];
        aa0[t] += e0.x * xa[0] + e0.y * xa[1] + e0.z * xa[2] + e0.w * xa[3];
        aa1[t] += e1.x * xb[0] + e1.y * xb[1] + e1.z * xb[2] + e1.w * xb[3];
      }
    }
    for (int rr = 0; rr < 128; rr += 4) {
      float gg[4];
#pragma unroll
      for (int q = 0; q < 4; ++q) gg[q] = g2p[(rr + q) * 256];
#pragma unroll
      for (int t = 0; t < 8; ++t) {
        float4 d0 = *(const float4*)(cvb + t * 1152 + 1024 + rr);
        ag[t] += d0.x * gg[0] + d0.y * gg[1] + d0.z * gg[2] + d0.w * gg[3];
      }
    }
    const float w00 = p.rwkv_w0[(l * 2 + 0) * 256 + c], w01 = p.rwkv_w0[(l * 2 + 1) * 256 + c];
    const float a00 = p.rwkv_a0[(l * 2 + 0) * 256 + c], a01 = p.rwkv_a0[(l * 2 + 1) * 256 + c];
    const float kkc = p.rwkv_kk[l * 256 + c], kac = p.rwkv_ka[l * 256 + c], rkc = p.rwkv_rk[l * 256 + c];
#pragma unroll
    for (int t = 0; t < 8; ++t) {
      const int row = r0 + tg * 8 + t;
      const float r = cvb[t * 1152 + c], k = cvb[t * 1152 + 256 + c], v = cvb[t * 1152 + 512 + c];
      const float wd0 = FEXP(-sigmoidf_(w00 + aw0[t]) * 0.6065306597126334f);
      const float wd1 = FEXP(-sigmoidf_(w01 + aw1[t]) * 0.6065306597126334f);
      const float ad0 = sigmoidf_(a00 + aa0[t]), ad1 = sigmoidf_(a01 + aa1[t]);
      const float kr = k * kkc;
      const float kk = kr * (1.0f / sqrtf(wsum(kr * kr) + 1e-6f));
      const float kd0 = k * (1.0f + (ad0 - 1.0f) * kac), kd1 = k * (1.0f + (ad1 - 1.0f) * kac);
      const float ka0 = kk * ad0, ka1 = kk * ad1;
      const float c10 = wsum(kd0 * r), c20 = wsum(ka0 * r), c11 = wsum(kd1 * r), c21 = wsum(ka1 * r);
      const float bonus = wsum(r * (kd0 + kd1) * rkc);
      float* rec = p.RW() + ((size_t)row * 4 + h) * RWREC;
      rec[lane] = kk; rec[64 + lane] = v;
      rec[128 + lane] = wd0 * r; rec[192 + lane] = wd0; rec[256 + lane] = kd0; rec[320 + lane] = ka0;
      rec[384 + lane] = wd1 * r; rec[448 + lane] = wd1; rec[512 + lane] = kd1; rec[576 + lane] = ka1;
      if (lane == 0) { *(float4*)(rec + 640) = make_float4(c10, c20, bonus, 0.f); *(float4*)(rec + 644) = make_float4(c11, c21, 0.f, 0.f); }
      p.G16()[(size_t)row * 256 + c] = f2bf(ag[t]);
    }
    __syncthreads();
  }
}

__device__ __forceinline__ void fast_gdprep(const Params& p, int l, int wave_s) {
  int tid = make_tid(wave_s);
  const int c = tid & 255, lane = tid & 63, h = c >> 6, tg = tid >> 8;
  const float* cw = p.gdn_conv + (size_t)l * 3 * 768;
  float w0[3], w1[3], w2[3];
#pragma unroll
  for (int j = 0; j < 3; ++j) { w0[j] = cw[j * 256 + c]; w1[j] = cw[768 + j * 256 + c]; w2[j] = cw[1536 + j * 256 + c]; }
  for (int r0 = blockIdx.x * 8; r0 < NTOK; r0 += gridDim.x * 8) {
    float raw[4][3][3];
#pragma unroll
    for (int i = 0; i < 4; ++i) {
      const int row = r0 + tg * 4 + i;
      int t, len; seq_pos(row, t, len);
#pragma unroll
      for (int j = 0; j < 3; ++j) {
        const bf16_t* src = p.P() + (size_t)row * INC + OFF_C + j * 256 + c;
        raw[i][j][1] = bf2f(src[0]);
        raw[i][j][0] = t > 0 ? bf2f(src[-INC]) : 0.f;
        raw[i][j][2] = t < len - 1 ? bf2f(src[INC]) : 0.f;
      }
    }
#pragma unroll
    for (int i = 0; i < 4; ++i) {
      const int row = r0 + tg * 4 + i;
      float qkv[3];
#pragma unroll
      for (int j = 0; j < 3; ++j) qkv[j] = siluf_(raw[i][j][0] * w0[j] + raw[i][j][1] * w1[j] + raw[i][j][2] * w2[j]);
      const float qn = qkv[0] * FRSQ(wsum(qkv[0] * qkv[0]) + 1e-6f) * 0.125f;
      const float kn = qkv[1] * FRSQ(wsum(qkv[1] * qkv[1]) + 1e-6f);
      const float qk = wsum(qn * kn);
      float* rec = p.GP() + ((size_t)row * 4 + h) * GDREC;
      rec[lane] = qn; rec[64 + lane] = kn; rec[128 + lane] = qkv[2];
      if (lane < 2) {
        const int d = lane;
        const bf16_t* ab = p.P() + (size_t)row * INC + OFF_C + 1024;
        const float la = -FEXP(p.gdn_a_log[(l * 2 + d) * 4 + h]) * softplusf_(bf2f(ab[d * 4 + h]) + p.gdn_dt_bias[(l * 2 + d) * 4 + h]);
        *(float4*)(rec + 192 + d * 4) = make_float4(FEXP(la), sigmoidf_(bf2f(ab[8 + d * 4 + h])), qk, 0.f);
      }
    }
  }
}

constexpr int SCH = 16;
template <bool RWKV>
__device__ __forceinline__ void scan_pair(const Params& p, bool last, int task0, char* smem, int tid) {
  constexpr int STEPF = RWKV ? 340 : 148;
  constexpr int NF4 = STEPF / 4;
  constexpr int NLD = (SCH * NF4 + 255) / 256;
  const int hb = tid >> 8, ht = tid & 255;
  const int task = task0 + hb, chain = task >> 2, qr = task & 3;
  const int d = chain / (NB * 4), b = (chain / 4) % NB, h = chain % 4;
  const int v0 = qr * 16;
  float* buf = (float*)(smem + hb * 45056);
  float* ybuf = buf + 2 * SCH * STEPF;
  const int rl = ht >> 4, seg = ht & 15;
  const float* recbase = RWKV ? p.RW() : p.GP();
  constexpr int REC = RWKV ? RWREC : GDREC;
  float S0 = 0.f, S1 = 0.f, S2 = 0.f, S3 = 0.f;
  float4 st0, st1, st2, st3, st4, st5;
  const int nch = (NCX + NTL) / SCH;
#define SCAN_LOAD1(ch, q, dst)                                                                         \
  if ((q) < NLD) {                                                                                     \
    int idx = ht + (q) * 256;                                                                          \
    if (idx < SCH * NF4) {                                                                             \
      int i = idx / NF4, e4 = idx - i * NF4;                                                           \
      int row = scan_row(b, d, (ch) * SCH + i);                                                        \
      const float* rec = recbase + ((size_t)row * 4 + h) * REC;                                        \
      int off;                                                                                         \
      if (RWKV) off = e4 < 16 ? e4 * 4 : (e4 < 80 ? 128 + d * 256 + (e4 - 16) * 4 : (e4 < 84 ? 64 + v0 + (e4 - 80) * 4 : 640 + d * 4)); \
      else off = e4 < 16 ? 64 + e4 * 4 : (e4 < 32 ? (e4 - 16) * 4 : (e4 < 36 ? 128 + v0 + (e4 - 32) * 4 : 192 + d * 4)); \
      dst = *(const float4*)(rec + off);                                                               \
    }                                                                                                  \
  }
#define SCAN_LOAD(ch) { SCAN_LOAD1(ch, 0, st0) SCAN_LOAD1(ch, 1, st1) SCAN_LOAD1(ch, 2, st2) SCAN_LOAD1(ch, 3, st3) SCAN_LOAD1(ch, 4, st4) SCAN_LOAD1(ch, 5, st5) }
#define SCAN_STORE1(bi, q, srcv)                                                                       \
  if ((q) < NLD) {                                                                                     \
    int idx = ht + (q) * 256;                                                                          \
    if (idx < SCH * NF4) *(float4*)(buf + (bi) * SCH * STEPF + idx * 4) = srcv;                        \
  }
#define SCAN_STORE(bi) { SCAN_STORE1(bi, 0, st0) SCAN_STORE1(bi, 1, st1) SCAN_STORE1(bi, 2, st2) SCAN_STORE1(bi, 3, st3) SCAN_STORE1(bi, 4, st4) SCAN_STORE1(bi, 5, st5) }
  SCAN_LOAD(0); SCAN_STORE(0);
  __syncthreads();
  for (int ch = 0; ch < nch; ++ch) {
    const int cur = ch & 1;
    if (ch + 1 < nch) SCAN_LOAD(ch + 1);
    const float* sb = buf + cur * SCH * STEPF;
    float yk = 0.f;
    if (RWKV) {
      float4 kkA, wrA, wA, kdA, kaA, kkB, wrB, wB, kdB, kaB; float2 ccA, ccB; float vA, vB;
#define RW_LD(sp, X) { kk##X = *(const float4*)((sp) + seg * 4); wr##X = *(const float4*)((sp) + 64 + seg * 4); w##X = *(const float4*)((sp) + 128 + seg * 4); \
        kd##X = *(const float4*)((sp) + 192 + seg * 4); ka##X = *(const float4*)((sp) + 256 + seg * 4); v##X = (sp)[320 + rl]; cc##X = *(const float2*)((sp) + 336); }
#define RW_STEP(X, i) { float sa = (S0 * kk##X.x + S1 * kk##X.y) + (S2 * kk##X.z + S3 * kk##X.w); float z = (S0 * wr##X.x + S1 * wr##X.y) + (S2 * wr##X.z + S3 * wr##X.w); \
        sa = reduce16(sa); z = reduce16(z); \
        S0 = S0 * w##X.x + (v##X * kd##X.x - sa * ka##X.x); S1 = S1 * w##X.y + (v##X * kd##X.y - sa * ka##X.y); \
        S2 = S2 * w##X.z + (v##X * kd##X.z - sa * ka##X.z); S3 = S3 * w##X.w + (v##X * kd##X.w - sa * ka##X.w); \
        const float y_ = z + v##X * cc##X.x - sa * cc##X.y; yk = (seg == (i)) ? y_ : yk; }
      RW_LD(sb, A);
#pragma unroll 1
      for (int i = 0; i < SCH; i += 2) {
        RW_LD(sb + (i + 1) * STEPF, B);
        RW_STEP(A, i);
        if (i + 2 < SCH) RW_LD(sb + (i + 2) * STEPF, A);
        RW_STEP(B, i + 1);
      }
#undef RW_LD
#undef RW_STEP
    } else {
      float4 kA, qA, kB, qB, sA, sB; float vA, vB;
#define GD_LD(sp, X) { k##X = *(const float4*)((sp) + seg * 4); q##X = *(const float4*)((sp) + 64 + seg * 4); v##X = (sp)[128 + rl]; s##X = *(const float4*)((sp) + 144); }
#define GD_STEP(X, i) { float ks = (S0 * k##X.x + S1 * k##X.y) + (S2 * k##X.z + S3 * k##X.w); float qs = (S0 * q##X.x + S1 * q##X.y) + (S2 * q##X.z + S3 * q##X.w); \
        ks = reduce16(ks); qs = reduce16(qs); \
        const float vn = s##X.y * (v##X - s##X.x * ks); \
        S0 = S0 * s##X.x + k##X.x * vn; S1 = S1 * s##X.x + k##X.y * vn; S2 = S2 * s##X.x + k##X.z * vn; S3 = S3 * s##X.x + k##X.w * vn; \
        const float y_ = s##X.x * qs + s##X.z * vn; yk = (seg == (i)) ? y_ : yk; }
      GD_LD(sb, A);
#pragma unroll 1
      for (int i = 0; i < SCH; i += 2) {
        GD_LD(sb + (i + 1) * STEPF, B);
        GD_STEP(A, i);
        if (i + 2 < SCH) GD_LD(sb + (i + 2) * STEPF, A);
        GD_STEP(B, i + 1);
      }
#undef GD_LD
#undef GD_STEP
    }
    ybuf[seg * 16 + rl] = yk;
    __syncthreads();
    {
      const int i = ht >> 4, j = ht & 15;
      const int row = scan_row(b, d, ch * SCH + i);
      if (!(last && row >= NLAT)) p.YS()[(size_t)row * 1024 + (RWKV ? 0 : 512) + d * 256 + h * 64 + v0 + j] = f2bf(ybuf[i * 16 + j]);
    }
    if (ch + 1 < nch) SCAN_STORE(cur ^ 1);
    __syncthreads();
  }
#undef SCAN_LOAD
#undef SCAN_STORE
#undef SCAN_LOAD1
#undef SCAN_STORE1
}
__device__ __forceinline__ int scan_npairs() { return 2 * (2 * NB * 4) * 4 / 2; }
__device__ __forceinline__ void scan_run_pair(const Params& p, bool last, int pair, char* smem, int tid) {
  const int nrw = (2 * NB * 4) * 4;
  const int task0 = pair * 2;
  if (task0 < nrw) scan_pair<true>(p, last, task0, smem, tid);
  else scan_pair<false>(p, last, task0 - nrw, smem, tid);
}

__device__ __forceinline__ void fast_post(const Params& p, int l, int nr, int wave_s) {
  int tid = make_tid(wave_s);
  const int lane = tid & 63;
  for (int row = blockIdx.x * 8 + (tid >> 6); row < nr; row += gridDim.x * 8) {
    const bf16_t* ys = p.YS() + (size_t)row * 1024;
    bf16_t* yo = p.Y() + (size_t)row * DM;
#pragma unroll
    for (int h = 0; h < 4; ++h) {
      const int c = h * 64 + lane;
      {
        const float* rec = p.RW() + ((size_t)row * 4 + h) * RWREC;
        const float y = bf2f(ys[c]) + bf2f(ys[256 + c]);
        const float m = wave_sum(y) * (1.0f / 64);
        const float dd = y - m;
        const float rstd = 1.0f / sqrtf(wave_sum(dd * dd) * (1.0f / 64) + 64e-5f);
        const float yn = dd * rstd * p.rwkv_ln_g[l * 256 + c] + p.rwkv_ln_b[l * 256 + c];
        yo[256 + c] = f2bf((yn + rec[642] * rec[64 + lane]) * bf2f(p.G16()[(size_t)row * 256 + c]));
      }
      {
        const float o = bf2f(ys[512 + c]) + bf2f(ys[768 + c]);
        const float rs = 1.0f / sqrtf(wave_sum(o * o) * (1.0f / 64) + 1e-6f);
        const float gate = bf2f(p.P()[(size_t)row * INC + OFF_C + 768 + c]);
        yo[512 + c] = f2bf(o * rs * p.gdn_norm_g[l * 64 + lane] * siluf_(gate));
      }
    }
  }
}

constexpr int NKEY = NTL + NCX;
__device__ __forceinline__ int key_row(int b, int j) { return j < NTL ? b * NTL + j : NLAT + b * NCX + (j - NTL); }

__device__ __forceinline__ void fast_attprep(const Params& p, char* smem, int wave_s) {
  int tid = make_tid(wave_s);
  for (int it = blockIdx.x * NTHREADS + tid; it < NLAT * 32; it += gridDim.x * NTHREADS) {
    const int token = it >> 5, j = it & 31;
    const int blk = j & 3;
    const int t = token % NTL;
    const int pos = (blk & 1) ? (t & 63) : (t >> 6);
    bf16_t* base = p.P() + (size_t)token * INC + OFF_A + (j >> 4) * 256 + ((j >> 2) & 3) * 64 + blk * 16;
    uint4 a = *(const uint4*)base, b = *(const uint4*)(base + 8);
    float x1[8], x2[8];
    unpack8(a, x1); unpack8(b, x2);
#pragma unroll
    for (int i = 0; i < 8; ++i) {
      const float ang = (float)pos * FEXP(-(float)i * (9.210340371976184f / 8.0f));
      const float cs = FCOS(ang), sn = FSIN(ang);
      const float y1 = x1[i] * cs - x2[i] * sn, y2 = x1[i] * sn + x2[i] * cs;
      x1[i] = y1; x2[i] = y2;
    }
    a.x = pk_bf16(x1[0], x1[1]); a.y = pk_bf16(x1[2], x1[3]); a.z = pk_bf16(x1[4], x1[5]); a.w = pk_bf16(x1[6], x1[7]);
    b.x = pk_bf16(x2[0], x2[1]); b.y = pk_bf16(x2[2], x2[3]); b.z = pk_bf16(x2[4], x2[5]); b.w = pk_bf16(x2[6], x2[7]);
    *(uint4*)base = a; *(uint4*)(base + 8) = b;
  }
  bf16_t* Ts = (bf16_t*)smem;
  const int ntile = NKEY / 64;
  const int nt_all = 2 * NB * 4 * ntile;
#define VT_SRC(tix_) (p.P() + (size_t)key_row((((tix_) % (NB * 4 * ntile)) / ntile) >> 2, (((tix_) % (NB * 4 * ntile)) % ntile) * 64 + (tid >> 3)) * INC \
      + (((tix_) / (NB * 4 * ntile)) ? OFF_D : OFF_A) + 512 + ((((tix_) % (NB * 4 * ntile)) / ntile) & 3) * 64 + (tid & 7) * 8)
  uint4 vnext = make_uint4(0u, 0u, 0u, 0u);
  if ((int)blockIdx.x < nt_all) vnext = *(const uint4*)VT_SRC(min((int)blockIdx.x, nt_all - 1));
  for (int tix = blockIdx.x; tix < nt_all; tix += gridDim.x) {
    const int mixer = tix / (NB * 4 * ntile), rem = tix % (NB * 4 * ntile);
    const int bh = rem / ntile, kt = rem % ntile;
    const uint4 v = vnext;
    {
      const int tn = min(tix + (int)gridDim.x, nt_all - 1);
      vnext = *(const uint4*)VT_SRC(tn);
    }
    {
      const int key = tid >> 3, dc = tid & 7;
      const int pos = (key & 32) | ((key & 12) << 1) | ((key & 16) >> 2) | (key & 3);
      bf16_t e[8];
      *(uint4*)e = v;
#pragma unroll
      for (int i = 0; i < 8; ++i) Ts[(dc * 8 + i) * 72 + pos] = e[i];
    }
    LDS_BAR();
    {
      const int d = tid >> 3, pc = tid & 7;
      const uint4 vv = *(const uint4*)(Ts + d * 72 + pc * 8);
      *(uint4*)(p.VT() + (((size_t)mixer * NB * 4 + bh) * 64 + d) * NKEY + kt * 64 + pc * 8) = vv;
    }
    LDS_BAR();
  }
#undef VT_SRC
}

__device__ __forceinline__ float xmax_16_32(float x) {
  float a = x, b = x;
  asm volatile("s_nop 1\n\tv_permlane16_swap_b32 %0, %1" : "+v"(a), "+v"(b));
  x = fmaxf(a, b); a = x; b = x;
  asm volatile("s_nop 1\n\tv_permlane32_swap_b32 %0, %1" : "+v"(a), "+v"(b));
  return fmaxf(a, b);
}
__device__ __forceinline__ float xsum_16_32(float x) {
  float a = x, b = x;
  asm volatile("s_nop 1\n\tv_permlane16_swap_b32 %0, %1" : "+v"(a), "+v"(b));
  x = a + b; a = x; b = x;
  asm volatile("s_nop 1\n\tv_permlane32_swap_b32 %0, %1" : "+v"(a), "+v"(b));
  return a + b;
}
__device__ __forceinline__ bf16x8 pack_p8(const f32x4& lo, const f32x4& hi) {
  uint4 u;
  u.x = pk_bf16(lo[0], lo[1]); u.y = pk_bf16(lo[2], lo[3]); u.z = pk_bf16(hi[0], hi[1]); u.w = pk_bf16(hi[2], hi[3]);
  return __builtin_bit_cast(bf16x8, u);
}

template <int NQT>
__device__ __forceinline__ void attnA_task(const Params& p, int l, int task, int half, char* smem, int tid) {
  const int nlat_tasks = NB * 4 * (NTL / 256);
  const bool lat = task < nlat_tasks;
  int b, h, qrow0, kt0;
  if (lat) { const int bh = task / (NTL / 256), qb = task % (NTL / 256); b = bh >> 2; h = bh & 3; qrow0 = b * NTL + qb * 256; kt0 = 0; }
  else { const int t2 = task - nlat_tasks; const int bh = t2 / (NCX / 256), qb = t2 % (NCX / 256); b = bh >> 2; h = bh & 3; qrow0 = NLAT + b * NCX + qb * 256; kt0 = NTL / 64; }
  const int nkt = NKEY / 64;
  const int lane = tid & 63, w = tid >> 6, l15 = lane & 15, lq = lane >> 4, sw = l15 & 7;
  char* Ks = smem;
  char* Vs = smem + 16384;
  const float c = 0.17677669529663687f * 1.4426950408889634f;
  bf16x8 qf[2][NQT];
#pragma unroll
  for (int qt = 0; qt < NQT; ++qt)
#pragma unroll
    for (int br = 0; br < 2; ++br)
      qf[br][qt] = *(const bf16x8*)(p.P() + (size_t)(qrow0 + half * 128 + w * (16 * NQT) + qt * 16 + l15) * INC + OFF_A + h * 64 + br * 32 + lq * 8);
  f32x4 O[2][NQT][4];
  float L[2][NQT];
  float m_[2][NQT];
#pragma unroll
  for (int br = 0; br < 2; ++br)
#pragma unroll
    for (int qt = 0; qt < NQT; ++qt) {
      m_[br][qt] = 0.f; L[br][qt] = 0.f;
#pragma unroll
      for (int dt = 0; dt < 4; ++dt) O[br][qt][dt] = f32x4{0.f, 0.f, 0.f, 0.f};
    }
  const int srow = tid >> 3, sch = tid & 7;
  const int soff = srow * 128 + ((sch ^ (srow & 7)) << 4);
  const bf16_t* vtbase = p.VT() + (((size_t)0 * NB * 4 + b * 4 + h) * 64 + srow) * NKEY + sch * 8;
  uint4 rk, rv;
#define ATT_LOAD(kt) { rk = *(const uint4*)(p.P() + (size_t)key_row(b, (kt) * 64 + srow) * INC + OFF_A + 256 + h * 64 + sch * 8); rv = *(const uint4*)(vtbase + (kt) * 64); }
#define ATT_STORE(bi) { *(uint4*)(Ks + (bi) * 8192 + soff) = rk; *(uint4*)(Vs + (bi) * 8192 + soff) = rv; }
  ATT_LOAD(kt0);
  ATT_STORE(0);
  LDS_BAR();
  for (int kt = kt0; kt < nkt; ++kt) {
    const int cur = (kt - kt0) & 1;
    const bool first = kt == kt0;
    if (kt + 1 < nkt) ATT_LOAD(kt + 1);
    const char* kb = Ks + cur * 8192;
    const char* vb = Vs + cur * 8192;
    bf16x8 vf[4][2];
#pragma unroll
    for (int dt = 0; dt < 4; ++dt)
#pragma unroll
      for (int ks = 0; ks < 2; ++ks) vf[dt][ks] = *(const bf16x8*)(vb + (16 * dt + l15) * 128 + (((ks * 4 + lq) ^ sw) << 4));
#pragma unroll
    for (int br = 0; br < 2; ++br) {
      f32x4 S[NQT][4];
      {
        bf16x8 kf[4];
#pragma unroll
        for (int a = 0; a < 4; ++a) kf[a] = *(const bf16x8*)(kb + (16 * a + l15) * 128 + (((br * 4 + lq) ^ sw) << 4));
#pragma unroll
        for (int qt = 0; qt < NQT; ++qt) {
          const float nm = m_[br][qt] * (-1.0f / c);
          const f32x4 ci = f32x4{nm, nm, nm, nm};
#pragma unroll
          for (int a = 0; a < 4; ++a) S[qt][a] = __builtin_amdgcn_mfma_f32_16x16x32_bf16(kf[a], qf[br][qt], ci, 0, 0, 0);
        }
      }
#pragma unroll
      for (int qt = 0; qt < NQT; ++qt)
#pragma unroll
        for (int a = 0; a < 4; ++a) S[qt][a] *= c;
      float mx[NQT];
#pragma unroll
      for (int qt = 0; qt < NQT; ++qt) {
        float m0 = __builtin_elementwise_maximum(__builtin_elementwise_maximum(S[qt][0][0], S[qt][0][1]), S[qt][0][2]);
        m0 = __builtin_elementwise_maximum(__builtin_elementwise_maximum(m0, S[qt][0][3]), S[qt][1][0]);
        m0 = __builtin_elementwise_maximum(__builtin_elementwise_maximum(m0, S[qt][1][1]), S[qt][1][2]);
        m0 = __builtin_elementwise_maximum(__builtin_elementwise_maximum(m0, S[qt][1][3]), S[qt][2][0]);
        m0 = __builtin_elementwise_maximum(__builtin_elementwise_maximum(m0, S[qt][2][1]), S[qt][2][2]);
        m0 = __builtin_elementwise_maximum(__builtin_elementwise_maximum(m0, S[qt][2][3]), S[qt][3][0]);
        m0 = __builtin_elementwise_maximum(__builtin_elementwise_maximum(m0, S[qt][3][1]), S[qt][3][2]);
        mx[qt] = __builtin_elementwise_maximum(m0, S[qt][3][3]);
      }
      bool grow = first;
#pragma unroll
      for (int qt = 0; qt < NQT; ++qt) grow = grow || (mx[qt] > 8.0f);
      if (__any(grow)) {
#pragma unroll
        for (int qt = 0; qt < NQT; ++qt) {
          const float mxx = xmax_16_32(mx[qt]);
          const float d = first ? mxx : fmaxf(mxx, 0.f);
          const float alpha = first ? 1.0f : __builtin_amdgcn_exp2f(-d);
          m_[br][qt] += d;
          L[br][qt] *= alpha;
#pragma unroll
          for (int dt = 0; dt < 4; ++dt) O[br][qt][dt] *= alpha;
#pragma unroll
          for (int a = 0; a < 4; ++a) S[qt][a] -= d;
        }
      }
#pragma unroll
      for (int qt = 0; qt < NQT; ++qt) {
#pragma unroll
        for (int a = 0; a < 4; ++a)
#pragma unroll
          for (int r = 0; r < 4; ++r) S[qt][a][r] = __builtin_amdgcn_exp2f(S[qt][a][r]);
        const bf16x8 p0 = pack_p8(S[qt][0], S[qt][1]), p1 = pack_p8(S[qt][2], S[qt][3]);
#pragma unroll
        for (int dt = 0; dt < 4; ++dt) {
          O[br][qt][dt] = __builtin_amdgcn_mfma_f32_16x16x32_bf16(vf[dt][0], p0, O[br][qt][dt], 0, 0, 0);
          O[br][qt][dt] = __builtin_amdgcn_mfma_f32_16x16x32_bf16(vf[dt][1], p1, O[br][qt][dt], 0, 0, 0);
        }
        L[br][qt] += ((S[qt][0][0] + S[qt][0][1]) + (S[qt][0][2] + S[qt][0][3])) + ((S[qt][1][0] + S[qt][1][1]) + (S[qt][1][2] + S[qt][1][3]))
                   + ((S[qt][2][0] + S[qt][2][1]) + (S[qt][2][2] + S[qt][2][3])) + ((S[qt][3][0] + S[qt][3][1]) + (S[qt][3][2] + S[qt][3][3]));
      }
    }
    if (kt + 1 < nkt) ATT_STORE(cur ^ 1);
    LDS_BAR();
  }
#undef ATT_LOAD
#undef ATT_STORE
  const float* lv = p.diff_lam + l * 128;
  float d01 = 0.f, d23 = 0.f;
#pragma unroll 4
  for (int i = 0; i < 32; ++i) { d01 += lv[i] * lv[32 + i]; d23 += lv[64 + i] * lv[96 + i]; }
  int l2 = l;
  asm volatile("" : "+s"(l2));
  const float lam_init = 0.8f - 0.6f * FEXP(-0.3f * (float)l2);
  const float lam = FEXP(d01) - FEXP(d23) + lam_init;
#pragma unroll
  for (int qt = 0; qt < NQT; ++qt) {
    const float i1 = 1.0f / xsum_16_32(L[0][qt]), i2 = lam / xsum_16_32(L[1][qt]);
    float ss = 0.f;
    f32x4 o[4];
#pragma unroll
    for (int dt = 0; dt < 4; ++dt)
#pragma unroll
      for (int r = 0; r < 4; ++r) { o[dt][r] = O[0][qt][dt][r] * i1 - O[1][qt][dt][r] * i2; ss += o[dt][r] * o[dt][r]; }
    ss = xsum_16_32(ss);
    const float rs = (1.0f / sqrtf(ss * (1.0f / 64) + 1e-6f)) * (1.0f - lam_init);
    bf16_t* yp = p.Y() + (size_t)(qrow0 + half * 128 + w * (16 * NQT) + qt * 16 + l15) * DM + h * 64;
#pragma unroll
    for (int dt = 0; dt < 4; ++dt) {
      const float4 g = *(const float4*)(p.diff_norm_g + l * 64 + dt * 16 + lq * 4);
      uint2 v;
      v.x = pk_bf16(o[dt][0] * rs * g.x, o[dt][1] * rs * g.y);
      v.y = pk_bf16(o[dt][2] * rs * g.z, o[dt][3] * rs * g.w);
      *(uint2*)(yp + dt * 16 + lq * 4) = v;
    }
  }
  LDS_BAR();
}
__device__ __forceinline__ void fast_attnA(const Params& p, int l, char* smem, int wave_s, int vb, int nvb) {
  int tid = make_tid(wave_s);
  const int ntask = NB * 4 * (NTL / 256) + (l == 0 ? NB * 4 * (NCX / 256) : 0);
  for (int t = vb; t < ntask; t += nvb) { const int tid2 = make_tid(wave_s); attnA_task<2>(p, l, t, 0, smem, tid2); }
}

__device__ __forceinline__ void attnD_pair(const Params& p, int l, int pair, char* smem, int tid) {
  const int nlat = NB * 4 * GROWS;
  const int hb = tid >> 8;
  const int task = pair * 2 + hb;
  const bool lat = task < nlat;
  int b, h, qrow0, rq = 0, rs = 0, ntile;
  if (lat) {
    const int bh = task / GROWS; rq = task % GROWS; b = bh >> 2; h = bh & 3;
    qrow0 = b * NTL + rq * 64;
    rs = rq - 4; rs = rs < 0 ? 0 : (rs > GROWS - 8 ? GROWS - 8 : rs);
    ntile = 8 + NCX / 64;
  } else {
    const int t2 = task - nlat; const int bh = t2 / (NCX / 64), sub = t2 % (NCX / 64); b = bh >> 2; h = bh & 3;
    qrow0 = NLAT + b * NCX + sub * 64;
    ntile = NCX / 64;
  }
  const int ht = tid & 255, lane = tid & 63, wq = (tid >> 6) & 3, l15 = lane & 15, lq = lane >> 4, sw = l15 & 7;
  char* Ks = smem + hb * 34816;
  char* Vs = Ks + 16384;
  float* tbl = (float*)(Ks + 32768);
  for (int i = ht; i < 15 * 31; i += 256) tbl[i] = p.nat_rpb[((size_t)l * 4 + h) * 465 + i];
  const float LOG2E = 1.4426950408889634f;
  bf16x8 qf[2];
#pragma unroll
  for (int ks = 0; ks < 2; ++ks)
    qf[ks] = *(const bf16x8*)(p.P() + (size_t)(qrow0 + wq * 16 + l15) * INC + OFF_D + h * 64 + ks * 32 + lq * 8);
  f32x4 O[4];
#pragma unroll
  for (int dt = 0; dt < 4; ++dt) O[dt] = f32x4{0.f, 0.f, 0.f, 0.f};
  float m_ = -1e30f;
  f32x4 Ls = f32x4{0.f, 0.f, 0.f, 0.f};
  const uint4 ones_u = make_uint4(0x3f803f80u, 0x3f803f80u, 0x3f803f80u, 0x3f803f80u);
  const bf16x8 ones8 = __builtin_bit_cast(bf16x8, ones_u);
  const int cq = wq * 16 + l15;
  int cs = cq - 8; cs = cs < 0 ? 0 : (cs > 48 ? 48 : cs);
  const int wqu = __builtin_amdgcn_readfirstlane(wq);
  const int cs_lo = min(max(wqu * 16 - 8, 0), 48), cs_hi = min(max(wqu * 16 + 7, 0), 48);
  const int a_lo = cs_lo >> 4, a_hi = (cs_hi + 15) >> 4;
  const int srow = ht >> 2, sch = (ht & 3) * 2;
  const int soff0 = srow * 128 + ((sch ^ (srow & 7)) << 4), soff1 = srow * 128 + (((sch + 1) ^ (srow & 7)) << 4);
  const bf16_t* vtb = p.VT() + (((size_t)1 * NB * 4 + b * 4 + h) * 64 + srow) * NKEY + sch * 8;
  uint4 rk0, rk1, rv0, rv1;
#define ATD_KEY0(j) (lat ? ((j) < 8 ? (rs + (j)) * 64 : NTL + ((j) - 8) * 64) : NTL + (j) * 64)
#define ATD_LOAD(j) { const int k0_ = ATD_KEY0(j); const bf16_t* kp_ = p.P() + (size_t)key_row(b, k0_ + srow) * INC + OFF_D + 256 + h * 64 + sch * 8; \
    rk0 = *(const uint4*)kp_; rk1 = *(const uint4*)(kp_ + 8); rv0 = *(const uint4*)(vtb + k0_); rv1 = *(const uint4*)(vtb + k0_ + 8); }
#define ATD_STORE(bi) { *(uint4*)(Ks + (bi) * 8192 + soff0) = rk0; *(uint4*)(Ks + (bi) * 8192 + soff1) = rk1; \
    *(uint4*)(Vs + (bi) * 8192 + soff0) = rv0; *(uint4*)(Vs + (bi) * 8192 + soff1) = rv1; }
  ATD_LOAD(0);
  ATD_STORE(0);
  LDS_BAR();
  for (int j = 0; j < ntile; ++j) {
    const int cur = j & 1;
    if (j + 1 < ntile) ATD_LOAD(j + 1);
    const char* kb = Ks + cur * 8192;
    const char* vb = Vs + cur * 8192;
    const bool win = lat && j < 8;
    f32x4 S[4];
#pragma unroll
    for (int a = 0; a < 4; ++a) {
      S[a] = f32x4{0.f, 0.f, 0.f, 0.f};
      if (!win || (a >= a_lo && a <= a_hi)) {
#pragma unroll
        for (int ks = 0; ks < 2; ++ks) {
          const bf16x8 kf = *(const bf16x8*)(kb + (16 * a + l15) * 128 + (((ks * 4 + lq) ^ sw) << 4));
          S[a] = __builtin_amdgcn_mfma_f32_16x16x32_bf16(kf, qf[ks], S[a], 0, 0, 0);
        }
      }
    }
    const float* trow = tbl + (rs + j - rq + 7) * 31 - cq + 15;
    float mx = -1e30f;
#pragma unroll
    for (int a = 0; a < 4; ++a) {
      if (!win || (a >= a_lo && a <= a_hi)) {
#pragma unroll
        for (int r = 0; r < 4; ++r) {
          float v = S[a][r] * (0.125f * LOG2E);
          if (win) {
            const int ck = 16 * a + 4 * lq + r;
            const bool ok = (unsigned)(ck - cs) < 16u;
            v = ok ? v + trow[ok ? ck : cq] * LOG2E : -1e30f;
          }
          S[a][r] = v;
          mx = fmaxf(mx, v);
        }
      }
    }
    if (__any(mx > m_ + 8.0f)) {
      mx = xmax_16_32(mx);
      const float mn = fmaxf(m_, mx);
      const float alpha = __builtin_amdgcn_exp2f(m_ - mn);
      m_ = mn;
      Ls *= alpha;
#pragma unroll
      for (int dt = 0; dt < 4; ++dt) O[dt] *= alpha;
    }
#pragma unroll
    for (int a = 0; a < 4; ++a) {
      if (!win || (a >= a_lo && a <= a_hi)) {
#pragma unroll
        for (int r = 0; r < 4; ++r) S[a][r] = __builtin_amdgcn_exp2f(S[a][r] - m_);
      }
    }
    const bf16x8 p0 = pack_p8(S[0], S[1]), p1 = pack_p8(S[2], S[3]);
    const bool use0 = !win || a_lo <= 1, use1 = !win || a_hi >= 2;
    if (use0) {
#pragma unroll
      for (int dt = 0; dt < 4; ++dt) {
        const bf16x8 v0 = *(const bf16x8*)(vb + (16 * dt + l15) * 128 + (((0 * 4 + lq) ^ sw) << 4));
        O[dt] = __builtin_amdgcn_mfma_f32_16x16x32_bf16(v0, p0, O[dt], 0, 0, 0);
      }
      Ls = __builtin_amdgcn_mfma_f32_16x16x32_bf16(ones8, p0, Ls, 0, 0, 0);
    }
    if (use1) {
#pragma unroll
      for (int dt = 0; dt < 4; ++dt) {
        const bf16x8 v1 = *(const bf16x8*)(vb + (16 * dt + l15) * 128 + (((1 * 4 + lq) ^ sw) << 4));
        O[dt] = __builtin_amdgcn_mfma_f32_16x16x32_bf16(v1, p1, O[dt], 0, 0, 0);
      }
      Ls = __builtin_amdgcn_mfma_f32_16x16x32_bf16(ones8, p1, Ls, 0, 0, 0);
    }
    if (j + 1 < ntile) ATD_STORE(cur ^ 1);
    LDS_BAR();
  }
#undef ATD_KEY0
#undef ATD_LOAD
#undef ATD_STORE
  const float inv = 1.0f / Ls[0];
  bf16_t* yp = p.Y() + (size_t)(qrow0 + wq * 16 + l15) * DM + 768 + h * 64;
#pragma unroll
  for (int dt = 0; dt < 4; ++dt) {
    uint2 v;
    v.x = pk_bf16(O[dt][0] * inv, O[dt][1] * inv);
    v.y = pk_bf16(O[dt][2] * inv, O[dt][3] * inv);
    *(uint2*)(yp + dt * 16 + lq * 4) = v;
  }
  LDS_BAR();
}
__device__ __forceinline__ void fast_attnD(const Params& p, int l, char* smem, int wave_s, int vb, int nvb) {
  int tid = make_tid(wave_s);
  const int npair = (NB * 4 * GROWS + (l == 0 ? NB * 4 * (NCX / 64) : 0)) / 2;
  for (int t = vb; t < npair; t += nvb) { const int tid2 = make_tid(wave_s); attnD_pair(p, l, t, smem, tid2); }
}

__device__ __forceinline__ void fast_ada(const Params& p, char* smem, int wave_s) {
  int tid = make_tid(wave_s);
  float* red = (float*)smem;
  const int jc = tid & 31, ks = tid >> 5;
  for (int t = blockIdx.x; t < 2 * (6144 / 32); t += gridDim.x) {
    const int l = t / (6144 / 32), j = (t % (6144 / 32)) * 32 + jc;
    float acc[NMODV];
#pragma unroll
    for (int v = 0; v < NMODV; ++v) acc[v] = 0.f;
    for (int i = ks * 64; i < ks * 64 + 64; ++i) {
      const float w = p.w_ada[((size_t)l * DM + i) * 6144 + j];
#pragma unroll
      for (int v = 0; v < NB; ++v) acc[v] += siluf_(p.c[v * DM + i]) * w;
      acc[NB] += siluf_(p.c_ctx[i]) * w;
    }
#pragma unroll
    for (int v = 0; v < NMODV; ++v) red[(ks * NMODV + v) * 32 + jc] = acc[v];
    __syncthreads();
    if (tid < NMODV * 32) {
      const int v = tid >> 5;
      float sacc = p.b_ada[l * 6144 + j];
#pragma unroll
      for (int k2 = 0; k2 < 16; ++k2) sacc += red[(k2 * NMODV + v) * 32 + jc];
      p.mod()[((size_t)l * NMODV + v) * 6144 + j] = sacc;
    }
    __syncthreads();
  }
}

constexpr int CL = 16;
constexpr int NCHK = (NTL + NCX) / CL;
constexpr int IMG_KK = 0, IMG_RT = 2048, IMG_TR = 4096, IMG_BK = 6144, IMG_WL = 10240, IMG_VV = 10496, IMG_BYTES = 12544;
__device__ __forceinline__ char* img_ptr(const Params& p, int mixer, int d, int b, int h, int cidx) {
  return (char*)p.RW() + ((size_t)((((mixer * 2 + d) * NB + b) * 4 + h)) * NCHK + cidx) * IMG_BYTES;
}
__device__ __forceinline__ bf16_t* rv16(const Params& p) { return (bf16_t*)((char*)p.RW() + (size_t)2 * 2 * NB * 4 * NCHK * IMG_BYTES); }
__device__ __forceinline__ float* bonbuf(const Params& p) { return (float*)(rv16(p) + (size_t)NTOK * 256); }
constexpr int LORAT_LAYER = 2 * 256 * 64 * 2 + 256 * 128;
__device__ __forceinline__ bf16_t* lorat(const Params& p, int l) { return (bf16_t*)(bonbuf(p) + (size_t)NTOK * 4) + (size_t)l * LORAT_LAYER; }
__device__ __forceinline__ void conv_lora(const Params& p, int wave_s) {
  const int tid = make_tid(wave_s);
  for (int idx = blockIdx.x * NTHREADS + tid; idx < 2 * LORAT_LAYER; idx += gridDim.x * NTHREADS) {
    const int l = idx / LORAT_LAYER, e = idx % LORAT_LAYER;
    float v;
    if (e < 2 * 256 * 64) { const int d = e / (256 * 64), c = (e / 64) % 256, k = e % 64; v = p.rwkv_w2[((size_t)(l * 2 + d) * 64 + k) * 256 + c]; }
    else if (e < 4 * 256 * 64) { const int e2 = e - 2 * 256 * 64; const int d = e2 / (256 * 64), c = (e2 / 64) % 256, k = e2 % 64; v = p.rwkv_a2[((size_t)(l * 2 + d) * 64 + k) * 256 + c]; }
    else { const int e2 = e - 4 * 256 * 64; const int c = e2 / 128, k = e2 % 128; v = p.rwkv_g2[((size_t)l * 128 + k) * 256 + c]; }
    lorat(p, l)[e] = f2bf(v);
  }
}
__device__ __forceinline__ int colp(int pp) { return 16 * (2 * (pp >> 5) + ((pp & 7) >> 2)) + 4 * ((pp >> 3) & 3) + (pp & 3); }
__device__ __forceinline__ int tile_cidx(bool is_ctx, int t0, int d) {
  const int j = t0 >> 4;
  if (is_ctx) return d == 0 ? j : NCX / 16 - 1 - j;
  return NCX / 16 + (d == 0 ? j : NTL / 16 - 1 - j);
}
constexpr int VEC_OFF = 77824;
constexpr int VS = 258;
constexpr int WCS = 65, MS = 17;
constexpr int VEC_W0 = 0, VEC_W1 = 16384, VEC_KK = 32768, VEC_R = VEC_KK + 16 * VS * 2, VEC_B0 = VEC_R + 16 * VS * 2, VEC_B1 = VEC_B0 + 16 * VS * 2,
              VEC_KD0 = VEC_B1 + 16 * VS * 2, VEC_KD1 = VEC_KD0 + 16 * VS * 2;
constexpr int SCR_WC = 0, SCR_T6 = 8192, SCR_MAT = 57344;

template <bool NOWRITE>
__device__ __forceinline__ void chunk_prep_head(const Params& p, int mixer, int b, bool is_ctx, int t0, int h, char* smem, int tid) {
  const char* vec = smem + VEC_OFF;
  float* Wc = (float*)(smem + SCR_WC);
  float* T6 = (float*)(smem + SCR_T6);
  float* MAT = (float*)(smem + SCR_MAT);
  if (tid < 128) {
    const int d = tid >> 6, k = tid & 63;
    const float* wv = (const float*)(vec + (d ? VEC_W1 : VEC_W0));
    float acc = 1.f;
#pragma unroll
    for (int s_ = 0; s_ < 16; ++s_) {
      const int tok = d ? 15 - s_ : s_;
      acc *= wv[tok * 256 + h * 64 + k];
      Wc[(d * 16 + s_) * 64 + k] = acc;
    }
  }
  __syncthreads();
#pragma unroll
  for (int q = 0; q < 4; ++q) {
    const int idx = tid + q * NTHREADS;
    const int d = idx >> 10, s_ = (idx >> 6) & 15, k = idx & 63;
    const int tok = d ? 15 - s_ : s_;
    const int vi = tok * 256 + h * 64 + k;
    const float W = Wc[(d * 16 + s_) * 64 + k];
    const float Wp = s_ ? Wc[(d * 16 + s_ - 1) * 64 + k] : 1.f;
    const float WL = Wc[(d * 16 + 15) * 64 + k];
    const float iW = 1.0f / W;
    const float kk = bf2f(((const bf16_t*)(vec + VEC_KK))[vi]), r = bf2f(((const bf16_t*)(vec + VEC_R))[vi]);
    const float bb = bf2f(((const bf16_t*)(vec + (d ? VEC_B1 : VEC_B0)))[vi]), kd = bf2f(((const bf16_t*)(vec + (d ? VEC_KD1 : VEC_KD0)))[vi]);
    float* t6 = T6 + (size_t)d * 6 * 1024 + s_ * 64 + k;
    t6[0] = kk * Wp; t6[1024] = r * W; t6[2048] = bb * iW; t6[3072] = kd * iW; t6[4096] = bb * (WL * iW); t6[5120] = kd * (WL * iW);
  }
  __syncthreads();
  {
    const int lane = tid & 63, w = tid >> 6, d = w >> 2, mat = w & 3, i = lane & 15, g = lane >> 4;
    const float* X = T6 + (size_t)d * 6 * 1024 + (mat < 2 ? 0 : 1024) + i * 64 + g;
    const float* Yv = T6 + (size_t)d * 6 * 1024 + ((mat & 1) ? 3072 : 2048) + i * 64 + g;
    float xa[16], ya[16];
#pragma unroll
    for (int k4 = 0; k4 < 16; ++k4) { xa[k4] = X[4 * k4]; ya[k4] = Yv[4 * k4]; }
    f32x4 ac4[4];
#pragma unroll
    for (int q = 0; q < 4; ++q) ac4[q] = f32x4{0.f, 0.f, 0.f, 0.f};
#pragma unroll
    for (int k4 = 0; k4 < 16; ++k4) ac4[k4 & 3] = __builtin_amdgcn_mfma_f32_16x16x4f32(xa[k4], ya[k4], ac4[k4 & 3], 0, 0, 0);
    const f32x4 acc = (ac4[0] + ac4[1]) + (ac4[2] + ac4[3]);
#pragma unroll
    for (int r_ = 0; r_ < 4; ++r_) {
      const int s_ = 4 * g + r_;
      const bool keep = mat < 2 ? (i < s_) : (i <= s_);
      MAT[((d * 6 + mat) * 16 + s_) * 16 + i] = keep ? acc[r_] : 0.f;
    }
  }
  __syncthreads();
  {
    const int d = tid >> 8, col = (tid >> 4) & 15, j = tid & 15;
    const float* A = MAT + (d * 6 + 0) * 256 + j;
    float a[16];
#pragma unroll
    for (int i = 0; i < 16; ++i) a[i] = A[i * 16];
    float xj = 0.f;
#pragma unroll
    for (int i = 0; i < 16; ++i) {
      const float part = (j < i) ? a[i] * xj : 0.f;
      const float sum = reduce16(part);
      const float xi = ((i == col) ? 1.f : 0.f) - sum;
      xj = (j == i) ? xi : xj;
    }
    MAT[(d * 6 + 4) * 256 + j * 16 + col] = xj;
  }
  __syncthreads();
  {
    const int d = tid >> 8, s_ = (tid >> 4) & 15, j = tid & 15;
    const float* Ti = MAT + (d * 6 + 4) * 256 + s_ * 16;
    const float* Ak = MAT + (d * 6 + 1) * 256 + j;
    float acc = 0.f;
#pragma unroll
    for (int u = 0; u < 16; ++u) acc += Ti[u] * Ak[u * 16];
    MAT[(d * 6 + 5) * 256 + s_ * 16 + j] = acc;
  }
  __syncthreads();
#pragma unroll
  for (int q = 0; q < 3; ++q) {
    const int idx = tid + q * NTHREADS;
    if (!NOWRITE && idx < 2 * 656) {
      const int d = idx / 656, c = idx - d * 656;
      char* img = img_ptr(p, mixer, d, b, h, tile_cidx(is_ctx, t0, d));
      const float* t6 = T6 + (size_t)d * 6 * 1024;
      const float* mt = MAT + d * 6 * 256;
      if (c < 640) {
        float e[8];
        int off;
        if (c < 256) {
          const int which = c >> 7, cc = c & 127, s_ = cc >> 3, ch = cc & 7;
          const float* src = t6 + which * 1024 + s_ * 64;
#pragma unroll
          for (int e_ = 0; e_ < 8; ++e_) e[e_] = src[colp(ch * 8 + e_)];
          off = (which ? IMG_RT : IMG_KK) + s_ * 128 + ((ch ^ (s_ & 7)) << 4);
        } else if (c < 384) {
          const int cc = c - 256, s_ = cc >> 3, ch = cc & 7, g = ch & 3;
          const float* m0 = mt + (ch < 4 ? 4 : 2) * 256 + s_ * 16 + 4 * g;
          const float* m1 = mt + (ch < 4 ? 5 : 3) * 256 + s_ * 16 + 4 * g;
#pragma unroll
          for (int e_ = 0; e_ < 4; ++e_) { e[e_] = m0[e_]; e[4 + e_] = m1[e_]; }
          off = IMG_TR + s_ * 128 + ((ch ^ (s_ & 7)) << 4);
        } else {
          const int cc = c - 384, kc = cc >> 2, g = cc & 3;
#pragma unroll
          for (int e_ = 0; e_ < 4; ++e_) { e[e_] = t6[4096 + (4 * g + e_) * 64 + kc]; e[4 + e_] = t6[5120 + (4 * g + e_) * 64 + kc]; }
          const int row = kc & 31, ch = (kc >> 5) * 4 + g;
          off = IMG_BK + row * 128 + ((ch ^ (row & 7)) << 4);
        }
        uint4 v;
        v.x = pk_bf16(e[0], e[1]); v.y = pk_bf16(e[2], e[3]); v.z = pk_bf16(e[4], e[5]); v.w = pk_bf16(e[6], e[7]);
        *(uint4*)(img + off) = v;
      } else {
        const int k0 = (c - 640) * 4;
        *(float4*)(img + IMG_WL + k0 * 4) = *(const float4*)(Wc + (d * 16 + 15) * 64 + k0);
      }
    }
  }
  __syncthreads();
}

__device__ __forceinline__ float4 ld4f(const float* q) { return make_float4(q[0], q[1], q[2], q[3]); }
__device__ __forceinline__ f32x4 mm16(const float* X, const float* Y, int i, int g, bool neg_x_plus_eye) {
  f32x4 acc = f32x4{0.f, 0.f, 0.f, 0.f};
#pragma unroll
  for (int k4 = 0; k4 < 4; ++k4) {
    float a = X[i * MS + 4 * k4 + g];
    if (neg_x_plus_eye) a = ((i == 4 * k4 + g) ? 1.f : 0.f) - a;
    const float b = Y[(4 * k4 + g) * MS + i];
    acc = __builtin_amdgcn_mfma_f32_16x16x4f32(a, b, acc, 0, 0, 0);
  }
  return acc;
}
__device__ __forceinline__ void st16(float* M, const f32x4& v, int i, int g) {
#pragma unroll
  for (int r_ = 0; r_ < 4; ++r_) M[(4 * g + r_) * MS + i] = v[r_];
}
__device__ __forceinline__ void chunk_prep_wave(const Params& p, int mixer, int b, bool is_ctx, int t0, char* smem, int tid) {
  const int lane = tid & 63, w = tid >> 6, h = w & 3, d = w >> 2, i = lane & 15, g = lane >> 4;
  const char* vec = smem + VEC_OFF;
  float* Wc = (float*)(smem + w * 9728);
  float* M0 = Wc + 16 * WCS;
  float* M1 = M0 + 16 * MS;
  float* M2 = M1 + 16 * MS;
  float* M3 = M2 + 16 * MS;
  float* M4 = M3 + 16 * MS;
  char* img = img_ptr(p, mixer, d, b, h, tile_cidx(is_ctx, t0, d));
  const float* wv = (const float*)(vec + (d ? VEC_W1 : VEC_W0)) + h * 64;
  const bf16_t* vkk = (const bf16_t*)(vec + VEC_KK) + h * 64;
  const bf16_t* vr = (const bf16_t*)(vec + VEC_R) + h * 64;
  const bf16_t* vb = (const bf16_t*)(vec + (d ? VEC_B1 : VEC_B0)) + h * 64;
  const bf16_t* vkd = (const bf16_t*)(vec + (d ? VEC_KD1 : VEC_KD0)) + h * 64;
  {
    float acc = 1.f;
#pragma unroll
    for (int s_ = 0; s_ < 16; ++s_) {
      const int tok = d ? 15 - s_ : s_;
      acc *= wv[tok * 256 + lane];
      Wc[s_ * WCS + lane] = acc;
    }
  }
  {
    const int tok = d ? 15 - i : i;
    float KKT[16], RT[16], BT[16], KDT[16];
#pragma unroll
    for (int k4 = 0; k4 < 16; ++k4) {
      const int k = 4 * k4 + g;
      const float W = Wc[i * WCS + k];
      const float Wp = i ? Wc[(i - 1) * WCS + k] : 1.f;
      const float iW = __builtin_amdgcn_rcpf(W);
      KKT[k4] = bf2f(vkk[tok * VS + k]) * Wp;
      RT[k4] = bf2f(vr[tok * VS + k]) * W;
      BT[k4] = bf2f(vb[tok * VS + k]) * iW;
      KDT[k4] = bf2f(vkd[tok * VS + k]) * iW;
    }
    f32x4 aab = f32x4{0.f, 0.f, 0.f, 0.f}, aak = aab, rbb = aab, rkk = aab;
#pragma unroll
    for (int k4 = 0; k4 < 16; ++k4) {
      aab = __builtin_amdgcn_mfma_f32_16x16x4f32(KKT[k4], BT[k4], aab, 0, 0, 0);
      aak = __builtin_amdgcn_mfma_f32_16x16x4f32(KKT[k4], KDT[k4], aak, 0, 0, 0);
      rbb = __builtin_amdgcn_mfma_f32_16x16x4f32(RT[k4], BT[k4], rbb, 0, 0, 0);
      rkk = __builtin_amdgcn_mfma_f32_16x16x4f32(RT[k4], KDT[k4], rkk, 0, 0, 0);
    }
#pragma unroll
    for (int r_ = 0; r_ < 4; ++r_) {
      const int s_ = 4 * g + r_;
      const bool st = i < s_, inc = i <= s_;
      M0[s_ * MS + i] = st ? aab[r_] : 0.f;
      M1[s_ * MS + i] = st ? aak[r_] : 0.f;
      M2[s_ * MS + i] = inc ? rbb[r_] : 0.f;
      M3[s_ * MS + i] = inc ? rkk[r_] : 0.f;
    }
  }
  {
    const int s_ = lane >> 2, gg = lane & 3;
    const float4 x0 = ld4f(M2 + s_ * MS + 4 * gg), x1 = ld4f(M3 + s_ * MS + 4 * gg);
    uint4 v;
    v.x = pk_bf16(x0.x, x0.y); v.y = pk_bf16(x0.z, x0.w); v.z = pk_bf16(x1.x, x1.y); v.w = pk_bf16(x1.z, x1.w);
    *(uint4*)(img + IMG_TR + s_ * 128 + (((4 + gg) ^ (s_ & 7)) << 4)) = v;
  }
  {
    f32x4 P;
#pragma unroll
    for (int r_ = 0; r_ < 4; ++r_) { const int s_ = 4 * g + r_; P[r_] = ((s_ == i) ? 1.f : 0.f) - M0[s_ * MS + i]; }
    f32x4 X2 = mm16(M0, M0, i, g, false);
    st16(M2, X2, i, g);
    st16(M3, P, i, g);
    P += mm16(M3, M2, i, g, false);
    f32x4 X4 = mm16(M2, M2, i, g, false);
    st16(M4, X4, i, g);
    st16(M3, P, i, g);
    P += mm16(M3, M4, i, g, false);
    f32x4 X8 = mm16(M4, M4, i, g, false);
    st16(M2, X8, i, g);
    st16(M3, P, i, g);
    P += mm16(M3, M2, i, g, false);
    st16(M3, P, i, g);
    f32x4 Mm = mm16(M3, M1, i, g, false);
    st16(M2, Mm, i, g);
  }
  {
    const int s_ = lane >> 2, gg = lane & 3;
    const float4 x0 = ld4f(M3 + s_ * MS + 4 * gg), x1 = ld4f(M2 + s_ * MS + 4 * gg);
    uint4 v;
    v.x = pk_bf16(x0.x, x0.y); v.y = pk_bf16(x0.z, x0.w); v.z = pk_bf16(x1.x, x1.y); v.w = pk_bf16(x1.z, x1.w);
    *(uint4*)(img + IMG_TR + s_ * 128 + ((gg ^ (s_ & 7)) << 4)) = v;
  }
#pragma unroll
  for (int q = 0; q < 2; ++q) {
    const int cc = lane + 64 * q, s_ = cc >> 3, ch = cc & 7;
    const int tok = d ? 15 - s_ : s_;
    float ek[8], er[8];
#pragma unroll
    for (int e_ = 0; e_ < 8; ++e_) {
      const int k = colp(ch * 8 + e_);
      const float W = Wc[s_ * WCS + k];
      const float Wp = s_ ? Wc[(s_ - 1) * WCS + k] : 1.f;
      ek[e_] = bf2f(vkk[tok * VS + k]) * Wp;
      er[e_] = bf2f(vr[tok * VS + k]) * W;
    }
    uint4 v;
    v.x = pk_bf16(ek[0], ek[1]); v.y = pk_bf16(ek[2], ek[3]); v.z = pk_bf16(ek[4], ek[5]); v.w = pk_bf16(ek[6], ek[7]);
    *(uint4*)(img + IMG_KK + s_ * 128 + ((ch ^ (s_ & 7)) << 4)) = v;
    v.x = pk_bf16(er[0], er[1]); v.y = pk_bf16(er[2], er[3]); v.z = pk_bf16(er[4], er[5]); v.w = pk_bf16(er[6], er[7]);
    *(uint4*)(img + IMG_RT + s_ * 128 + ((ch ^ (s_ & 7)) << 4)) = v;
  }
#pragma unroll
  for (int q = 0; q < 4; ++q) {
    const int cc = lane + 64 * q, kc = cc >> 2, gg = cc & 3;
    const float WL = Wc[15 * WCS + kc];
    float e[8];
#pragma unroll
    for (int e_ = 0; e_ < 4; ++e_) {
      const int s_ = 4 * gg + e_, tok = d ? 15 - s_ : s_;
      const float f = WL * __builtin_amdgcn_rcpf(Wc[s_ * WCS + kc]);
      e[e_] = bf2f(vb[tok * VS + kc]) * f;
      e[4 + e_] = bf2f(vkd[tok * VS + kc]) * f;
    }
    const int row = kc & 31, ch = (kc >> 5) * 4 + gg;
    uint4 v;
    v.x = pk_bf16(e[0], e[1]); v.y = pk_bf16(e[2], e[3]); v.z = pk_bf16(e[4], e[5]); v.w = pk_bf16(e[6], e[7]);
    *(uint4*)(img + IMG_BK + row * 128 + ((ch ^ (row & 7)) << 4)) = v;
  }
  if (lane < 16) *(float4*)(img + IMG_WL + lane * 16) = ld4f(Wc + 15 * WCS + lane * 4);
}

constexpr int CVS = 1156;
__device__ __forceinline__ bf16x8 cv_frag(const float* q) {
  const float4 a = *(const float4*)q, b = *(const float4*)(q + 4);
  uint4 u; u.x = pk_bf16(a.x, a.y); u.y = pk_bf16(a.z, a.w); u.z = pk_bf16(b.x, b.y); u.w = pk_bf16(b.z, b.w);
  return __builtin_bit_cast(bf16x8, u);
}
struct RwFill { uint4 cu, pu, nu; float4 m0a, m0b, m1a, m1b; };
__device__ __forceinline__ void rw_fill_load(const Params& p, const float* mu, int r0, int tk, int ch, RwFill& f) {
  const int col = ch * 8;
  const int row = r0 + tk;
  int t, len; seq_pos(row, t, len);
  const bf16_t* src = p.P() + (size_t)row * INC + OFF_B + col;
  const uint4 zero4 = make_uint4(0u, 0u, 0u, 0u);
  f.cu = *(const uint4*)src;
  const bool hp = t > 0, hn = t < len - 1;
  const uint4 pu = *(const uint4*)(src - (hp ? INC : 0)), nu = *(const uint4*)(src + (hn ? INC : 0));
  f.pu = hp ? pu : zero4;
  f.nu = hn ? nu : zero4;
  f.m0a = *(const float4*)(mu + col); f.m0b = *(const float4*)(mu + col + 4);
  f.m1a = *(const float4*)(mu + 1152 + col); f.m1b = *(const float4*)(mu + 1152 + col + 4);
}
template <int ACT>
__device__ __forceinline__ void rw_fill_store(float* Cv, int tk, int ch, const RwFill& f) {
  const int col = ch * 8;
  float xc[8], xp[8], xn[8];
  unpack8(f.cu, xc); unpack8(f.pu, xp); unpack8(f.nu, xn);
  const float m0[8] = {f.m0a.x, f.m0a.y, f.m0a.z, f.m0a.w, f.m0b.x, f.m0b.y, f.m0b.z, f.m0b.w};
  const float m1[8] = {f.m1a.x, f.m1a.y, f.m1a.z, f.m1a.w, f.m1b.x, f.m1b.y, f.m1b.z, f.m1b.w};
  float o[8];
#pragma unroll
  for (int e = 0; e < 8; ++e) {
    float v = xc[e] * (1.0f - m0[e] - m1[e]) + xp[e] * m0[e] + xn[e] * m1[e];
    if (ACT == 1) v = tanhf_(v);
    if (ACT == 2) v = sigmoidf_(v);
    o[e] = v;
  }
  *(float4*)(Cv + tk * CVS + col) = make_float4(o[0], o[1], o[2], o[3]);
  *(float4*)(Cv + tk * CVS + col + 4) = make_float4(o[4], o[5], o[6], o[7]);
}
template <int RPM = 0>
__device__ __forceinline__ void chunk_rwprep(const Params& p, int l, char* smem, int wave_s) {
  const int tid0 = make_tid(wave_s);
  float* Cv = (float*)smem;
  char* vec = smem + VEC_OFF;
  const float* mu = p.rwkv_mu + (size_t)l * 2 * 1152;
  const bf16_t* LT = lorat(p, l);
  for (int tile = blockIdx.x; tile < NTOK / 16; tile += gridDim.x) {
    int tid = tid0; asm volatile("" : "+v"(tid));
    const int lane = tid & 63, w = tid >> 6, h = w & 3, i = lane & 15, g = lane >> 4;
    const int r0 = tile * 16;
    const bool is_ctx = r0 >= NLAT;
    const int b = is_ctx ? (r0 - NLAT) / NCX : r0 / NTL;
    const int t0 = is_ctx ? (r0 - NLAT) % NCX : r0 % NTL;
    {
      const int wu = __builtin_amdgcn_readfirstlane(tid >> 6);
      const int cidx = tid & 255;
      const int tkA = cidx >> 4, chA = (wu < 4 ? 96 : 128) + (cidx & 15);
      int tkP[4], chP[4];
#pragma unroll
      for (int q = 0; q < 4; ++q) { const int idx = min(tid + q * NTHREADS, 1791); tkP[q] = idx / 112; const int c = idx - tkP[q] * 112; chP[q] = c < 96 ? c : c + 16; }
      RwFill fa, f0, f1, f2, f3;
      rw_fill_load(p, mu, r0, tkA, chA, fa);
      rw_fill_load(p, mu, r0, tkP[0], chP[0], f0); rw_fill_load(p, mu, r0, tkP[1], chP[1], f1);
      rw_fill_load(p, mu, r0, tkP[2], chP[2], f2); rw_fill_load(p, mu, r0, tkP[3], chP[3], f3);
      __builtin_amdgcn_sched_barrier(0);
      if (wu < 4) rw_fill_store<1>(Cv, tkA, chA, fa); else rw_fill_store<2>(Cv, tkA, chA, fa);
      rw_fill_store<0>(Cv, tkP[0], chP[0], f0); rw_fill_store<0>(Cv, tkP[1], chP[1], f1);
      rw_fill_store<0>(Cv, tkP[2], chP[2], f2);
      if (wu < 4) rw_fill_store<0>(Cv, tkP[3], chP[3], f3);
    }
    const bool gate_wave = __builtin_amdgcn_readfirstlane(tid >> 6) >= 4;
    LDS_BAR();
    __builtin_amdgcn_sched_barrier(0);
    if (gate_wave) {
      f32x4 ag[4];
#pragma unroll
      for (int nt = 0; nt < 4; ++nt) ag[nt] = f32x4{0.f, 0.f, 0.f, 0.f};
      bf16x8 lf[16];
#pragma unroll
      for (int ks = 0; ks < 4; ++ks)
#pragma unroll
        for (int nt = 0; nt < 4; ++nt)
          lf[ks * 4 + nt] = *(const bf16x8*)(LT + 4 * 256 * 64 + (size_t)(h * 64 + nt * 16 + i) * 128 + ks * 32 + g * 8);
      __builtin_amdgcn_sched_barrier(0);
#pragma unroll
      for (int ks = 0; ks < 4; ++ks) {
        const bf16x8 af = cv_frag(Cv + i * CVS + 1024 + ks * 32 + g * 8);
#pragma unroll
        for (int nt = 0; nt < 4; ++nt) {
          ag[nt] = __builtin_amdgcn_mfma_f32_16x16x32_bf16(af, lf[ks * 4 + nt], ag[nt], 0, 0, 0);
        }
      }
#pragma unroll
      for (int nt = 0; nt < 4; ++nt)
#pragma unroll
        for (int r_ = 0; r_ < 4; ++r_) p.G16()[(size_t)(r0 + 4 * g + r_) * 256 + h * 64 + nt * 16 + i] = f2bf(ag[nt][r_]);
    } else {
      f32x4 aw0[4], aw1[4], aa0[4], aa1[4];
#pragma unroll
      for (int nt = 0; nt < 4; ++nt) { aw0[nt] = f32x4{0.f, 0.f, 0.f, 0.f}; aw1[nt] = aw0[nt]; aa0[nt] = aw0[nt]; aa1[nt] = aw0[nt]; }
#pragma unroll
      for (int ks = 0; ks < 2; ++ks) {
        bf16x8 lf[16];
#pragma unroll
        for (int nt = 0; nt < 4; ++nt) {
          const size_t co = (size_t)(h * 64 + nt * 16 + i) * 64 + ks * 32 + g * 8;
          lf[nt * 4 + 0] = *(const bf16x8*)(LT + co);
          lf[nt * 4 + 1] = *(const bf16x8*)(LT + 256 * 64 + co);
          lf[nt * 4 + 2] = *(const bf16x8*)(LT + 2 * 256 * 64 + co);
          lf[nt * 4 + 3] = *(const bf16x8*)(LT + 3 * 256 * 64 + co);
        }
        __builtin_amdgcn_sched_barrier(0);
        const bf16x8 fw0 = cv_frag(Cv + i * CVS + 768 + ks * 32 + g * 8), fw1 = cv_frag(Cv + i * CVS + 832 + ks * 32 + g * 8);
        const bf16x8 fa0 = cv_frag(Cv + i * CVS + 896 + ks * 32 + g * 8), fa1 = cv_frag(Cv + i * CVS + 960 + ks * 32 + g * 8);
#pragma unroll
        for (int nt = 0; nt < 4; ++nt) {
          aw0[nt] = __builtin_amdgcn_mfma_f32_16x16x32_bf16(fw0, lf[nt * 4 + 0], aw0[nt], 0, 0, 0);
          aw1[nt] = __builtin_amdgcn_mfma_f32_16x16x32_bf16(fw1, lf[nt * 4 + 1], aw1[nt], 0, 0, 0);
          aa0[nt] = __builtin_amdgcn_mfma_f32_16x16x32_bf16(fa0, lf[nt * 4 + 2], aa0[nt], 0, 0, 0);
          aa1[nt] = __builtin_amdgcn_mfma_f32_16x16x32_bf16(fa1, lf[nt * 4 + 3], aa1[nt], 0, 0, 0);
        }
        __builtin_amdgcn_sched_barrier(0);
      }
      if (RPM == 2) {
        float z = 0.f;
#pragma unroll
        for (int nt = 0; nt < 4; ++nt) z += aw0[nt][0] + aw1[nt][1] + aa0[nt][2] + aa1[nt][3];
        if (z == 123.456f) bonbuf(p)[0] = z;
      } else {
      float n2[4], bon[4];
#pragma unroll
      for (int r_ = 0; r_ < 4; ++r_) { n2[r_] = 0.f; bon[r_] = 0.f; }
#pragma unroll
      for (int nt = 0; nt < 4; ++nt) {
        const int c = h * 64 + nt * 16 + i;
        const float kkc = p.rwkv_kk[l * 256 + c];
#pragma unroll
        for (int r_ = 0; r_ < 4; ++r_) { const float kr = Cv[(4 * g + r_) * CVS + 256 + c] * kkc; n2[r_] += kr * kr; }
      }
#pragma unroll
      for (int r_ = 0; r_ < 4; ++r_) n2[r_] = FRSQ(reduce16(n2[r_]) + 1e-6f);
      char* vv0 = img_ptr(p, 0, 0, b, h, tile_cidx(is_ctx, t0, 0)) + IMG_VV;
      char* vv1 = img_ptr(p, 0, 1, b, h, tile_cidx(is_ctx, t0, 1)) + IMG_VV;
#pragma unroll
      for (int nt = 0; nt < 4; ++nt) {
        const int c = h * 64 + nt * 16 + i;
        const float w00 = p.rwkv_w0[(l * 2 + 0) * 256 + c], w01 = p.rwkv_w0[(l * 2 + 1) * 256 + c];
        const float a00 = p.rwkv_a0[(l * 2 + 0) * 256 + c], a01 = p.rwkv_a0[(l * 2 + 1) * 256 + c];
        const float kkc = p.rwkv_kk[l * 256 + c], kac = p.rwkv_ka[l * 256 + c], rkc = p.rwkv_rk[l * 256 + c];
#pragma unroll
        for (int r_ = 0; r_ < 4; ++r_) {
          const int tok = 4 * g + r_;
          const float r = Cv[tok * CVS + c], k = Cv[tok * CVS + 256 + c], v = Cv[tok * CVS + 512 + c];
          const float wd0 = FEXP(-sigmoidf_(w00 + aw0[nt][r_]) * 0.6065306597126334f);
          const float wd1 = FEXP(-sigmoidf_(w01 + aw1[nt][r_]) * 0.6065306597126334f);
          const float ad0 = sigmoidf_(a00 + aa0[nt][r_]), ad1 = sigmoidf_(a01 + aa1[nt][r_]);
          const float kk = k * kkc * n2[r_];
          const float kd0 = k * (1.0f + (ad0 - 1.0f) * kac), kd1 = k * (1.0f + (ad1 - 1.0f) * kac);
          bon[r_] += r * (kd0 + kd1) * rkc;
          ((float*)(vec + VEC_W0))[tok * 256 + c] = wd0; ((float*)(vec + VEC_W1))[tok * 256 + c] = wd1;
          ((bf16_t*)(vec + VEC_KK))[tok * VS + c] = f2bf(kk); ((bf16_t*)(vec + VEC_R))[tok * VS + c] = f2bf(r);
          ((bf16_t*)(vec + VEC_B0))[tok * VS + c] = f2bf(kk * ad0); ((bf16_t*)(vec + VEC_B1))[tok * VS + c] = f2bf(kk * ad1);
          ((bf16_t*)(vec + VEC_KD0))[tok * VS + c] = f2bf(kd0); ((bf16_t*)(vec + VEC_KD1))[tok * VS + c] = f2bf(kd1);
          const bf16_t vb = f2bf(v);
          *(bf16_t*)(vv0 + ((nt * 16 + i) * 16 + tok) * 2) = vb;
          *(bf16_t*)(vv1 + ((nt * 16 + i) * 16 + 15 - tok) * 2) = vb;
          rv16(p)[(size_t)(r0 + tok) * 256 + c] = vb;
        }
      }
#pragma unroll
      for (int r_ = 0; r_ < 4; ++r_) {
        const float bs = reduce16(bon[r_]);
        if (i == 0) bonbuf(p)[(size_t)(r0 + 4 * g + r_) * 4 + h] = bs;
      }
      }
    }
    LDS_BAR();
    if (RPM == 0) chunk_prep_wave(p, 0, b, is_ctx, t0, smem, tid);
    LDS_BAR();
  }
}

template <int PMODE = 0>
__device__ __forceinline__ void chunk_gdprep(const Params& p, int l, char* smem, int wave_s) {
  const int tid0 = make_tid(wave_s);
  char* vec = smem + VEC_OFF;
  const float* cw = p.gdn_conv + (size_t)l * 3 * 768;
  for (int tile = (int)((blockIdx.x + gridDim.x - (NTOK / 16) % gridDim.x) % gridDim.x); tile < NTOK / 16; tile += gridDim.x) {
    int tid = tid0; asm volatile("" : "+v"(tid));
    const int c = tid & 255, lane = tid & 63, h = c >> 6, tg = tid >> 8;
    float w0[3], w1[3], w2[3];
#pragma unroll
    for (int j = 0; j < 3; ++j) { w0[j] = cw[j * 256 + c]; w1[j] = cw[768 + j * 256 + c]; w2[j] = cw[1536 + j * 256 + c]; }
    const float nal0 = -FEXP(p.gdn_a_log[(l * 2 + 0) * 4 + h]), nal1 = -FEXP(p.gdn_a_log[(l * 2 + 1) * 4 + h]);
    const float dtb0 = p.gdn_dt_bias[(l * 2 + 0) * 4 + h], dtb1 = p.gdn_dt_bias[(l * 2 + 1) * 4 + h];
    const int r0 = tile * 16;
    const bool is_ctx = r0 >= NLAT;
    const int b = is_ctx ? (r0 - NLAT) / NCX : r0 / NTL;
    const int t0 = is_ctx ? (r0 - NLAT) % NCX : r0 % NTL;
    char* vv0 = img_ptr(p, 1, 0, b, h, tile_cidx(is_ctx, t0, 0)) + IMG_VV + lane * 32;
    char* vv1 = img_ptr(p, 1, 1, b, h, tile_cidx(is_ctx, t0, 1)) + IMG_VV + lane * 32;
    char* vbf = vec + (tg * 8 * 256 + c) * 4;
    char* vbh = vec + VEC_KK + (tg * 8 * VS + c) * 2;
    asm volatile("" : "+v"(vbf), "+v"(vbh));
    bf16_t* rawP = (bf16_t*)smem;
    constexpr int RPS = 792;
    {
      const int slen = is_ctx ? NCX : NTL;
      uint4 sv[4];
#pragma unroll
      for (int q = 0; q < 4; ++q) {
        const int idx = min(tid + q * NTHREADS, 18 * 98 - 1);
        const int rr = idx / 98, ch = idx - rr * 98;
        const int t = t0 + rr - 1;
        const bool ok = t >= 0 && t < slen;
        sv[q] = *(const uint4*)(p.P() + (size_t)(r0 + (ok ? rr - 1 : 0)) * INC + OFF_C + (ch < 96 ? ch * 8 : 1024 + (ch - 96) * 8));
      }
      __builtin_amdgcn_sched_barrier(0);
#pragma unroll
      for (int q = 0; q < 4; ++q) {
        const int idx = min(tid + q * NTHREADS, 18 * 98 - 1);
        const int rr = idx / 98, ch = idx - rr * 98;
        const int t = t0 + rr - 1;
        const bool ok = t >= 0 && t < slen;
        *(uint4*)(rawP + rr * RPS + ch * 8) = ok ? sv[q] : make_uint4(0u, 0u, 0u, 0u);
      }
    }
    LDS_BAR();
#pragma unroll
    for (int tt = 0; tt < (PMODE >= 2 ? 0 : 8); ++tt) {
      const int tok = tg * 8 + tt;
      const bf16_t* rp = rawP + (tok + 1) * RPS;
      float qkv[3];
#pragma unroll
      for (int j = 0; j < 3; ++j)
        qkv[j] = siluf_(bf2f(rp[-RPS + j * 256 + c]) * w0[j] + bf2f(rp[j * 256 + c]) * w1[j] + bf2f(rp[RPS + j * 256 + c]) * w2[j]);
      const float ab0 = bf2f(rp[768 + 0 * 4 + h]), ab1 = bf2f(rp[768 + 1 * 4 + h]), ab2 = bf2f(rp[768 + 8 + 0 * 4 + h]), ab3 = bf2f(rp[768 + 8 + 1 * 4 + h]);
      const float qn = qkv[0] * FRSQ(wsum(qkv[0] * qkv[0]) + 1e-6f) * 0.125f;
      const float kn = qkv[1] * FRSQ(wsum(qkv[1] * qkv[1]) + 1e-6f);
      const float eg0 = FEXP(nal0 * softplusf_(ab0 + dtb0)), eg1 = FEXP(nal1 * softplusf_(ab1 + dtb1));
      const float be0 = sigmoidf_(ab2), be1 = sigmoidf_(ab3);
      *(float*)(vbf + VEC_W0 + tt * 1024) = eg0; *(float*)(vbf + VEC_W1 + tt * 1024) = eg1;
      *(bf16_t*)(vbh + tt * (VS * 2)) = f2bf(kn); *(bf16_t*)(vbh + (VEC_R - VEC_KK) + tt * (VS * 2)) = f2bf(qn);
      *(bf16_t*)(vbh + (VEC_B0 - VEC_KK) + tt * (VS * 2)) = f2bf(be0 * eg0 * kn); *(bf16_t*)(vbh + (VEC_B1 - VEC_KK) + tt * (VS * 2)) = f2bf(be1 * eg1 * kn);
      *(bf16_t*)(vbh + (VEC_KD0 - VEC_KK) + tt * (VS * 2)) = f2bf(be0 * kn); *(bf16_t*)(vbh + (VEC_KD1 - VEC_KK) + tt * (VS * 2)) = f2bf(be1 * kn);
      const bf16_t vb = f2bf(qkv[2]);
      *(bf16_t*)(vv0 + tok * 2) = vb;
      *(bf16_t*)(vv1 + (15 - tok) * 2) = vb;
    }
    LDS_BAR();
    if (PMODE != 1) chunk_prep_wave(p, 1, b, is_ctx, t0, smem, tid);
    LDS_BAR();
  }
}

constexpr int SGRP = 4;
constexpr int SGRP_BYTES = SGRP * IMG_BYTES;
__device__ __forceinline__ void cs_group(const Params& p, bool last, const char* buf, int gi, f32x4 (&Sd)[4],
                                         int mixer, int d, int b, int h, int lane, int rho0) {
  const int i = lane & 15, g = lane >> 4, sw = i & 7;
#pragma unroll
    for (int cc = 0; cc < SGRP; ++cc) {
      const char* im = buf + cc * IMG_BYTES;
      const int cidx = gi * SGRP + cc;
      const bf16x8 bs0 = pack_p8(Sd[0], Sd[1]), bs1 = pack_p8(Sd[2], Sd[3]);
      const bf16x8 kk0 = *(const bf16x8*)(im + IMG_KK + i * 128 + (((0 + g) ^ sw) << 4));
      const bf16x8 kk1 = *(const bf16x8*)(im + IMG_KK + i * 128 + (((4 + g) ^ sw) << 4));
      const bf16x8 rt0 = *(const bf16x8*)(im + IMG_RT + i * 128 + (((0 + g) ^ sw) << 4));
      const bf16x8 rt1 = *(const bf16x8*)(im + IMG_RT + i * 128 + (((4 + g) ^ sw) << 4));
      const bf16x8 tm = *(const bf16x8*)(im + IMG_TR + i * 128 + (((0 + g) ^ sw) << 4));
      const bf16x8 rb = *(const bf16x8*)(im + IMG_TR + i * 128 + (((4 + g) ^ sw) << 4));
      const uint2 vraw = *(const uint2*)(im + IMG_VV + ((rho0 + i) * 16 + 4 * g) * 2);
      f32x4 zt = __builtin_amdgcn_mfma_f32_16x16x32_bf16(kk0, bs0, f32x4{0.f, 0.f, 0.f, 0.f}, 0, 0, 0);
      zt = __builtin_amdgcn_mfma_f32_16x16x32_bf16(kk1, bs1, zt, 0, 0, 0);
      f32x4 yt = __builtin_amdgcn_mfma_f32_16x16x32_bf16(rt0, bs0, f32x4{0.f, 0.f, 0.f, 0.f}, 0, 0, 0);
      yt = __builtin_amdgcn_mfma_f32_16x16x32_bf16(rt1, bs1, yt, 0, 0, 0);
      uint4 zv; zv.x = pk_bf16(zt[0], zt[1]); zv.y = pk_bf16(zt[2], zt[3]); zv.z = vraw.x; zv.w = vraw.y;
      f32x4 pt = __builtin_amdgcn_mfma_f32_16x16x32_bf16(tm, __builtin_bit_cast(bf16x8, zv), f32x4{0.f, 0.f, 0.f, 0.f}, 0, 0, 0);
      uint4 pv; pv.x = pk_bf16(-pt[0], -pt[1]); pv.y = pk_bf16(-pt[2], -pt[3]); pv.z = vraw.x; pv.w = vraw.y;
      const bf16x8 pvf = __builtin_bit_cast(bf16x8, pv);
      yt = __builtin_amdgcn_mfma_f32_16x16x32_bf16(rb, pvf, yt, 0, 0, 0);
#pragma unroll
      for (int m = 0; m < 4; ++m) {
        const int row = (16 * m + i) & 31, ch = (m >> 1) * 4 + g;
        const bf16x8 bk = *(const bf16x8*)(im + IMG_BK + row * 128 + ((ch ^ (row & 7)) << 4));
        const float4 wl = *(const float4*)(im + IMG_WL + (16 * m + 4 * g) * 4);
        f32x4 cin = Sd[m];
        cin[0] *= wl.x; cin[1] *= wl.y; cin[2] *= wl.z; cin[3] *= wl.w;
        Sd[m] = __builtin_amdgcn_mfma_f32_16x16x32_bf16(bk, pvf, cin, 0, 0, 0);
      }
      const bool is_ctx = cidx < NCX / 16;
      {
        const int j = is_ctx ? cidx : cidx - NCX / 16;
        const int tile = d == 0 ? j : (is_ctx ? NCX / 16 : NTL / 16) - 1 - j;
        const int rbase = (is_ctx ? NLAT + b * NCX : b * NTL) + tile * 16;
#pragma unroll
        for (int r_ = 0; r_ < 4; ++r_) {
          const int s_ = 4 * g + r_, tok = d ? 15 - s_ : s_;
          p.YS()[(size_t)(rbase + tok) * 1024 + mixer * 512 + d * 256 + h * 64 + rho0 + i] = f2bf(yt[r_]);
        }
      }
    }
}
__device__ __forceinline__ void chunk_scan(const Params& p, bool last, int task, char* smem, int tid) {
  const int mixer = task / (2 * NB * 4), rem = task % (2 * NB * 4);
  const int d = rem / (NB * 4), b = (rem / 4) % NB, h = rem % 4;
  const char* gimg = img_ptr(p, mixer, d, b, h, 0);
  const int lane = tid & 63, w = tid >> 6;
  const int rho0 = (w & 3) * 16;
  const bool computes = __builtin_amdgcn_readfirstlane(tid >> 6) < 4;
  f32x4 Sd[4];
#pragma unroll
  for (int m = 0; m < 4; ++m) Sd[m] = f32x4{0.f, 0.f, 0.f, 0.f};
  uint4 sa0, sa1, sa2, sa3, sa4, sa5, sa6, sb0, sb1, sb2, sb3, sb4, sb5, sb6;
  const int ngrp = NCHK / SGRP;
#define CS_PC(q) min(tid + (q) * NTHREADS, SGRP_BYTES / 16 - 1)
#define CS_LD1(gi, q, dst) dst = *(const uint4*)(gimg + (size_t)min((gi), ngrp - 1) * SGRP_BYTES + CS_PC(q) * 16);
#define CS_ST1(bi, q, srcv) *(uint4*)(smem + (bi) * SGRP_BYTES + CS_PC(q) * 16) = srcv;
#define CS_LOAD(gi, s_) { CS_LD1(gi, 0, s_##0) CS_LD1(gi, 1, s_##1) CS_LD1(gi, 2, s_##2) CS_LD1(gi, 3, s_##3) CS_LD1(gi, 4, s_##4) CS_LD1(gi, 5, s_##5) CS_LD1(gi, 6, s_##6) }
#define CS_STORE(bi, s_) { CS_ST1(bi, 0, s_##0) CS_ST1(bi, 1, s_##1) CS_ST1(bi, 2, s_##2) CS_ST1(bi, 3, s_##3) CS_ST1(bi, 4, s_##4) CS_ST1(bi, 5, s_##5) CS_ST1(bi, 6, s_##6) }
#define CS_BAR() { asm volatile("s_waitcnt lgkmcnt(0)" ::: "memory"); __builtin_amdgcn_s_barrier(); asm volatile("" ::: "memory"); }
#define CS_LOOP(COMPUTE_) { \
    CS_LOAD(0, sa); CS_LOAD(1, sb); CS_STORE(0, sa); CS_BAR(); \
    for (int gi = 0; gi < ngrp; gi += 2) { \
      CS_LOAD(gi + 2, sa); __builtin_amdgcn_sched_barrier(0); \
      COMPUTE_(gi) \
      __builtin_amdgcn_sched_barrier(0); CS_STORE((gi + 1) % 3, sb); CS_BAR(); \
      CS_LOAD(gi + 3, sb); __builtin_amdgcn_sched_barrier(0); \
      COMPUTE_(gi + 1) \
      __builtin_amdgcn_sched_barrier(0); CS_STORE((gi + 2) % 3, sa); CS_BAR(); \
    } }
#define CS_DO(g_) cs_group(p, last, smem + ((g_) % 3) * SGRP_BYTES, (g_), Sd, mixer, d, b, h, lane, rho0);
#define CS_SKIP(g_)
  static_assert((NCHK / SGRP) % 2 == 0, "group loop is unrolled by two");
  if (computes) CS_LOOP(CS_DO) else CS_LOOP(CS_SKIP)
#undef CS_LOOP
#undef CS_DO
#undef CS_SKIP
#undef CS_PC
#undef CS_LOAD
#undef CS_STORE
#undef CS_LD1
#undef CS_ST1
#undef CS_BAR
}

__device__ __forceinline__ void chunk_post(const Params& p, int l, int nr, int wave_s) {
  for (int row = blockIdx.x * 8 + wave_s; row < nr; row += gridDim.x * 8) {
    const int lane = make_tid(wave_s) & 63;
    const int c0 = lane * 4, h = lane >> 4;
    const bf16_t* ys = p.YS() + (size_t)row * 1024;
    bf16_t* yo = p.Y() + (size_t)row * DM;
    {
      const float4 y0 = ld4(ys + c0), y1 = ld4(ys + 256 + c0);
      const float4 gq = ld4(p.G16() + (size_t)row * 256 + c0), vq = ld4(rv16(p) + (size_t)row * 256 + c0);
      const float4 lg = *(const float4*)(p.rwkv_ln_g + l * 256 + c0), lb = *(const float4*)(p.rwkv_ln_b + l * 256 + c0);
      const float bon = bonbuf(p)[(size_t)row * 4 + h];
      float y[4] = {y0.x + y1.x, y0.y + y1.y, y0.z + y1.z, y0.w + y1.w};
      const float m = reduce16((y[0] + y[1]) + (y[2] + y[3])) * (1.0f / 64);
      float dd[4] = {y[0] - m, y[1] - m, y[2] - m, y[3] - m};
      const float rstd = 1.0f / sqrtf(reduce16((dd[0] * dd[0] + dd[1] * dd[1]) + (dd[2] * dd[2] + dd[3] * dd[3])) * (1.0f / 64) + 64e-5f);
      uint2 o;
      o.x = pk_bf16((dd[0] * rstd * lg.x + lb.x + bon * vq.x) * gq.x, (dd[1] * rstd * lg.y + lb.y + bon * vq.y) * gq.y);
      o.y = pk_bf16((dd[2] * rstd * lg.z + lb.z + bon * vq.z) * gq.z, (dd[3] * rstd * lg.w + lb.w + bon * vq.w) * gq.w);
      *(uint2*)(yo + 256 + c0) = o;
    }
    {
      const float4 o0 = ld4(ys + 512 + c0), o1 = ld4(ys + 768 + c0);
      const float4 gt = ld4(p.P() + (size_t)row * INC + OFF_C + 768 + c0);
      const float4 ng = *(const float4*)(p.gdn_norm_g + l * 64 + (c0 & 63));
      float o[4] = {o0.x + o1.x, o0.y + o1.y, o0.z + o1.z, o0.w + o1.w};
      const float rs = 1.0f / sqrtf(reduce16((o[0] * o[0] + o[1] * o[1]) + (o[2] * o[2] + o[3] * o[3])) * (1.0f / 64) + 1e-6f);
      uint2 r;
      r.x = pk_bf16(o[0] * rs * ng.x * siluf_(gt.x), o[1] * rs * ng.y * siluf_(gt.y));
      r.y = pk_bf16(o[2] * rs * ng.z * siluf_(gt.z), o[3] * rs * ng.w * siluf_(gt.w));
      *(uint2*)(yo + 512 + c0) = r;
    }
  }
}

template <int MMODE = 0>
__device__ __forceinline__ void fast_mixers(const Params& p, int l, char* smem, int wave_s) {
  const int np = 2 * (2 * NB * 4);
  const int nb = gridDim.x;
  if (MMODE != 2) {
    for (int t = blockIdx.x; t < np; t += nb) { int tid = make_tid(wave_s); chunk_scan(p, l == 1, t, smem, tid); }
  }
  if (MMODE != 1) {
    const int nA = NB * 4 * (NTL / 256) + (l == 0 ? NB * 4 * (NCX / 256) : 0);
    const int nD = (NB * 4 * GROWS + (l == 0 ? NB * 4 * (NCX / 64) : 0)) / 2;
    const int nA_full = min(nA, max(nb - np, 0));
    const int nA_q = nA_full + 2 * (nA - nA_full);
    unsigned* ctr = p.bar() + 16 + 16 * l + (MMODE == 2 ? 8 : 0);
    volatile __attribute__((address_space(3))) int* slot = (volatile __attribute__((address_space(3))) int*)(smem + 160256 + 8);
    for (;;) {
      LDS_BAR();
      if (make_tid(wave_s) == 0) *slot = (int)xb_add(ctr, 1u);
      LDS_BAR();
      const int t = __builtin_amdgcn_readfirstlane(*slot);
      if (t >= nA_q + nD) break;
      const int tid = make_tid(wave_s);
      if (t < nA_full) attnA_task<2>(p, l, t, 0, smem, tid);
      else if (t < nA_q) attnA_task<1>(p, l, nA_full + ((t - nA_full) >> 1), (t - nA_full) & 1, smem, tid);
      else attnD_pair(p, l, t - nA_q, smem, tid);
    }
  }
}

template <int PH>
__device__ __forceinline__ void run_phase(const Params& p, int l) {
  long n = phase_items(PH, l);
  int tid = threadIdx.x;
  long gtid = (long)(blockIdx.x * NTHREADS + tid);
  long nth = (long)(gridDim.x * NTHREADS);
  for (long i = gtid; i < n; i += nth) phase_item<PH>(p, l, i);
}

#define ITEM_LOOP(n_, ...)                                            \
  {                                                                  \
    int tid_ = threadIdx.x;                                          \
    asm volatile("" : "+v"(tid_));                                   \
    long nth_ = (long)(gridDim.x * NTHREADS);                        \
    for (long i = (long)(blockIdx.x * NTHREADS + tid_); i < (n_); i += nth_) __VA_ARGS__ \
  }
#if MEGA == 1
__global__ void __launch_bounds__(NTHREADS) fwd_megakernel(Params p) {
  __shared__ __attribute__((aligned(16))) char smem[160256 + 16];
#define xb_words (*(uint4*)(smem + 160256))
  cg::grid_group grid = cg::this_grid();
  const int wave_s = __builtin_amdgcn_readfirstlane((int)(threadIdx.x >> 6));
  if (threadIdx.x == 0) xb_words = make_uint4(0u, 0u, 0u, 0u);
  __syncthreads();
  (void)xcd_barrier_post(p.bar(), (volatile LAS unsigned*)&xb_words);
#define GSYNC() { XcdBarrier xb_; xb_.bar = p.bar(); xb_.x = xb_xcc_id(); xb_.st = (volatile LAS unsigned*)&xb_words; xcd_barrier(xb_, wave_s); }
  fast_ada(p, smem, wave_s);
  conv_lora(p, wave_s);
  conv_weights(p, smem, wave_s);
  conv_tables(p, 0, wave_s);
#if PROBE_DUP & 16384
  conv_tables(p, 0, wave_s);
#endif
#if PROBE_DUP & 32768
  conv_weights(p, smem, wave_s);
  fast_ada(p, smem, wave_s);
#endif
  grid.sync();
  fast_ln1(p, 0, wave_s); GSYNC();
  for (int l = 0; l < 2; ++l) {
    const int nr = rows_out(l);
    if (l == 1) conv_tables(p, 1, wave_s);
    gemm_phase_8ph(p.Y(), wbt_in(p, l), INC, p.P(), INC, NTOK, smem, wave_s); GSYNC();
#if PROBE_DUP & 1
    gemm_phase<256>(p.Y(), DM, wbt_in(p, l), INC, p.P(), INC, NTOK, smem, wave_s); GSYNC();
#endif
    fast_attprep(p, smem, wave_s);
    chunk_rwprep(p, l, smem, wave_s);
    chunk_gdprep(p, l, smem, wave_s);
#if PROBE_DUP & 32
    chunk_rwprep<1>(p, l, smem, wave_s);
#endif
#if PROBE_DUP & 524288
    chunk_rwprep<2>(p, l, smem, wave_s);
#endif
#if PROBE_DUP & 64
    chunk_gdprep(p, l, smem, wave_s);
#endif
#if PROBE_DUP & 128
    chunk_gdprep<1>(p, l, smem, wave_s);
#endif
#if PROBE_DUP & 256
    chunk_gdprep<2>(p, l, smem, wave_s);
#endif
#if PROBE_DUP & 512
    chunk_gdprep<3>(p, l, smem, wave_s);
#endif
    GSYNC();
    fast_mixers(p, l, smem, wave_s); GSYNC();
#if PROBE_DUP & 2
    fast_mixers(p, l, smem, wave_s); GSYNC();
#endif
#if PROBE_DUP & 1024
    fast_mixers<1>(p, l, smem, wave_s); GSYNC();
#endif
#if PROBE_DUP & 2048
    fast_mixers<2>(p, l, smem, wave_s); GSYNC();
#endif
    chunk_post(p, l, nr, wave_s); GSYNC();
#if PROBE_DUP & 4096
    chunk_post(p, l, nr, wave_s); GSYNC();
#endif
#if PROBE_DUP & 8192
    GSYNC(); GSYNC(); GSYNC(); GSYNC();
#endif
    gemm_phase_8ph(p.Y(), wbt_out(p, l), DM, (bf16_t*)p.RW(), DM, NLAT, smem, wave_s);
    if (nr > NLAT) gemm_phase<128>(p.Y() + (size_t)NLAT * DM, DM, wbt_out(p, l), DM, (bf16_t*)p.RW() + (size_t)NLAT * DM, DM, nr - NLAT, smem, wave_s);
    GSYNC();
    fast_pn1(p, l, nr, wave_s); GSYNC();
    gemm_phase_8ph(p.Y(), wbt_q(p, l), 2048, peerQ(p), 2048, NLAT, smem, wave_s);
    if (nr > NLAT) gemm_phase<128>(p.Y() + (size_t)NLAT * DM, DM, wbt_q(p, l), 2048, peerQ(p) + (size_t)NLAT * 2048, 2048, nr - NLAT, smem, wave_s);
    GSYNC();
#if PROBE_DUP & 8
    gemm_phase<128>(p.Y(), DM, wbt_q(p, l), 2048, peerQ(p), 2048, nr, smem, wave_s); GSYNC();
#endif
    select_phase(p, l, nr, smem, wave_s); GSYNC();
#if PROBE_DUP & 16
    select_phase(p, l, nr, smem, wave_s); GSYNC();
#endif
    expert_u_phase(p, l, nr, wave_s, smem); GSYNC();
#if PROBE_DUP & 65536
    expert_u_phase(p, l, nr, wave_s, smem); GSYNC();
#endif
    expert_v_sliced(p, l, nr, wave_s); GSYNC();
    ffn_tail_phase(p, l, nr, wave_s);
    if (l == 0) GSYNC();
  }
}
#elif MEGA == 0
template <int PH>
__global__ void __launch_bounds__(256) phase_kernel(Params p, int l) {
  run_phase<PH>(p, l);
}
template <int PH>
static void launch_phase(const Params& p, int l, hipStream_t stream) {
  long n = phase_items(PH, l);
  if (n <= 0) return;
  long blocks = (n + 255) / 256;
  if (blocks > 8192) blocks = 8192;
  hipLaunchKernelGGL(phase_kernel<PH>, dim3((unsigned)blocks), dim3(256), 0, stream, p, l);
}
#endif

extern "C" void kernel_launch(void* const* d_in, const int* in_sizes, int n_in, void* d_out, int out_size, void* d_ws,
                              size_t ws_size, hipStream_t stream) {
  Params p{};
  const float** pin = (const float**)&p;
  for (int i = 0; i < 34; ++i) pin[i] = (const float*)d_in[i];
  p.out = (float*)d_out;
  if (ws_size < WS_END) return;
  p.ws = (char*)d_ws;
#if MEGA == 1
  static int grid_blocks = 0;
  if (!grid_blocks) {
    int dev = 0, cus = 0, per_cu = 0;
    hipGetDevice(&dev);
    hipDeviceGetAttribute(&cus, hipDeviceAttributeMultiprocessorCount, dev);
    hipOccupancyMaxActiveBlocksPerMultiprocessor(&per_cu, fwd_megakernel, NTHREADS, 0);
    if (per_cu > 1) per_cu = 1;
    grid_blocks = cus * per_cu;
  }
  (void)hipMemsetAsync(p.bar(), 0, WS_BAR_BYTES, stream);
  void* args[] = {&p};
  (void)hipLaunchCooperativeKernel((void*)fwd_megakernel, dim3(grid_blocks), dim3(NTHREADS), args, 0, stream);
#elif MEGA == 0
  launch_phase<PH_ADA>(p, 0, stream);
  for (int l = 0; l < 2; ++l) {
    launch_phase<PH_LN1>(p, l, stream);
    launch_phase<PH_GEMM_IN>(p, l, stream);
    launch_phase<PH_ROPE>(p, l, stream);
    launch_phase<PH_MIX>(p, l, stream);
    launch_phase<PH_GDPREP>(p, l, stream);
    launch_phase<PH_SCAN>(p, l, stream);
    launch_phase<PH_POST>(p, l, stream);
    launch_phase<PH_GEMM_OUT>(p, l, stream);
    launch_phase<PH_PN1>(p, l, stream);
    launch_phase<PH_GEMM_Q>(p, l, stream);
    launch_phase<PH_TOPK1>(p, l, stream);
    launch_phase<PH_TOPK2>(p, l, stream);
    launch_phase<PH_ACT>(p, l, stream);
    launch_phase<PH_FFN>(p, l, stream);
    launch_phase<PH_PN2>(p, l, stream);
  }
#endif
}
#endif
```
